# Optimizing an MI355X kernel written in HIP

```python
import math
import jax, jax.numpy as jnp
from jax import lax
import numpy as np

D_MODEL = 1024
BATCH = 16
SEQ = 4096
DEPTH = 1

EPS = 1e-6
ROPE_BASE = 10000.0
Q_BLOCK = 128
POOL_WINDOWS = (2, 4, 8, 16)
N_POOL_GROUPS = 4
POOL_GROUP_DIM = 128
POOL_W = N_POOL_GROUPS * POOL_GROUP_DIM
MLA_HEADS = 8
QK_NOPE = 64
QK_ROPE = 32
QK_HEAD = QK_NOPE + QK_ROPE
V_HEAD = 64
Q_LORA = 384
KV_LORA = 256
MLA_W = MLA_HEADS * V_HEAD
MEM_LEN = 256
CROSS_HEADS = 4
CROSS_HEAD_DIM = 128
CROSS_W = CROSS_HEADS * CROSS_HEAD_DIM
N_BRANCHES = 3
OFF_POOL = 0
OFF_QL = OFF_POOL + POOL_W
OFF_KVL = OFF_QL + Q_LORA
OFF_KPE = OFF_KVL + KV_LORA
OFF_XQ = OFF_KPE + QK_ROPE
OFF_GATE = OFF_XQ + CROSS_W
IN_COLS = OFF_GATE + N_BRANCHES * D_MODEL
N_EXPERTS = 32
TOP_K = 4
D_FF = D_MODEL
SWIGLU_LIMIT = 7.0
SWIGLU_ALPHA = 1.702
EXPERT_BLOCK = 512

kernel_name = "hybrid_pool_mla_xattn_moe_block"


def rms_norm(x, g):
    xf = x.astype(jnp.float32)
    y = xf * lax.rsqrt(jnp.mean(xf * xf, axis=-1, keepdims=True) + EPS)
    return (y * g.astype(jnp.float32)).astype(x.dtype)


def rope(x, positions):
    half = x.shape[-1] // 2
    inv = ROPE_BASE ** (-jnp.arange(half, dtype=jnp.float32) / half)
    ang = positions.astype(jnp.float32)[..., None] * inv
    cos = jnp.cos(ang)[:, :, None, :]
    sin = jnp.sin(ang)[:, :, None, :]
    xf = x.astype(jnp.float32)
    x1, x2 = xf[..., :half], xf[..., half:]
    out = jnp.concatenate([x1 * cos - x2 * sin, x2 * cos + x1 * sin], axis=-1)
    return out.astype(x.dtype)


def multiscale_pool(u, w_pool, pool_scale):
    B, S, _ = u.shape
    ug = u.reshape(B, S, N_POOL_GROUPS, POOL_GROUP_DIM).astype(jnp.float32)
    cs = jnp.cumsum(ug, axis=1)
    cs = jnp.concatenate([jnp.zeros_like(cs[:, :1]), cs], axis=1)
    win = jnp.array(POOL_WINDOWS, dtype=jnp.int32)
    t = jnp.arange(S, dtype=jnp.int32)
    lower = jnp.maximum(t[:, None] + 1 - win[None, :], 0)
    cnt = jnp.minimum(t[:, None] + 1, win[None, :]).astype(jnp.float32)
    cs_low = cs[:, lower, jnp.arange(N_POOL_GROUPS)[None, :], :]
    mean = (cs[:, 1:] - cs_low) / cnt[None, :, :, None]
    mixed = (mean - ug).astype(u.dtype)
    y = jnp.einsum('bsgc,gcd->bsgd', mixed, w_pool) * pool_scale
    return y.reshape(B, S, POOL_W)


def causal_block_attention(q, k, v, scale):
    B, S, H, Dk = q.shape
    nb = S // Q_BLOCK
    qb = q.reshape(B, nb, Q_BLOCK, H, Dk).transpose(1, 0, 2, 3, 4)
    kpos = jnp.arange(S)

    def one_block(args):
        qi, i = args
        s = jnp.einsum('bqhd,bkhd->bhqk', qi, k).astype(jnp.float32) * scale
        qpos = i * Q_BLOCK + jnp.arange(Q_BLOCK)
        mask = kpos[None, :] <= qpos[:, None]
        s = jnp.where(mask[None, None], s, -jnp.inf)
        p = jax.nn.softmax(s, axis=-1).astype(v.dtype)
        return jnp.einsum('bhqk,bkhd->bqhd', p, v)

    o = lax.map(one_block, (qb, jnp.arange(nb)))
    return o.transpose(1, 0, 2, 3, 4).reshape(B, S, H, v.shape[-1])


def mla_branch(c_q, c_kv, k_pe, positions, g_q_lora, w_uq, g_kv_lora, w_ukv, g_q_mla, g_k_mla):
    B, S, _ = c_q.shape
    q = (rms_norm(c_q, g_q_lora) @ w_uq).reshape(B, S, MLA_HEADS, QK_HEAD)
    kv = (rms_norm(c_kv, g_kv_lora) @ w_ukv).reshape(B, S, MLA_HEADS, QK_NOPE + V_HEAD)
    k_nope, v = kv[..., :QK_NOPE], kv[..., QK_NOPE:]
    k_pe_h = jnp.broadcast_to(k_pe[:, :, None, :], (B, S, MLA_HEADS, QK_ROPE))
    k = jnp.concatenate([k_nope, k_pe_h], axis=-1)
    q = rms_norm(q, g_q_mla)
    k = rms_norm(k, g_k_mla)
    q = jnp.concatenate([q[..., :QK_NOPE], rope(q[..., QK_NOPE:], positions)], axis=-1)
    k = jnp.concatenate([k[..., :QK_NOPE], rope(k[..., QK_NOPE:], positions)], axis=-1)
    o = causal_block_attention(q, k, v, QK_HEAD ** -0.5)
    return o.reshape(B, S, MLA_W)


def cross_branch(q_in, mem, g_mem_norm, w_mem_kv, g_q_cross, g_k_cross):
    B, S, _ = q_in.shape
    M = mem.shape[1]
    q = rms_norm(q_in.reshape(B, S, CROSS_HEADS, CROSS_HEAD_DIM), g_q_cross)
    kv = (rms_norm(mem, g_mem_norm) @ w_mem_kv).reshape(B, M, 2, CROSS_HEADS, CROSS_HEAD_DIM)
    k = rms_norm(kv[:, :, 0], g_k_cross)
    v = kv[:, :, 1]
    s = jnp.einsum('bshd,bmhd->bhsm', q, k).astype(jnp.float32) * (CROSS_HEAD_DIM ** -0.5)
    p = jax.nn.softmax(s, axis=-1).astype(v.dtype)
    o = jnp.einsum('bhsm,bmhd->bshd', p, v)
    return o.reshape(B, S, CROSS_W)


def moe_ffn(h, w_router, b_router, w_exp_in, b_exp_in, w_exp_out, b_exp_out):
    B, S, D = h.shape
    t = h.reshape(-1, D)
    T = t.shape[0]
    N = T * TOP_K
    R = EXPERT_BLOCK
    NB = (N + N_EXPERTS * (R - 1) + R - 1) // R
    logits = (t @ w_router + b_router).astype(jnp.float32)
    top_val, top_idx = lax.top_k(logits, TOP_K)
    gate = jax.nn.softmax(top_val, axis=-1)
    flat_e = top_idx.reshape(-1).astype(jnp.int32)
    order = jnp.argsort(flat_e)
    sorted_e = flat_e[order]
    counts = jnp.bincount(flat_e, length=N_EXPERTS).astype(jnp.int32)
    starts = jnp.cumsum(counts) - counts
    padded = (counts + R - 1) // R * R
    pend = jnp.cumsum(padded)
    pstart = pend - padded
    dest_sorted = (pstart[sorted_e] + jnp.arange(N, dtype=jnp.int32) - starts[sorted_e]).astype(jnp.int32)
    dest = jnp.zeros((N,), jnp.int32).at[order].set(dest_sorted)
    buf_tok = jnp.zeros((NB * R,), jnp.int32).at[dest].set(jnp.arange(N, dtype=jnp.int32) // TOP_K)
    block_e = jnp.minimum(jnp.searchsorted(pend, jnp.arange(NB, dtype=jnp.int32) * R, side='right'),
                          N_EXPERTS - 1).astype(jnp.int32)

    def expert_block(args):
        rows, e = args
        xin = t[rows]
        hm = xin @ w_exp_in[e] + b_exp_in[e]
        glu, lin = hm[:, :D_FF], hm[:, D_FF:]
        glu = jnp.minimum(glu, SWIGLU_LIMIT)
        lin = jnp.clip(lin, -SWIGLU_LIMIT, SWIGLU_LIMIT)
        act = glu * jax.nn.sigmoid(SWIGLU_ALPHA * glu) * (lin + 1)
        return act @ w_exp_out[e] + b_exp_out[e]

    out_buf = lax.map(expert_block, (buf_tok.reshape(NB, R), block_e)).reshape(NB * R, D)
    picked = out_buf[dest].reshape(T, TOP_K, D)
    y = jnp.einsum('tk,tkd->td', gate.astype(picked.dtype), picked)
    return y.reshape(B, S, D)


def setup_inputs(seed: int = 0) -> dict:
    key = jax.random.key(seed)
    ks = jax.random.split(key, 32)
    f32 = jnp.float32

    def w(k, shape, fan_in):
        return jax.random.normal(k, shape, f32) * (fan_in ** -0.5)

    def gain(k, shape):
        return 1.0 + 0.05 * jax.random.normal(k, shape, f32)

    offs = jax.random.randint(ks[2], (BATCH, 1), 0, 1024, dtype=jnp.int32)
    positions = offs + jnp.arange(SEQ, dtype=jnp.int32)[None, :]
    return {
        "x": jax.random.normal(ks[0], (BATCH, SEQ, D_MODEL), f32),
        "mem": jax.random.normal(ks[1], (BATCH, MEM_LEN, D_MODEL), f32),
        "positions": positions,
        "g_attn_norm": gain(ks[3], (D_MODEL,)),
        "w_in": w(ks[4], (D_MODEL, IN_COLS), D_MODEL),
        "w_pool": w(ks[5], (N_POOL_GROUPS, POOL_GROUP_DIM, POOL_GROUP_DIM), POOL_GROUP_DIM),
        "pool_scale": 1.0 + 0.1 * jax.random.normal(ks[6], (N_POOL_GROUPS, POOL_GROUP_DIM), f32),
        "g_q_lora": gain(ks[7], (Q_LORA,)),
        "w_uq": w(ks[8], (Q_LORA, MLA_HEADS * QK_HEAD), Q_LORA),
        "g_kv_lora": gain(ks[9], (KV_LORA,)),
        "w_ukv": w(ks[10], (KV_LORA, MLA_HEADS * (QK_NOPE + V_HEAD)), KV_LORA),
        "g_q_mla": gain(ks[11], (QK_HEAD,)),
        "g_k_mla": gain(ks[12], (QK_HEAD,)),
        "g_mem_norm": gain(ks[13], (D_MODEL,)),
        "w_mem_kv": w(ks[14], (D_MODEL, 2 * CROSS_W), D_MODEL),
        "g_q_cross": gain(ks[15], (CROSS_HEAD_DIM,)),
        "g_k_cross": gain(ks[16], (CROSS_HEAD_DIM,)),
        "w_pool_out": w(ks[17], (POOL_W, D_MODEL), POOL_W),
        "w_mla_out": w(ks[18], (MLA_W, D_MODEL), MLA_W),
        "w_cross_out": w(ks[19], (CROSS_W, D_MODEL), CROSS_W),
        "w_o": w(ks[20], (D_MODEL, D_MODEL), D_MODEL),
        "g_ffn_norm": gain(ks[21], (D_MODEL,)),
        "w_router": w(ks[22], (D_MODEL, N_EXPERTS), D_MODEL),
        "b_router": 0.01 * jax.random.normal(ks[23], (N_EXPERTS,), f32),
        "w_exp_in": w(ks[24], (N_EXPERTS, D_MODEL, 2 * D_FF), D_MODEL),
        "b_exp_in": 0.01 * jax.random.normal(ks[25], (N_EXPERTS, 2 * D_FF), f32),
        "w_exp_out": w(ks[26], (N_EXPERTS, D_FF, D_MODEL), D_FF),
        "b_exp_out": 0.01 * jax.random.normal(ks[27], (N_EXPERTS, D_MODEL), f32),
    }


def reference(x, mem, positions, g_attn_norm, w_in, w_pool, pool_scale, g_q_lora, w_uq, g_kv_lora,
              w_ukv, g_q_mla, g_k_mla, g_mem_norm, w_mem_kv, g_q_cross, g_k_cross, w_pool_out,
              w_mla_out, w_cross_out, w_o, g_ffn_norm, w_router, b_router, w_exp_in, b_exp_in,
              w_exp_out, b_exp_out):
    for _ in range(DEPTH):
        h = rms_norm(x, g_attn_norm)
        z = h @ w_in
        u_pool = z[..., OFF_POOL:OFF_QL]
        c_q = z[..., OFF_QL:OFF_KVL]
        c_kv = z[..., OFF_KVL:OFF_KPE]
        k_pe = z[..., OFF_KPE:OFF_XQ]
        q_x = z[..., OFF_XQ:OFF_GATE]
        gates = jax.nn.sigmoid(z[..., OFF_GATE:].astype(jnp.float32)).astype(x.dtype)
        g_pool = gates[..., :D_MODEL]
        g_mla = gates[..., D_MODEL:2 * D_MODEL]
        g_cross = gates[..., 2 * D_MODEL:]

        y_pool = multiscale_pool(u_pool, w_pool, pool_scale) @ w_pool_out
        y_mla = mla_branch(c_q, c_kv, k_pe, positions, g_q_lora, w_uq, g_kv_lora, w_ukv,
                           g_q_mla, g_k_mla) @ w_mla_out
        y_cross = cross_branch(q_x, mem, g_mem_norm, w_mem_kv, g_q_cross, g_k_cross) @ w_cross_out

        merged = g_pool * y_pool + g_mla * y_mla + g_cross * y_cross
        x = x + merged @ w_o
        x = x + moe_ffn(rms_norm(x, g_ffn_norm), w_router, b_router, w_exp_in, b_exp_in,
                        w_exp_out, b_exp_out)
    return x
```

```cpp
#include <hip/hip_runtime.h>
#include <hip/hip_bf16.h>
#include <cstdio>
#include <cstdint>

#ifndef MK_N_LAUNCHES
#define MK_N_LAUNCHES 1
#endif
#ifndef MK_LAST_PHASE
#define MK_LAST_PHASE 11
#endif

namespace pg8 {
#define PG8_LAS __attribute__((address_space(3)))
typedef unsigned short bf16_t;
typedef short bf16x8 __attribute__((ext_vector_type(8)));
typedef float f32x4 __attribute__((ext_vector_type(4)));
typedef unsigned u32x4 __attribute__((ext_vector_type(4)));
typedef unsigned u32x2 __attribute__((ext_vector_type(2)));
constexpr int BM = 256, BK = 64, HALF = 128, HTB = HALF * BK * 2, STAGE_BYTES = 8 * HTB, NXCD = 8, WGM = 8;

__host__ __device__ __forceinline__ int lds_byte(int r, int c) { const int st = (r >> 4) * 2 + (c >> 5), rr = r & 15, cc = c & 31, ob = rr * 64 + cc * 2; return st * 1024 + (ob ^ (((ob >> 9) & 1) << 5)); }
__host__ __device__ __forceinline__ void stage_rc(int b, int& R, int& C) { const int st = b / 1024, sb = b % 1024, swz = sb ^ (((sb >> 9) & 1) << 5); R = (st >> 1) * 16 + swz / 64; C = (st & 1) * 32 + (swz % 64) / 2; }
__host__ __device__ __forceinline__ int perm32(int rho) { const int n = rho >> 4, i = rho & 15; return 8 * (i >> 2) + 4 * n + (i & 3); }

struct Unit { int pm, pn; const char* A; const char* B; int aux; };

__device__ __forceinline__ void tile_order(int L, int nM, int nN, int& pm, int& pn) {
    const int nwg = nM * nN; int wgid = L;
    { const int q = nwg / NXCD, r = nwg % NXCD, xcd = wgid % NXCD, off = wgid / NXCD; wgid = (xcd < r ? xcd * (q + 1) : r * (q + 1) + (xcd - r) * q) + off; }
    const int nig = WGM * nN, gid = wgid / nig, fm = gid * WGM, gsz = (nM - fm) < WGM ? (nM - fm) : WGM;
    pm = fm + ((wgid % nig) % gsz); pn = (wgid % nig) / gsz;
}

__device__ __forceinline__ unsigned cvt_pk_bf16(float lo, float hi) { unsigned r; asm volatile("v_cvt_pk_bf16_f32 %0, %1, %2" : "=v"(r) : "v"(lo), "v"(hi)); return r; }
__device__ __forceinline__ float bf_lo(unsigned w) { return __uint_as_float(w << 16); }
__device__ __forceinline__ float bf_hi(unsigned w) { return __uint_as_float(w & 0xffff0000u); }
__device__ __forceinline__ float sigmoidf_fast(float x) { return __builtin_amdgcn_rcpf(1.0f + __builtin_amdgcn_exp2f(-1.4426950408889634f * x)); }

template <class Epi, class Sched, bool GATHER = false, bool ALIGN_EPI = true>
__device__ __forceinline__ void gemm_phase(PG8_LAS unsigned char* lds, const int tid, const int K, const int lda, const int ldb, const Sched& S, const Epi& E) {
    const int wid = __builtin_amdgcn_readfirstlane(tid >> 6), lane = tid & 63, wr = wid >> 2, wc = wid & 3, fr = lane & 15, fq = lane >> 4;
    const int nt = K / BK;
    int RA[2], CA[2]; unsigned voffB[2];
#pragma unroll
    for (int i = 0; i < 2; ++i) { int R, C; stage_rc(tid * 16 + i * 8192, R, C); const int Rb = Epi::PERM ? ((R & ~31) + perm32(R & 31)) : R;
        RA[i] = R; CA[i] = C; voffB[i] = (unsigned)(Rb * ldb + C) * 2u; }
    const size_t kstep = (size_t)(BK * 2);
    const size_t hstepB = (size_t)HALF * ldb * 2;
    const unsigned ldsw = (unsigned)wid * 1024u;
    const int aoff = lds_byte(wr * 64 + fr, fq * 8), boff = lds_byte(wc * 32 + fr, fq * 8);
#define PG8_SA(b, h) (((b) * 2 + (h)) * HTB)
#define PG8_SB(b, h) ((4 + (b) * 2 + (h)) * HTB)
#define PG8_STAGE2(bufoff, gbase, o0, o1) do { \
        __builtin_amdgcn_global_load_lds((const unsigned*)((const char*)(gbase) + (o0)), (PG8_LAS unsigned*)(lds + (bufoff) + ldsw), 16, 0, 0); \
        __builtin_amdgcn_global_load_lds((const unsigned*)((const char*)(gbase) + (o1)), (PG8_LAS unsigned*)(lds + (bufoff) + ldsw + 8192), 16, 0, 0); } while (0)
#define PG8_STAGEB(bufoff, gbase) PG8_STAGE2(bufoff, gbase, voffB[0], voffB[1])
#define PG8_STAGEA(bufoff, gbase, OFF, h) PG8_STAGE2(bufoff, gbase, OFF[h][0], OFF[h][1])
#define PG8_LDA(dst, b, h) do { _Pragma("unroll") for (int m = 0; m < 4; ++m) _Pragma("unroll") for (int k = 0; k < 2; ++k) dst[m][k] = *(const PG8_LAS bf16x8*)(lds + PG8_SA(b, h) + aoff + m * 2048 + k * 1024); } while (0)
#define PG8_LDB(dst, b, h) do { _Pragma("unroll") for (int n = 0; n < 2; ++n) _Pragma("unroll") for (int k = 0; k < 2; ++k) dst[n][k] = *(const PG8_LAS bf16x8*)(lds + PG8_SB(b, h) + boff + n * 2048 + k * 1024); } while (0)
#define PG8_MMA(ai, bj, At, Bt) do { __builtin_amdgcn_s_setprio(1); _Pragma("unroll") for (int m = 0; m < 4; ++m) _Pragma("unroll") for (int n = 0; n < 2; ++n) _Pragma("unroll") for (int k = 0; k < 2; ++k) \
        acc[ai][bj][m][n] = __builtin_amdgcn_mfma_f32_16x16x32_bf16(Bt[n][k], At[m][k], acc[ai][bj][m][n], 0, 0, 0); __builtin_amdgcn_s_setprio(0); } while (0)
#define PG8_WAIT_V(n) asm volatile("s_waitcnt vmcnt(" #n ")" ::: "memory")
#define PG8_WAIT_L(n) asm volatile("s_waitcnt lgkmcnt(" #n ")" ::: "memory")
#define PG8_BAR __builtin_amdgcn_s_barrier()
#define PG8_SCHED __builtin_amdgcn_sched_barrier(0)
    Unit cur, nxt; int ui = 0;
    if (!S.next(0, cur)) return;
    f32x4 acc[2][2][4][2];
#pragma unroll
    for (int a = 0; a < 2; ++a)
#pragma unroll
        for (int b = 0; b < 2; ++b)
#pragma unroll
            for (int m = 0; m < 4; ++m)
#pragma unroll
                for (int n = 0; n < 2; ++n) acc[a][b][m][n] = (f32x4){0.f, 0.f, 0.f, 0.f};
    bf16x8 At[4][2], B0[2][2], B1[2][2];
    unsigned cOff[2][2], nOff[2][2];
#pragma unroll
    for (int h = 0; h < 2; ++h)
#pragma unroll
        for (int i = 0; i < 2; ++i) {
            if constexpr (GATHER) cOff[h][i] = S.row_off(cur, h * HALF + RA[i]) + (unsigned)CA[i] * 2u;
            else cOff[h][i] = (unsigned)((h * HALF + RA[i]) * lda + CA[i]) * 2u;
            nOff[h][i] = cOff[h][i];
        }
    const char* cA = cur.A; const char* cB = cur.B;
    PG8_STAGEB(PG8_SB(0, 0), cB); PG8_STAGEB(PG8_SB(0, 1), cB + hstepB); PG8_STAGEA(PG8_SA(0, 0), cA, cOff, 0); PG8_STAGEA(PG8_SA(0, 1), cA, cOff, 1);
    if (wr == 1) PG8_BAR;
    PG8_WAIT_V(2); PG8_BAR;
    PG8_STAGEB(PG8_SB(1, 0), cB + kstep); PG8_STAGEA(PG8_SA(1, 0), cA + kstep, cOff, 0); PG8_STAGEB(PG8_SB(1, 1), cB + hstepB + kstep);
    PG8_WAIT_V(6); PG8_BAR;
    for (;;) {
        const bool has_next = S.next(ui + 1, nxt);
        const char* nA = has_next ? nxt.A : cA; const char* nB = has_next ? nxt.B : cB;
        if constexpr (GATHER) {
            if (has_next) {
#pragma unroll
                for (int h = 0; h < 2; ++h)
#pragma unroll
                    for (int i = 0; i < 2; ++i) nOff[h][i] = S.row_off(nxt, h * HALF + RA[i]) + (unsigned)CA[i] * 2u;
            }
        }
        for (int t = 0; t < nt; t += 2) {
            const bool last = (t == nt - 2);
            const char* a1 = cA + (size_t)(t + 1) * kstep;
            const char* a2 = last ? nA : cA + (size_t)(t + 2) * kstep; const char* b2 = last ? nB : cB + (size_t)(t + 2) * kstep;
            const char* a3 = a2 + kstep; const char* b3 = b2 + kstep;
            unsigned o2[2][2];
#pragma unroll
            for (int h = 0; h < 2; ++h)
#pragma unroll
                for (int i = 0; i < 2; ++i) { if constexpr (GATHER) o2[h][i] = last ? nOff[h][i] : cOff[h][i]; else o2[h][i] = cOff[h][i]; }
            PG8_LDB(B0, 0, 0); PG8_LDB(B1, 0, 1); PG8_SCHED; PG8_LDA(At, 0, 0); PG8_STAGEA(PG8_SA(1, 1), a1, cOff, 1);
            PG8_WAIT_V(8); PG8_WAIT_L(0); PG8_BAR; PG8_MMA(0, 0, At, B0); PG8_MMA(0, 1, At, B1); PG8_BAR; PG8_SCHED;
            PG8_LDA(At, 0, 1); PG8_STAGEB(PG8_SB(0, 0), b2); PG8_STAGEB(PG8_SB(0, 1), b2 + hstepB); PG8_STAGEA(PG8_SA(0, 0), a2, o2, 0);
            PG8_WAIT_V(8); PG8_WAIT_L(0); PG8_BAR; PG8_MMA(1, 0, At, B0); PG8_MMA(1, 1, At, B1); PG8_BAR; PG8_SCHED;
            PG8_LDB(B0, 1, 0); PG8_LDB(B1, 1, 1); PG8_SCHED; PG8_LDA(At, 1, 0); PG8_STAGEA(PG8_SA(0, 1), a2, o2, 1);
            PG8_WAIT_V(8); PG8_WAIT_L(0); PG8_BAR; PG8_MMA(0, 0, At, B0); PG8_MMA(0, 1, At, B1); PG8_BAR; PG8_SCHED;
            PG8_LDA(At, 1, 1); PG8_STAGEB(PG8_SB(1, 0), b3); PG8_STAGEB(PG8_SB(1, 1), b3 + hstepB); PG8_STAGEA(PG8_SA(1, 0), a3, o2, 0);
            PG8_WAIT_V(8); PG8_WAIT_L(0); PG8_BAR; PG8_MMA(1, 0, At, B0); PG8_MMA(1, 1, At, B1); PG8_BAR; PG8_SCHED;
        }
        if constexpr (ALIGN_EPI) { if (wr == 0) PG8_BAR; }
        E(acc, cur, wr, wc, fr, fq);
        if (!has_next) break;
#pragma unroll
        for (int a = 0; a < 2; ++a)
#pragma unroll
            for (int b = 0; b < 2; ++b)
#pragma unroll
                for (int m = 0; m < 4; ++m)
#pragma unroll
                    for (int n = 0; n < 2; ++n) acc[a][b][m][n] = (f32x4){0.f, 0.f, 0.f, 0.f};
        cur = nxt; cA = nA; cB = nB; ++ui;
        if constexpr (GATHER) {
#pragma unroll
            for (int h = 0; h < 2; ++h)
#pragma unroll
                for (int i = 0; i < 2; ++i) cOff[h][i] = nOff[h][i];
        }
        if constexpr (ALIGN_EPI) { if (wr == 1) PG8_BAR; }
    }
    PG8_WAIT_V(0);
    if constexpr (!ALIGN_EPI) { if (wr == 0) PG8_BAR; }
    PG8_BAR;
#undef PG8_SA
#undef PG8_SB
#undef PG8_STAGE2
#undef PG8_STAGEA
#undef PG8_STAGEB
#undef PG8_LDA
#undef PG8_LDB
#undef PG8_MMA
#undef PG8_WAIT_V
#undef PG8_WAIT_L
#undef PG8_BAR
#undef PG8_SCHED
}
}

namespace mla {
using bf16=__hip_bfloat16;
using bf16x8=__attribute__((ext_vector_type(8)))short;
using s16x4=__attribute__((ext_vector_type(4)))short;
using f32x16=__attribute__((ext_vector_type(16)))float;
using u32x4=__attribute__((ext_vector_type(4)))unsigned;
constexpr int SEQ=4096,DQK=96,DV=64,NHEAD=8;
constexpr int QP=768,KP=1024,VP=512,OP=512;
constexpr int NW=8,QBLK=32,QB=QBLK*NW,KVBLK=64,NQB=SEQ/QB;
__device__ __forceinline__ int crow(int r,int hi){return (r&3)+8*(r>>2)+4*hi;}
#define SBAR() __builtin_amdgcn_sched_barrier(0)
__device__ __forceinline__ void cmask(f32x16&p0,f32x16&p1,int jb,int qrel,int hi){
  const float NEG=-INFINITY; int kb=64*jb+4*hi;
  #pragma unroll
  for(int r=0;r<16;++r){int kv=kb+(r&3)+8*(r>>2); if(kv>qrel)p0[r]=NEG; if(kv+32>qrel)p1[r]=NEG;}
}
constexpr int NSLOT=3, KSLOT=12288, VSLOT=8192;
constexpr int LDS_K=0, LDS_V=NSLOT*KSLOT, LDS_WS=LDS_V+NSLOT*VSLOT, LDS_OST=LDS_WS+NW*64*4, LDS_BYTES=LDS_OST+NW*4096;
__device__ __forceinline__ void glds16(const char*sbase,unsigned voff,unsigned lds_dst){unsigned keep;
  asm volatile("s_mov_b32 %0, m0\n\ts_mov_b32 m0, %2\n\ts_nop 0\n\tglobal_load_lds_dwordx4 %1, %3\n\ts_mov_b32 m0, %0":"=&s"(keep):"v"(voff),"s"(lds_dst),"s"(sbase):"memory");}
__device__ __forceinline__ const char* uni_ptr(const void*p){ const unsigned long long v=(unsigned long long)(uintptr_t)p; const unsigned lo=__builtin_amdgcn_readfirstlane((unsigned)v),hi=__builtin_amdgcn_readfirstlane((unsigned)(v>>32)); return (const char*)(uintptr_t)(((unsigned long long)hi<<32)|lo); }
__device__ __forceinline__ float max3f(float a,float b,float c){float r;asm("v_max3_f32 %0, %1, %2, %3":"=v"(r):"v"(a),"v"(b),"v"(c));return r;}
__device__ __forceinline__ float max2f(float a,float b){float r;asm("v_max_f32_e32 %0, %1, %2":"=v"(r):"v"(a),"v"(b));return r;}
__device__ __forceinline__ float fadd_s(float a,float b){float r;asm("v_add_f32_e32 %0, %1, %2":"=v"(r):"v"(a),"v"(b));return r;}
__device__ __forceinline__ float fsub_s(float a,float b){float r;asm("v_sub_f32_e32 %0, %1, %2":"=v"(r):"v"(a),"v"(b));return r;}
typedef float f32x2_t __attribute__((ext_vector_type(2))); typedef __bf16 bf16x2_t __attribute__((ext_vector_type(2)));
__device__ __forceinline__ unsigned cvtpk_s(float lo,float hi){f32x2_t v={lo,hi};bf16x2_t b=__builtin_convertvector(v,bf16x2_t);return __builtin_bit_cast(unsigned,b);}
#define WAIT_BAR(N) asm volatile("s_waitcnt vmcnt(" #N ") lgkmcnt(0)\n\ts_barrier":::"memory")

__device__ __forceinline__ void qkt(f32x16&p0,f32x16&p1,const char*Kslot,const bf16x8*qr,int r32,int hi){
  const f32x16 negm=f32x16{};
  const char*kb=Kslot+hi*1024+r32*16;
  #pragma unroll
  for(int d0=0;d0<6;++d0){
    const bf16x8 b0=*reinterpret_cast<const bf16x8*>(kb+d0*2048);
    const bf16x8 b1=*reinterpret_cast<const bf16x8*>(kb+d0*2048+512);
    if(d0==0){p0=__builtin_amdgcn_mfma_f32_32x32x16_bf16(b0,qr[0],negm,0,0,0);p1=__builtin_amdgcn_mfma_f32_32x32x16_bf16(b1,qr[0],negm,0,0,0);}
    else{p0=__builtin_amdgcn_mfma_f32_32x32x16_bf16(b0,qr[d0],p0,0,0,0);p1=__builtin_amdgcn_mfma_f32_32x32x16_bf16(b1,qr[d0],p1,0,0,0);}}
}
typedef __attribute__((address_space(3))) const char* lds_cptr;
typedef short v4i16_t __attribute__((ext_vector_type(4)));
__device__ __forceinline__ void kload12(bf16x8*kf,lds_cptr kp){
  #pragma unroll
  for(int j=0;j<6;++j){ kf[2*j]=*(const __attribute__((address_space(3))) bf16x8*)(kp+j*2048); kf[2*j+1]=*(const __attribute__((address_space(3))) bf16x8*)(kp+j*2048+512); }
}
__device__ __forceinline__ void kload2(bf16x8*kf,lds_cptr kp,int j){ kf[2*j]=*(const __attribute__((address_space(3))) bf16x8*)(kp+j*2048); kf[2*j+1]=*(const __attribute__((address_space(3))) bf16x8*)(kp+j*2048+512); }
__device__ __forceinline__ s16x4 vtr(lds_cptr p){ return __builtin_bit_cast(s16x4,__builtin_amdgcn_ds_read_tr16_b64_v4i16((__attribute__((address_space(3))) v4i16_t*)p)); }
__device__ __forceinline__ float rowmax(const f32x16&p0,const f32x16&p1){
  float a=max3f(p0[0],p0[1],p1[0]),b=max3f(p0[2],p0[3],p1[1]);a=max3f(a,p1[2],p1[3]);
  #pragma unroll
  for(int r=4;r<16;r+=4){a=max3f(a,p0[r],p0[r+1]);b=max3f(b,p0[r+2],p0[r+3]);a=max3f(a,p1[r],p1[r+1]);b=max3f(b,p1[r+2],p1[r+3]);}
  const float m=max2f(a,b);
  auto rr=__builtin_amdgcn_permlane32_swap(__float_as_uint(m),__float_as_uint(m),false,false);
  return max2f(__uint_as_float(rr[0]),__uint_as_float(rr[1]));
}
__device__ __forceinline__ void pv(f32x16*o,int vb,bf16x8 pa0,bf16x8 pa1,bf16x8 pa2,bf16x8 pa3){
  #pragma unroll
  for(int d0=0;d0<2;++d0){s16x4 lo[4],hi[4];
    #pragma unroll
    for(int ks=0;ks<4;++ks){
      asm volatile("ds_read_b64_tr_b16 %0,%1 offset:%c2":"=&v"(lo[ks]):"v"(vb),"i"(d0*4096+ks*1024):"memory");
      asm volatile("ds_read_b64_tr_b16 %0,%1 offset:%c2":"=&v"(hi[ks]):"v"(vb),"i"(d0*4096+ks*1024+512):"memory");}
    asm volatile("s_waitcnt lgkmcnt(0)":::"memory");SBAR();
    #define PK(k) (bf16x8){lo[k][0],lo[k][1],lo[k][2],lo[k][3],hi[k][0],hi[k][1],hi[k][2],hi[k][3]}
    o[d0]=__builtin_amdgcn_mfma_f32_32x32x16_bf16(pa0,PK(0),o[d0],0,0,0);
    o[d0]=__builtin_amdgcn_mfma_f32_32x32x16_bf16(pa1,PK(1),o[d0],0,0,0);
    o[d0]=__builtin_amdgcn_mfma_f32_32x32x16_bf16(pa2,PK(2),o[d0],0,0,0);
    o[d0]=__builtin_amdgcn_mfma_f32_32x32x16_bf16(pa3,PK(3),o[d0],0,0,0);
    #undef PK
  }
}

template<int THRL> __device__ __forceinline__ void attn_unit(const int tid,int b,int h,int qb,const bf16*Q,const bf16*__restrict__ K,const bf16*__restrict__ V,bf16*O,char*shm){
  const int lane=tid&63,r32=lane&31,hi=lane>>5; const int wid=__builtin_amdgcn_readfirstlane(tid>>6);
  const long rowbase=(long)b*SEQ; const int q0=qb*QB;
  const bf16*Qw=Q+(rowbase+q0+wid*QBLK)*QP+h*DQK;
  const bf16*Kh=K+rowbase*KP+h*DQK,*Vh=V+rowbase*VP+h*DV;
  const unsigned lds0=(unsigned)(uintptr_t)shm;
  float*wsf=(float*)(shm+LDS_WS)+wid*64;
  const char*Kb=uni_ptr(Kh); const char*Vb=uni_ptr(Vh);
  const unsigned koffA=(unsigned)(lane*KP+wid*8)*2u, koffB=(unsigned)(lane*KP+(8+(wid&3))*8)*2u;
  const unsigned voffV=(unsigned)((16*(wid&3)+(lane>>2))*VP+(wid>>2)*32+(lane&3)*8)*2u;
  const unsigned kdstA=lds0+LDS_K+wid*1024, kdstB=lds0+LDS_K+(8+(wid&3))*1024, vdst=lds0+LDS_V+wid*1024;
  #define KOF(s) ((s)+((s)>>1))
  #define DMA_K(t,slot) do{ const char*kt_=Kb+(size_t)(t)*(KVBLK*KP*2); glds16(kt_,koffA,(unsigned)__builtin_amdgcn_readfirstlane(kdstA+KOF(slot))); glds16(kt_,koffB,(unsigned)__builtin_amdgcn_readfirstlane(kdstB+KOF(slot))); }while(0)
  #define DMA_V(t,slot) glds16(Vb+(size_t)(t)*(KVBLK*VP*2),voffV,(unsigned)__builtin_amdgcn_readfirstlane(vdst+(slot)))
  const int vb0=(int)(lds0+LDS_V)+((lane>>4)&1)*32+(lane&3)*8+(4*hi+((lane&15)>>2))*64;
  const char*Kbase=shm+LDS_K; bf16x8 kf[12];
  const lds_cptr shm3=(lds_cptr)shm; const lds_cptr kp0=shm3+LDS_K+hi*1024+r32*16; const lds_cptr vp0=shm3+LDS_V+((lane>>4)&1)*32+(lane&3)*8+(4*hi+((lane&15)>>2))*64;
  const int NT=(q0+QB)/KVBLK;
  DMA_K(0,0);DMA_V(0,0);DMA_K(1,VSLOT);
  bf16x8 qr[6];
  { int lq=lane; asm volatile("":"+v"(lq));
    const bf16*qp=Qw+(long)(lq&31)*QP+(lq>>5)*8;
    _Pragma("unroll") for(int d0=0;d0<6;++d0)qr[d0]=*reinterpret_cast<const bf16x8*>(qp+d0*16); }
  float mhat=0.f,l_reg=0.f;f32x16 o[2];o[0]=f32x16{};o[1]=f32x16{};
  const int qrel=wid*QBLK+r32;
  #define CMASK(P0,P1,t) do{int jb_=(t)-(NT-4); if(jb_>=0)cmask(P0,P1,jb_,qrel,hi);}while(0)
  bool resc=false;
  #define START(P0,P1) do{ const float rm=rowmax(P0,P1); resc=false; \
    { const float dl=rm; mhat=fadd_s(mhat,dl); \
      _Pragma("unroll") for(int r=0;r<16;++r){P0[r]=fsub_s(P0[r],dl);P1[r]=fsub_s(P1[r],dl);} } \
    _Pragma("unroll") for(int r=0;r<16;++r)P0[r]=__builtin_amdgcn_exp2f(P0[r]); }while(0)
  #define RESC() do{ if(resc){ asm volatile("s_waitcnt lgkmcnt(0)":::"memory"); \
      _Pragma("unroll") for(int d_=0;d_<2;++d_) _Pragma("unroll") for(int r=0;r<16;++r)o[d_][r]*=wsf[crow(r,hi)]; } }while(0)
  f32x16 pA0,pA1,pB0,pB1;
  int sl_prev=0,sl_cur=0,sl_next=VSLOT;
  #define ROT() do{sl_prev=sl_cur;sl_cur=sl_next;sl_next=(sl_next==(NSLOT-1)*VSLOT)?0:sl_next+VSLOT;}while(0)
  DMA_K(2,2*VSLOT);
  WAIT_BAR(5);
  qkt(pA0,pA1,Kbase,qr,r32,hi);asm volatile("s_nop 15\n\ts_nop 7":"+v"(pA0),"+v"(pA1));CMASK(pA0,pA1,0);
  START(pA0,pA1);
  _Pragma("unroll") for(int r=0;r<16;++r)pA1[r]=__builtin_amdgcn_exp2f(pA1[r]);
  WAIT_BAR(0);
  DMA_K(3,0);DMA_V(1,VSLOT);
  ROT();
  kload12(kf,kp0+KOF(sl_cur));
  WAIT_BAR(3);
  s16x4 vlo[8],vhi[8]; u32x4 pw0,pw1,pw2,pw3;
  #define PKW(P,B) cvtpk_s(P[B],P[B+1])
  #define PAF(k) __builtin_bit_cast(bf16x8,pw##k)
  #define VFR(i) (bf16x8){vlo[i][0],vlo[i][1],vlo[i][2],vlo[i][3],vhi[i][0],vhi[i][1],vhi[i][2],vhi[i][3]}
  #define PIN(x) asm volatile("":"+v"(x))
  #define MX3(a,b,c) __builtin_fmaxf(__builtin_fmaxf((a),(b)),(c))
  #define GAPA(MF,A0,A1,A2,A3,W0,W1,PW) do{ MF; sacc+=A0; sacc+=A1; sacc+=A2; sacc+=A3; PIN(sacc); W0; W1; PIN(PW); SBAR(); }while(0)
  #define EX(v) __builtin_amdgcn_exp2f(v)
  #define GAPB(MF,X,B) do{ MF; X[B]=EX(X[B]); X[B+1]=EX(X[B+1]); X[B+2]=EX(X[B+2]); X[B+3]=EX(X[B+3]); PIN(X); SBAR(); }while(0)
  #define VRD(i) do{ vlo[i]=vtr(vp_+(((i)>>2)*4096+((i)&3)*1024)); vhi[i]=vtr(vp_+(((i)>>2)*4096+((i)&3)*1024+512)); }while(0)
  #define KRD(G,j) do{ if(G){ kload2(kf,kp0+KOF(sl_next),j); SBAR(); } }while(0)
  const f32x16 zero16=f32x16{};
  #define STEP(C0,C1,P0,P1,t,GK,GV,GL) do{ SBAR(); \
    const lds_cptr vp_=vp0+sl_prev; \
    float sacc=(P0[0]+P0[1]); \
    GAPA(C0=__builtin_amdgcn_mfma_f32_32x32x16_bf16(kf[0],qr[0],zero16,0,0,0), P0[2],P0[3],P0[4],P0[5],     pw0[0]=PKW(P0,0), pw0[1]=PKW(P0,2), pw0); \
    GAPA(C1=__builtin_amdgcn_mfma_f32_32x32x16_bf16(kf[1],qr[0],zero16,0,0,0), P0[6],P0[7],P0[8],P0[9],     pw0[2]=PKW(P0,4), pw0[3]=PKW(P0,6), pw0); \
    GAPA(C0=__builtin_amdgcn_mfma_f32_32x32x16_bf16(kf[2],qr[1],C0,0,0,0),   P0[10],P0[11],P0[12],P0[13], pw1[0]=PKW(P0,8), pw1[1]=PKW(P0,10), pw1); \
    GAPA(C1=__builtin_amdgcn_mfma_f32_32x32x16_bf16(kf[3],qr[1],C1,0,0,0),   P0[14],P0[15],P1[0],P1[1],   pw1[2]=PKW(P0,12),pw1[3]=PKW(P0,14), pw1); \
    GAPA(C0=__builtin_amdgcn_mfma_f32_32x32x16_bf16(kf[4],qr[2],C0,0,0,0),   P1[2],P1[3],P1[4],P1[5],     pw2[0]=PKW(P1,0), pw2[1]=PKW(P1,2), pw2); \
    GAPA(C1=__builtin_amdgcn_mfma_f32_32x32x16_bf16(kf[5],qr[2],C1,0,0,0),   P1[6],P1[7],P1[8],P1[9],     pw2[2]=PKW(P1,4), pw2[3]=PKW(P1,6), pw2); \
    GAPA(C0=__builtin_amdgcn_mfma_f32_32x32x16_bf16(kf[6],qr[3],C0,0,0,0),   P1[10],P1[11],P1[12],P1[13], pw3[0]=PKW(P1,8), pw3[1]=PKW(P1,10), pw3); \
    GAPA(C1=__builtin_amdgcn_mfma_f32_32x32x16_bf16(kf[7],qr[3],C1,0,0,0),   P1[14],P1[15],0.f,0.f,       pw3[2]=PKW(P1,12),pw3[3]=PKW(P1,14), pw3); \
    C0=__builtin_amdgcn_mfma_f32_32x32x16_bf16(kf[8],qr[4],C0,0,0,0); C1=__builtin_amdgcn_mfma_f32_32x32x16_bf16(kf[9],qr[4],C1,0,0,0); VRD(0); SBAR(); \
    C0=__builtin_amdgcn_mfma_f32_32x32x16_bf16(kf[10],qr[5],C0,0,0,0); C1=__builtin_amdgcn_mfma_f32_32x32x16_bf16(kf[11],qr[5],C1,0,0,0); VRD(4); SBAR(); \
    l_reg+=sacc; \
    _Pragma("unroll") for(int r=0;r<16;++r){C0[r]-=mhat;C1[r]-=mhat;} \
    if(GK){DMA_K((t)+3,sl_cur);} if(GV){DMA_V((t)+1,sl_next);} \
    CMASK(C0,C1,t); \
    { float a=MX3(C0[0],C0[1],C1[0]),b=MX3(C0[2],C0[3],C1[1]); a=MX3(a,C1[2],C1[3]); \
      _Pragma("unroll") for(int r=4;r<16;r+=4){a=MX3(a,C0[r],C0[r+1]);b=MX3(b,C0[r+2],C0[r+3]);a=MX3(a,C1[r],C1[r+1]);b=MX3(b,C1[r+2],C1[r+3]);} \
      float rm=__builtin_fmaxf(a,b); { auto rr=__builtin_amdgcn_permlane32_swap(__float_as_uint(rm),__float_as_uint(rm),false,false); rm=__builtin_fmaxf(__uint_as_float(rr[0]),__uint_as_float(rr[1])); } \
      resc=false; \
      if(__builtin_expect(__any(rm>(float)THRL),0)){ const float dl=__builtin_fmaxf(rm,0.f); mhat+=dl; \
        _Pragma("unroll") for(int r=0;r<16;++r){C0[r]-=dl;C1[r]-=dl;} \
        const float f=__builtin_amdgcn_exp2f(-dl); l_reg*=f; if(hi==0)wsf[r32]=f; resc=true; } } \
    SBAR(); \
    VRD(1); SBAR(); GAPB(o[0]=__builtin_amdgcn_mfma_f32_32x32x16_bf16(PAF(0),VFR(0),o[0],0,0,0), C0,0); \
    VRD(5); KRD(GL,0); GAPB(o[1]=__builtin_amdgcn_mfma_f32_32x32x16_bf16(PAF(0),VFR(4),o[1],0,0,0), C0,4); \
    VRD(2); KRD(GL,1); GAPB(o[0]=__builtin_amdgcn_mfma_f32_32x32x16_bf16(PAF(1),VFR(1),o[0],0,0,0), C0,8); \
    VRD(6); KRD(GL,2); GAPB(o[1]=__builtin_amdgcn_mfma_f32_32x32x16_bf16(PAF(1),VFR(5),o[1],0,0,0), C0,12); \
    VRD(3); KRD(GL,3); GAPB(o[0]=__builtin_amdgcn_mfma_f32_32x32x16_bf16(PAF(2),VFR(2),o[0],0,0,0), C1,0); \
    VRD(7); KRD(GL,4); GAPB(o[1]=__builtin_amdgcn_mfma_f32_32x32x16_bf16(PAF(2),VFR(6),o[1],0,0,0), C1,4); \
    KRD(GL,5); GAPB(o[0]=__builtin_amdgcn_mfma_f32_32x32x16_bf16(PAF(3),VFR(3),o[0],0,0,0), C1,8); \
    GAPB(o[1]=__builtin_amdgcn_mfma_f32_32x32x16_bf16(PAF(3),VFR(7),o[1],0,0,0), C1,12); \
    }while(0)
  int t=1;
  #undef CMASK
  #define CMASK(P0,P1,t) do{}while(0)
  for(;t+5<NT;t+=2){
    STEP(pB0,pB1,pA0,pA1,t,true,true,true);     WAIT_BAR(3); RESC(); ROT();
    STEP(pA0,pA1,pB0,pB1,t+1,true,true,true);   WAIT_BAR(3); RESC(); ROT();
  }
  #undef CMASK
  #define CMASK(P0,P1,t) do{int jb_=(t)-(NT-4); if(jb_>=0)cmask(P0,P1,jb_,qrel,hi);}while(0)
  #define ENDW(tt) do{ if((tt)+3<NT){WAIT_BAR(3);} else if((tt)+2<NT){WAIT_BAR(1);} else {WAIT_BAR(0);} }while(0)
  for(;t+1<NT;t+=2){
    STEP(pB0,pB1,pA0,pA1,t,(t+3<NT),(t+1<NT),(t+1<NT));       ENDW(t);   RESC(); ROT();
    STEP(pA0,pA1,pB0,pB1,t+1,(t+4<NT),(t+2<NT),(t+2<NT));     ENDW(t+1); RESC(); ROT();
  }
  STEP(pB0,pB1,pA0,pA1,NT-1,false,false,false); RESC();
  { float sacc=pB0[0]+pB0[1]; _Pragma("unroll") for(int r=2;r<16;++r)sacc+=pB0[r]; _Pragma("unroll") for(int r=0;r<16;++r)sacc+=pB1[r]; l_reg+=sacc;
    pw0=(u32x4){PKW(pB0,0),PKW(pB0,2),PKW(pB0,4),PKW(pB0,6)};pw1=(u32x4){PKW(pB0,8),PKW(pB0,10),PKW(pB0,12),PKW(pB0,14)};pw2=(u32x4){PKW(pB1,0),PKW(pB1,2),PKW(pB1,4),PKW(pB1,6)};pw3=(u32x4){PKW(pB1,8),PKW(pB1,10),PKW(pB1,12),PKW(pB1,14)};
    SBAR(); pv(o,vb0+sl_cur,PAF(0),PAF(1),PAF(2),PAF(3)); }
  #undef PKW
  #undef PAF
  #undef VFR
  #undef PIN
  #undef MX3
  #undef GAPA
  #undef GAPB
  #undef EX
  #undef VRD
  #undef KRD
  #undef STEP
  #undef ENDW
  {auto rr=__builtin_amdgcn_permlane32_swap(__float_as_uint(l_reg),__float_as_uint(l_reg),false,false);l_reg=__uint_as_float(rr[0])+__uint_as_float(rr[1]);}
  if(hi==0)wsf[32+r32]=l_reg;asm volatile("s_waitcnt lgkmcnt(0)":::"memory");
  float rli[16];
  #pragma unroll
  for(int r=0;r<16;++r)rli[r]=__builtin_amdgcn_rcpf(wsf[32+crow(r,hi)]);
  bf16*Ow=O+(rowbase+q0+wid*QBLK)*OP+h*DV;
  { bf16*stg=(bf16*)(shm+LDS_OST)+wid*2048;
    #pragma unroll
    for(int r=0;r<16;++r){const int orow=crow(r,hi);
      #pragma unroll
      for(int d0=0;d0<2;++d0)stg[orow*64+d0*32+r32]=__float2bfloat16(o[d0][r]*rli[r]);}
    asm volatile("s_waitcnt lgkmcnt(0)":::"memory");
    int lo_=lane; asm volatile("":"+v"(lo_));
    #pragma unroll
    for(int i=0;i<4;++i){const int row=i*8+(lo_>>3),ch=lo_&7; const u32x4 v=*(const u32x4*)(stg+row*64+ch*8); *(u32x4*)(Ow+(long)row*OP+ch*8)=v;} }
  asm volatile("s_waitcnt lgkmcnt(0)\n\ts_barrier":::"memory");
  #undef DMA_K
  #undef DMA_V
  #undef KOF
  #undef CMASK
  #undef START
  #undef RESC
  #undef ROT
}
#undef WAIT_BAR
}

constexpr int NWAVES = 8;
constexpr int BATCH = 16, SEQ = 4096, D = 1024, T = BATCH * SEQ;
constexpr int IN_COLS = 4768, N1 = 4864;
constexpr int MEM_LEN = 256, MROWS = BATCH * MEM_LEN;
constexpr int NEXP = 32, TOPK = 4, DFF = 1024, LISTCAP = T;
constexpr int ACT_TILES_MAX = (T * TOPK) / 256 + NEXP;
constexpr float EPS = 1e-6f;
constexpr float C2_MLA = 0.10206207261596575f * 1.4426950408889634f;
constexpr float C2_X = 0.08838834764831845f * 1.4426950408889634f;
constexpr int PER_PHASE = 11;
constexpr int N_LAUNCHES = MK_N_LAUNCHES;

constexpr size_t MiB = 1u << 20;
constexpr size_t WS_CTL = 0, CTL_ZERO_BYTES = 1 * MiB;
constexpr size_t WS_LIST = 1 * MiB;
constexpr size_t WS_TOKG = 9 * MiB;
constexpr size_t WS_RSTD2 = 10 * MiB;
constexpr size_t WS_W1T = 9 * MiB;
constexpr size_t WS_WUQ = 19 * MiB;
constexpr size_t WS_WUKV = 20 * MiB;
constexpr size_t WS_WMEM = 21 * MiB;
constexpr size_t WS_WPOOL = 23 * MiB;
constexpr size_t WS_WMO = 24 * MiB, WS_WCO = 25 * MiB;
constexpr size_t WS_WO = 26 * MiB;
constexpr size_t WS_MEMN = 28 * MiB;
constexpr size_t WS_KVMK = 36 * MiB;
constexpr size_t WS_VTG = 40 * MiB;
constexpr size_t WS_HN = 64 * MiB;
constexpr size_t WS_V = 64 * MiB, WS_MIXED = 128 * MiB;
constexpr size_t WS_GATES = 192 * MiB;
constexpr size_t WS_U = 576 * MiB, WS_AO = 576 * MiB;
constexpr size_t WS_CQKV = 640 * MiB, WS_CO = 640 * MiB;
constexpr size_t WS_QX = 736 * MiB;
constexpr size_t WS_Q = 800 * MiB;
constexpr size_t WS_KV = 896 * MiB, WS_MERGED = 896 * MiB;
constexpr size_t WS_HN2 = 16 * MiB;
constexpr size_t WS_WEI = 144 * MiB;
constexpr size_t WS_Y = 16 * MiB;
constexpr size_t WS_ACT = 400 * MiB;
constexpr size_t WS_WEO = 928 * MiB;
constexpr size_t WS_END = 992 * MiB;
static_assert(WS_ACT + (size_t)ACT_TILES_MAX * 256 * 1024 * 2 <= WS_WEO && WS_Y + (size_t)T * 3 * 1024 * 2 <= WS_ACT && WS_WEI + (size_t)NEXP * 2048 * 1024 * 2 <= WS_ACT, "late map");
static_assert(WS_W1T + (size_t)N1 * 1024 * 2 <= WS_WUQ && WS_VTG + 4 * MiB <= WS_HN && WS_GATES + (size_t)T * 3072 * 2 <= WS_U && WS_CQKV + (size_t)T * 768 * 2 <= WS_QX && WS_Q + (size_t)T * 768 * 2 <= WS_KV, "early map");
constexpr int CW_TMO = 0, CW_CODE = 1;
constexpr int CW_BAR = 4096;
constexpr int CW_GCNT = 16384;
constexpr int RING_OFF = 0, RING_BYTES = 131072;
constexpr int LDSCTL_OFF = RING_BYTES, MISC_OFF = LDSCTL_OFF + 320;
constexpr int LX_TSTART = LDSCTL_OFF + 512;
constexpr int LX_CNT = LDSCTL_OFF + 768;
constexpr int LX_LCNT = LDSCTL_OFF + 1024;
constexpr int LX_BASE = LDSCTL_OFF + 1280;
constexpr int LX_XWS = LDSCTL_OFF + 2048;
constexpr int LX_STASH = LDSCTL_OFF + 4096;
constexpr int LX_GATE = LDSCTL_OFF + 8192;
constexpr int LDS_BYTES = 147456;
static_assert(LX_GATE + 4096 <= LDS_BYTES && mla::LDS_BYTES <= RING_BYTES, "LDS map");

#define GAS __attribute__((address_space(1)))
#define LAS __attribute__((address_space(3)))
typedef unsigned short bf16;
typedef unsigned v4u __attribute__((ext_vector_type(4)));
typedef unsigned v2u __attribute__((ext_vector_type(2)));
typedef float f32x4 __attribute__((ext_vector_type(4)));
typedef float f32x16 __attribute__((ext_vector_type(16)));
typedef short bf16x8 __attribute__((ext_vector_type(8)));
typedef GAS unsigned gu32;
#define RLX_AGENT __ATOMIC_RELAXED, __HIP_MEMORY_SCOPE_AGENT
#define LDS_WAIT() asm volatile("s_waitcnt lgkmcnt(0)" ::: "memory")
#define VM_WAIT() asm volatile("s_waitcnt vmcnt(0)" ::: "memory")
__device__ __forceinline__ unsigned f2bf(float f) { unsigned u = __builtin_bit_cast(unsigned, f); return (u + 0x7fffu + ((u >> 16) & 1u)) >> 16; }
__device__ __forceinline__ unsigned pk2(float lo, float hi) { return pg8::cvt_pk_bf16(lo, hi); }
__device__ __forceinline__ float bflo(unsigned w) { return __uint_as_float(w << 16); }
__device__ __forceinline__ float bfhi(unsigned w) { return __uint_as_float(w & 0xffff0000u); }

#define XB_TMO      128
#define XB_XCNT(j)  (256  + 64 * (j))
#define XB_XSUB(j)  (1280 + 64 * (j))
#define XB_XGEN(j)  (2304 + 64 * (j))
#define XB_TOP      3328
#define XB_TOPGEN   3392
#define XCD_BAR_WORDS 3456
#define XB_SPIN_CAP (1u << 18)
__device__ __forceinline__ unsigned xb_ld(unsigned* p)              { return __hip_atomic_load(p, __ATOMIC_RELAXED, __HIP_MEMORY_SCOPE_AGENT); }
__device__ __forceinline__ unsigned xb_add(unsigned* p, unsigned v) { return __hip_atomic_fetch_add(p, v, __ATOMIC_RELAXED, __HIP_MEMORY_SCOPE_AGENT); }
__device__ __forceinline__ unsigned xb_xcc_id() { return (unsigned)__builtin_amdgcn_s_getreg((3 << 11) | 20) & 0xFu; }
#define XB_SPIN(cond, bar) do { unsigned _sp = 0; while (cond) { __builtin_amdgcn_s_sleep(1); \
    if ((++_sp & 255u) == 0u) { if (xb_ld(&(bar)[XB_TMO])) break; if (_sp > XB_SPIN_CAP) { atomicAdd(&(bar)[XB_TMO], 1u); break; } } } } while (0)
struct XcdBarrier { unsigned* bar; unsigned x; volatile LAS unsigned* st; };
__device__ __forceinline__ XcdBarrier xcd_barrier_post(unsigned* bar, volatile LAS unsigned* st, const bool thread0) {
    XcdBarrier b; b.bar = bar; b.x = xb_xcc_id(); b.st = st;
    if (thread0) (void)xb_add(&bar[XB_XCNT(b.x)], 1u);
    return b;
}
__device__ __forceinline__ void xcd_barrier_complete(unsigned* bar, unsigned x, unsigned& nloc, unsigned& nx) {
    const unsigned G = gridDim.x * gridDim.y * gridDim.z;
    unsigned sum, cnt, mine, sp = 0u;
    for (;;) {
        sum = 0u; cnt = 0u; mine = 0u;
#pragma unroll
        for (unsigned j = 0; j < 16; ++j) { const unsigned c = xb_ld(&bar[XB_XCNT(j)]); sum += c; cnt += (c > 0u) ? 1u : 0u; mine = (j == x) ? c : mine; }
        if (sum == G) break;
        __builtin_amdgcn_s_sleep(1);
        if ((++sp & 255u) == 0u) { if (xb_ld(&bar[XB_TMO])) break; if (sp > XB_SPIN_CAP) { atomicAdd(&bar[XB_TMO], 1u); break; } }
    }
    nloc = mine > 0u ? mine : 1u; nx = cnt > 0u ? cnt : 1u;
}
__device__ __forceinline__ void xcd_barrier(const XcdBarrier& b, const bool thread0) {
    asm volatile("s_waitcnt vmcnt(0)" ::: "memory");
    __syncthreads();
    if (thread0) {
        unsigned* bar = b.bar;
        __builtin_amdgcn_s_waitcnt(0);
        unsigned nloc = b.st[0], nx = b.st[1];
        if (nloc == 0u) { xcd_barrier_complete(bar, b.x, nloc, nx); b.st[0] = nloc; b.st[1] = nx; }
        const unsigned old = xb_add(&bar[XB_XSUB(b.x)], 1u);
        const unsigned gen = old / nloc;
        if (old + 1u == (gen + 1u) * nloc) {
            __builtin_amdgcn_fence(__ATOMIC_RELEASE, "agent");
            asm volatile("s_waitcnt vmcnt(0)" ::: "memory");
            const unsigned og = xb_add(&bar[XB_TOP], 1u);
            const unsigned tg = og / nx;
            if (og + 1u == (tg + 1u) * nx) xb_add(&bar[XB_TOPGEN], 1u);
            else XB_SPIN(xb_ld(&bar[XB_TOPGEN]) == tg, bar);
            __builtin_amdgcn_fence(__ATOMIC_ACQUIRE, "agent");
            xb_add(&bar[XB_XGEN(b.x)], 1u);
            asm volatile("s_waitcnt vmcnt(0)" ::: "memory");
        } else {
            XB_SPIN(xb_ld(&bar[XB_XGEN(b.x)]) == gen, bar);
            __builtin_amdgcn_fence(__ATOMIC_ACQUIRE, "agent");
            asm volatile("s_waitcnt vmcnt(0)" ::: "memory");
        }
    }
    __syncthreads();
}

struct Frame {
    LAS unsigned char* lds;
    volatile LAS unsigned* MISC;
    gu32* ctl;
    int tid, lane, wave;
    int vcu, G;
    unsigned char* ws;
    const float* const* in;
    float* out;
};
__device__ __forceinline__ float wave_sum(float v) {
#pragma unroll
    for (int o = 1; o < 64; o <<= 1) v += __shfl_xor(v, o);
    return v;
}
__device__ __forceinline__ float sumsq8(v4u w) {
    float s = 0.f;
#pragma unroll
    for (int i = 0; i < 4; ++i) { const float a = bflo(w[i]), b = bfhi(w[i]); s += a * a + b * b; }
    return s;
}
__device__ __forceinline__ void transpose_item(const float* W, int ldw, int srccol, const float* ks, bf16* WT, int K, int nrow0, int k0, LAS float* scr, int lane) {
#pragma unroll 8
    for (int i = 0; i < 32; ++i) { const int kk = 2 * i + (lane >> 5); float v = 0.f;
        if (srccol >= 0) { v = W[(size_t)(k0 + kk) * ldw + srccol + (lane & 31)]; if (ks) v *= ks[k0 + kk]; }
        scr[kk * 33 + (lane & 31)] = v; }
    LDS_WAIT(); asm volatile("" ::: "memory");
    const int c = lane & 7;
#pragma unroll
    for (int j = 0; j < 4; ++j) { const int n = (lane >> 3) + 8 * j; const LAS float* s = scr + (8 * c) * 33 + n;
        v4u o; o.x = pk2(s[0 * 33], s[1 * 33]); o.y = pk2(s[2 * 33], s[3 * 33]); o.z = pk2(s[4 * 33], s[5 * 33]); o.w = pk2(s[6 * 33], s[7 * 33]);
        *(GAS v4u*)(WT + (size_t)(nrow0 + n) * K + k0 + 8 * c) = o; }
    LDS_WAIT(); asm volatile("" ::: "memory");
}
__device__ __forceinline__ void rms_row_to_bf16(int lane, const float* xrow, const float* g, bf16* orow) {
    const GAS f32x4* xr = (const GAS f32x4*)xrow + lane; const GAS f32x4* gr = (const GAS f32x4*)g + lane;
    f32x4 v[4]; float s = 0.f;
#pragma unroll
    for (int j = 0; j < 4; ++j) { v[j] = xr[64 * j]; s += (v[j].x * v[j].x + v[j].y * v[j].y) + (v[j].z * v[j].z + v[j].w * v[j].w); }
    const float rstd = 1.0f / sqrtf(wave_sum(s) * (1.f / 1024.f) + EPS);
    GAS unsigned long long* o8 = (GAS unsigned long long*)orow + lane;
#pragma unroll
    for (int j = 0; j < 4; ++j) { const f32x4 gg = gr[64 * j];
        o8[64 * j] = (unsigned long long)pk2(v[j].x * rstd * gg.x, v[j].y * rstd * gg.y) | ((unsigned long long)pk2(v[j].z * rstd * gg.z, v[j].w * rstd * gg.w) << 32); }
}

enum { I_X = 0, I_MEM, I_POS, I_GATTN, I_WIN, I_WPOOL, I_PSCALE, I_GQL, I_WUQ, I_GKVL, I_WUKV, I_GQM, I_GKM, I_GMEM, I_WMEMKV, I_GQC, I_GKC, I_WPO, I_WMO, I_WCO, I_WO, I_GFFN,
       I_WR, I_BR, I_WEI, I_BEI, I_WEO, I_BEO, N_IN };

__device__ __forceinline__ int fresh_lane() { int l; asm volatile("v_mbcnt_lo_u32_b32 %0, -1, 0\n\tv_mbcnt_hi_u32_b32 %0, -1, %0" : "=v"(l)); return l; }
#define REFRESH(F) do { int w_ = (F).wave; asm volatile("" : "+s"(w_)); (F).wave = w_; (F).lane = fresh_lane(); (F).tid = w_ * 64 + (F).lane; } while (0)
__device__ __forceinline__ void p0_prologue(Frame& F) {
    LAS float* scr = (LAS float*)(F.lds + RING_OFF + F.wave * 16384);
    const int gw = F.vcu * NWAVES + F.wave, NGW = F.G * NWAVES, lane = F.lane;
    unsigned char* ws = F.ws;
    constexpr int I1 = 16 * (N1 / 32), I2 = 6 * 24, I3 = 4 * 32, I4 = 16 * 32, I5 = 8 * 32, I6 = 8 * 32, I7 = 16 * 32;
    constexpr int NITEMS = I1 + I2 + I3 + I4 + I5 + I6 + I7;
    for (int it = gw; it < NITEMS; it += NGW) {
        int r = it;
        if (r < I1) { const int nnb = N1 / 32, kb = r / nnb, nb = r % nnb, n0 = nb * 32; const int src = n0 < 1184 ? n0 : (n0 < 1280 ? -1 : n0 - 96);
            transpose_item(F.in[I_WIN], IN_COLS, src, nullptr, (bf16*)(ws + WS_W1T), 1024, n0, kb * 64, scr, lane); continue; } r -= I1;
        if (r < I2) { const int kb = r / 24, nb = r % 24; transpose_item(F.in[I_WUQ], 768, nb * 32, F.in[I_GQL], (bf16*)(ws + WS_WUQ), 384, nb * 32, kb * 64, scr, lane); continue; } r -= I2;
        if (r < I3) { const int kb = r / 32, nb = r % 32; transpose_item(F.in[I_WUKV], 1024, nb * 32, F.in[I_GKVL], (bf16*)(ws + WS_WUKV), 256, nb * 32, kb * 64, scr, lane); continue; } r -= I3;
        if (r < I4) { const int kb = r / 32, nb = r % 32; transpose_item(F.in[I_WMEMKV], 1024, nb * 32, nullptr, (bf16*)(ws + WS_WMEM), 1024, nb * 32, kb * 64, scr, lane); continue; } r -= I4;
        if (r < I5) { const int kb = r / 32, nb = r % 32; transpose_item(F.in[I_WMO], 1024, nb * 32, nullptr, (bf16*)(ws + WS_WMO), 512, nb * 32, kb * 64, scr, lane); continue; } r -= I5;
        if (r < I6) { const int kb = r / 32, nb = r % 32; transpose_item(F.in[I_WCO], 1024, nb * 32, nullptr, (bf16*)(ws + WS_WCO), 512, nb * 32, kb * 64, scr, lane); continue; } r -= I6;
        { const int kb = r / 32, nb = r % 32; transpose_item(F.in[I_WO], 1024, nb * 32, nullptr, (bf16*)(ws + WS_WO), 1024, nb * 32, kb * 64, scr, lane); }
    }
    for (int it = gw; it < 512; it += NGW) {
        const int g = it >> 7; const float* wp = F.in[I_WPOOL] + (size_t)it * 128; const float* ps = F.in[I_PSCALE] + g * 128; const float* wpo = F.in[I_WPO] + (size_t)(g * 128) * 1024;
        float a[16];
#pragma unroll
        for (int i = 0; i < 16; ++i) a[i] = 0.f;
        for (int j = 0; j < 128; ++j) { const float s = wp[j] * ps[j]; const float* row = wpo + (size_t)j * 1024 + lane;
#pragma unroll
            for (int i = 0; i < 16; ++i) a[i] += s * row[64 * i]; }
        bf16* wt = (bf16*)(ws + WS_WPOOL);
#pragma unroll
        for (int i = 0; i < 16; ++i) wt[(size_t)(lane + 64 * i) * 512 + it] = (bf16)f2bf(a[i]);
    }
    for (int m = gw; m < T; m += NGW) rms_row_to_bf16(lane, F.in[I_X] + (size_t)m * D, F.in[I_GATTN], (bf16*)(ws + WS_HN) + (size_t)m * D);
    for (int m = gw; m < MROWS; m += NGW) rms_row_to_bf16(lane, F.in[I_MEM] + (size_t)m * D, F.in[I_GMEM], (bf16*)(ws + WS_MEMN) + (size_t)m * D);
}

using pg8::Unit; using pg8::bf16_t;
struct DenseSched {
    int nM, nN, G, c; const char* A; const char* B; size_t tA, tB;
    __device__ __forceinline__ void init(const void* A_, int lda, const void* B_, int ldb, int M, int N, int G_, int c_) { A = (const char*)A_; B = (const char*)B_; nM = M / 256; nN = N / 256; G = G_; c = c_; tA = (size_t)256 * lda * 2; tB = (size_t)256 * ldb * 2; }
    __device__ __forceinline__ bool next(int i, Unit& u) const {
        const long L = (long)i * G + c; if (L >= (long)nM * nN) return false;
        pg8::tile_order((int)L, nM, nN, u.pm, u.pn); u.A = A + (size_t)u.pm * tA; u.B = B + (size_t)u.pn * tB; u.aux = 0; return true; }
};
struct EpiStore {
    static constexpr bool PERM = true;
    bf16_t* O; int ldc;
    __device__ __forceinline__ void operator()(const pg8::f32x4 (&acc)[2][2][4][2], const Unit& u, int wr, int wc, int fr_, int fq_) const {
        int fr = fr_, fq = fq_; asm volatile("" : "+v"(fr), "+v"(fq));
        const int row0 = u.pm * 256 + wr * 64 + fr, col0 = u.pn * 256 + wc * 32 + 8 * fq;
#pragma unroll
        for (int ai = 0; ai < 2; ++ai)
#pragma unroll
            for (int m = 0; m < 4; ++m) { bf16_t* rowp = O + (size_t)(row0 + ai * 128 + m * 16) * ldc + col0;
#pragma unroll
                for (int bj = 0; bj < 2; ++bj) { const pg8::f32x4 v0 = acc[ai][bj][m][0], v1 = acc[ai][bj][m][1]; pg8::u32x4 w;
                    w.x = pg8::cvt_pk_bf16(v0[0], v0[1]); w.y = pg8::cvt_pk_bf16(v0[2], v0[3]); w.z = pg8::cvt_pk_bf16(v1[0], v1[1]); w.w = pg8::cvt_pk_bf16(v1[2], v1[3]);
                    *(pg8::u32x4*)(rowp + bj * 128) = w; } }
    }
};
struct EpiP1 {
    static constexpr bool PERM = true;
    bf16_t *U, *CQKV, *QX, *GATES;
    __device__ __forceinline__ void operator()(const pg8::f32x4 (&acc)[2][2][4][2], const Unit& u, int wr, int wc, int fr_, int fq_) const {
        int fr = fr_, fq = fq_; asm volatile("" : "+v"(fr), "+v"(fq));
        const int pn = u.pn; bf16_t* base; int ldc, colt; bool sg = false;
        if (pn < 2) { base = U; ldc = 512; colt = pn * 256; } else if (pn < 5) { base = CQKV; ldc = 768; colt = (pn - 2) * 256; }
        else if (pn < 7) { base = QX; ldc = 512; colt = (pn - 5) * 256; } else { base = GATES; ldc = 3072; colt = (pn - 7) * 256; sg = true; }
        const int row0 = u.pm * 256 + wr * 64 + fr, col0 = colt + wc * 32 + 8 * fq;
#pragma unroll
        for (int ai = 0; ai < 2; ++ai)
#pragma unroll
            for (int m = 0; m < 4; ++m) { bf16_t* rowp = base + (size_t)(row0 + ai * 128 + m * 16) * ldc + col0;
#pragma unroll
                for (int bj = 0; bj < 2; ++bj) { pg8::f32x4 v0 = acc[ai][bj][m][0], v1 = acc[ai][bj][m][1];
                    if (sg) {
#pragma unroll
                        for (int i = 0; i < 4; ++i) { v0[i] = pg8::sigmoidf_fast(v0[i]); v1[i] = pg8::sigmoidf_fast(v1[i]); } }
                    pg8::u32x4 w; w.x = pg8::cvt_pk_bf16(v0[0], v0[1]); w.y = pg8::cvt_pk_bf16(v0[2], v0[3]); w.z = pg8::cvt_pk_bf16(v1[0], v1[1]); w.w = pg8::cvt_pk_bf16(v1[2], v1[3]);
                    *(pg8::u32x4*)(rowp + bj * 128) = w; } }
    }
};
struct EpiMemKV {
    static constexpr bool PERM = true;
    bf16_t *KVMK, *VTG;
    __device__ __forceinline__ void operator()(const pg8::f32x4 (&acc)[2][2][4][2], const Unit& u, int wr, int wc, int fr_, int fq_) const {
        int fr = fr_, fq = fq_; asm volatile("" : "+v"(fr), "+v"(fq));
        const int row0 = u.pm * 256 + wr * 64 + fr;
        if (u.pn < 2) {
            const int col0 = u.pn * 256 + wc * 32 + 8 * fq;
#pragma unroll
            for (int ai = 0; ai < 2; ++ai)
#pragma unroll
                for (int m = 0; m < 4; ++m) { bf16_t* rowp = KVMK + (size_t)(row0 + ai * 128 + m * 16) * 512 + col0;
#pragma unroll
                    for (int bj = 0; bj < 2; ++bj) { const pg8::f32x4 v0 = acc[ai][bj][m][0], v1 = acc[ai][bj][m][1]; pg8::u32x4 w;
                        w.x = pg8::cvt_pk_bf16(v0[0], v0[1]); w.y = pg8::cvt_pk_bf16(v0[2], v0[3]); w.z = pg8::cvt_pk_bf16(v1[0], v1[1]); w.w = pg8::cvt_pk_bf16(v1[2], v1[3]);
                        *(pg8::u32x4*)(rowp + bj * 128) = w; } }
        } else {
#pragma unroll
            for (int ai = 0; ai < 2; ++ai)
#pragma unroll
                for (int m = 0; m < 4; ++m) { const int row = row0 + ai * 128 + m * 16, b = row >> 8, mm = row & 255;
                    const int pos = (mm & ~12) | ((mm & 4) << 1) | ((mm & 8) >> 1);
#pragma unroll
                    for (int bj = 0; bj < 2; ++bj) { const int hc = (u.pn - 2) * 2 + bj;
                        bf16_t* dst = VTG + ((size_t)(b * 4 + hc) * 128 + wc * 32 + 8 * fq) * 256 + pos;
#pragma unroll
                        for (int n = 0; n < 2; ++n)
#pragma unroll
                            for (int i = 0; i < 4; ++i) dst[(size_t)(4 * n + i) * 256] = (bf16_t)f2bf(acc[ai][bj][m][n][i]); } }
        }
    }
};
struct MergeSched {
    int G, c; const char *A0, *B0; long dA1, dA2, dB1, dB2;
    __device__ __forceinline__ bool next(int i, Unit& u) const {
        const int ti = i / 3, br = i - 3 * ti; const long L = (long)ti * G + c; if (L >= 256 * 4) return false;
        pg8::tile_order((int)L, 256, 4, u.pm, u.pn); u.aux = br;
        const long b1 = br & 1, b2 = br >> 1;
        u.A = A0 + b1 * dA1 + b2 * dA2 + (size_t)u.pm * (256 * 512 * 2); u.B = B0 + b1 * dB1 + b2 * dB2 + (size_t)u.pn * (256 * 512 * 2); return true; }
};
struct EpiMerge {
    static constexpr bool PERM = true;
    const bf16_t* GATES; bf16_t* MERGED;
    __device__ __forceinline__ void operator()(const pg8::f32x4 (&acc)[2][2][4][2], const Unit& u, int wr, int wc, int fr_, int fq_) const {
        int fr = fr_, fq = fq_; asm volatile("" : "+v"(fr), "+v"(fq));
        const int br = u.aux, row0 = u.pm * 256 + wr * 64 + fr, col0 = u.pn * 256 + wc * 32 + 8 * fq;
#pragma unroll
        for (int ai = 0; ai < 2; ++ai)
#pragma unroll
            for (int m = 0; m < 4; ++m) { const size_t row = (size_t)(row0 + ai * 128 + m * 16);
#pragma unroll
                for (int bj = 0; bj < 2; ++bj) { const int c0 = col0 + bj * 128;
                    const pg8::u32x4 g = *(const pg8::u32x4*)(GATES + row * 3072 + br * 1024 + c0);
                    pg8::f32x4 v0 = acc[ai][bj][m][0], v1 = acc[ai][bj][m][1];
                    v0[0] *= bflo(g.x); v0[1] *= bfhi(g.x); v0[2] *= bflo(g.y); v0[3] *= bfhi(g.y); v1[0] *= bflo(g.z); v1[1] *= bfhi(g.z); v1[2] *= bflo(g.w); v1[3] *= bfhi(g.w);
                    bf16_t* dst = MERGED + row * 1024 + c0;
                    if (br > 0) { const pg8::u32x4 p = *(const pg8::u32x4*)dst;
                        v0[0] += bflo(p.x); v0[1] += bfhi(p.x); v0[2] += bflo(p.y); v0[3] += bfhi(p.y); v1[0] += bflo(p.z); v1[1] += bfhi(p.z); v1[2] += bflo(p.w); v1[3] += bfhi(p.w); }
                    pg8::u32x4 w; w.x = pg8::cvt_pk_bf16(v0[0], v0[1]); w.y = pg8::cvt_pk_bf16(v0[2], v0[3]); w.z = pg8::cvt_pk_bf16(v1[0], v1[1]); w.w = pg8::cvt_pk_bf16(v1[2], v1[3]);
                    *(pg8::u32x4*)dst = w; } }
    }
};
struct EpiResF32 {
    static constexpr bool PERM = false;
    const float* X; float* O;
    __device__ __forceinline__ void operator()(const pg8::f32x4 (&acc)[2][2][4][2], const Unit& u, int wr, int wc, int fr_, int fq_) const {
        int fr = fr_, fq = fq_; asm volatile("" : "+v"(fr), "+v"(fq));
        const int row0 = u.pm * 256 + wr * 64 + fr, col0 = u.pn * 256 + wc * 32 + 4 * fq;
#pragma unroll
        for (int ai = 0; ai < 2; ++ai)
#pragma unroll
            for (int m = 0; m < 4; ++m) { const size_t off = (size_t)(row0 + ai * 128 + m * 16) * 1024 + col0;
#pragma unroll
                for (int bj = 0; bj < 2; ++bj)
#pragma unroll
                    for (int n = 0; n < 2; ++n) { const pg8::f32x4 xv = *(const pg8::f32x4*)(X + off + bj * 128 + n * 16); *(pg8::f32x4*)(O + off + bj * 128 + n * 16) = xv + acc[ai][bj][m][n]; } }
    }
};
struct MoeSched {
    int G, c, nM, nN; const LAS int* tstart; const LAS int* cnt; const int* list; const char* A; const char* B; size_t bexp, tB, tA; bool gather;
    __device__ __forceinline__ bool next(int i, Unit& u) const {
        const long L = (long)i * G + c; if (L >= (long)nM * nN) return false;
        int pm, pn; pg8::tile_order((int)L, nM, nN, pm, pn);
        int e = 0; while (e < NEXP - 1 && __builtin_amdgcn_readfirstlane(tstart[e + 1]) <= pm) ++e;
        const int ts = __builtin_amdgcn_readfirstlane(tstart[e]);
        u.pm = pm; u.pn = pn; u.aux = e | ((pm - ts) << 8);
        u.A = gather ? A : A + (size_t)pm * tA; u.B = B + (size_t)e * bexp + (size_t)pn * tB; return true; }
    __device__ __forceinline__ unsigned row_off(const Unit& u, int row) const {
        const int e = u.aux & 255, idx = (u.aux >> 8) * 256 + row; const int ent = idx < cnt[e] ? list[(size_t)e * LISTCAP + idx] : 0; return (unsigned)(ent >> 2) * 2048u; }
};
struct EpiMoeIn {
    static constexpr bool PERM = true;
    const LAS int* cnt; const int* list; const float* rstd2; const float* bin; bf16_t* ACT;
    __device__ __forceinline__ void operator()(const pg8::f32x4 (&acc)[2][2][4][2], const Unit& u, int wr, int wc, int fr_, int fq_) const {
        int fr = fr_, fq = fq_; asm volatile("" : "+v"(fr), "+v"(fq));
        const int e = u.aux & 255, rt = u.aux >> 8, ce = cnt[e], j0 = u.pn * 128 + wc * 32 + 8 * fq;
        const float* bg = bin + (size_t)e * 2048 + j0; const pg8::f32x4 bg0 = *(const pg8::f32x4*)bg, bg1 = *(const pg8::f32x4*)(bg + 4), bl0 = *(const pg8::f32x4*)(bg + 1024), bl1 = *(const pg8::f32x4*)(bg + 1028);
#pragma unroll
        for (int ai = 0; ai < 2; ++ai)
#pragma unroll
            for (int m = 0; m < 4; ++m) { const int rl = ai * 128 + wr * 64 + m * 16 + fr, idx = rt * 256 + rl; float rs = 0.f;
                if (idx < ce) rs = rstd2[list[(size_t)e * LISTCAP + idx] >> 2];
                float a[8];
#pragma unroll
                for (int n = 0; n < 2; ++n)
#pragma unroll
                    for (int i = 0; i < 4; ++i) { float gl = acc[ai][0][m][n][i] * rs + (n ? bg1[i] : bg0[i]), li = acc[ai][1][m][n][i] * rs + (n ? bl1[i] : bl0[i]);
                        gl = fminf(gl, 7.0f); li = fminf(fmaxf(li, -7.0f), 7.0f);
                        a[4 * n + i] = gl * pg8::sigmoidf_fast(1.702f * gl) * (li + 1.0f); }
                pg8::u32x4 w; w.x = pg8::cvt_pk_bf16(a[0], a[1]); w.y = pg8::cvt_pk_bf16(a[2], a[3]); w.z = pg8::cvt_pk_bf16(a[4], a[5]); w.w = pg8::cvt_pk_bf16(a[6], a[7]);
                *(pg8::u32x4*)(ACT + ((size_t)u.pm * 256 + rl) * 1024 + j0) = w; }
    }
};
struct EpiMoeOut {
    static constexpr bool PERM = true;
    const LAS int* cnt; const int* list; const float* tokg; const float* bout; float* OUT; bf16_t* Y;
    __device__ __forceinline__ void operator()(const pg8::f32x4 (&acc)[2][2][4][2], const Unit& u, int wr, int wc, int fr_, int fq_) const {
        int fr = fr_, fq = fq_; asm volatile("" : "+v"(fr), "+v"(fq));
        const int e = u.aux & 255, rt = u.aux >> 8, ce = cnt[e], c0 = u.pn * 256 + wc * 32 + 8 * fq;
        const float* bo = bout + (size_t)e * 1024 + c0; pg8::f32x4 bv[2][2];
#pragma unroll
        for (int bj = 0; bj < 2; ++bj)
#pragma unroll
            for (int n = 0; n < 2; ++n) bv[bj][n] = *(const pg8::f32x4*)(bo + bj * 128 + 4 * n);
#pragma unroll
        for (int ai = 0; ai < 2; ++ai)
#pragma unroll
            for (int m = 0; m < 4; ++m) { const int rl = ai * 128 + wr * 64 + m * 16 + fr, idx = rt * 256 + rl;
                if (idx < ce) { const int ent = list[(size_t)e * LISTCAP + idx], t = ent >> 2, k = ent & 3; const float g = tokg[ent];
#pragma unroll
                    for (int bj = 0; bj < 2; ++bj) { const pg8::f32x4 v0 = (acc[ai][bj][m][0] + bv[bj][0]) * g, v1 = (acc[ai][bj][m][1] + bv[bj][1]) * g;
                        if (k == 0) { float* p = OUT + (size_t)t * 1024 + c0 + bj * 128; const pg8::f32x4 o0 = *(const pg8::f32x4*)p, o1 = *(const pg8::f32x4*)(p + 4); *(pg8::f32x4*)p = o0 + v0; *(pg8::f32x4*)(p + 4) = o1 + v1; }
                        else { pg8::u32x4 w; w.x = pg8::cvt_pk_bf16(v0[0], v0[1]); w.y = pg8::cvt_pk_bf16(v0[2], v0[3]); w.z = pg8::cvt_pk_bf16(v1[0], v1[1]); w.w = pg8::cvt_pk_bf16(v1[2], v1[3]);
                            *(pg8::u32x4*)(Y + ((size_t)t * 3 + (k - 1)) * 1024 + c0 + bj * 128) = w; } } } }
    }
};

__device__ const float ROPE_INVREV[16] = { 1.591549431e-01f, 8.949940161e-02f, 5.032921210e-02f, 2.830219583e-02f, 1.591549431e-02f, 8.949940161e-03f, 5.032921210e-03f, 2.830219583e-03f,
                                           1.591549431e-03f, 8.949940161e-04f, 5.032921210e-04f, 2.830219583e-04f, 1.591549431e-04f, 8.949940161e-05f, 5.032921210e-05f, 2.830219583e-05f };
__device__ __forceinline__ void p3_token(Frame& F, int t) {
    const int lane = F.lane, h = lane >> 3, sub = lane & 7;
    unsigned char* ws = F.ws;
    const bf16* cq = (const bf16*)(ws + WS_CQKV) + (size_t)t * 768;
    float sq = 0.f, skv = 0.f;
    if (lane < 48) sq = sumsq8(*(const GAS v4u*)(cq + lane * 8));
    if (lane < 32) skv = sumsq8(*(const GAS v4u*)(cq + 384 + lane * 8));
    sq = wave_sum(sq); skv = wave_sum(skv);
    const float rs_q = 1.0f / sqrtf(sq * (1.f / 384.f) + EPS), rs_kv = 1.0f / sqrtf(skv * (1.f / 256.f) + EPS);
    const unsigned pe_lo = *(const GAS unsigned*)(cq + 640 + 2 * sub), pe_hi = *(const GAS unsigned*)(cq + 656 + 2 * sub);
    const float posf = (float)((const int*)F.in[I_POS])[t];
    float cs[2], sn[2];
#pragma unroll
    for (int p = 0; p < 2; ++p) { float rev = posf * ROPE_INVREV[2 * sub + p]; rev -= floorf(rev); sn[p] = __builtin_amdgcn_sinf(rev); cs[p] = __builtin_amdgcn_cosf(rev); }
    const float* gq = F.in[I_GQM]; const float* gk = F.in[I_GKM];
    {
        bf16* qrow = (bf16*)(ws + WS_Q) + (size_t)t * 768 + h * 96;
        const v4u qn = *(const GAS v4u*)(qrow + sub * 8); const unsigned ql = *(const GAS unsigned*)(qrow + 64 + 2 * sub), qh = *(const GAS unsigned*)(qrow + 80 + 2 * sub);
        float q[8], a[2], b[2];
#pragma unroll
        for (int i = 0; i < 4; ++i) { q[2 * i] = bflo(qn[i]) * rs_q; q[2 * i + 1] = bfhi(qn[i]) * rs_q; }
        a[0] = bflo(ql) * rs_q; a[1] = bfhi(ql) * rs_q; b[0] = bflo(qh) * rs_q; b[1] = bfhi(qh) * rs_q;
        float ss = a[0] * a[0] + a[1] * a[1] + b[0] * b[0] + b[1] * b[1];
#pragma unroll
        for (int i = 0; i < 8; ++i) ss += q[i] * q[i];
        ss += __shfl_xor(ss, 1); ss += __shfl_xor(ss, 2); ss += __shfl_xor(ss, 4);
        const float rn = C2_MLA / sqrtf(ss * (1.f / 96.f) + EPS);
#pragma unroll
        for (int i = 0; i < 8; ++i) q[i] *= rn * gq[sub * 8 + i];
        float lo[2], hi[2];
#pragma unroll
        for (int p = 0; p < 2; ++p) { const float x1 = a[p] * rn * gq[64 + 2 * sub + p], x2 = b[p] * rn * gq[80 + 2 * sub + p]; lo[p] = x1 * cs[p] - x2 * sn[p]; hi[p] = x2 * cs[p] + x1 * sn[p]; }
        v4u o; o.x = pk2(q[0], q[1]); o.y = pk2(q[2], q[3]); o.z = pk2(q[4], q[5]); o.w = pk2(q[6], q[7]);
        *(GAS v4u*)(qrow + sub * 8) = o; *(GAS unsigned*)(qrow + 64 + 2 * sub) = pk2(lo[0], lo[1]); *(GAS unsigned*)(qrow + 80 + 2 * sub) = pk2(hi[0], hi[1]);
    }
    {
        bf16* kvrow = (bf16*)(ws + WS_KV) + (size_t)t * 1024;
        const v4u kn = *(const GAS v4u*)(kvrow + h * 128 + sub * 8), vv = *(const GAS v4u*)(kvrow + h * 128 + 64 + sub * 8);
        float k[8], v[8], a[2], b[2];
#pragma unroll
        for (int i = 0; i < 4; ++i) { k[2 * i] = bflo(kn[i]) * rs_kv; k[2 * i + 1] = bfhi(kn[i]) * rs_kv; v[2 * i] = bflo(vv[i]) * rs_kv; v[2 * i + 1] = bfhi(vv[i]) * rs_kv; }
        a[0] = bflo(pe_lo); a[1] = bfhi(pe_lo); b[0] = bflo(pe_hi); b[1] = bfhi(pe_hi);
        float ss = a[0] * a[0] + a[1] * a[1] + b[0] * b[0] + b[1] * b[1];
#pragma unroll
        for (int i = 0; i < 8; ++i) ss += k[i] * k[i];
        ss += __shfl_xor(ss, 1); ss += __shfl_xor(ss, 2); ss += __shfl_xor(ss, 4);
        const float rn = 1.0f / sqrtf(ss * (1.f / 96.f) + EPS);
#pragma unroll
        for (int i = 0; i < 8; ++i) k[i] *= rn * gk[sub * 8 + i];
        float lo[2], hi[2];
#pragma unroll
        for (int p = 0; p < 2; ++p) { const float x1 = a[p] * rn * gk[64 + 2 * sub + p], x2 = b[p] * rn * gk[80 + 2 * sub + p]; lo[p] = x1 * cs[p] - x2 * sn[p]; hi[p] = x2 * cs[p] + x1 * sn[p]; }
        v4u o; o.x = pk2(k[0], k[1]); o.y = pk2(k[2], k[3]); o.z = pk2(k[4], k[5]); o.w = pk2(k[6], k[7]);
        v4u ov; ov.x = pk2(v[0], v[1]); ov.y = pk2(v[2], v[3]); ov.z = pk2(v[4], v[5]); ov.w = pk2(v[6], v[7]);
        asm volatile("" ::: "memory");
        bf16* krow = kvrow + h * 96;
        *(GAS v4u*)(krow + sub * 8) = o; *(GAS unsigned*)(krow + 64 + 2 * sub) = pk2(lo[0], lo[1]); *(GAS unsigned*)(krow + 80 + 2 * sub) = pk2(hi[0], hi[1]);
        *(GAS v4u*)((bf16*)(ws + WS_V) + (size_t)t * 512 + h * 64 + sub * 8) = ov;
    }
    {
        const int s = t & (SEQ - 1), g = lane >> 4, win = 2 << g, cntw = (s + 1 < win) ? s + 1 : win;
        const bf16* urow = (const bf16*)(ws + WS_U) + (size_t)t * 512 + lane * 8;
        float acc[8], u0[8];
#pragma unroll
        for (int i = 0; i < 8; ++i) acc[i] = 0.f;
        for (int j = 0; j < cntw; ++j) { const v4u w = *(const GAS v4u*)(urow - (size_t)j * 512);
#pragma unroll
            for (int i = 0; i < 4; ++i) { const float x0 = bflo(w[i]), x1 = bfhi(w[i]); acc[2 * i] += x0; acc[2 * i + 1] += x1; if (j == 0) { u0[2 * i] = x0; u0[2 * i + 1] = x1; } } }
        const float inv = 1.0f / (float)cntw;
#pragma unroll
        for (int i = 0; i < 8; ++i) acc[i] = acc[i] * inv - u0[i];
        v4u o; o.x = pk2(acc[0], acc[1]); o.y = pk2(acc[2], acc[3]); o.z = pk2(acc[4], acc[5]); o.w = pk2(acc[6], acc[7]);
        *(GAS v4u*)((bf16*)(ws + WS_MIXED) + (size_t)t * 512 + lane * 8) = o;
    }
}

namespace xat {
__device__ __forceinline__ int crow(int r, int hi) { return (r & 3) + 8 * (r >> 2) + 4 * hi; }
__device__ __forceinline__ void stage_kv(Frame& F, int b, int hc) {
    const int tid = F.tid; unsigned char* ws = F.ws; LAS unsigned char* lds = F.lds;
    { const int row = tid >> 1, half = tid & 1; const bf16* src = (const bf16*)(ws + WS_KVMK) + (size_t)(b * 256 + row) * 512 + hc * 128 + half * 64;
      v4u v[8]; float ss = 0.f;
#pragma unroll
      for (int c = 0; c < 8; ++c) { v[c] = *(const GAS v4u*)(src + 8 * c); ss += sumsq8(v[c]); }
      ss += __shfl_xor(ss, 1);
      const float rstd = 1.0f / sqrtf(ss * (1.f / 128.f) + EPS); const float* gk = F.in[I_GKC] + half * 64;
#pragma unroll
      for (int c = 0; c < 8; ++c) { v4u o;
#pragma unroll
          for (int i = 0; i < 4; ++i) o[i] = pk2(bflo(v[c][i]) * rstd * gk[8 * c + 2 * i], bfhi(v[c][i]) * rstd * gk[8 * c + 2 * i + 1]);
          *(LAS v4u*)(lds + row * 256 + (((half * 8 + c) ^ (row & 15)) << 4)) = o; } }
    { const bf16* src = (const bf16*)(ws + WS_VTG) + (size_t)(b * 4 + hc) * 128 * 256;
#pragma unroll
      for (int i = 0; i < 8; ++i) { const int q = tid + 512 * i, d = q >> 5, ch = q & 31; const v4u v = *(const GAS v4u*)(src + (size_t)q * 8);
          *(LAS v4u*)(lds + 65536 + d * 512 + ((ch ^ (d & 15)) << 4)) = v; } }
}
__device__ __forceinline__ void unit(Frame& F, int b, int hc, int qb) {
    const int lane = F.lane, r32 = lane & 31, hi = lane >> 5, wid = F.wave; unsigned char* ws = F.ws; LAS unsigned char* lds = F.lds;
    LAS float* wsf = (LAS float*)(lds + LX_XWS) + wid * 64;
    const size_t row = (size_t)b * SEQ + qb * 256 + wid * 32 + r32;
    bf16x8 qr[8];
    { const bf16* qsrc = (const bf16*)(ws + WS_QX) + row * 512 + hc * 128 + hi * 8; v4u qv[8]; float ss = 0.f;
#pragma unroll
      for (int d0 = 0; d0 < 8; ++d0) { qv[d0] = *(const GAS v4u*)(qsrc + 16 * d0); ss += sumsq8(qv[d0]); }
      ss += __shfl_xor(ss, 32);
      const float rn = C2_X / sqrtf(ss * (1.f / 128.f) + EPS); const float* gq = F.in[I_GQC] + hi * 8;
#pragma unroll
      for (int d0 = 0; d0 < 8; ++d0) { v4u o;
#pragma unroll
          for (int i = 0; i < 4; ++i) o[i] = pk2(bflo(qv[d0][i]) * rn * gq[16 * d0 + 2 * i], bfhi(qv[d0][i]) * rn * gq[16 * d0 + 2 * i + 1]);
          qr[d0] = __builtin_bit_cast(bf16x8, o); } }
    f32x16 o[4];
#pragma unroll
    for (int i = 0; i < 4; ++i) o[i] = f32x16{};
    float mrun = -1e30f, lrun = 0.f;
#pragma unroll 1
    for (int tt = 0; tt < 4; ++tt) {
        f32x16 p0 = f32x16{}, p1 = f32x16{};
        const int kr0 = 64 * tt + r32, kr1 = kr0 + 32;
#pragma unroll
        for (int d0 = 0; d0 < 8; ++d0) {
            const bf16x8 k0 = *(const LAS bf16x8*)(lds + kr0 * 256 + (((2 * d0 + hi) ^ (kr0 & 15)) << 4));
            const bf16x8 k1 = *(const LAS bf16x8*)(lds + kr1 * 256 + (((2 * d0 + hi) ^ (kr1 & 15)) << 4));
            p0 = __builtin_amdgcn_mfma_f32_32x32x16_bf16(k0, qr[d0], p0, 0, 0, 0);
            p1 = __builtin_amdgcn_mfma_f32_32x32x16_bf16(k1, qr[d0], p1, 0, 0, 0);
        }
        float rm = fmaxf(p0[0], p1[0]);
#pragma unroll
        for (int r = 1; r < 16; ++r) rm = fmaxf(rm, fmaxf(p0[r], p1[r]));
        rm = fmaxf(rm, __shfl_xor(rm, 32));
        const float mnew = fmaxf(mrun, rm), sc = __builtin_amdgcn_exp2f(mrun - mnew); mrun = mnew;
        float ps = 0.f;
#pragma unroll
        for (int r = 0; r < 16; ++r) { p0[r] = __builtin_amdgcn_exp2f(p0[r] - mnew); p1[r] = __builtin_amdgcn_exp2f(p1[r] - mnew); ps += p0[r] + p1[r]; }
        lrun = lrun * sc + ps;
        if (hi == 0) wsf[r32] = sc;
        LDS_WAIT();
#pragma unroll
        for (int d = 0; d < 4; ++d)
#pragma unroll
            for (int r = 0; r < 16; ++r) o[d][r] *= wsf[crow(r, hi)];
        v4u pw[4];
#pragma unroll
        for (int i = 0; i < 4; ++i) { pw[0][i] = pk2(p0[2 * i], p0[2 * i + 1]); pw[1][i] = pk2(p0[8 + 2 * i], p0[9 + 2 * i]); pw[2][i] = pk2(p1[2 * i], p1[2 * i + 1]); pw[3][i] = pk2(p1[8 + 2 * i], p1[9 + 2 * i]); }
#pragma unroll
        for (int ks = 0; ks < 4; ++ks) { const int ch = 2 * (4 * tt + ks) + hi; const bf16x8 pa = __builtin_bit_cast(bf16x8, pw[ks]);
#pragma unroll
            for (int d = 0; d < 4; ++d) { const int dr = r32 + 32 * d; const bf16x8 vf = *(const LAS bf16x8*)(lds + 65536 + dr * 512 + ((ch ^ (dr & 15)) << 4));
                o[d] = __builtin_amdgcn_mfma_f32_32x32x16_bf16(pa, vf, o[d], 0, 0, 0); } }
        LDS_WAIT();
    }
    lrun += __shfl_xor(lrun, 32);
    if (hi == 0) wsf[32 + r32] = lrun;
    LDS_WAIT();
    bf16* orow = (bf16*)(ws + WS_CO) + ((size_t)b * SEQ + qb * 256 + wid * 32) * 512 + hc * 128 + r32;
#pragma unroll
    for (int r = 0; r < 16; ++r) { const int qrow = crow(r, hi); const float rl = 1.0f / wsf[32 + qrow];
#pragma unroll
        for (int d = 0; d < 4; ++d) orow[(size_t)qrow * 512 + 32 * d] = (bf16)f2bf(o[d][r] * rl); }
    LDS_WAIT();
}
}

__device__ __forceinline__ void router_tile(Frame& F, int t0, int lt0) {
    const int lane = F.lane, tok = lane & 31, kk = lane >> 5; unsigned char* ws = F.ws; LAS unsigned char* lds = F.lds;
    const LAS float* wr = (const LAS float*)(lds + RING_OFF);
    const float* xrow = F.out + (size_t)(t0 + tok) * 1024 + 8 * kk;
    bf16* hrow = (bf16*)(ws + WS_HN2) + (size_t)(t0 + tok) * 1024 + 8 * kk;
    f32x16 acc = f32x16{}; float ss = 0.f;
    f32x4 a = *(const GAS f32x4*)(xrow), b = *(const GAS f32x4*)(xrow + 4);
#pragma unroll 2
    for (int q = 0; q < 64; ++q) {
        const int qn = q < 63 ? q + 1 : 63;
        const f32x4 an = *(const GAS f32x4*)(xrow + 16 * qn), bn = *(const GAS f32x4*)(xrow + 16 * qn + 4);
        ss += (a.x * a.x + a.y * a.y) + (a.z * a.z + a.w * a.w) + (b.x * b.x + b.y * b.y) + (b.z * b.z + b.w * b.w);
        const LAS float* wq = wr + (16 * q + 8 * kk) * 32 + tok;
        acc = __builtin_amdgcn_mfma_f32_32x32x2f32(wq[0 * 32], a.x, acc, 0, 0, 0); acc = __builtin_amdgcn_mfma_f32_32x32x2f32(wq[1 * 32], a.y, acc, 0, 0, 0);
        acc = __builtin_amdgcn_mfma_f32_32x32x2f32(wq[2 * 32], a.z, acc, 0, 0, 0); acc = __builtin_amdgcn_mfma_f32_32x32x2f32(wq[3 * 32], a.w, acc, 0, 0, 0);
        acc = __builtin_amdgcn_mfma_f32_32x32x2f32(wq[4 * 32], b.x, acc, 0, 0, 0); acc = __builtin_amdgcn_mfma_f32_32x32x2f32(wq[5 * 32], b.y, acc, 0, 0, 0);
        acc = __builtin_amdgcn_mfma_f32_32x32x2f32(wq[6 * 32], b.z, acc, 0, 0, 0); acc = __builtin_amdgcn_mfma_f32_32x32x2f32(wq[7 * 32], b.w, acc, 0, 0, 0);
        v4u o; o.x = pk2(a.x, a.y); o.y = pk2(a.z, a.w); o.z = pk2(b.x, b.y); o.w = pk2(b.z, b.w);
        *(GAS v4u*)(hrow + 16 * q) = o;
        a = an; b = bn;
    }
    ss += __shfl_xor(ss, 32);
    const float rstd = 1.0f / sqrtf(ss * (1.f / 1024.f) + EPS);
    if (kk == 0) ((float*)(ws + WS_RSTD2))[t0 + tok] = rstd;
    const float* br = F.in[I_BR];
    float lg[16];
#pragma unroll
    for (int r = 0; r < 16; ++r) lg[r] = acc[r] * rstd + br[xat::crow(r, kk)];
    float tv[4]; int ti[4];
#pragma unroll
    for (int k = 0; k < 4; ++k) { float best = lg[0]; int bi = 0;
#pragma unroll
        for (int r = 1; r < 16; ++r) { const bool gt = lg[r] > best; best = gt ? lg[r] : best; bi = gt ? r : bi; }
        tv[k] = best; ti[k] = xat::crow(bi, kk);
#pragma unroll
        for (int r = 0; r < 16; ++r) lg[r] = (r == bi) ? -INFINITY : lg[r]; }
    float cv[8]; int ci[8];
#pragma unroll
    for (int k = 0; k < 4; ++k) { cv[k] = tv[k]; ci[k] = ti[k]; cv[4 + k] = __shfl_xor(tv[k], 32); ci[4 + k] = __shfl_xor(ti[k], 32); }
    float gv[4]; int ge[4];
#pragma unroll
    for (int k = 0; k < 4; ++k) { float best = cv[0]; int be = ci[0], bj = 0;
#pragma unroll
        for (int j = 1; j < 8; ++j) { const bool gt = (cv[j] > best) || (cv[j] == best && ci[j] < be); best = gt ? cv[j] : best; be = gt ? ci[j] : be; bj = gt ? j : bj; }
        gv[k] = best; ge[k] = be;
#pragma unroll
        for (int j = 0; j < 8; ++j) cv[j] = (j == bj) ? -INFINITY : cv[j]; }
    float ex[4], es = 0.f;
#pragma unroll
    for (int k = 0; k < 4; ++k) { ex[k] = __expf(gv[k] - gv[0]); es += ex[k]; }
    const float ies = 1.0f / es;
    if (kk == 0) {
        LAS int* lcnt = (LAS int*)(lds + LX_LCNT); LAS int* stash = (LAS int*)(lds + LX_STASH); LAS float* gst = (LAS float*)(lds + LX_GATE);
#pragma unroll
        for (int k = 0; k < 4; ++k) { const int li = __hip_atomic_fetch_add(lcnt + ge[k], 1, __ATOMIC_RELAXED, __HIP_MEMORY_SCOPE_WORKGROUP);
            stash[(lt0 + tok) * 4 + k] = ge[k] | (li << 8); gst[(lt0 + tok) * 4 + k] = ex[k] * ies; }
    }
}

__device__ __forceinline__ void p7_router(Frame& F) {
    const int lane = F.lane, tid = F.tid; unsigned char* ws = F.ws; LAS unsigned char* lds = F.lds;
    {
        LAS float* scr = (LAS float*)(lds + RING_OFF + F.wave * 16384);
        const int gw = F.vcu * NWAVES + F.wave, NGW = F.G * NWAVES;
        constexpr int IE1 = 16 * 64, IE2 = 16 * 32;
        for (int it = gw; it < NEXP * (IE1 + IE2); it += NGW) {
            const int e = it / (IE1 + IE2); int r = it - e * (IE1 + IE2);
            if (r < IE1) { const int kb = r >> 6, nb = r & 63, n0 = nb * 32, src = ((n0 >> 7) & 1) * 1024 + (n0 >> 8) * 128 + (n0 & 127);
                transpose_item(F.in[I_WEI] + (size_t)e * 1024 * 2048, 2048, src, F.in[I_GFFN], (bf16*)(ws + WS_WEI) + (size_t)e * 2048 * 1024, 1024, n0, kb * 64, scr, lane); }
            else { r -= IE1; const int kb = r >> 5, nb = r & 31;
                transpose_item(F.in[I_WEO] + (size_t)e * 1024 * 1024, 1024, nb * 32, nullptr, (bf16*)(ws + WS_WEO) + (size_t)e * 1024 * 1024, 1024, nb * 32, kb * 64, scr, lane); }
        }
    }
    __syncthreads();
    { const float* wr = F.in[I_WR]; const float* g = F.in[I_GFFN];
      for (int i = tid; i < 8192; i += NWAVES * 64) { const f32x4 v = *(const GAS f32x4*)(wr + 4 * i); const float gg = g[i >> 3]; *(LAS f32x4*)(lds + RING_OFF + 16 * i) = v * gg; } }
    __syncthreads();
    LAS int* lcnt = (LAS int*)(lds + LX_LCNT); LAS int* lbase = (LAS int*)(lds + LX_BASE); LAS int* stash = (LAS int*)(lds + LX_STASH); LAS float* gst = (LAS float*)(lds + LX_GATE);
    for (int chunk = F.vcu; chunk < T / 256; chunk += F.G) {
        if (tid < NEXP) lcnt[tid] = 0;
        __syncthreads();
        router_tile(F, chunk * 256 + F.wave * 32, F.wave * 32);
        __syncthreads();
        if (tid < NEXP) lbase[tid] = (int)__hip_atomic_fetch_add((unsigned*)(F.ctl + CW_GCNT + 64 * tid), (unsigned)lcnt[tid], RLX_AGENT);
        __syncthreads();
        for (int idx = tid; idx < 1024; idx += NWAVES * 64) { const int st = stash[idx], e = st & 255, pos = lbase[e] + (st >> 8), ent = (chunk * 256 + (idx >> 2)) * 4 + (idx & 3);
            if (pos < LISTCAP) ((int*)(ws + WS_LIST))[(size_t)e * LISTCAP + pos] = ent;
            ((float*)(ws + WS_TOKG))[ent] = gst[idx]; }
        __syncthreads();
    }
}
__device__ __forceinline__ int moe_setup(Frame& F) {
    LAS int* tstart = (LAS int*)(F.lds + LX_TSTART); LAS int* cnt = (LAS int*)(F.lds + LX_CNT);
    if (F.tid == 0) { int acc = 0;
        for (int e = 0; e < NEXP; ++e) { int c = (int)__hip_atomic_load((unsigned*)(F.ctl + CW_GCNT + 64 * e), RLX_AGENT); c = c < LISTCAP ? c : LISTCAP; cnt[e] = c; tstart[e] = acc; acc += (c + 255) >> 8; }
        tstart[NEXP] = acc < ACT_TILES_MAX ? acc : ACT_TILES_MAX; }
    __syncthreads();
    return __builtin_amdgcn_readfirstlane(tstart[NEXP]);
}

struct Args { const float* in[N_IN]; float* out; unsigned char* ws; int ph_lo, ph_hi, li, pad; };
__global__ void __launch_bounds__(NWAVES * 64, 2) fwd_kernel(Args args) {
    extern __shared__ __attribute__((aligned(16))) unsigned char lds[];
    Frame F;
    F.lds = (LAS unsigned char*)lds;
    F.MISC = (volatile LAS unsigned*)(F.lds + MISC_OFF);
    F.tid = threadIdx.x; F.lane = F.tid & 63; F.wave = __builtin_amdgcn_readfirstlane(F.tid >> 6);
    F.G = gridDim.x; { const int bx = blockIdx.x; F.vcu = (F.G % 8 == 0) ? (bx % 8) * (F.G / 8) + bx / 8 : bx; }
    F.ws = args.ws; F.out = args.out; F.in = args.in;
    unsigned char* ws = args.ws;
    F.ctl = (gu32*)(ws + WS_CTL);
    for (int u = F.tid; u < (LDS_BYTES - LDSCTL_OFF) / 4; u += NWAVES * 64) ((LAS unsigned*)(F.lds + LDSCTL_OFF))[u] = 0u;
    __syncthreads();
    XcdBarrier bar; bar.bar = (unsigned*)(F.ctl + CW_BAR); bar.x = 0; bar.st = nullptr;
    if (N_LAUNCHES != PER_PHASE) bar = xcd_barrier_post((unsigned*)(F.ctl + CW_BAR), F.MISC + 8, F.tid == 0);
#define GRID_BAR(seam) do { if (N_LAUNCHES == PER_PHASE) { if (F.tid == 0) __hip_atomic_store(F.ctl + CW_TMO, 0xBADBA0u | (unsigned)(seam), RLX_AGENT); } else { xcd_barrier(bar, F.tid == 0); } } while (0)
    const int lo = args.ph_lo, hi = args.ph_hi;
#ifndef MK_PHASE_MASK
#define MK_PHASE_MASK 0x7ff
#endif
#define IN(k) (((MK_PHASE_MASK >> (k)) & 1) && lo <= (k) && (k) < hi)
#define BOTH(k) (IN(k) && IN((k) + 1))
    const int gw = F.vcu * NWAVES + F.wave, NGW = F.G * NWAVES;

    if (IN(0)) { REFRESH(F); p0_prologue(F); if (BOTH(0)) GRID_BAR(0); }

    if (IN(1)) { REFRESH(F);
        DenseSched S; S.init(ws + WS_HN, 1024, ws + WS_W1T, 1024, T, N1, F.G, (int)blockIdx.x);
        EpiP1 E{(bf16_t*)(ws + WS_U), (bf16_t*)(ws + WS_CQKV), (bf16_t*)(ws + WS_QX), (bf16_t*)(ws + WS_GATES)};
        pg8::gemm_phase<EpiP1, DenseSched>(F.lds + RING_OFF, F.tid, 1024, 1024, 1024, S, E);
        if (BOTH(1)) GRID_BAR(1);
    }

    if (IN(2)) { REFRESH(F);
        { DenseSched S; S.init(ws + WS_CQKV, 768, ws + WS_WUQ, 384, T, 768, F.G, (int)blockIdx.x);
          EpiStore E{(bf16_t*)(ws + WS_Q), 768};
          pg8::gemm_phase<EpiStore, DenseSched>(F.lds + RING_OFF, F.tid, 384, 768, 384, S, E); }
        { DenseSched S; S.init(ws + WS_CQKV + 384 * 2, 768, ws + WS_WUKV, 256, T, 1024, F.G, (int)blockIdx.x);
          EpiStore E{(bf16_t*)(ws + WS_KV), 1024};
          pg8::gemm_phase<EpiStore, DenseSched>(F.lds + RING_OFF, F.tid, 256, 768, 256, S, E); }
        { DenseSched S; S.init(ws + WS_MEMN, 1024, ws + WS_WMEM, 1024, MROWS, 1024, F.G, (int)blockIdx.x);
          EpiMemKV E{(bf16_t*)(ws + WS_KVMK), (bf16_t*)(ws + WS_VTG)};
          pg8::gemm_phase<EpiMemKV, DenseSched>(F.lds + RING_OFF, F.tid, 1024, 1024, 1024, S, E); }
        if (BOTH(2)) GRID_BAR(2);
    }

    if (IN(3)) { REFRESH(F);
        const int per = T / NGW;
        if (per * NGW == T) { for (int i = 0; i < per; ++i) p3_token(F, gw * per + i); }
        else { for (int t = gw; t < T; t += NGW) p3_token(F, t); }
        if (BOTH(3)) GRID_BAR(3);
    }

    if (IN(4)) { REFRESH(F);
#ifndef NO_MLA
        for (int vv = F.vcu; vv < 256; vv += F.G) {
            const int bh = vv >> 1, s = vv & 1;
            for (int i = 0; i < 8; ++i) { const int j2 = (i >> 1) * 2 + s, qb = (i & 1) ? 15 - j2 : j2;
                mla::attn_unit<8>(F.tid, bh >> 3, bh & 7, qb, (const mla::bf16*)(ws + WS_Q), (const mla::bf16*)(ws + WS_KV), (const mla::bf16*)(ws + WS_V), (mla::bf16*)(ws + WS_AO), (char*)lds + RING_OFF); }
        }
#endif
        __syncthreads();
        REFRESH(F);
#ifndef NO_XAT
        for (int vv = F.vcu; vv < 256; vv += F.G) {
            const int b = vv >> 4, hc = (vv >> 2) & 3;
            xat::stage_kv(F, b, hc);
            __syncthreads();
            for (int i = 0; i < 4; ++i) xat::unit(F, b, hc, (vv & 3) * 4 + i);
            __syncthreads();
        }
#endif
        if (BOTH(4)) GRID_BAR(4);
    }

    if (IN(5)) { REFRESH(F);
        MergeSched S; S.G = F.G; S.c = (int)blockIdx.x;
        S.A0 = (const char*)(ws + WS_MIXED); S.dA1 = (long)WS_AO - (long)WS_MIXED; S.dA2 = (long)WS_CO - (long)WS_MIXED;
        S.B0 = (const char*)(ws + WS_WPOOL); S.dB1 = (long)WS_WMO - (long)WS_WPOOL; S.dB2 = (long)WS_WCO - (long)WS_WPOOL;
        EpiMerge E{(const bf16_t*)(ws + WS_GATES), (bf16_t*)(ws + WS_MERGED)};
        pg8::gemm_phase<EpiMerge, MergeSched>(F.lds + RING_OFF, F.tid, 512, 512, 512, S, E);
        if (BOTH(5)) GRID_BAR(5);
    }

    if (IN(6)) { REFRESH(F);
        DenseSched S; S.init(ws + WS_MERGED, 1024, ws + WS_WO, 1024, T, 1024, F.G, (int)blockIdx.x);
        EpiResF32 E{F.in[I_X], F.out};
        pg8::gemm_phase<EpiResF32, DenseSched>(F.lds + RING_OFF, F.tid, 1024, 1024, 1024, S, E);
        if (BOTH(6)) GRID_BAR(6);
    }

    if (IN(7)) { REFRESH(F); p7_router(F); if (BOTH(7)) GRID_BAR(7); }

    if (IN(8)) { REFRESH(F);
        const int ntiles = moe_setup(F);
        MoeSched S; S.G = F.G; S.c = (int)blockIdx.x; S.nM = ntiles; S.nN = 8; S.tstart = (const LAS int*)(F.lds + LX_TSTART); S.cnt = (const LAS int*)(F.lds + LX_CNT);
        S.list = (const int*)(ws + WS_LIST); S.A = (const char*)(ws + WS_HN2); S.B = (const char*)(ws + WS_WEI); S.bexp = (size_t)2048 * 1024 * 2; S.tB = (size_t)256 * 1024 * 2; S.tA = 0; S.gather = true;
        EpiMoeIn E{S.cnt, S.list, (const float*)(ws + WS_RSTD2), F.in[I_BEI], (bf16_t*)(ws + WS_ACT)};
        pg8::gemm_phase<EpiMoeIn, MoeSched, true>(F.lds + RING_OFF, F.tid, 1024, 1024, 1024, S, E);
        if (BOTH(8)) GRID_BAR(8);
    }

    if (IN(9)) { REFRESH(F);
        const int ntiles = moe_setup(F);
        MoeSched S; S.G = F.G; S.c = (int)blockIdx.x; S.nM = ntiles; S.nN = 4; S.tstart = (const LAS int*)(F.lds + LX_TSTART); S.cnt = (const LAS int*)(F.lds + LX_CNT);
        S.list = (const int*)(ws + WS_LIST); S.A = (const char*)(ws + WS_ACT); S.B = (const char*)(ws + WS_WEO); S.bexp = (size_t)1024 * 1024 * 2; S.tB = (size_t)256 * 1024 * 2; S.tA = (size_t)256 * 1024 * 2; S.gather = false;
        EpiMoeOut E{S.cnt, S.list, (const float*)(ws + WS_TOKG), F.in[I_BEO], F.out, (bf16_t*)(ws + WS_Y)};
        pg8::gemm_phase<EpiMoeOut, MoeSched, false>(F.lds + RING_OFF, F.tid, 1024, 1024, 1024, S, E);
        if (BOTH(9)) GRID_BAR(9);
    }

    if (IN(10)) { REFRESH(F);
        for (int t = gw; t < T; t += NGW) {
            GAS f32x4* o = (GAS f32x4*)(F.out + (size_t)t * 1024) + F.lane; const GAS v2u* y = (const GAS v2u*)((const bf16*)(ws + WS_Y) + (size_t)t * 3072) + F.lane;
#pragma unroll
            for (int j = 0; j < 4; ++j) { f32x4 v = o[64 * j];
#pragma unroll
                for (int s = 0; s < 3; ++s) { const v2u w = y[s * 256 + 64 * j]; v.x += bflo(w.x); v.y += bfhi(w.x); v.z += bflo(w.y); v.w += bfhi(w.y); }
                o[64 * j] = v; }
        }
    }
#undef IN
#undef BOTH
#undef GRID_BAR
}

extern "C" void kernel_launch(void* const* d_in, const int* in_sizes, int n_in, void* d_out, int out_size, void* d_ws, size_t ws_size, hipStream_t stream) {
    static int grid = 0;
    if (grid == 0) {
        if (n_in != N_IN || in_sizes[0] != T * D || out_size != T * D || ws_size < WS_END) { fprintf(stderr, "kernel_launch: unexpected shapes (n_in %d, in0 %d, out %d, ws %zu); nothing launched\n", n_in, n_in > 0 ? in_sizes[0] : -1, out_size, ws_size); grid = -1; return; }
        int dev = 0, cus = 0, per_cu = 0;
        if (hipGetDevice(&dev) != hipSuccess || hipDeviceGetAttribute(&cus, hipDeviceAttributeMultiprocessorCount, dev) != hipSuccess) { grid = -1; return; }
        if (hipFuncSetAttribute((const void*)fwd_kernel, hipFuncAttributeMaxDynamicSharedMemorySize, LDS_BYTES) != hipSuccess) { fprintf(stderr, "kernel_launch: hipFuncSetAttribute failed\n"); grid = -1; return; }
        if (hipOccupancyMaxActiveBlocksPerMultiprocessor(&per_cu, (const void*)fwd_kernel, NWAVES * 64, LDS_BYTES) != hipSuccess || per_cu < 1)
            fprintf(stderr, "kernel_launch: note: occupancy query reports %d workgroups per CU\n", per_cu);
        (void)hipGetLastError();
        grid = cus;
    }
    if (grid < 0) return;
    if (hipMemsetAsync((char*)d_ws + WS_CTL, 0, CTL_ZERO_BYTES, stream) != hipSuccess) { fprintf(stderr, "kernel_launch: hipMemsetAsync failed\n"); return; }
    Args a{};
    for (int i = 0; i < N_IN; ++i) a.in[i] = (const float*)d_in[i];
    a.out = (float*)d_out; a.ws = (unsigned char*)d_ws;
    const int last = MK_LAST_PHASE;
    if (N_LAUNCHES == PER_PHASE) {
        for (int li = 0; li < last; ++li) { a.ph_lo = li; a.ph_hi = li + 1; a.li = li; hipLaunchKernelGGL(fwd_kernel, dim3(grid), dim3(NWAVES * 64), LDS_BYTES, stream, a); }
    } else {
        a.ph_lo = 0; a.ph_hi = last; a.li = 0; hipLaunchKernelGGL(fwd_kernel, dim3(grid), dim3(NWAVES * 64), LDS_BYTES, stream, a);
    }
    const hipError_t le = hipPeekAtLastError();
    if (le != hipSuccess) fprintf(stderr, "kernel_launch: launch failed: %s\n", hipGetErrorName(le));
}
```

```cpp
#include <hip/hip_runtime.h>
#include <hip/hip_bf16.h>
#include <cstdio>
#include <cstdint>

#ifndef MK_N_LAUNCHES
#define MK_N_LAUNCHES 1
#endif
#ifndef MK_REP1
#define MK_REP1 1
#endif
#ifndef MK_REP4
#define MK_REP4 1
#endif
#ifndef MK_REP56
#define MK_REP56 1
#endif
#ifndef MK_REP8
#define MK_REP8 1
#endif
#ifndef MK_REPMLA
#define MK_REPMLA 1
#endif
#ifndef MK_REP0
#define MK_REP0 1
#endif
#ifndef MK_REP2
#define MK_REP2 1
#endif
#ifndef MK_REPX
#define MK_REPX 1
#endif
#ifndef MK_LAST_PHASE
#define MK_LAST_PHASE 11
#endif

namespace pg8 {
#define PG8_LAS __attribute__((address_space(3)))
typedef unsigned short bf16_t;
typedef short bf16x8 __attribute__((ext_vector_type(8)));
typedef float f32x4 __attribute__((ext_vector_type(4)));
typedef unsigned u32x4 __attribute__((ext_vector_type(4)));
typedef unsigned u32x2 __attribute__((ext_vector_type(2)));
constexpr int BM = 256, BK = 64, HALF = 128, HTB = HALF * BK * 2, STAGE_BYTES = 8 * HTB, NXCD = 8, WGM = 8;

__host__ __device__ __forceinline__ int lds_byte(int r, int c) { const int st = (r >> 4) * 2 + (c >> 5), rr = r & 15, cc = c & 31, ob = rr * 64 + cc * 2; return st * 1024 + (ob ^ (((ob >> 9) & 1) << 5)); }
__host__ __device__ __forceinline__ void stage_rc(int b, int& R, int& C) { const int st = b / 1024, sb = b % 1024, swz = sb ^ (((sb >> 9) & 1) << 5); R = (st >> 1) * 16 + swz / 64; C = (st & 1) * 32 + (swz % 64) / 2; }
__host__ __device__ __forceinline__ int perm32(int rho) { const int n = rho >> 4, i = rho & 15; return 8 * (i >> 2) + 4 * n + (i & 3); }

struct Unit { int pm, pn; const char* A; const char* B; int aux; };

__device__ __forceinline__ void tile_order(int L, int nM, int nN, int& pm, int& pn) {
    const int nwg = nM * nN; int wgid = L;
    { const int q = nwg / NXCD, r = nwg % NXCD, xcd = wgid % NXCD, off = wgid / NXCD; wgid = (xcd < r ? xcd * (q + 1) : r * (q + 1) + (xcd - r) * q) + off; }
    const int nig = WGM * nN, gid = wgid / nig, fm = gid * WGM, gsz = (nM - fm) < WGM ? (nM - fm) : WGM;
    pm = fm + ((wgid % nig) % gsz); pn = (wgid % nig) / gsz;
}

__device__ __forceinline__ unsigned cvt_pk_bf16(float lo, float hi) { unsigned r; asm volatile("v_cvt_pk_bf16_f32 %0, %1, %2" : "=v"(r) : "v"(lo), "v"(hi)); return r; }
__device__ __forceinline__ float bf_lo(unsigned w) { return __uint_as_float(w << 16); }
__device__ __forceinline__ float bf_hi(unsigned w) { return __uint_as_float(w & 0xffff0000u); }
__device__ __forceinline__ float sigmoidf_fast(float x) { return __builtin_amdgcn_rcpf(1.0f + __builtin_amdgcn_exp2f(-1.4426950408889634f * x)); }

template <class Epi, class Sched, bool GATHER = false, bool ALIGN_EPI = true>
__device__ __forceinline__ void gemm_phase(PG8_LAS unsigned char* lds, const int tid, const int K, const int lda, const int ldb, const Sched& S, const Epi& E) {
    const int wid = __builtin_amdgcn_readfirstlane(tid >> 6), lane = tid & 63, wr = wid >> 2, wc = wid & 3, fr = lane & 15, fq = lane >> 4;
    const int nt = K / BK;
    int RA[2], CA[2]; unsigned voffB[2];
#pragma unroll
    for (int i = 0; i < 2; ++i) { int R, C; stage_rc(tid * 16 + i * 8192, R, C); const int Rb = Epi::PERM ? ((R & ~31) + perm32(R & 31)) : R;
        RA[i] = R; CA[i] = C; voffB[i] = (unsigned)(Rb * ldb + C) * 2u; }
    const size_t kstep = (size_t)(BK * 2);
    const size_t hstepB = (size_t)HALF * ldb * 2;
    const unsigned ldsw = (unsigned)wid * 1024u;
    const int aoff = lds_byte(wr * 64 + fr, fq * 8), boff = lds_byte(wc * 32 + fr, fq * 8);
#define PG8_SA(b, h) (((b) * 2 + (h)) * HTB)
#define PG8_SB(b, h) ((4 + (b) * 2 + (h)) * HTB)
#define PG8_STAGE2(bufoff, gbase, o0, o1) do { \
        __builtin_amdgcn_global_load_lds((const unsigned*)((const char*)(gbase) + (o0)), (PG8_LAS unsigned*)(lds + (bufoff) + ldsw), 16, 0, 0); \
        __builtin_amdgcn_global_load_lds((const unsigned*)((const char*)(gbase) + (o1)), (PG8_LAS unsigned*)(lds + (bufoff) + ldsw + 8192), 16, 0, 0); } while (0)
#define PG8_STAGEB(bufoff, gbase) PG8_STAGE2(bufoff, gbase, voffB[0], voffB[1])
#define PG8_STAGEA(bufoff, gbase, OFF, h) PG8_STAGE2(bufoff, gbase, OFF[h][0], OFF[h][1])
#define PG8_LDA(dst, b, h) do { _Pragma("unroll") for (int m = 0; m < 4; ++m) _Pragma("unroll") for (int k = 0; k < 2; ++k) dst[m][k] = *(const PG8_LAS bf16x8*)(lds + PG8_SA(b, h) + aoff + m * 2048 + k * 1024); } while (0)
#define PG8_LDB(dst, b, h) do { _Pragma("unroll") for (int n = 0; n < 2; ++n) _Pragma("unroll") for (int k = 0; k < 2; ++k) dst[n][k] = *(const PG8_LAS bf16x8*)(lds + PG8_SB(b, h) + boff + n * 2048 + k * 1024); } while (0)
#define PG8_MMA(ai, bj, At, Bt) do { __builtin_amdgcn_s_setprio(1); _Pragma("unroll") for (int m = 0; m < 4; ++m) _Pragma("unroll") for (int n = 0; n < 2; ++n) _Pragma("unroll") for (int k = 0; k < 2; ++k) \
        acc[ai][bj][m][n] = __builtin_amdgcn_mfma_f32_16x16x32_bf16(Bt[n][k], At[m][k], acc[ai][bj][m][n], 0, 0, 0); __builtin_amdgcn_s_setprio(0); } while (0)
#define PG8_WAIT_V(n) asm volatile("s_waitcnt vmcnt(" #n ")" ::: "memory")
#define PG8_WAIT_L(n) asm volatile("s_waitcnt lgkmcnt(" #n ")" ::: "memory")
#define PG8_BAR __builtin_amdgcn_s_barrier()
#define PG8_SCHED __builtin_amdgcn_sched_barrier(0)
    Unit cur, nxt; int ui = 0;
    if (!S.next(0, cur)) return;
    f32x4 acc[2][2][4][2];
#pragma unroll
    for (int a = 0; a < 2; ++a)
#pragma unroll
        for (int b = 0; b < 2; ++b)
#pragma unroll
            for (int m = 0; m < 4; ++m)
#pragma unroll
                for (int n = 0; n < 2; ++n) acc[a][b][m][n] = (f32x4){0.f, 0.f, 0.f, 0.f};
    bf16x8 At[4][2], B0[2][2], B1[2][2];
    unsigned cOff[2][2], nOff[2][2];
#pragma unroll
    for (int h = 0; h < 2; ++h)
#pragma unroll
        for (int i = 0; i < 2; ++i) {
            if constexpr (GATHER) cOff[h][i] = S.row_off(cur, h * HALF + RA[i]) + (unsigned)CA[i] * 2u;
            else cOff[h][i] = (unsigned)((h * HALF + RA[i]) * lda + CA[i]) * 2u;
            nOff[h][i] = cOff[h][i];
        }
    const char* cA = cur.A; const char* cB = cur.B;
    PG8_STAGEB(PG8_SB(0, 0), cB); PG8_STAGEB(PG8_SB(0, 1), cB + hstepB); PG8_STAGEA(PG8_SA(0, 0), cA, cOff, 0); PG8_STAGEA(PG8_SA(0, 1), cA, cOff, 1);
    if (wr == 1) PG8_BAR;
    PG8_WAIT_V(2); PG8_BAR;
    PG8_STAGEB(PG8_SB(1, 0), cB + kstep); PG8_STAGEA(PG8_SA(1, 0), cA + kstep, cOff, 0); PG8_STAGEB(PG8_SB(1, 1), cB + hstepB + kstep);
    PG8_WAIT_V(6); PG8_BAR;
    for (;;) {
        const bool has_next = S.next(ui + 1, nxt);
        const char* nA = has_next ? nxt.A : cA; const char* nB = has_next ? nxt.B : cB;
        if constexpr (GATHER) {
            if (has_next) {
#pragma unroll
                for (int h = 0; h < 2; ++h)
#pragma unroll
                    for (int i = 0; i < 2; ++i) nOff[h][i] = S.row_off(nxt, h * HALF + RA[i]) + (unsigned)CA[i] * 2u;
            }
        }
        for (int t = 0; t < nt; t += 2) {
            const bool last = (t == nt - 2);
            const char* a1 = cA + (size_t)(t + 1) * kstep;
            const char* a2 = last ? nA : cA + (size_t)(t + 2) * kstep; const char* b2 = last ? nB : cB + (size_t)(t + 2) * kstep;
            const char* a3 = a2 + kstep; const char* b3 = b2 + kstep;
            unsigned o2[2][2];
#pragma unroll
            for (int h = 0; h < 2; ++h)
#pragma unroll
                for (int i = 0; i < 2; ++i) { if constexpr (GATHER) o2[h][i] = last ? nOff[h][i] : cOff[h][i]; else o2[h][i] = cOff[h][i]; }
            PG8_LDB(B0, 0, 0); PG8_LDB(B1, 0, 1); PG8_SCHED; PG8_LDA(At, 0, 0); PG8_STAGEA(PG8_SA(1, 1), a1, cOff, 1);
            PG8_WAIT_V(8); PG8_WAIT_L(0); PG8_BAR; PG8_MMA(0, 0, At, B0); PG8_MMA(0, 1, At, B1); PG8_BAR; PG8_SCHED;
            PG8_LDA(At, 0, 1); PG8_STAGEB(PG8_SB(0, 0), b2); PG8_STAGEB(PG8_SB(0, 1), b2 + hstepB); PG8_STAGEA(PG8_SA(0, 0), a2, o2, 0);
            PG8_WAIT_V(8); PG8_WAIT_L(0); PG8_BAR; PG8_MMA(1, 0, At, B0); PG8_MMA(1, 1, At, B1); PG8_BAR; PG8_SCHED;
            PG8_LDB(B0, 1, 0); PG8_LDB(B1, 1, 1); PG8_SCHED; PG8_LDA(At, 1, 0); PG8_STAGEA(PG8_SA(0, 1), a2, o2, 1);
            PG8_WAIT_V(8); PG8_WAIT_L(0); PG8_BAR; PG8_MMA(0, 0, At, B0); PG8_MMA(0, 1, At, B1); PG8_BAR; PG8_SCHED;
            PG8_LDA(At, 1, 1); PG8_STAGEB(PG8_SB(1, 0), b3); PG8_STAGEB(PG8_SB(1, 1), b3 + hstepB); PG8_STAGEA(PG8_SA(1, 0), a3, o2, 0);
            PG8_WAIT_V(8); PG8_WAIT_L(0); PG8_BAR; PG8_MMA(1, 0, At, B0); PG8_MMA(1, 1, At, B1); PG8_BAR; PG8_SCHED;
        }
        if constexpr (ALIGN_EPI) { if (wr == 0) PG8_BAR; }
        E(acc, cur, wr, wc, fr, fq);
        if (!has_next) break;
#pragma unroll
        for (int a = 0; a < 2; ++a)
#pragma unroll
            for (int b = 0; b < 2; ++b)
#pragma unroll
                for (int m = 0; m < 4; ++m)
#pragma unroll
                    for (int n = 0; n < 2; ++n) acc[a][b][m][n] = (f32x4){0.f, 0.f, 0.f, 0.f};
        cur = nxt; cA = nA; cB = nB; ++ui;
        if constexpr (GATHER) {
#pragma unroll
            for (int h = 0; h < 2; ++h)
#pragma unroll
                for (int i = 0; i < 2; ++i) cOff[h][i] = nOff[h][i];
        }
        if constexpr (ALIGN_EPI) { if (wr == 1) PG8_BAR; }
    }
    PG8_WAIT_V(0);
    if constexpr (!ALIGN_EPI) { if (wr == 0) PG8_BAR; }
    PG8_BAR;
#undef PG8_SA
#undef PG8_SB
#undef PG8_STAGE2
#undef PG8_STAGEA
#undef PG8_STAGEB
#undef PG8_LDA
#undef PG8_LDB
#undef PG8_MMA
#undef PG8_WAIT_V
#undef PG8_WAIT_L
#undef PG8_BAR
#undef PG8_SCHED
}
}

namespace mla {
using bf16=__hip_bfloat16;
using bf16x8=__attribute__((ext_vector_type(8)))short;
using s16x4=__attribute__((ext_vector_type(4)))short;
using f32x16=__attribute__((ext_vector_type(16)))float;
using u32x4=__attribute__((ext_vector_type(4)))unsigned;
constexpr int SEQ=4096,DQK=96,DV=64,NHEAD=8;
constexpr int QP=768,KP=1024,VP=512,OP=512;
constexpr int NW=8,QBLK=32,QB=QBLK*NW,KVBLK=64,NQB=SEQ/QB;
__device__ __forceinline__ int crow(int r,int hi){return (r&3)+8*(r>>2)+4*hi;}
#define SBAR() __builtin_amdgcn_sched_barrier(0)
__device__ __forceinline__ void cmask(f32x16&p0,f32x16&p1,int jb,int qrel,int hi){
  const float NEG=-INFINITY; int kb=64*jb+4*hi;
  #pragma unroll
  for(int r=0;r<16;++r){int kv=kb+(r&3)+8*(r>>2); if(kv>qrel)p0[r]=NEG; if(kv+32>qrel)p1[r]=NEG;}
}
constexpr int NSLOT=3, KSLOT=12288, VSLOT=8192;
constexpr int LDS_K=0, LDS_V=NSLOT*KSLOT, LDS_WS=LDS_V+NSLOT*VSLOT, LDS_OST=LDS_WS+NW*64*4, LDS_BYTES=LDS_OST+NW*4096;
__device__ __forceinline__ void glds16(const char*sbase,unsigned voff,unsigned lds_dst){unsigned keep;
  asm volatile("s_mov_b32 %0, m0\n\ts_mov_b32 m0, %2\n\ts_nop 0\n\tglobal_load_lds_dwordx4 %1, %3\n\ts_mov_b32 m0, %0":"=&s"(keep):"v"(voff),"s"(lds_dst),"s"(sbase):"memory");}
__device__ __forceinline__ const char* uni_ptr(const void*p){ const unsigned long long v=(unsigned long long)(uintptr_t)p; const unsigned lo=__builtin_amdgcn_readfirstlane((unsigned)v),hi=__builtin_amdgcn_readfirstlane((unsigned)(v>>32)); return (const char*)(uintptr_t)(((unsigned long long)hi<<32)|lo); }
__device__ __forceinline__ float max3f(float a,float b,float c){float r;asm("v_max3_f32 %0, %1, %2, %3":"=v"(r):"v"(a),"v"(b),"v"(c));return r;}
__device__ __forceinline__ float max2f(float a,float b){float r;asm("v_max_f32_e32 %0, %1, %2":"=v"(r):"v"(a),"v"(b));return r;}
__device__ __forceinline__ float fadd_s(float a,float b){float r;asm("v_add_f32_e32 %0, %1, %2":"=v"(r):"v"(a),"v"(b));return r;}
__device__ __forceinline__ float fsub_s(float a,float b){float r;asm("v_sub_f32_e32 %0, %1, %2":"=v"(r):"v"(a),"v"(b));return r;}
typedef float f32x2_t __attribute__((ext_vector_type(2))); typedef __bf16 bf16x2_t __attribute__((ext_vector_type(2)));
__device__ __forceinline__ unsigned cvtpk_s(float lo,float hi){f32x2_t v={lo,hi};bf16x2_t b=__builtin_convertvector(v,bf16x2_t);return __builtin_bit_cast(unsigned,b);}
#define WAIT_BAR(N) asm volatile("s_waitcnt vmcnt(" #N ") lgkmcnt(0)\n\ts_barrier":::"memory")

__device__ __forceinline__ void qkt(f32x16&p0,f32x16&p1,const char*Kslot,const bf16x8*qr,int r32,int hi){
  const f32x16 negm=f32x16{};
  const char*kb=Kslot+hi*1024+r32*16;
  #pragma unroll
  for(int d0=0;d0<6;++d0){
    const bf16x8 b0=*reinterpret_cast<const bf16x8*>(kb+d0*2048);
    const bf16x8 b1=*reinterpret_cast<const bf16x8*>(kb+d0*2048+512);
    if(d0==0){p0=__builtin_amdgcn_mfma_f32_32x32x16_bf16(b0,qr[0],negm,0,0,0);p1=__builtin_amdgcn_mfma_f32_32x32x16_bf16(b1,qr[0],negm,0,0,0);}
    else{p0=__builtin_amdgcn_mfma_f32_32x32x16_bf16(b0,qr[d0],p0,0,0,0);p1=__builtin_amdgcn_mfma_f32_32x32x16_bf16(b1,qr[d0],p1,0,0,0);}}
}
typedef __attribute__((address_space(3))) const char* lds_cptr;
typedef short v4i16_t __attribute__((ext_vector_type(4)));
__device__ __forceinline__ void kload12(bf16x8*kf,lds_cptr kp){
  #pragma unroll
  for(int j=0;j<6;++j){ kf[2*j]=*(const __attribute__((address_space(3))) bf16x8*)(kp+j*2048); kf[2*j+1]=*(const __attribute__((address_space(3))) bf16x8*)(kp+j*2048+512); }
}
__device__ __forceinline__ void kload2(bf16x8*kf,lds_cptr kp,int j){ kf[2*j]=*(const __attribute__((address_space(3))) bf16x8*)(kp+j*2048); kf[2*j+1]=*(const __attribute__((address_space(3))) bf16x8*)(kp+j*2048+512); }
__device__ __forceinline__ s16x4 vtr(lds_cptr p){ return __builtin_bit_cast(s16x4,__builtin_amdgcn_ds_read_tr16_b64_v4i16((__attribute__((address_space(3))) v4i16_t*)p)); }
__device__ __forceinline__ float rowmax(const f32x16&p0,const f32x16&p1){
  float a=max3f(p0[0],p0[1],p1[0]),b=max3f(p0[2],p0[3],p1[1]);a=max3f(a,p1[2],p1[3]);
  #pragma unroll
  for(int r=4;r<16;r+=4){a=max3f(a,p0[r],p0[r+1]);b=max3f(b,p0[r+2],p0[r+3]);a=max3f(a,p1[r],p1[r+1]);b=max3f(b,p1[r+2],p1[r+3]);}
  const float m=max2f(a,b);
  auto rr=__builtin_amdgcn_permlane32_swap(__float_as_uint(m),__float_as_uint(m),false,false);
  return max2f(__uint_as_float(rr[0]),__uint_as_float(rr[1]));
}
__device__ __forceinline__ void pv(f32x16*o,int vb,bf16x8 pa0,bf16x8 pa1,bf16x8 pa2,bf16x8 pa3){
  #pragma unroll
  for(int d0=0;d0<2;++d0){s16x4 lo[4],hi[4];
    #pragma unroll
    for(int ks=0;ks<4;++ks){
      asm volatile("ds_read_b64_tr_b16 %0,%1 offset:%c2":"=&v"(lo[ks]):"v"(vb),"i"(d0*4096+ks*1024):"memory");
      asm volatile("ds_read_b64_tr_b16 %0,%1 offset:%c2":"=&v"(hi[ks]):"v"(vb),"i"(d0*4096+ks*1024+512):"memory");}
    asm volatile("s_waitcnt lgkmcnt(0)":::"memory");SBAR();
    #define PK(k) (bf16x8){lo[k][0],lo[k][1],lo[k][2],lo[k][3],hi[k][0],hi[k][1],hi[k][2],hi[k][3]}
    o[d0]=__builtin_amdgcn_mfma_f32_32x32x16_bf16(pa0,PK(0),o[d0],0,0,0);
    o[d0]=__builtin_amdgcn_mfma_f32_32x32x16_bf16(pa1,PK(1),o[d0],0,0,0);
    o[d0]=__builtin_amdgcn_mfma_f32_32x32x16_bf16(pa2,PK(2),o[d0],0,0,0);
    o[d0]=__builtin_amdgcn_mfma_f32_32x32x16_bf16(pa3,PK(3),o[d0],0,0,0);
    #undef PK
  }
}

template<int THRL> __device__ __forceinline__ void attn_unit(const int tid,int b,int h,int qb,const bf16*Q,const bf16*__restrict__ K,const bf16*__restrict__ V,bf16*O,char*shm){
  const int lane=tid&63,r32=lane&31,hi=lane>>5; const int wid=__builtin_amdgcn_readfirstlane(tid>>6);
  const long rowbase=(long)b*SEQ; const int q0=qb*QB;
  const bf16*Qw=Q+(rowbase+q0+wid*QBLK)*QP+h*DQK;
  const bf16*Kh=K+rowbase*KP+h*DQK,*Vh=V+rowbase*VP+h*DV;
  const unsigned lds0=(unsigned)(uintptr_t)shm;
  float*wsf=(float*)(shm+LDS_WS)+wid*64;
  const char*Kb=uni_ptr(Kh); const char*Vb=uni_ptr(Vh);
  const unsigned koffA=(unsigned)(lane*KP+wid*8)*2u, koffB=(unsigned)(lane*KP+(8+(wid&3))*8)*2u;
  const unsigned voffV=(unsigned)((16*(wid&3)+(lane>>2))*VP+(wid>>2)*32+(lane&3)*8)*2u;
  const unsigned kdstA=lds0+LDS_K+wid*1024, kdstB=lds0+LDS_K+(8+(wid&3))*1024, vdst=lds0+LDS_V+wid*1024;
  #define KOF(s) ((s)+((s)>>1))
  #define DMA_K(t,slot) do{ const char*kt_=Kb+(size_t)(t)*(KVBLK*KP*2); glds16(kt_,koffA,(unsigned)__builtin_amdgcn_readfirstlane(kdstA+KOF(slot))); glds16(kt_,koffB,(unsigned)__builtin_amdgcn_readfirstlane(kdstB+KOF(slot))); }while(0)
  #define DMA_V(t,slot) glds16(Vb+(size_t)(t)*(KVBLK*VP*2),voffV,(unsigned)__builtin_amdgcn_readfirstlane(vdst+(slot)))
  const int vb0=(int)(lds0+LDS_V)+((lane>>4)&1)*32+(lane&3)*8+(4*hi+((lane&15)>>2))*64;
  const char*Kbase=shm+LDS_K; bf16x8 kf[12];
  const lds_cptr shm3=(lds_cptr)shm; const lds_cptr kp0=shm3+LDS_K+hi*1024+r32*16; const lds_cptr vp0=shm3+LDS_V+((lane>>4)&1)*32+(lane&3)*8+(4*hi+((lane&15)>>2))*64;
  const int NT=(q0+QB)/KVBLK;
  DMA_K(0,0);DMA_V(0,0);DMA_K(1,VSLOT);
  bf16x8 qr[6];
  { int lq=lane; asm volatile("":"+v"(lq));
    const bf16*qp=Qw+(long)(lq&31)*QP+(lq>>5)*8;
    _Pragma("unroll") for(int d0=0;d0<6;++d0)qr[d0]=*reinterpret_cast<const bf16x8*>(qp+d0*16); }
  float mhat=0.f,l_reg=0.f;f32x16 o[2];o[0]=f32x16{};o[1]=f32x16{};
  const int qrel=wid*QBLK+r32;
  #define CMASK(P0,P1,t) do{int jb_=(t)-(NT-4); if(jb_>=0)cmask(P0,P1,jb_,qrel,hi);}while(0)
  bool resc=false;
  #define START(P0,P1) do{ const float rm=rowmax(P0,P1); resc=false; \
    { const float dl=rm; mhat=fadd_s(mhat,dl); \
      _Pragma("unroll") for(int r=0;r<16;++r){P0[r]=fsub_s(P0[r],dl);P1[r]=fsub_s(P1[r],dl);} } \
    _Pragma("unroll") for(int r=0;r<16;++r)P0[r]=__builtin_amdgcn_exp2f(P0[r]); }while(0)
  #define RESC() do{ if(resc){ asm volatile("s_waitcnt lgkmcnt(0)":::"memory"); \
      _Pragma("unroll") for(int d_=0;d_<2;++d_) _Pragma("unroll") for(int r=0;r<16;++r)o[d_][r]*=wsf[crow(r,hi)]; } }while(0)
  f32x16 pA0,pA1,pB0,pB1;
  int sl_prev=0,sl_cur=0,sl_next=VSLOT;
  #define ROT() do{sl_prev=sl_cur;sl_cur=sl_next;sl_next=(sl_next==(NSLOT-1)*VSLOT)?0:sl_next+VSLOT;}while(0)
  DMA_K(2,2*VSLOT);
  WAIT_BAR(5);
  qkt(pA0,pA1,Kbase,qr,r32,hi);asm volatile("s_nop 15\n\ts_nop 7":"+v"(pA0),"+v"(pA1));CMASK(pA0,pA1,0);
  START(pA0,pA1);
  _Pragma("unroll") for(int r=0;r<16;++r)pA1[r]=__builtin_amdgcn_exp2f(pA1[r]);
  WAIT_BAR(0);
  DMA_K(3,0);DMA_V(1,VSLOT);
  ROT();
  kload12(kf,kp0+KOF(sl_cur));
  WAIT_BAR(3);
  s16x4 vlo[8],vhi[8]; u32x4 pw0,pw1,pw2,pw3;
  #define PKW(P,B) cvtpk_s(P[B],P[B+1])
  #define PAF(k) __builtin_bit_cast(bf16x8,pw##k)
  #define VFR(i) (bf16x8){vlo[i][0],vlo[i][1],vlo[i][2],vlo[i][3],vhi[i][0],vhi[i][1],vhi[i][2],vhi[i][3]}
  #define PIN(x) asm volatile("":"+v"(x))
  #define MX3(a,b,c) __builtin_fmaxf(__builtin_fmaxf((a),(b)),(c))
  #define GAPA(MF,A0,A1,A2,A3,W0,W1,PW) do{ MF; sacc+=A0; sacc+=A1; sacc+=A2; sacc+=A3; PIN(sacc); W0; W1; PIN(PW); SBAR(); }while(0)
  #define EX(v) __builtin_amdgcn_exp2f(v)
  #define GAPB(MF,X,B) do{ MF; X[B]=EX(X[B]); X[B+1]=EX(X[B+1]); X[B+2]=EX(X[B+2]); X[B+3]=EX(X[B+3]); PIN(X); SBAR(); }while(0)
  #define VRD(i) do{ vlo[i]=vtr(vp_+(((i)>>2)*4096+((i)&3)*1024)); vhi[i]=vtr(vp_+(((i)>>2)*4096+((i)&3)*1024+512)); }while(0)
  #define KRD(G,j) do{ if(G){ kload2(kf,kp0+KOF(sl_next),j); SBAR(); } }while(0)
  const f32x16 zero16=f32x16{};
  #define STEP(C0,C1,P0,P1,t,GK,GV,GL) do{ SBAR(); \
    const lds_cptr vp_=vp0+sl_prev; \
    float sacc=(P0[0]+P0[1]); \
    GAPA(C0=__builtin_amdgcn_mfma_f32_32x32x16_bf16(kf[0],qr[0],zero16,0,0,0), P0[2],P0[3],P0[4],P0[5],     pw0[0]=PKW(P0,0), pw0[1]=PKW(P0,2), pw0); \
    GAPA(C1=__builtin_amdgcn_mfma_f32_32x32x16_bf16(kf[1],qr[0],zero16,0,0,0), P0[6],P0[7],P0[8],P0[9],     pw0[2]=PKW(P0,4), pw0[3]=PKW(P0,6), pw0); \
    GAPA(C0=__builtin_amdgcn_mfma_f32_32x32x16_bf16(kf[2],qr[1],C0,0,0,0),   P0[10],P0[11],P0[12],P0[13], pw1[0]=PKW(P0,8), pw1[1]=PKW(P0,10), pw1); \
    GAPA(C1=__builtin_amdgcn_mfma_f32_32x32x16_bf16(kf[3],qr[1],C1,0,0,0),   P0[14],P0[15],P1[0],P1[1],   pw1[2]=PKW(P0,12),pw1[3]=PKW(P0,14), pw1); \
    GAPA(C0=__builtin_amdgcn_mfma_f32_32x32x16_bf16(kf[4],qr[2],C0,0,0,0),   P1[2],P1[3],P1[4],P1[5],     pw2[0]=PKW(P1,0), pw2[1]=PKW(P1,2), pw2); \
    GAPA(C1=__builtin_amdgcn_mfma_f32_32x32x16_bf16(kf[5],qr[2],C1,0,0,0),   P1[6],P1[7],P1[8],P1[9],     pw2[2]=PKW(P1,4), pw2[3]=PKW(P1,6), pw2); \
    GAPA(C0=__builtin_amdgcn_mfma_f32_32x32x16_bf16(kf[6],qr[3],C0,0,0,0),   P1[10],P1[11],P1[12],P1[13], pw3[0]=PKW(P1,8), pw3[1]=PKW(P1,10), pw3); \
    GAPA(C1=__builtin_amdgcn_mfma_f32_32x32x16_bf16(kf[7],qr[3],C1,0,0,0),   P1[14],P1[15],0.f,0.f,       pw3[2]=PKW(P1,12),pw3[3]=PKW(P1,14), pw3); \
    C0=__builtin_amdgcn_mfma_f32_32x32x16_bf16(kf[8],qr[4],C0,0,0,0); C1=__builtin_amdgcn_mfma_f32_32x32x16_bf16(kf[9],qr[4],C1,0,0,0); VRD(0); SBAR(); \
    C0=__builtin_amdgcn_mfma_f32_32x32x16_bf16(kf[10],qr[5],C0,0,0,0); C1=__builtin_amdgcn_mfma_f32_32x32x16_bf16(kf[11],qr[5],C1,0,0,0); VRD(4); SBAR(); \
    l_reg+=sacc; \
    _Pragma("unroll") for(int r=0;r<16;++r){C0[r]-=mhat;C1[r]-=mhat;} \
    if(GK){DMA_K((t)+3,sl_cur);} if(GV){DMA_V((t)+1,sl_next);} \
    CMASK(C0,C1,t); \
    { float a=MX3(C0[0],C0[1],C1[0]),b=MX3(C0[2],C0[3],C1[1]); a=MX3(a,C1[2],C1[3]); \
      _Pragma("unroll") for(int r=4;r<16;r+=4){a=MX3(a,C0[r],C0[r+1]);b=MX3(b,C0[r+2],C0[r+3]);a=MX3(a,C1[r],C1[r+1]);b=MX3(b,C1[r+2],C1[r+3]);} \
      float rm=__builtin_fmaxf(a,b); { auto rr=__builtin_amdgcn_permlane32_swap(__float_as_uint(rm),__float_as_uint(rm),false,false); rm=__builtin_fmaxf(__uint_as_float(rr[0]),__uint_as_float(rr[1])); } \
      resc=false; \
      if(__builtin_expect(__any(rm>(float)THRL),0)){ const float dl=__builtin_fmaxf(rm,0.f); mhat+=dl; \
        _Pragma("unroll") for(int r=0;r<16;++r){C0[r]-=dl;C1[r]-=dl;} \
        const float f=__builtin_amdgcn_exp2f(-dl); l_reg*=f; if(hi==0)wsf[r32]=f; resc=true; } } \
    SBAR(); \
    VRD(1); SBAR(); GAPB(o[0]=__builtin_amdgcn_mfma_f32_32x32x16_bf16(PAF(0),VFR(0),o[0],0,0,0), C0,0); \
    VRD(5); KRD(GL,0); GAPB(o[1]=__builtin_amdgcn_mfma_f32_32x32x16_bf16(PAF(0),VFR(4),o[1],0,0,0), C0,4); \
    VRD(2); KRD(GL,1); GAPB(o[0]=__builtin_amdgcn_mfma_f32_32x32x16_bf16(PAF(1),VFR(1),o[0],0,0,0), C0,8); \
    VRD(6); KRD(GL,2); GAPB(o[1]=__builtin_amdgcn_mfma_f32_32x32x16_bf16(PAF(1),VFR(5),o[1],0,0,0), C0,12); \
    VRD(3); KRD(GL,3); GAPB(o[0]=__builtin_amdgcn_mfma_f32_32x32x16_bf16(PAF(2),VFR(2),o[0],0,0,0), C1,0); \
    VRD(7); KRD(GL,4); GAPB(o[1]=__builtin_amdgcn_mfma_f32_32x32x16_bf16(PAF(2),VFR(6),o[1],0,0,0), C1,4); \
    KRD(GL,5); GAPB(o[0]=__builtin_amdgcn_mfma_f32_32x32x16_bf16(PAF(3),VFR(3),o[0],0,0,0), C1,8); \
    GAPB(o[1]=__builtin_amdgcn_mfma_f32_32x32x16_bf16(PAF(3),VFR(7),o[1],0,0,0), C1,12); \
    }while(0)
  int t=1;
  #undef CMASK
  #define CMASK(P0,P1,t) do{}while(0)
  for(;t+5<NT;t+=2){
    STEP(pB0,pB1,pA0,pA1,t,true,true,true);     WAIT_BAR(3); RESC(); ROT();
    STEP(pA0,pA1,pB0,pB1,t+1,true,true,true);   WAIT_BAR(3); RESC(); ROT();
  }
  #undef CMASK
  #define CMASK(P0,P1,t) do{int jb_=(t)-(NT-4); if(jb_>=0)cmask(P0,P1,jb_,qrel,hi);}while(0)
  #define ENDW(tt) do{ if((tt)+3<NT){WAIT_BAR(3);} else if((tt)+2<NT){WAIT_BAR(1);} else {WAIT_BAR(0);} }while(0)
  for(;t+1<NT;t+=2){
    STEP(pB0,pB1,pA0,pA1,t,(t+3<NT),(t+1<NT),(t+1<NT));       ENDW(t);   RESC(); ROT();
    STEP(pA0,pA1,pB0,pB1,t+1,(t+4<NT),(t+2<NT),(t+2<NT));     ENDW(t+1); RESC(); ROT();
  }
  STEP(pB0,pB1,pA0,pA1,NT-1,false,false,false); RESC();
  { float sacc=pB0[0]+pB0[1]; _Pragma("unroll") for(int r=2;r<16;++r)sacc+=pB0[r]; _Pragma("unroll") for(int r=0;r<16;++r)sacc+=pB1[r]; l_reg+=sacc;
    pw0=(u32x4){PKW(pB0,0),PKW(pB0,2),PKW(pB0,4),PKW(pB0,6)};pw1=(u32x4){PKW(pB0,8),PKW(pB0,10),PKW(pB0,12),PKW(pB0,14)};pw2=(u32x4){PKW(pB1,0),PKW(pB1,2),PKW(pB1,4),PKW(pB1,6)};pw3=(u32x4){PKW(pB1,8),PKW(pB1,10),PKW(pB1,12),PKW(pB1,14)};
    SBAR(); pv(o,vb0+sl_cur,PAF(0),PAF(1),PAF(2),PAF(3)); }
  #undef PKW
  #undef PAF
  #undef VFR
  #undef PIN
  #undef MX3
  #undef GAPA
  #undef GAPB
  #undef EX
  #undef VRD
  #undef KRD
  #undef STEP
  #undef ENDW
  {auto rr=__builtin_amdgcn_permlane32_swap(__float_as_uint(l_reg),__float_as_uint(l_reg),false,false);l_reg=__uint_as_float(rr[0])+__uint_as_float(rr[1]);}
  if(hi==0)wsf[32+r32]=l_reg;asm volatile("s_waitcnt lgkmcnt(0)":::"memory");
  float rli[16];
  #pragma unroll
  for(int r=0;r<16;++r)rli[r]=__builtin_amdgcn_rcpf(wsf[32+crow(r,hi)]);
  bf16*Ow=O+(rowbase+q0+wid*QBLK)*OP+h*DV;
  { bf16*stg=(bf16*)(shm+LDS_OST)+wid*2048;
    #pragma unroll
    for(int r=0;r<16;++r){const int orow=crow(r,hi);
      #pragma unroll
      for(int d0=0;d0<2;++d0)stg[orow*64+d0*32+r32]=__float2bfloat16(o[d0][r]*rli[r]);}
    asm volatile("s_waitcnt lgkmcnt(0)":::"memory");
    int lo_=lane; asm volatile("":"+v"(lo_));
    #pragma unroll
    for(int i=0;i<4;++i){const int row=i*8+(lo_>>3),ch=lo_&7; const u32x4 v=*(const u32x4*)(stg+row*64+ch*8); *(u32x4*)(Ow+(long)row*OP+ch*8)=v;} }
  asm volatile("s_waitcnt lgkmcnt(0)\n\ts_barrier":::"memory");
  #undef DMA_K
  #undef DMA_V
  #undef KOF
  #undef CMASK
  #undef START
  #undef RESC
  #undef ROT
}
#undef WAIT_BAR
}

constexpr int NWAVES = 8;
constexpr int BATCH = 16, SEQ = 4096, D = 1024, T = BATCH * SEQ;
constexpr int IN_COLS = 4768, N1 = 4864;
constexpr int MEM_LEN = 256, MROWS = BATCH * MEM_LEN;
constexpr int NEXP = 32, TOPK = 4, DFF = 1024, LISTCAP = T;
constexpr int ACT_TILES_MAX = (T * TOPK) / 256 + NEXP;
constexpr float EPS = 1e-6f;
constexpr float C2_MLA = 0.10206207261596575f * 1.4426950408889634f;
constexpr float C2_X = 0.08838834764831845f * 1.4426950408889634f;
constexpr int PER_PHASE = 11;
constexpr int N_LAUNCHES = MK_N_LAUNCHES;

constexpr size_t MiB = 1u << 20;
constexpr size_t WS_CTL = 0, CTL_ZERO_BYTES = 1 * MiB;
constexpr size_t WS_LIST = 1 * MiB;
constexpr size_t WS_TOKG = 9 * MiB;
constexpr size_t WS_RSTD2 = 10 * MiB;
constexpr size_t WS_W1T = 9 * MiB;
constexpr size_t WS_WUQ = 19 * MiB;
constexpr size_t WS_WUKV = 20 * MiB;
constexpr size_t WS_WMEM = 21 * MiB;
constexpr size_t WS_WPOOL = 23 * MiB;
constexpr size_t WS_WMO = 24 * MiB, WS_WCO = 25 * MiB;
constexpr size_t WS_WO = 26 * MiB;
constexpr size_t WS_MEMN = 28 * MiB;
constexpr size_t WS_KVMK = 36 * MiB;
constexpr size_t WS_VTG = 40 * MiB;
constexpr size_t WS_HN = 64 * MiB;
constexpr size_t WS_V = 64 * MiB, WS_MIXED = 128 * MiB;
constexpr size_t WS_GATES = 192 * MiB;
constexpr size_t WS_U = 576 * MiB, WS_AO = 576 * MiB;
constexpr size_t WS_CQKV = 640 * MiB, WS_CO = 640 * MiB;
constexpr size_t WS_QX = 736 * MiB;
constexpr size_t WS_Q = 800 * MiB;
constexpr size_t WS_KV = 896 * MiB, WS_MERGED = 896 * MiB;
constexpr size_t WS_HN2 = 16 * MiB;
constexpr size_t WS_WEI = 144 * MiB;
constexpr size_t WS_Y = 16 * MiB;
constexpr size_t WS_ACT = 400 * MiB;
constexpr size_t WS_WEO = 928 * MiB;
constexpr size_t WS_END = 992 * MiB;
static_assert(WS_ACT + (size_t)ACT_TILES_MAX * 256 * 1024 * 2 <= WS_WEO && WS_Y + (size_t)T * 3 * 1024 * 2 <= WS_ACT && WS_WEI + (size_t)NEXP * 2048 * 1024 * 2 <= WS_ACT, "late map");
static_assert(WS_W1T + (size_t)N1 * 1024 * 2 <= WS_WUQ && WS_VTG + 4 * MiB <= WS_HN && WS_GATES + (size_t)T * 3072 * 2 <= WS_U && WS_CQKV + (size_t)T * 768 * 2 <= WS_QX && WS_Q + (size_t)T * 768 * 2 <= WS_KV, "early map");
constexpr int CW_TMO = 0, CW_CODE = 1;
constexpr int CW_BAR = 4096;
constexpr int CW_GCNT = 16384;
constexpr int RING_OFF = 0, RING_BYTES = 131072;
constexpr int LDSCTL_OFF = RING_BYTES, MISC_OFF = LDSCTL_OFF + 320;
constexpr int LX_TSTART = LDSCTL_OFF + 512;
constexpr int LX_CNT = LDSCTL_OFF + 768;
constexpr int LX_LCNT = LDSCTL_OFF + 1024;
constexpr int LX_BASE = LDSCTL_OFF + 1280;
constexpr int LX_XWS = LDSCTL_OFF + 2048;
constexpr int LX_STASH = LDSCTL_OFF + 4096;
constexpr int LX_GATE = LDSCTL_OFF + 8192;
constexpr int LDS_BYTES = 147456;
static_assert(LX_GATE + 4096 <= LDS_BYTES && mla::LDS_BYTES <= RING_BYTES, "LDS map");

#define GAS __attribute__((address_space(1)))
#define LAS __attribute__((address_space(3)))
typedef unsigned short bf16;
typedef unsigned v4u __attribute__((ext_vector_type(4)));
typedef unsigned v2u __attribute__((ext_vector_type(2)));
typedef float f32x4 __attribute__((ext_vector_type(4)));
typedef float f32x16 __attribute__((ext_vector_type(16)));
typedef short bf16x8 __attribute__((ext_vector_type(8)));
typedef GAS unsigned gu32;
#define RLX_AGENT __ATOMIC_RELAXED, __HIP_MEMORY_SCOPE_AGENT
#define LDS_WAIT() asm volatile("s_waitcnt lgkmcnt(0)" ::: "memory")
#define VM_WAIT() asm volatile("s_waitcnt vmcnt(0)" ::: "memory")
__device__ __forceinline__ unsigned f2bf(float f) { unsigned u = __builtin_bit_cast(unsigned, f); return (u + 0x7fffu + ((u >> 16) & 1u)) >> 16; }
__device__ __forceinline__ unsigned pk2(float lo, float hi) { return pg8::cvt_pk_bf16(lo, hi); }
__device__ __forceinline__ float bflo(unsigned w) { return __uint_as_float(w << 16); }
__device__ __forceinline__ float bfhi(unsigned w) { return __uint_as_float(w & 0xffff0000u); }

#define XB_TMO      128
#define XB_XCNT(j)  (256  + 64 * (j))
#define XB_XSUB(j)  (1280 + 64 * (j))
#define XB_XGEN(j)  (2304 + 64 * (j))
#define XB_TOP      3328
#define XB_TOPGEN   3392
#define XCD_BAR_WORDS 3456
#define XB_SPIN_CAP (1u << 18)
__device__ __forceinline__ unsigned xb_ld(unsigned* p)              { return __hip_atomic_load(p, __ATOMIC_RELAXED, __HIP_MEMORY_SCOPE_AGENT); }
__device__ __forceinline__ unsigned xb_add(unsigned* p, unsigned v) { return __hip_atomic_fetch_add(p, v, __ATOMIC_RELAXED, __HIP_MEMORY_SCOPE_AGENT); }
__device__ __forceinline__ unsigned xb_xcc_id() { return (unsigned)__builtin_amdgcn_s_getreg((3 << 11) | 20) & 0xFu; }
#define XB_SPIN(cond, bar) do { unsigned _sp = 0; while (cond) { __builtin_amdgcn_s_sleep(1); \
    if ((++_sp & 255u) == 0u) { if (xb_ld(&(bar)[XB_TMO])) break; if (_sp > XB_SPIN_CAP) { atomicAdd(&(bar)[XB_TMO], 1u); break; } } } } while (0)
struct XcdBarrier { unsigned* bar; unsigned x; volatile LAS unsigned* st; };
__device__ __forceinline__ XcdBarrier xcd_barrier_post(unsigned* bar, volatile LAS unsigned* st, const bool thread0) {
    XcdBarrier b; b.bar = bar; b.x = xb_xcc_id(); b.st = st;
    if (thread0) (void)xb_add(&bar[XB_XCNT(b.x)], 1u);
    return b;
}
__device__ __forceinline__ void xcd_barrier_complete(unsigned* bar, unsigned x, unsigned& nloc, unsigned& nx) {
    const unsigned G = gridDim.x * gridDim.y * gridDim.z;
    unsigned sum, cnt, mine, sp = 0u;
    for (;;) {
        sum = 0u; cnt = 0u; mine = 0u;
#pragma unroll
        for (unsigned j = 0; j < 16; ++j) { const unsigned c = xb_ld(&bar[XB_XCNT(j)]); sum += c; cnt += (c > 0u) ? 1u : 0u; mine = (j == x) ? c : mine; }
        if (sum == G) break;
        __builtin_amdgcn_s_sleep(1);
        if ((++sp & 255u) == 0u) { if (xb_ld(&bar[XB_TMO])) break; if (sp > XB_SPIN_CAP) { atomicAdd(&bar[XB_TMO], 1u); break; } }
    }
    nloc = mine > 0u ? mine : 1u; nx = cnt > 0u ? cnt : 1u;
}
__device__ __forceinline__ void xcd_barrier(const XcdBarrier& b, const bool thread0) {
    asm volatile("s_waitcnt vmcnt(0)" ::: "memory");
    __syncthreads();
    if (thread0) {
        unsigned* bar = b.bar;
        __builtin_amdgcn_s_waitcnt(0);
        unsigned nloc = b.st[0], nx = b.st[1];
        if (nloc == 0u) { xcd_barrier_complete(bar, b.x, nloc, nx); b.st[0] = nloc; b.st[1] = nx; }
        const unsigned old = xb_add(&bar[XB_XSUB(b.x)], 1u);
        const unsigned gen = old / nloc;
        if (old + 1u == (gen + 1u) * nloc) {
            __builtin_amdgcn_fence(__ATOMIC_RELEASE, "agent");
            asm volatile("s_waitcnt vmcnt(0)" ::: "memory");
            const unsigned og = xb_add(&bar[XB_TOP], 1u);
            const unsigned tg = og / nx;
            if (og + 1u == (tg + 1u) * nx) xb_add(&bar[XB_TOPGEN], 1u);
            else XB_SPIN(xb_ld(&bar[XB_TOPGEN]) == tg, bar);
            __builtin_amdgcn_fence(__ATOMIC_ACQUIRE, "agent");
            xb_add(&bar[XB_XGEN(b.x)], 1u);
            asm volatile("s_waitcnt vmcnt(0)" ::: "memory");
        } else {
            XB_SPIN(xb_ld(&bar[XB_XGEN(b.x)]) == gen, bar);
            __builtin_amdgcn_fence(__ATOMIC_ACQUIRE, "agent");
            asm volatile("s_waitcnt vmcnt(0)" ::: "memory");
        }
    }
    __syncthreads();
}

struct Frame {
    LAS unsigned char* lds;
    volatile LAS unsigned* MISC;
    gu32* ctl;
    int tid, lane, wave;
    int vcu, G;
    unsigned char* ws;
    const float* const* in;
    float* out;
};
__device__ __forceinline__ float wave_sum(float v) {
#pragma unroll
    for (int o = 1; o < 64; o <<= 1) v += __shfl_xor(v, o);
    return v;
}
__device__ __forceinline__ float sumsq8(v4u w) {
    float s = 0.f;
#pragma unroll
    for (int i = 0; i < 4; ++i) { const float a = bflo(w[i]), b = bfhi(w[i]); s += a * a + b * b; }
    return s;
}
__device__ __forceinline__ void transpose_item(const float* W, int ldw, int srccol, const float* ks, bf16* WT, int K, int nrow0, int k0, LAS float* scr, int lane) {
    float v[32];
#pragma unroll
    for (int i = 0; i < 32; ++i) { const int kk = 2 * i + (lane >> 5); v[i] = (srccol >= 0) ? W[(size_t)(k0 + kk) * ldw + srccol + (lane & 31)] : 0.f; }
    if (ks) {
#pragma unroll
        for (int i = 0; i < 32; ++i) v[i] *= ks[k0 + 2 * i + (lane >> 5)]; }
#pragma unroll
    for (int i = 0; i < 32; ++i) scr[(2 * i + (lane >> 5)) * 33 + (lane & 31)] = v[i];
    LDS_WAIT(); asm volatile("" ::: "memory");
    const int c = lane & 7;
#pragma unroll
    for (int j = 0; j < 4; ++j) { const int n = (lane >> 3) + 8 * j; const LAS float* s = scr + (8 * c) * 33 + n;
        v4u o; o.x = pk2(s[0 * 33], s[1 * 33]); o.y = pk2(s[2 * 33], s[3 * 33]); o.z = pk2(s[4 * 33], s[5 * 33]); o.w = pk2(s[6 * 33], s[7 * 33]);
        *(GAS v4u*)(WT + (size_t)(nrow0 + n) * K + k0 + 8 * c) = o; }
    LDS_WAIT(); asm volatile("" ::: "memory");
}
template <int NR> __device__ __forceinline__ void rms_rows_to_bf16(int lane, const float* x0, size_t xstride, const f32x4 (&gg)[4], bf16* o0, size_t ostride) {
    f32x4 v[NR][4];
#pragma unroll
    for (int r = 0; r < NR; ++r) { const GAS f32x4* xr = (const GAS f32x4*)(x0 + r * xstride) + lane;
#pragma unroll
        for (int j = 0; j < 4; ++j) v[r][j] = xr[64 * j]; }
#pragma unroll
    for (int r = 0; r < NR; ++r) { float s = 0.f;
#pragma unroll
        for (int j = 0; j < 4; ++j) s += (v[r][j].x * v[r][j].x + v[r][j].y * v[r][j].y) + (v[r][j].z * v[r][j].z + v[r][j].w * v[r][j].w);
        const float rstd = 1.0f / sqrtf(wave_sum(s) * (1.f / 1024.f) + EPS);
        GAS unsigned long long* o8 = (GAS unsigned long long*)(o0 + r * ostride) + lane;
#pragma unroll
        for (int j = 0; j < 4; ++j)
            o8[64 * j] = (unsigned long long)pk2(v[r][j].x * rstd * gg[j].x, v[r][j].y * rstd * gg[j].y) | ((unsigned long long)pk2(v[r][j].z * rstd * gg[j].z, v[r][j].w * rstd * gg[j].w) << 32); }
}
__device__ __forceinline__ void rms_rows_all(int lane, int gw, int NGW, const float* X, const float* g, bf16* O, int nrows) {
    f32x4 gg[4];
#pragma unroll
    for (int j = 0; j < 4; ++j) gg[j] = ((const GAS f32x4*)g + lane)[64 * j];
    int m = gw;
    for (; m + 3 * NGW < nrows; m += 4 * NGW) rms_rows_to_bf16<4>(lane, X + (size_t)m * D, (size_t)NGW * D, gg, O + (size_t)m * D, (size_t)NGW * D);
    for (; m < nrows; m += NGW) rms_rows_to_bf16<1>(lane, X + (size_t)m * D, 0, gg, O + (size_t)m * D, 0);
}

enum { I_X = 0, I_MEM, I_POS, I_GATTN, I_WIN, I_WPOOL, I_PSCALE, I_GQL, I_WUQ, I_GKVL, I_WUKV, I_GQM, I_GKM, I_GMEM, I_WMEMKV, I_GQC, I_GKC, I_WPO, I_WMO, I_WCO, I_WO, I_GFFN,
       I_WR, I_BR, I_WEI, I_BEI, I_WEO, I_BEO, N_IN };

__device__ __forceinline__ int fresh_lane() { int l; asm volatile("v_mbcnt_lo_u32_b32 %0, -1, 0\n\tv_mbcnt_hi_u32_b32 %0, -1, %0" : "=v"(l)); return l; }
#define REFRESH(F) do { int w_ = (F).wave; asm volatile("" : "+s"(w_)); (F).wave = w_; (F).lane = fresh_lane(); (F).tid = w_ * 64 + (F).lane; } while (0)
__device__ __forceinline__ void p0_prologue(Frame& F) {
    LAS float* scr = (LAS float*)(F.lds + RING_OFF + F.wave * 16384);
    const int gw = F.vcu * NWAVES + F.wave, NGW = F.G * NWAVES, lane = F.lane;
    unsigned char* ws = F.ws;
    constexpr int I1 = 16 * (N1 / 32), I2 = 6 * 24, I3 = 4 * 32, I4 = 16 * 32, I5 = 8 * 32, I6 = 8 * 32, I7 = 16 * 32;
    constexpr int NITEMS = I1 + I2 + I3 + I4 + I5 + I6 + I7;
    for (int it = gw; it < NITEMS; it += NGW) {
        int r = it;
        if (r < I1) { const int nnb = N1 / 32, kb = r / nnb, nb = r % nnb, n0 = nb * 32; const int src = n0 < 1184 ? n0 : (n0 < 1280 ? -1 : n0 - 96);
            transpose_item(F.in[I_WIN], IN_COLS, src, nullptr, (bf16*)(ws + WS_W1T), 1024, n0, kb * 64, scr, lane); continue; } r -= I1;
        if (r < I2) { const int kb = r / 24, nb = r % 24; transpose_item(F.in[I_WUQ], 768, nb * 32, F.in[I_GQL], (bf16*)(ws + WS_WUQ), 384, nb * 32, kb * 64, scr, lane); continue; } r -= I2;
        if (r < I3) { const int kb = r / 32, nb = r % 32; transpose_item(F.in[I_WUKV], 1024, nb * 32, F.in[I_GKVL], (bf16*)(ws + WS_WUKV), 256, nb * 32, kb * 64, scr, lane); continue; } r -= I3;
        if (r < I4) { const int kb = r / 32, nb = r % 32; transpose_item(F.in[I_WMEMKV], 1024, nb * 32, nullptr, (bf16*)(ws + WS_WMEM), 1024, nb * 32, kb * 64, scr, lane); continue; } r -= I4;
        if (r < I5) { const int kb = r / 32, nb = r % 32; transpose_item(F.in[I_WMO], 1024, nb * 32, nullptr, (bf16*)(ws + WS_WMO), 512, nb * 32, kb * 64, scr, lane); continue; } r -= I5;
        if (r < I6) { const int kb = r / 32, nb = r % 32; transpose_item(F.in[I_WCO], 1024, nb * 32, nullptr, (bf16*)(ws + WS_WCO), 512, nb * 32, kb * 64, scr, lane); continue; } r -= I6;
        { const int kb = r / 32, nb = r % 32; transpose_item(F.in[I_WO], 1024, nb * 32, nullptr, (bf16*)(ws + WS_WO), 1024, nb * 32, kb * 64, scr, lane); }
    }
    for (int it = gw; it < 2048; it += NGW) {
        const int kc = it >> 2, dq = it & 3, g = kc >> 7; const float* wp = F.in[I_WPOOL] + (size_t)kc * 128; const float* ps = F.in[I_PSCALE] + g * 128; const float* wpo = F.in[I_WPO] + (size_t)(g * 128) * 1024 + dq * 256 + lane;
        float a[4] = {0.f, 0.f, 0.f, 0.f};
#pragma unroll 8
        for (int j = 0; j < 128; ++j) { const float sc = wp[j] * ps[j]; const float* row = wpo + (size_t)j * 1024;
#pragma unroll
            for (int i = 0; i < 4; ++i) a[i] += sc * row[64 * i]; }
        bf16* wt = (bf16*)(ws + WS_WPOOL);
#pragma unroll
        for (int i = 0; i < 4; ++i) wt[(size_t)(dq * 256 + lane + 64 * i) * 512 + kc] = (bf16)f2bf(a[i]);
    }
    rms_rows_all(lane, gw, NGW, F.in[I_X], F.in[I_GATTN], (bf16*)(ws + WS_HN), T);
    rms_rows_all(lane, gw, NGW, F.in[I_MEM], F.in[I_GMEM], (bf16*)(ws + WS_MEMN), MROWS);
}

using pg8::Unit; using pg8::bf16_t;
struct DenseSched {
    int nM, nN, G, c; const char* A; const char* B; size_t tA, tB;
    __device__ __forceinline__ void init(const void* A_, int lda, const void* B_, int ldb, int M, int N, int G_, int c_) { A = (const char*)A_; B = (const char*)B_; nM = M / 256; nN = N / 256; G = G_; c = c_; tA = (size_t)256 * lda * 2; tB = (size_t)256 * ldb * 2; }
    __device__ __forceinline__ bool next(int i, Unit& u) const {
        const long L = (long)i * G + c; if (L >= (long)nM * nN) return false;
        pg8::tile_order((int)L, nM, nN, u.pm, u.pn); u.A = A + (size_t)u.pm * tA; u.B = B + (size_t)u.pn * tB; u.aux = 0; return true; }
};
struct EpiStore {
    static constexpr bool PERM = true;
    bf16_t* O; int ldc;
    __device__ __forceinline__ void operator()(const pg8::f32x4 (&acc)[2][2][4][2], const Unit& u, int wr, int wc, int fr_, int fq_) const {
        int fr = fr_, fq = fq_; asm volatile("" : "+v"(fr), "+v"(fq));
        const int row0 = u.pm * 256 + wr * 64 + fr, col0 = u.pn * 256 + wc * 32 + 8 * fq;
#pragma unroll
        for (int ai = 0; ai < 2; ++ai)
#pragma unroll
            for (int m = 0; m < 4; ++m) { bf16_t* rowp = O + (size_t)(row0 + ai * 128 + m * 16) * ldc + col0;
#pragma unroll
                for (int bj = 0; bj < 2; ++bj) { const pg8::f32x4 v0 = acc[ai][bj][m][0], v1 = acc[ai][bj][m][1]; pg8::u32x4 w;
                    w.x = pg8::cvt_pk_bf16(v0[0], v0[1]); w.y = pg8::cvt_pk_bf16(v0[2], v0[3]); w.z = pg8::cvt_pk_bf16(v1[0], v1[1]); w.w = pg8::cvt_pk_bf16(v1[2], v1[3]);
                    *(pg8::u32x4*)(rowp + bj * 128) = w; } }
    }
};
struct EpiP1 {
    static constexpr bool PERM = true;
    bf16_t *U, *CQKV, *QX, *GATES;
    __device__ __forceinline__ void operator()(const pg8::f32x4 (&acc)[2][2][4][2], const Unit& u, int wr, int wc, int fr_, int fq_) const {
        int fr = fr_, fq = fq_; asm volatile("" : "+v"(fr), "+v"(fq));
        const int pn = u.pn; bf16_t* base; int ldc, colt; bool sg = false;
        if (pn < 2) { base = U; ldc = 512; colt = pn * 256; } else if (pn < 5) { base = CQKV; ldc = 768; colt = (pn - 2) * 256; }
        else if (pn < 7) { base = QX; ldc = 512; colt = (pn - 5) * 256; } else { base = GATES; ldc = 3072; colt = (pn - 7) * 256; sg = true; }
        const int row0 = u.pm * 256 + wr * 64 + fr, col0 = colt + wc * 32 + 8 * fq;
#pragma unroll
        for (int ai = 0; ai < 2; ++ai)
#pragma unroll
            for (int m = 0; m < 4; ++m) { bf16_t* rowp = base + (size_t)(row0 + ai * 128 + m * 16) * ldc + col0;
#pragma unroll
                for (int bj = 0; bj < 2; ++bj) { pg8::f32x4 v0 = acc[ai][bj][m][0], v1 = acc[ai][bj][m][1];
                    if (sg) {
#pragma unroll
                        for (int i = 0; i < 4; ++i) { v0[i] = pg8::sigmoidf_fast(v0[i]); v1[i] = pg8::sigmoidf_fast(v1[i]); } }
                    pg8::u32x4 w; w.x = pg8::cvt_pk_bf16(v0[0], v0[1]); w.y = pg8::cvt_pk_bf16(v0[2], v0[3]); w.z = pg8::cvt_pk_bf16(v1[0], v1[1]); w.w = pg8::cvt_pk_bf16(v1[2], v1[3]);
                    *(pg8::u32x4*)(rowp + bj * 128) = w; } }
    }
};
struct EpiMemKV {
    static constexpr bool PERM = true;
    bf16_t *KVMK, *VTG;
    __device__ __forceinline__ void operator()(const pg8::f32x4 (&acc)[2][2][4][2], const Unit& u, int wr, int wc, int fr_, int fq_) const {
        int fr = fr_, fq = fq_; asm volatile("" : "+v"(fr), "+v"(fq));
        const int row0 = u.pm * 256 + wr * 64 + fr;
        if (u.pn < 2) {
            const int col0 = u.pn * 256 + wc * 32 + 8 * fq;
#pragma unroll
            for (int ai = 0; ai < 2; ++ai)
#pragma unroll
                for (int m = 0; m < 4; ++m) { bf16_t* rowp = KVMK + (size_t)(row0 + ai * 128 + m * 16) * 512 + col0;
#pragma unroll
                    for (int bj = 0; bj < 2; ++bj) { const pg8::f32x4 v0 = acc[ai][bj][m][0], v1 = acc[ai][bj][m][1]; pg8::u32x4 w;
                        w.x = pg8::cvt_pk_bf16(v0[0], v0[1]); w.y = pg8::cvt_pk_bf16(v0[2], v0[3]); w.z = pg8::cvt_pk_bf16(v1[0], v1[1]); w.w = pg8::cvt_pk_bf16(v1[2], v1[3]);
                        *(pg8::u32x4*)(rowp + bj * 128) = w; } }
        } else {
#pragma unroll
            for (int ai = 0; ai < 2; ++ai)
#pragma unroll
                for (int m = 0; m < 4; ++m) { const int row = row0 + ai * 128 + m * 16, b = row >> 8, mm = row & 255;
                    const int pos = (mm & ~12) | ((mm & 4) << 1) | ((mm & 8) >> 1);
#pragma unroll
                    for (int bj = 0; bj < 2; ++bj) { const int hc = (u.pn - 2) * 2 + bj;
                        bf16_t* dst = VTG + ((size_t)(b * 4 + hc) * 128 + wc * 32 + 8 * fq) * 256 + pos;
#pragma unroll
                        for (int n = 0; n < 2; ++n)
#pragma unroll
                            for (int i = 0; i < 4; ++i) dst[(size_t)(4 * n + i) * 256] = (bf16_t)f2bf(acc[ai][bj][m][n][i]); } }
        }
    }
};
struct MergeSched {
    int G, c; const char *A0, *B0; long dA1, dA2, dB1, dB2;
    __device__ __forceinline__ bool next(int i, Unit& u) const {
        const int ti = i / 3, br = i - 3 * ti; const long L = (long)ti * G + c; if (L >= 256 * 4) return false;
        pg8::tile_order((int)L, 256, 4, u.pm, u.pn); u.aux = br;
        const long b1 = br & 1, b2 = br >> 1;
        u.A = A0 + b1 * dA1 + b2 * dA2 + (size_t)u.pm * (256 * 512 * 2); u.B = B0 + b1 * dB1 + b2 * dB2 + (size_t)u.pn * (256 * 512 * 2); return true; }
};
struct EpiMerge {
    static constexpr bool PERM = true;
    const bf16_t* GATES; bf16_t* MERGED;
    __device__ __forceinline__ void operator()(const pg8::f32x4 (&acc)[2][2][4][2], const Unit& u, int wr, int wc, int fr_, int fq_) const {
        int fr = fr_, fq = fq_; asm volatile("" : "+v"(fr), "+v"(fq));
        const int br = u.aux, row0 = u.pm * 256 + wr * 64 + fr, col0 = u.pn * 256 + wc * 32 + 8 * fq;
#pragma unroll
        for (int ai = 0; ai < 2; ++ai)
#pragma unroll
            for (int m = 0; m < 4; ++m) { const size_t row = (size_t)(row0 + ai * 128 + m * 16);
#pragma unroll
                for (int bj = 0; bj < 2; ++bj) { const int c0 = col0 + bj * 128;
                    const pg8::u32x4 g = *(const pg8::u32x4*)(GATES + row * 3072 + br * 1024 + c0);
                    pg8::f32x4 v0 = acc[ai][bj][m][0], v1 = acc[ai][bj][m][1];
                    v0[0] *= bflo(g.x); v0[1] *= bfhi(g.x); v0[2] *= bflo(g.y); v0[3] *= bfhi(g.y); v1[0] *= bflo(g.z); v1[1] *= bfhi(g.z); v1[2] *= bflo(g.w); v1[3] *= bfhi(g.w);
                    bf16_t* dst = MERGED + row * 1024 + c0;
                    if (br > 0) { const pg8::u32x4 p = *(const pg8::u32x4*)dst;
                        v0[0] += bflo(p.x); v0[1] += bfhi(p.x); v0[2] += bflo(p.y); v0[3] += bfhi(p.y); v1[0] += bflo(p.z); v1[1] += bfhi(p.z); v1[2] += bflo(p.w); v1[3] += bfhi(p.w); }
                    pg8::u32x4 w; w.x = pg8::cvt_pk_bf16(v0[0], v0[1]); w.y = pg8::cvt_pk_bf16(v0[2], v0[3]); w.z = pg8::cvt_pk_bf16(v1[0], v1[1]); w.w = pg8::cvt_pk_bf16(v1[2], v1[3]);
                    *(pg8::u32x4*)dst = w; } }
    }
};
struct EpiResF32 {
    static constexpr bool PERM = false;
    const float* X; float* O;
    __device__ __forceinline__ void operator()(const pg8::f32x4 (&acc)[2][2][4][2], const Unit& u, int wr, int wc, int fr_, int fq_) const {
        int fr = fr_, fq = fq_; asm volatile("" : "+v"(fr), "+v"(fq));
        const int row0 = u.pm * 256 + wr * 64 + fr, col0 = u.pn * 256 + wc * 32 + 4 * fq;
#pragma unroll
        for (int ai = 0; ai < 2; ++ai)
#pragma unroll
            for (int m = 0; m < 4; ++m) { const size_t off = (size_t)(row0 + ai * 128 + m * 16) * 1024 + col0;
#pragma unroll
                for (int bj = 0; bj < 2; ++bj)
#pragma unroll
                    for (int n = 0; n < 2; ++n) { const pg8::f32x4 xv = *(const pg8::f32x4*)(X + off + bj * 128 + n * 16); *(pg8::f32x4*)(O + off + bj * 128 + n * 16) = xv + acc[ai][bj][m][n]; } }
    }
};
struct MoeSched {
    int G, c, nM, nN; const LAS int* tstart; const LAS int* cnt; const int* list; const char* A; const char* B; size_t bexp, tB, tA; bool gather;
    __device__ __forceinline__ bool next(int i, Unit& u) const {
        const long L = (long)i * G + c; if (L >= (long)nM * nN) return false;
        int pm, pn; pg8::tile_order((int)L, nM, nN, pm, pn);
        int e = 0; while (e < NEXP - 1 && __builtin_amdgcn_readfirstlane(tstart[e + 1]) <= pm) ++e;
        const int ts = __builtin_amdgcn_readfirstlane(tstart[e]);
        u.pm = pm; u.pn = pn; u.aux = e | ((pm - ts) << 8);
        u.A = gather ? A : A + (size_t)pm * tA; u.B = B + (size_t)e * bexp + (size_t)pn * tB; return true; }
    __device__ __forceinline__ unsigned row_off(const Unit& u, int row) const {
        const int e = u.aux & 255, idx = (u.aux >> 8) * 256 + row; const int ent = idx < cnt[e] ? list[(size_t)e * LISTCAP + idx] : 0; return (unsigned)(ent >> 2) * 2048u; }
};
struct EpiMoeIn {
    static constexpr bool PERM = true;
    const LAS int* cnt; const int* list; const float* rstd2; const float* bin; bf16_t* ACT;
    __device__ __forceinline__ void operator()(const pg8::f32x4 (&acc)[2][2][4][2], const Unit& u, int wr, int wc, int fr_, int fq_) const {
        int fr = fr_, fq = fq_; asm volatile("" : "+v"(fr), "+v"(fq));
        const int e = u.aux & 255, rt = u.aux >> 8, ce = cnt[e], j0 = u.pn * 128 + wc * 32 + 8 * fq;
        const float* bg = bin + (size_t)e * 2048 + j0; const pg8::f32x4 bg0 = *(const pg8::f32x4*)bg, bg1 = *(const pg8::f32x4*)(bg + 4), bl0 = *(const pg8::f32x4*)(bg + 1024), bl1 = *(const pg8::f32x4*)(bg + 1028);
#pragma unroll
        for (int ai = 0; ai < 2; ++ai)
#pragma unroll
            for (int m = 0; m < 4; ++m) { const int rl = ai * 128 + wr * 64 + m * 16 + fr, idx = rt * 256 + rl; float rs = 0.f;
                if (idx < ce) rs = rstd2[list[(size_t)e * LISTCAP + idx] >> 2];
                float a[8];
#pragma unroll
                for (int n = 0; n < 2; ++n)
#pragma unroll
                    for (int i = 0; i < 4; ++i) { float gl = acc[ai][0][m][n][i] * rs + (n ? bg1[i] : bg0[i]), li = acc[ai][1][m][n][i] * rs + (n ? bl1[i] : bl0[i]);
                        gl = fminf(gl, 7.0f); li = fminf(fmaxf(li, -7.0f), 7.0f);
                        a[4 * n + i] = gl * pg8::sigmoidf_fast(1.702f * gl) * (li + 1.0f); }
                pg8::u32x4 w; w.x = pg8::cvt_pk_bf16(a[0], a[1]); w.y = pg8::cvt_pk_bf16(a[2], a[3]); w.z = pg8::cvt_pk_bf16(a[4], a[5]); w.w = pg8::cvt_pk_bf16(a[6], a[7]);
                *(pg8::u32x4*)(ACT + ((size_t)u.pm * 256 + rl) * 1024 + j0) = w; }
    }
};
struct EpiMoeOut {
    static constexpr bool PERM = true;
    const LAS int* cnt; const int* list; const float* tokg; const float* bout; float* OUT; bf16_t* Y;
    __device__ __forceinline__ void operator()(const pg8::f32x4 (&acc)[2][2][4][2], const Unit& u, int wr, int wc, int fr_, int fq_) const {
        int fr = fr_, fq = fq_; asm volatile("" : "+v"(fr), "+v"(fq));
        const int e = u.aux & 255, rt = u.aux >> 8, ce = cnt[e], c0 = u.pn * 256 + wc * 32 + 8 * fq;
        const float* bo = bout + (size_t)e * 1024 + c0; pg8::f32x4 bv[2][2];
#pragma unroll
        for (int bj = 0; bj < 2; ++bj)
#pragma unroll
            for (int n = 0; n < 2; ++n) bv[bj][n] = *(const pg8::f32x4*)(bo + bj * 128 + 4 * n);
#pragma unroll
        for (int ai = 0; ai < 2; ++ai)
#pragma unroll
            for (int m = 0; m < 4; ++m) { const int rl = ai * 128 + wr * 64 + m * 16 + fr, idx = rt * 256 + rl;
                if (idx < ce) { const int ent = list[(size_t)e * LISTCAP + idx], t = ent >> 2, k = ent & 3; const float g = tokg[ent];
#pragma unroll
                    for (int bj = 0; bj < 2; ++bj) { const pg8::f32x4 v0 = (acc[ai][bj][m][0] + bv[bj][0]) * g, v1 = (acc[ai][bj][m][1] + bv[bj][1]) * g;
                        if (k == 0) { float* p = OUT + (size_t)t * 1024 + c0 + bj * 128; const pg8::f32x4 o0 = *(const pg8::f32x4*)p, o1 = *(const pg8::f32x4*)(p + 4); *(pg8::f32x4*)p = o0 + v0; *(pg8::f32x4*)(p + 4) = o1 + v1; }
                        else { pg8::u32x4 w; w.x = pg8::cvt_pk_bf16(v0[0], v0[1]); w.y = pg8::cvt_pk_bf16(v0[2], v0[3]); w.z = pg8::cvt_pk_bf16(v1[0], v1[1]); w.w = pg8::cvt_pk_bf16(v1[2], v1[3]);
                            *(pg8::u32x4*)(Y + ((size_t)t * 3 + (k - 1)) * 1024 + c0 + bj * 128) = w; } } } }
    }
};

__device__ const float ROPE_INVREV[16] = { 1.591549431e-01f, 8.949940161e-02f, 5.032921210e-02f, 2.830219583e-02f, 1.591549431e-02f, 8.949940161e-03f, 5.032921210e-03f, 2.830219583e-03f,
                                           1.591549431e-03f, 8.949940161e-04f, 5.032921210e-04f, 2.830219583e-04f, 1.591549431e-04f, 8.949940161e-05f, 5.032921210e-05f, 2.830219583e-05f };
struct P3In { v4u cqa, cqb, qn, kn, vv; unsigned pe_lo, pe_hi, ql, qh; int pos; v4u uw[16]; };
__device__ __forceinline__ void p3_load(Frame& F, int t, P3In& I) {
    const int lane = F.lane, h = lane >> 3, sub = lane & 7; unsigned char* ws = F.ws;
    const bf16* cq = (const bf16*)(ws + WS_CQKV) + (size_t)t * 768;
    I.cqa = (v4u){0u, 0u, 0u, 0u}; I.cqb = (v4u){0u, 0u, 0u, 0u};
    if (lane < 48) I.cqa = *(const GAS v4u*)(cq + lane * 8);
    if (lane < 32) I.cqb = *(const GAS v4u*)(cq + 384 + lane * 8);
    I.pe_lo = *(const GAS unsigned*)(cq + 640 + 2 * sub); I.pe_hi = *(const GAS unsigned*)(cq + 656 + 2 * sub);
    I.pos = ((const int*)F.in[I_POS])[t];
    const bf16* qrow = (const bf16*)(ws + WS_Q) + (size_t)t * 768 + h * 96;
    I.qn = *(const GAS v4u*)(qrow + sub * 8); I.ql = *(const GAS unsigned*)(qrow + 64 + 2 * sub); I.qh = *(const GAS unsigned*)(qrow + 80 + 2 * sub);
    const bf16* kvrow = (const bf16*)(ws + WS_KV) + (size_t)t * 1024;
    I.kn = *(const GAS v4u*)(kvrow + h * 128 + sub * 8); I.vv = *(const GAS v4u*)(kvrow + h * 128 + 64 + sub * 8);
    const int s = t & (SEQ - 1), win = 2 << (lane >> 4), cntw = (s + 1 < win) ? s + 1 : win;
    const bf16* urow = (const bf16*)(ws + WS_U) + (size_t)t * 512 + lane * 8;
#pragma unroll
    for (int j = 0; j < 16; ++j) { I.uw[j] = (v4u){0u, 0u, 0u, 0u}; if (j < cntw) I.uw[j] = *(const GAS v4u*)(urow - (size_t)j * 512); }
}
__device__ __forceinline__ void p3_compute(Frame& F, int t, const P3In& I) {
    const int lane = F.lane, h = lane >> 3, sub = lane & 7; unsigned char* ws = F.ws;
    float sq = sumsq8(I.cqa), skv = sumsq8(I.cqb);
    sq = wave_sum(sq); skv = wave_sum(skv);
    const float rs_q = 1.0f / sqrtf(sq * (1.f / 384.f) + EPS), rs_kv = 1.0f / sqrtf(skv * (1.f / 256.f) + EPS);
    const float posf = (float)I.pos;
    float cs[2], sn[2];
#pragma unroll
    for (int p = 0; p < 2; ++p) { float rev = posf * ROPE_INVREV[2 * sub + p]; rev -= floorf(rev); sn[p] = __builtin_amdgcn_sinf(rev); cs[p] = __builtin_amdgcn_cosf(rev); }
    const float* gq = F.in[I_GQM]; const float* gk = F.in[I_GKM];
    {
        bf16* qrow = (bf16*)(ws + WS_Q) + (size_t)t * 768 + h * 96;
        float q[8], a[2], b[2];
#pragma unroll
        for (int i = 0; i < 4; ++i) { q[2 * i] = bflo(I.qn[i]) * rs_q; q[2 * i + 1] = bfhi(I.qn[i]) * rs_q; }
        a[0] = bflo(I.ql) * rs_q; a[1] = bfhi(I.ql) * rs_q; b[0] = bflo(I.qh) * rs_q; b[1] = bfhi(I.qh) * rs_q;
        float ss = a[0] * a[0] + a[1] * a[1] + b[0] * b[0] + b[1] * b[1];
#pragma unroll
        for (int i = 0; i < 8; ++i) ss += q[i] * q[i];
        ss += __shfl_xor(ss, 1); ss += __shfl_xor(ss, 2); ss += __shfl_xor(ss, 4);
        const float rn = C2_MLA / sqrtf(ss * (1.f / 96.f) + EPS);
#pragma unroll
        for (int i = 0; i < 8; ++i) q[i] *= rn * gq[sub * 8 + i];
        float lo[2], hi[2];
#pragma unroll
        for (int p = 0; p < 2; ++p) { const float x1 = a[p] * rn * gq[64 + 2 * sub + p], x2 = b[p] * rn * gq[80 + 2 * sub + p]; lo[p] = x1 * cs[p] - x2 * sn[p]; hi[p] = x2 * cs[p] + x1 * sn[p]; }
        v4u o; o.x = pk2(q[0], q[1]); o.y = pk2(q[2], q[3]); o.z = pk2(q[4], q[5]); o.w = pk2(q[6], q[7]);
        *(GAS v4u*)(qrow + sub * 8) = o; *(GAS unsigned*)(qrow + 64 + 2 * sub) = pk2(lo[0], lo[1]); *(GAS unsigned*)(qrow + 80 + 2 * sub) = pk2(hi[0], hi[1]);
    }
    {
        bf16* kvrow = (bf16*)(ws + WS_KV) + (size_t)t * 1024;
        float k[8], v[8], a[2], b[2];
#pragma unroll
        for (int i = 0; i < 4; ++i) { k[2 * i] = bflo(I.kn[i]) * rs_kv; k[2 * i + 1] = bfhi(I.kn[i]) * rs_kv; v[2 * i] = bflo(I.vv[i]) * rs_kv; v[2 * i + 1] = bfhi(I.vv[i]) * rs_kv; }
        a[0] = bflo(I.pe_lo); a[1] = bfhi(I.pe_lo); b[0] = bflo(I.pe_hi); b[1] = bfhi(I.pe_hi);
        float ss = a[0] * a[0] + a[1] * a[1] + b[0] * b[0] + b[1] * b[1];
#pragma unroll
        for (int i = 0; i < 8; ++i) ss += k[i] * k[i];
        ss += __shfl_xor(ss, 1); ss += __shfl_xor(ss, 2); ss += __shfl_xor(ss, 4);
        const float rn = 1.0f / sqrtf(ss * (1.f / 96.f) + EPS);
#pragma unroll
        for (int i = 0; i < 8; ++i) k[i] *= rn * gk[sub * 8 + i];
        float lo[2], hi[2];
#pragma unroll
        for (int p = 0; p < 2; ++p) { const float x1 = a[p] * rn * gk[64 + 2 * sub + p], x2 = b[p] * rn * gk[80 + 2 * sub + p]; lo[p] = x1 * cs[p] - x2 * sn[p]; hi[p] = x2 * cs[p] + x1 * sn[p]; }
        v4u o; o.x = pk2(k[0], k[1]); o.y = pk2(k[2], k[3]); o.z = pk2(k[4], k[5]); o.w = pk2(k[6], k[7]);
        v4u ov; ov.x = pk2(v[0], v[1]); ov.y = pk2(v[2], v[3]); ov.z = pk2(v[4], v[5]); ov.w = pk2(v[6], v[7]);
        bf16* krow = kvrow + h * 96;
        *(GAS v4u*)(krow + sub * 8) = o; *(GAS unsigned*)(krow + 64 + 2 * sub) = pk2(lo[0], lo[1]); *(GAS unsigned*)(krow + 80 + 2 * sub) = pk2(hi[0], hi[1]);
        *(GAS v4u*)((bf16*)(ws + WS_V) + (size_t)t * 512 + h * 64 + sub * 8) = ov;
    }
    {
        const int s = t & (SEQ - 1), win = 2 << (lane >> 4), cntw = (s + 1 < win) ? s + 1 : win;
        float acc[8];
#pragma unroll
        for (int i = 0; i < 8; ++i) acc[i] = 0.f;
#pragma unroll
        for (int j = 0; j < 16; ++j)
#pragma unroll
            for (int i = 0; i < 4; ++i) { acc[2 * i] += bflo(I.uw[j][i]); acc[2 * i + 1] += bfhi(I.uw[j][i]); }
        const float inv = 1.0f / (float)cntw;
#pragma unroll
        for (int i = 0; i < 4; ++i) { acc[2 * i] = acc[2 * i] * inv - bflo(I.uw[0][i]); acc[2 * i + 1] = acc[2 * i + 1] * inv - bfhi(I.uw[0][i]); }
        v4u o; o.x = pk2(acc[0], acc[1]); o.y = pk2(acc[2], acc[3]); o.z = pk2(acc[4], acc[5]); o.w = pk2(acc[6], acc[7]);
        *(GAS v4u*)((bf16*)(ws + WS_MIXED) + (size_t)t * 512 + lane * 8) = o;
    }
}
template <int NT> __device__ __forceinline__ void p3_tokens(Frame& F, int t0) {
    P3In I[NT];
#pragma unroll
    for (int i = 0; i < NT; ++i) p3_load(F, t0 + i, I[i]);
    asm volatile("" ::: "memory");
#pragma unroll
    for (int i = 0; i < NT; ++i) p3_compute(F, t0 + i, I[i]);
}

namespace xat {
__device__ __forceinline__ int crow(int r, int hi) { return (r & 3) + 8 * (r >> 2) + 4 * hi; }
__device__ __forceinline__ void stage_kv(Frame& F, int b, int hc) {
    const int tid = F.tid; unsigned char* ws = F.ws; LAS unsigned char* lds = F.lds;
    { const int row = tid >> 1, half = tid & 1; const bf16* src = (const bf16*)(ws + WS_KVMK) + (size_t)(b * 256 + row) * 512 + hc * 128 + half * 64;
      v4u v[8]; float ss = 0.f;
#pragma unroll
      for (int c = 0; c < 8; ++c) { v[c] = *(const GAS v4u*)(src + 8 * c); ss += sumsq8(v[c]); }
      ss += __shfl_xor(ss, 1);
      const float rstd = 1.0f / sqrtf(ss * (1.f / 128.f) + EPS); const float* gk = F.in[I_GKC] + half * 64;
#pragma unroll
      for (int c = 0; c < 8; ++c) { v4u o;
#pragma unroll
          for (int i = 0; i < 4; ++i) o[i] = pk2(bflo(v[c][i]) * rstd * gk[8 * c + 2 * i], bfhi(v[c][i]) * rstd * gk[8 * c + 2 * i + 1]);
          *(LAS v4u*)(lds + row * 256 + (((half * 8 + c) ^ (row & 15)) << 4)) = o; } }
    { const bf16* src = (const bf16*)(ws + WS_VTG) + (size_t)(b * 4 + hc) * 128 * 256;
#pragma unroll
      for (int i = 0; i < 8; ++i) { const int q = tid + 512 * i, d = q >> 5, ch = q & 31; const v4u v = *(const GAS v4u*)(src + (size_t)q * 8);
          *(LAS v4u*)(lds + 65536 + d * 512 + ((ch ^ (d & 15)) << 4)) = v; } }
}
__device__ __forceinline__ void unit(Frame& F, int b, int hc, int qb) {
    const int lane = F.lane, r32 = lane & 31, hi = lane >> 5, wid = F.wave; unsigned char* ws = F.ws; LAS unsigned char* lds = F.lds;
    LAS float* wsf = (LAS float*)(lds + LX_XWS) + wid * 64;
    const size_t row = (size_t)b * SEQ + qb * 256 + wid * 32 + r32;
    bf16x8 qr[8];
    { const bf16* qsrc = (const bf16*)(ws + WS_QX) + row * 512 + hc * 128 + hi * 8; v4u qv[8]; float ss = 0.f;
#pragma unroll
      for (int d0 = 0; d0 < 8; ++d0) { qv[d0] = *(const GAS v4u*)(qsrc + 16 * d0); ss += sumsq8(qv[d0]); }
      ss += __shfl_xor(ss, 32);
      const float rn = C2_X / sqrtf(ss * (1.f / 128.f) + EPS); const float* gq = F.in[I_GQC] + hi * 8;
#pragma unroll
      for (int d0 = 0; d0 < 8; ++d0) { v4u o;
#pragma unroll
          for (int i = 0; i < 4; ++i) o[i] = pk2(bflo(qv[d0][i]) * rn * gq[16 * d0 + 2 * i], bfhi(qv[d0][i]) * rn * gq[16 * d0 + 2 * i + 1]);
          qr[d0] = __builtin_bit_cast(bf16x8, o); } }
    f32x16 o[4];
#pragma unroll
    for (int i = 0; i < 4; ++i) o[i] = f32x16{};
    float mrun = -1e30f, lrun = 0.f;
#pragma unroll 1
    for (int tt = 0; tt < 4; ++tt) {
        f32x16 p0 = f32x16{}, p1 = f32x16{};
        const int kr0 = 64 * tt + r32, kr1 = kr0 + 32;
#pragma unroll
        for (int d0 = 0; d0 < 8; ++d0) {
            const bf16x8 k0 = *(const LAS bf16x8*)(lds + kr0 * 256 + (((2 * d0 + hi) ^ (kr0 & 15)) << 4));
            const bf16x8 k1 = *(const LAS bf16x8*)(lds + kr1 * 256 + (((2 * d0 + hi) ^ (kr1 & 15)) << 4));
            p0 = __builtin_amdgcn_mfma_f32_32x32x16_bf16(k0, qr[d0], p0, 0, 0, 0);
            p1 = __builtin_amdgcn_mfma_f32_32x32x16_bf16(k1, qr[d0], p1, 0, 0, 0);
        }
        float rm = fmaxf(p0[0], p1[0]);
#pragma unroll
        for (int r = 1; r < 16; ++r) rm = fmaxf(rm, fmaxf(p0[r], p1[r]));
        rm = fmaxf(rm, __shfl_xor(rm, 32));
        const float mnew = fmaxf(mrun, rm), sc = __builtin_amdgcn_exp2f(mrun - mnew); mrun = mnew;
        float ps = 0.f;
#pragma unroll
        for (int r = 0; r < 16; ++r) { p0[r] = __builtin_amdgcn_exp2f(p0[r] - mnew); p1[r] = __builtin_amdgcn_exp2f(p1[r] - mnew); ps += p0[r] + p1[r]; }
        lrun = lrun * sc + ps;
        if (hi == 0) wsf[r32] = sc;
        LDS_WAIT();
#pragma unroll
        for (int d = 0; d < 4; ++d)
#pragma unroll
            for (int r = 0; r < 16; ++r) o[d][r] *= wsf[crow(r, hi)];
        v4u pw[4];
#pragma unroll
        for (int i = 0; i < 4; ++i) { pw[0][i] = pk2(p0[2 * i], p0[2 * i + 1]); pw[1][i] = pk2(p0[8 + 2 * i], p0[9 + 2 * i]); pw[2][i] = pk2(p1[2 * i], p1[2 * i + 1]); pw[3][i] = pk2(p1[8 + 2 * i], p1[9 + 2 * i]); }
#pragma unroll
        for (int ks = 0; ks < 4; ++ks) { const int ch = 2 * (4 * tt + ks) + hi; const bf16x8 pa = __builtin_bit_cast(bf16x8, pw[ks]);
#pragma unroll
            for (int d = 0; d < 4; ++d) { const int dr = r32 + 32 * d; const bf16x8 vf = *(const LAS bf16x8*)(lds + 65536 + dr * 512 + ((ch ^ (dr & 15)) << 4));
                o[d] = __builtin_amdgcn_mfma_f32_32x32x16_bf16(pa, vf, o[d], 0, 0, 0); } }
        LDS_WAIT();
    }
    lrun += __shfl_xor(lrun, 32);
    if (hi == 0) wsf[32 + r32] = lrun;
    LDS_WAIT();
    bf16* orow = (bf16*)(ws + WS_CO) + ((size_t)b * SEQ + qb * 256 + wid * 32) * 512 + hc * 128 + r32;
#pragma unroll
    for (int r = 0; r < 16; ++r) { const int qrow = crow(r, hi); const float rl = 1.0f / wsf[32 + qrow];
#pragma unroll
        for (int d = 0; d < 4; ++d) orow[(size_t)qrow * 512 + 32 * d] = (bf16)f2bf(o[d][r] * rl); }
    LDS_WAIT();
}
}

__device__ __forceinline__ void router_tile(Frame& F, int t0, int lt0) {
    const int lane = F.lane, tok = lane & 31, kk = lane >> 5; unsigned char* ws = F.ws; LAS unsigned char* lds = F.lds;
    const LAS float* wr = (const LAS float*)(lds + RING_OFF);
    const float* xrow = F.out + (size_t)(t0 + tok) * 1024 + 8 * kk;
    bf16* hrow = (bf16*)(ws + WS_HN2) + (size_t)(t0 + tok) * 1024 + 8 * kk;
    f32x16 acc = f32x16{}; float ss = 0.f;
    constexpr int PD = 8;
    f32x4 ra[PD], rb[PD];
#pragma unroll
    for (int p = 0; p < PD; ++p) { ra[p] = *(const GAS f32x4*)(xrow + 16 * p); rb[p] = *(const GAS f32x4*)(xrow + 16 * p + 4); }
#pragma unroll 1
    for (int q0 = 0; q0 < 64; q0 += PD) {
#pragma unroll
        for (int p = 0; p < PD; ++p) {
            const int q = q0 + p; const f32x4 a = ra[p], b = rb[p];
            if (q0 + PD < 64) { ra[p] = *(const GAS f32x4*)(xrow + 16 * (q + PD)); rb[p] = *(const GAS f32x4*)(xrow + 16 * (q + PD) + 4); }
            ss += (a.x * a.x + a.y * a.y) + (a.z * a.z + a.w * a.w) + (b.x * b.x + b.y * b.y) + (b.z * b.z + b.w * b.w);
            const LAS float* wq = wr + (16 * q + 8 * kk) * 32 + tok;
            acc = __builtin_amdgcn_mfma_f32_32x32x2f32(wq[0 * 32], a.x, acc, 0, 0, 0); acc = __builtin_amdgcn_mfma_f32_32x32x2f32(wq[1 * 32], a.y, acc, 0, 0, 0);
            acc = __builtin_amdgcn_mfma_f32_32x32x2f32(wq[2 * 32], a.z, acc, 0, 0, 0); acc = __builtin_amdgcn_mfma_f32_32x32x2f32(wq[3 * 32], a.w, acc, 0, 0, 0);
            acc = __builtin_amdgcn_mfma_f32_32x32x2f32(wq[4 * 32], b.x, acc, 0, 0, 0); acc = __builtin_amdgcn_mfma_f32_32x32x2f32(wq[5 * 32], b.y, acc, 0, 0, 0);
            acc = __builtin_amdgcn_mfma_f32_32x32x2f32(wq[6 * 32], b.z, acc, 0, 0, 0); acc = __builtin_amdgcn_mfma_f32_32x32x2f32(wq[7 * 32], b.w, acc, 0, 0, 0);
            v4u o; o.x = pk2(a.x, a.y); o.y = pk2(a.z, a.w); o.z = pk2(b.x, b.y); o.w = pk2(b.z, b.w);
            *(GAS v4u*)(hrow + 16 * q) = o;
        }
    }
    ss += __shfl_xor(ss, 32);
    const float rstd = 1.0f / sqrtf(ss * (1.f / 1024.f) + EPS);
    if (kk == 0) ((float*)(ws + WS_RSTD2))[t0 + tok] = rstd;
    const float* br = F.in[I_BR];
    float lg[16];
#pragma unroll
    for (int r = 0; r < 16; ++r) lg[r] = acc[r] * rstd + br[xat::crow(r, kk)];
    float tv[4]; int ti[4];
#pragma unroll
    for (int k = 0; k < 4; ++k) { float best = lg[0]; int bi = 0;
#pragma unroll
        for (int r = 1; r < 16; ++r) { const bool gt = lg[r] > best; best = gt ? lg[r] : best; bi = gt ? r : bi; }
        tv[k] = best; ti[k] = xat::crow(bi, kk);
#pragma unroll
        for (int r = 0; r < 16; ++r) lg[r] = (r == bi) ? -INFINITY : lg[r]; }
    float cv[8]; int ci[8];
#pragma unroll
    for (int k = 0; k < 4; ++k) { cv[k] = tv[k]; ci[k] = ti[k]; cv[4 + k] = __shfl_xor(tv[k], 32); ci[4 + k] = __shfl_xor(ti[k], 32); }
    float gv[4]; int ge[4];
#pragma unroll
    for (int k = 0; k < 4; ++k) { float best = cv[0]; int be = ci[0], bj = 0;
#pragma unroll
        for (int j = 1; j < 8; ++j) { const bool gt = (cv[j] > best) || (cv[j] == best && ci[j] < be); best = gt ? cv[j] : best; be = gt ? ci[j] : be; bj = gt ? j : bj; }
        gv[k] = best; ge[k] = be;
#pragma unroll
        for (int j = 0; j < 8; ++j) cv[j] = (j == bj) ? -INFINITY : cv[j]; }
    float ex[4], es = 0.f;
#pragma unroll
    for (int k = 0; k < 4; ++k) { ex[k] = __expf(gv[k] - gv[0]); es += ex[k]; }
    const float ies = 1.0f / es;
    if (kk == 0) {
        LAS int* lcnt = (LAS int*)(lds + LX_LCNT); LAS int* stash = (LAS int*)(lds + LX_STASH); LAS float* gst = (LAS float*)(lds + LX_GATE);
#pragma unroll
        for (int k = 0; k < 4; ++k) { const int li = __hip_atomic_fetch_add(lcnt + ge[k], 1, __ATOMIC_RELAXED, __HIP_MEMORY_SCOPE_WORKGROUP);
            stash[(lt0 + tok) * 4 + k] = ge[k] | (li << 8); gst[(lt0 + tok) * 4 + k] = ex[k] * ies; }
    }
}

__device__ __forceinline__ void p7_router(Frame& F) {
    const int lane = F.lane, tid = F.tid; unsigned char* ws = F.ws; LAS unsigned char* lds = F.lds;
    {
        LAS float* scr = (LAS float*)(lds + RING_OFF + F.wave * 16384);
        const int gw = F.vcu * NWAVES + F.wave, NGW = F.G * NWAVES;
        constexpr int IE1 = 16 * 64, IE2 = 16 * 32;
        for (int it = gw; it < NEXP * (IE1 + IE2); it += NGW) {
            const int e = it / (IE1 + IE2); int r = it - e * (IE1 + IE2);
            if (r < IE1) { const int kb = r >> 6, nb = r & 63, n0 = nb * 32, src = ((n0 >> 7) & 1) * 1024 + (n0 >> 8) * 128 + (n0 & 127);
                transpose_item(F.in[I_WEI] + (size_t)e * 1024 * 2048, 2048, src, F.in[I_GFFN], (bf16*)(ws + WS_WEI) + (size_t)e * 2048 * 1024, 1024, n0, kb * 64, scr, lane); }
            else { r -= IE1; const int kb = r >> 5, nb = r & 31;
                transpose_item(F.in[I_WEO] + (size_t)e * 1024 * 1024, 1024, nb * 32, nullptr, (bf16*)(ws + WS_WEO) + (size_t)e * 1024 * 1024, 1024, nb * 32, kb * 64, scr, lane); }
        }
    }
    __syncthreads();
    { const float* wr = F.in[I_WR]; const float* g = F.in[I_GFFN];
      for (int i = tid; i < 8192; i += NWAVES * 64) { const f32x4 v = *(const GAS f32x4*)(wr + 4 * i); const float gg = g[i >> 3]; *(LAS f32x4*)(lds + RING_OFF + 16 * i) = v * gg; } }
    __syncthreads();
    LAS int* lcnt = (LAS int*)(lds + LX_LCNT); LAS int* lbase = (LAS int*)(lds + LX_BASE); LAS int* stash = (LAS int*)(lds + LX_STASH); LAS float* gst = (LAS float*)(lds + LX_GATE);
    for (int chunk = F.vcu; chunk < T / 256; chunk += F.G) {
        if (tid < NEXP) lcnt[tid] = 0;
        __syncthreads();
        router_tile(F, chunk * 256 + F.wave * 32, F.wave * 32);
        __syncthreads();
        if (tid < NEXP) lbase[tid] = (int)__hip_atomic_fetch_add((unsigned*)(F.ctl + CW_GCNT + 64 * tid), (unsigned)lcnt[tid], RLX_AGENT);
        __syncthreads();
        for (int idx = tid; idx < 1024; idx += NWAVES * 64) { const int st = stash[idx], e = st & 255, pos = lbase[e] + (st >> 8), ent = (chunk * 256 + (idx >> 2)) * 4 + (idx & 3);
            if (pos < LISTCAP) ((int*)(ws + WS_LIST))[(size_t)e * LISTCAP + pos] = ent;
            ((float*)(ws + WS_TOKG))[ent] = gst[idx]; }
        __syncthreads();
    }
}
__device__ __forceinline__ int moe_setup(Frame& F) {
    LAS int* tstart = (LAS int*)(F.lds + LX_TSTART); LAS int* cnt = (LAS int*)(F.lds + LX_CNT);
    if (F.tid == 0) { int acc = 0;
        for (int e = 0; e < NEXP; ++e) { int c = (int)__hip_atomic_load((unsigned*)(F.ctl + CW_GCNT + 64 * e), RLX_AGENT); c = c < LISTCAP ? c : LISTCAP; cnt[e] = c; tstart[e] = acc; acc += (c + 255) >> 8; }
        tstart[NEXP] = acc < ACT_TILES_MAX ? acc : ACT_TILES_MAX; }
    __syncthreads();
    return __builtin_amdgcn_readfirstlane(tstart[NEXP]);
}

struct Args { const float* in[N_IN]; float* out; unsigned char* ws; int ph_lo, ph_hi, li, pad; };
__global__ void __launch_bounds__(NWAVES * 64, 2) fwd_kernel(Args args) {
    extern __shared__ __attribute__((aligned(16))) unsigned char lds[];
    Frame F;
    F.lds = (LAS unsigned char*)lds;
    F.MISC = (volatile LAS unsigned*)(F.lds + MISC_OFF);
    F.tid = threadIdx.x; F.lane = F.tid & 63; F.wave = __builtin_amdgcn_readfirstlane(F.tid >> 6);
    F.G = gridDim.x; { const int bx = blockIdx.x; F.vcu = (F.G % 8 == 0) ? (bx % 8) * (F.G / 8) + bx / 8 : bx; }
    F.ws = args.ws; F.out = args.out; F.in = args.in;
    unsigned char* ws = args.ws;
    F.ctl = (gu32*)(ws + WS_CTL);
    for (int u = F.tid; u < (LDS_BYTES - LDSCTL_OFF) / 4; u += NWAVES * 64) ((LAS unsigned*)(F.lds + LDSCTL_OFF))[u] = 0u;
    __syncthreads();
    XcdBarrier bar; bar.bar = (unsigned*)(F.ctl + CW_BAR); bar.x = 0; bar.st = nullptr;
    if (N_LAUNCHES != PER_PHASE) bar = xcd_barrier_post((unsigned*)(F.ctl + CW_BAR), F.MISC + 8, F.tid == 0);
#define GRID_BAR(seam) do { if (N_LAUNCHES == PER_PHASE) { if (F.tid == 0) __hip_atomic_store(F.ctl + CW_TMO, 0xBADBA0u | (unsigned)(seam), RLX_AGENT); } else { xcd_barrier(bar, F.tid == 0); } } while (0)
    const int lo = args.ph_lo, hi = args.ph_hi;
#ifndef MK_PHASE_MASK
#define MK_PHASE_MASK 0x7ff
#endif
#define IN(k) (((MK_PHASE_MASK >> (k)) & 1) && lo <= (k) && (k) < hi)
#define BOTH(k) (IN(k) && IN((k) + 1))
    const int gw = F.vcu * NWAVES + F.wave, NGW = F.G * NWAVES;

    if (IN(0)) { REFRESH(F); for (int rep = 0; rep < MK_REP0; ++rep) p0_prologue(F); if (BOTH(0)) GRID_BAR(0); }

    if (IN(1)) { REFRESH(F);
        DenseSched S; S.init(ws + WS_HN, 1024, ws + WS_W1T, 1024, T, N1, F.G, (int)blockIdx.x);
        EpiP1 E{(bf16_t*)(ws + WS_U), (bf16_t*)(ws + WS_CQKV), (bf16_t*)(ws + WS_QX), (bf16_t*)(ws + WS_GATES)};
        for (int rep = 0; rep < MK_REP1; ++rep) pg8::gemm_phase<EpiP1, DenseSched>(F.lds + RING_OFF, F.tid, 1024, 1024, 1024, S, E);
        if (BOTH(1)) GRID_BAR(1);
    }

    if (IN(2)) { REFRESH(F);
        for (int rep = 0; rep < MK_REP2; ++rep) {
        { DenseSched S; S.init(ws + WS_CQKV, 768, ws + WS_WUQ, 384, T, 768, F.G, (int)blockIdx.x);
          EpiStore E{(bf16_t*)(ws + WS_Q), 768};
          pg8::gemm_phase<EpiStore, DenseSched>(F.lds + RING_OFF, F.tid, 384, 768, 384, S, E); }
        { DenseSched S; S.init(ws + WS_CQKV + 384 * 2, 768, ws + WS_WUKV, 256, T, 1024, F.G, (int)blockIdx.x);
          EpiStore E{(bf16_t*)(ws + WS_KV), 1024};
          pg8::gemm_phase<EpiStore, DenseSched>(F.lds + RING_OFF, F.tid, 256, 768, 256, S, E); }
        { DenseSched S; S.init(ws + WS_MEMN, 1024, ws + WS_WMEM, 1024, MROWS, 1024, F.G, (int)blockIdx.x);
          EpiMemKV E{(bf16_t*)(ws + WS_KVMK), (bf16_t*)(ws + WS_VTG)};
          pg8::gemm_phase<EpiMemKV, DenseSched>(F.lds + RING_OFF, F.tid, 1024, 1024, 1024, S, E); }
        }
        if (BOTH(2)) GRID_BAR(2);
    }

    if (IN(3)) { REFRESH(F);
        const int per = T / NGW;
        if (per * NGW == T && (per & 1) == 0) { for (int i = 0; i < per; i += 2) p3_tokens<2>(F, gw * per + i); }
        else { for (int t = gw; t < T; t += NGW) p3_tokens<1>(F, t); }
        if (BOTH(3)) GRID_BAR(3);
    }

    if (IN(4)) { for (int rep4 = 0; rep4 < MK_REP4; ++rep4) { REFRESH(F);
#ifndef NO_MLA
        for (int vv = F.vcu; vv < 256 * MK_REPMLA; vv += F.G) {
            const int bh = (vv & 255) >> 1, s = vv & 1;
            for (int i = 0; i < 8; ++i) { const int j2 = (i >> 1) * 2 + s, qb = (i & 1) ? 15 - j2 : j2;
                mla::attn_unit<8>(F.tid, bh >> 3, bh & 7, qb, (const mla::bf16*)(ws + WS_Q), (const mla::bf16*)(ws + WS_KV), (const mla::bf16*)(ws + WS_V), (mla::bf16*)(ws + WS_AO), (char*)lds + RING_OFF); }
        }
#endif
        __syncthreads();
        REFRESH(F);
#ifndef NO_XAT
        for (int vv = F.vcu; vv < 256 * MK_REPX; vv += F.G) {
            const int b = (vv & 255) >> 4, hc = (vv >> 2) & 3;
            xat::stage_kv(F, b, hc);
            __syncthreads();
            for (int i = 0; i < 4; ++i) xat::unit(F, b, hc, (vv & 3) * 4 + i);
            __syncthreads();
        }
#endif
        }
        if (BOTH(4)) GRID_BAR(4);
    }

    if (IN(5)) { REFRESH(F);
        MergeSched S; S.G = F.G; S.c = (int)blockIdx.x;
        S.A0 = (const char*)(ws + WS_MIXED); S.dA1 = (long)WS_AO - (long)WS_MIXED; S.dA2 = (long)WS_CO - (long)WS_MIXED;
        S.B0 = (const char*)(ws + WS_WPOOL); S.dB1 = (long)WS_WMO - (long)WS_WPOOL; S.dB2 = (long)WS_WCO - (long)WS_WPOOL;
        EpiMerge E{(const bf16_t*)(ws + WS_GATES), (bf16_t*)(ws + WS_MERGED)};
        for (int rep = 0; rep < MK_REP56; ++rep) pg8::gemm_phase<EpiMerge, MergeSched>(F.lds + RING_OFF, F.tid, 512, 512, 512, S, E);
        if (BOTH(5)) GRID_BAR(5);
    }

    if (IN(6)) { REFRESH(F);
        DenseSched S; S.init(ws + WS_MERGED, 1024, ws + WS_WO, 1024, T, 1024, F.G, (int)blockIdx.x);
        EpiResF32 E{F.in[I_X], F.out};
        for (int rep = 0; rep < MK_REP56; ++rep) pg8::gemm_phase<EpiResF32, DenseSched>(F.lds + RING_OFF, F.tid, 1024, 1024, 1024, S, E);
        if (BOTH(6)) GRID_BAR(6);
    }

    if (IN(7)) { REFRESH(F); p7_router(F); if (BOTH(7)) GRID_BAR(7); }

    if (IN(8)) { REFRESH(F);
        const int ntiles = moe_setup(F);
        MoeSched S; S.G = F.G; S.c = (int)blockIdx.x; S.nM = ntiles; S.nN = 8; S.tstart = (const LAS int*)(F.lds + LX_TSTART); S.cnt = (const LAS int*)(F.lds + LX_CNT);
        S.list = (const int*)(ws + WS_LIST); S.A = (const char*)(ws + WS_HN2); S.B = (const char*)(ws + WS_WEI); S.bexp = (size_t)2048 * 1024 * 2; S.tB = (size_t)256 * 1024 * 2; S.tA = 0; S.gather = true;
        EpiMoeIn E{S.cnt, S.list, (const float*)(ws + WS_RSTD2), F.in[I_BEI], (bf16_t*)(ws + WS_ACT)};
        for (int rep = 0; rep < MK_REP8; ++rep) pg8::gemm_phase<EpiMoeIn, MoeSched, true>(F.lds + RING_OFF, F.tid, 1024, 1024, 1024, S, E);
        if (BOTH(8)) GRID_BAR(8);
    }

    if (IN(9)) { REFRESH(F);
        const int ntiles = moe_setup(F);
        MoeSched S; S.G = F.G; S.c = (int)blockIdx.x; S.nM = ntiles; S.nN = 4; S.tstart = (const LAS int*)(F.lds + LX_TSTART); S.cnt = (const LAS int*)(F.lds + LX_CNT);
        S.list = (const int*)(ws + WS_LIST); S.A = (const char*)(ws + WS_ACT); S.B = (const char*)(ws + WS_WEO); S.bexp = (size_t)1024 * 1024 * 2; S.tB = (size_t)256 * 1024 * 2; S.tA = (size_t)256 * 1024 * 2; S.gather = false;
        EpiMoeOut E{S.cnt, S.list, (const float*)(ws + WS_TOKG), F.in[I_BEO], F.out, (bf16_t*)(ws + WS_Y)};
        pg8::gemm_phase<EpiMoeOut, MoeSched, false>(F.lds + RING_OFF, F.tid, 1024, 1024, 1024, S, E);
        if (BOTH(9)) GRID_BAR(9);
    }

    if (IN(10)) { REFRESH(F);
        for (int t0 = gw; t0 < T; t0 += 2 * NGW) {
            f32x4 v[2][4]; v2u w[2][3][4];
#pragma unroll
            for (int r = 0; r < 2; ++r) { const int t = t0 + r * NGW; if (t < T) {
                const GAS f32x4* o = (const GAS f32x4*)(F.out + (size_t)t * 1024) + F.lane; const GAS v2u* y = (const GAS v2u*)((const bf16*)(ws + WS_Y) + (size_t)t * 3072) + F.lane;
#pragma unroll
                for (int j = 0; j < 4; ++j) { v[r][j] = o[64 * j];
#pragma unroll
                    for (int s3 = 0; s3 < 3; ++s3) w[r][s3][j] = y[s3 * 256 + 64 * j]; } } }
#pragma unroll
            for (int r = 0; r < 2; ++r) { const int t = t0 + r * NGW; if (t < T) {
                GAS f32x4* o = (GAS f32x4*)(F.out + (size_t)t * 1024) + F.lane;
#pragma unroll
                for (int j = 0; j < 4; ++j) { f32x4 x = v[r][j];
#pragma unroll
                    for (int s3 = 0; s3 < 3; ++s3) { const v2u ww = w[r][s3][j]; x.x += bflo(ww.x); x.y += bfhi(ww.x); x.z += bflo(ww.y); x.w += bfhi(ww.y); }
                    o[64 * j] = x; } } }
        }
    }
#undef IN
#undef BOTH
#undef GRID_BAR
}

extern "C" void kernel_launch(void* const* d_in, const int* in_sizes, int n_in, void* d_out, int out_size, void* d_ws, size_t ws_size, hipStream_t stream) {
    static int grid = 0;
    if (grid == 0) {
        if (n_in != N_IN || in_sizes[0] != T * D || out_size != T * D || ws_size < WS_END) { fprintf(stderr, "kernel_launch: unexpected shapes (n_in %d, in0 %d, out %d, ws %zu); nothing launched\n", n_in, n_in > 0 ? in_sizes[0] : -1, out_size, ws_size); grid = -1; return; }
        int dev = 0, cus = 0, per_cu = 0;
        if (hipGetDevice(&dev) != hipSuccess || hipDeviceGetAttribute(&cus, hipDeviceAttributeMultiprocessorCount, dev) != hipSuccess) { grid = -1; return; }
        if (hipFuncSetAttribute((const void*)fwd_kernel, hipFuncAttributeMaxDynamicSharedMemorySize, LDS_BYTES) != hipSuccess) { fprintf(stderr, "kernel_launch: hipFuncSetAttribute failed\n"); grid = -1; return; }
        if (hipOccupancyMaxActiveBlocksPerMultiprocessor(&per_cu, (const void*)fwd_kernel, NWAVES * 64, LDS_BYTES) != hipSuccess || per_cu < 1)
            fprintf(stderr, "kernel_launch: note: occupancy query reports %d workgroups per CU\n", per_cu);
        (void)hipGetLastError();
        grid = cus;
    }
    if (grid < 0) return;
    if (hipMemsetAsync((char*)d_ws + WS_CTL, 0, CTL_ZERO_BYTES, stream) != hipSuccess) { fprintf(stderr, "kernel_launch: hipMemsetAsync failed\n"); return; }
    Args a{};
    for (int i = 0; i < N_IN; ++i) a.in[i] = (const float*)d_in[i];
    a.out = (float*)d_out; a.ws = (unsigned char*)d_ws;
    const int last = MK_LAST_PHASE;
    if (N_LAUNCHES == PER_PHASE) {
        for (int li = 0; li < last; ++li) { a.ph_lo = li; a.ph_hi = li + 1; a.li = li; hipLaunchKernelGGL(fwd_kernel, dim3(grid), dim3(NWAVES * 64), LDS_BYTES, stream, a); }
    } else {
        a.ph_lo = 0; a.ph_hi = last; a.li = 0; hipLaunchKernelGGL(fwd_kernel, dim3(grid), dim3(NWAVES * 64), LDS_BYTES, stream, a);
    }
    const hipError_t le = hipPeekAtLastError();
    if (le != hipSuccess) fprintf(stderr, "kernel_launch: launch failed: %s\n", hipGetErrorName(le));
}
```

```cpp
#include <hip/hip_runtime.h>
#include <hip/hip_bf16.h>
#include <cstdio>
#include <cstdint>

#ifndef MK_N_LAUNCHES
#define MK_N_LAUNCHES 1
#endif
#ifndef MK_REP1
#define MK_REP1 1
#endif
#ifndef MK_REP4
#define MK_REP4 1
#endif
#ifndef MK_REP56
#define MK_REP56 1
#endif
#ifndef MK_REP8
#define MK_REP8 1
#endif
#ifndef MK_REPMLA
#define MK_REPMLA 1
#endif
#ifndef MK_REP0
#define MK_REP0 1
#endif
#ifndef MK_REP2
#define MK_REP2 1
#endif
#ifndef MK_REPX
#define MK_REPX 1
#endif
#ifndef MK_LAST_PHASE
#define MK_LAST_PHASE 11
#endif

namespace pg8 {
#define PG8_LAS __attribute__((address_space(3)))
typedef unsigned short bf16_t;
typedef short bf16x8 __attribute__((ext_vector_type(8)));
typedef float f32x4 __attribute__((ext_vector_type(4)));
typedef unsigned u32x4 __attribute__((ext_vector_type(4)));
typedef unsigned u32x2 __attribute__((ext_vector_type(2)));
constexpr int BM = 256, BK = 64, HALF = 128, HTB = HALF * BK * 2, STAGE_BYTES = 8 * HTB, NXCD = 8, WGM = 8;

__host__ __device__ __forceinline__ int lds_byte(int r, int c) { const int st = (r >> 4) * 2 + (c >> 5), rr = r & 15, cc = c & 31, ob = rr * 64 + cc * 2; return st * 1024 + (ob ^ (((ob >> 9) & 1) << 5)); }
__host__ __device__ __forceinline__ void stage_rc(int b, int& R, int& C) { const int st = b / 1024, sb = b % 1024, swz = sb ^ (((sb >> 9) & 1) << 5); R = (st >> 1) * 16 + swz / 64; C = (st & 1) * 32 + (swz % 64) / 2; }
__host__ __device__ __forceinline__ int perm32(int rho) { const int n = rho >> 4, i = rho & 15; return 8 * (i >> 2) + 4 * n + (i & 3); }

struct Unit { int pm, pn; const char* A; const char* B; int aux; };

__device__ __forceinline__ void tile_order(int L, int nM, int nN, int& pm, int& pn) {
    const int nwg = nM * nN; int wgid = L;
    { const int q = nwg / NXCD, r = nwg % NXCD, xcd = wgid % NXCD, off = wgid / NXCD; wgid = (xcd < r ? xcd * (q + 1) : r * (q + 1) + (xcd - r) * q) + off; }
    const int nig = WGM * nN, gid = wgid / nig, fm = gid * WGM, gsz = (nM - fm) < WGM ? (nM - fm) : WGM;
    pm = fm + ((wgid % nig) % gsz); pn = (wgid % nig) / gsz;
}

__device__ __forceinline__ unsigned cvt_pk_bf16(float lo, float hi) { unsigned r; asm volatile("v_cvt_pk_bf16_f32 %0, %1, %2" : "=v"(r) : "v"(lo), "v"(hi)); return r; }
__device__ __forceinline__ float bf_lo(unsigned w) { return __uint_as_float(w << 16); }
__device__ __forceinline__ float bf_hi(unsigned w) { return __uint_as_float(w & 0xffff0000u); }
__device__ __forceinline__ float sigmoidf_fast(float x) { return __builtin_amdgcn_rcpf(1.0f + __builtin_amdgcn_exp2f(-1.4426950408889634f * x)); }

template <class Epi, class Sched, bool GATHER = false, bool ALIGN_EPI = true>
__device__ __forceinline__ void gemm_phase(PG8_LAS unsigned char* lds, const int tid, const int K, const int lda, const int ldb, const Sched& S, const Epi& E) {
    const int wid = __builtin_amdgcn_readfirstlane(tid >> 6), lane = tid & 63, wr = wid >> 2, wc = wid & 3, fr = lane & 15, fq = lane >> 4;
    const int nt = K / BK;
    int RA[2], CA[2]; unsigned voffB[2];
#pragma unroll
    for (int i = 0; i < 2; ++i) { int R, C; stage_rc(tid * 16 + i * 8192, R, C); const int Rb = Epi::PERM ? ((R & ~31) + perm32(R & 31)) : R;
        RA[i] = R; CA[i] = C; voffB[i] = (unsigned)(Rb * ldb + C) * 2u; }
    const size_t kstep = (size_t)(BK * 2);
    const size_t hstepB = (size_t)HALF * ldb * 2;
    const unsigned ldsw = (unsigned)wid * 1024u;
    const int aoff = lds_byte(wr * 64 + fr, fq * 8), boff = lds_byte(wc * 32 + fr, fq * 8);
#define PG8_SA(b, h) (((b) * 2 + (h)) * HTB)
#define PG8_SB(b, h) ((4 + (b) * 2 + (h)) * HTB)
#define PG8_STAGE2(bufoff, gbase, o0, o1) do { \
        __builtin_amdgcn_global_load_lds((const unsigned*)((const char*)(gbase) + (o0)), (PG8_LAS unsigned*)(lds + (bufoff) + ldsw), 16, 0, 0); \
        __builtin_amdgcn_global_load_lds((const unsigned*)((const char*)(gbase) + (o1)), (PG8_LAS unsigned*)(lds + (bufoff) + ldsw + 8192), 16, 0, 0); } while (0)
#define PG8_STAGEB(bufoff, gbase) PG8_STAGE2(bufoff, gbase, voffB[0], voffB[1])
#define PG8_STAGEA(bufoff, gbase, OFF, h) PG8_STAGE2(bufoff, gbase, OFF[h][0], OFF[h][1])
#define PG8_LDA(dst, b, h) do { _Pragma("unroll") for (int m = 0; m < 4; ++m) _Pragma("unroll") for (int k = 0; k < 2; ++k) dst[m][k] = *(const PG8_LAS bf16x8*)(lds + PG8_SA(b, h) + aoff + m * 2048 + k * 1024); } while (0)
#define PG8_LDB(dst, b, h) do { _Pragma("unroll") for (int n = 0; n < 2; ++n) _Pragma("unroll") for (int k = 0; k < 2; ++k) dst[n][k] = *(const PG8_LAS bf16x8*)(lds + PG8_SB(b, h) + boff + n * 2048 + k * 1024); } while (0)
#define PG8_MMA(ai, bj, At, Bt) do { __builtin_amdgcn_s_setprio(1); _Pragma("unroll") for (int m = 0; m < 4; ++m) _Pragma("unroll") for (int n = 0; n < 2; ++n) _Pragma("unroll") for (int k = 0; k < 2; ++k) \
        acc[ai][bj][m][n] = __builtin_amdgcn_mfma_f32_16x16x32_bf16(Bt[n][k], At[m][k], acc[ai][bj][m][n], 0, 0, 0); __builtin_amdgcn_s_setprio(0); } while (0)
#define PG8_WAIT_V(n) asm volatile("s_waitcnt vmcnt(" #n ")" ::: "memory")
#define PG8_WAIT_L(n) asm volatile("s_waitcnt lgkmcnt(" #n ")" ::: "memory")
#define PG8_BAR __builtin_amdgcn_s_barrier()
#define PG8_SCHED __builtin_amdgcn_sched_barrier(0)
    Unit cur, nxt; int ui = 0;
    if (!S.next(0, cur)) return;
    f32x4 acc[2][2][4][2];
#pragma unroll
    for (int a = 0; a < 2; ++a)
#pragma unroll
        for (int b = 0; b < 2; ++b)
#pragma unroll
            for (int m = 0; m < 4; ++m)
#pragma unroll
                for (int n = 0; n < 2; ++n) acc[a][b][m][n] = (f32x4){0.f, 0.f, 0.f, 0.f};
    bf16x8 At[4][2], B0[2][2], B1[2][2];
    unsigned cOff[2][2], nOff[2][2];
#pragma unroll
    for (int h = 0; h < 2; ++h)
#pragma unroll
        for (int i = 0; i < 2; ++i) {
            if constexpr (GATHER) cOff[h][i] = S.row_off(cur, h * HALF + RA[i]) + (unsigned)CA[i] * 2u;
            else cOff[h][i] = (unsigned)((h * HALF + RA[i]) * lda + CA[i]) * 2u;
            nOff[h][i] = cOff[h][i];
        }
    const char* cA = cur.A; const char* cB = cur.B;
    PG8_STAGEB(PG8_SB(0, 0), cB); PG8_STAGEB(PG8_SB(0, 1), cB + hstepB); PG8_STAGEA(PG8_SA(0, 0), cA, cOff, 0); PG8_STAGEA(PG8_SA(0, 1), cA, cOff, 1);
    if (wr == 1) PG8_BAR;
    PG8_WAIT_V(2); PG8_BAR;
    PG8_STAGEB(PG8_SB(1, 0), cB + kstep); PG8_STAGEA(PG8_SA(1, 0), cA + kstep, cOff, 0); PG8_STAGEB(PG8_SB(1, 1), cB + hstepB + kstep);
    PG8_WAIT_V(6); PG8_BAR;
    for (;;) {
        const bool has_next = S.next(ui + 1, nxt);
        const char* nA = has_next ? nxt.A : cA; const char* nB = has_next ? nxt.B : cB;
        if constexpr (GATHER) {
            if (has_next) {
#pragma unroll
                for (int h = 0; h < 2; ++h)
#pragma unroll
                    for (int i = 0; i < 2; ++i) nOff[h][i] = S.row_off(nxt, h * HALF + RA[i]) + (unsigned)CA[i] * 2u;
            }
        }
        for (int t = 0; t < nt; t += 2) {
            const bool last = (t == nt - 2);
            const char* a1 = cA + (size_t)(t + 1) * kstep;
            const char* a2 = last ? nA : cA + (size_t)(t + 2) * kstep; const char* b2 = last ? nB : cB + (size_t)(t + 2) * kstep;
            const char* a3 = a2 + kstep; const char* b3 = b2 + kstep;
            unsigned o2[2][2];
#pragma unroll
            for (int h = 0; h < 2; ++h)
#pragma unroll
                for (int i = 0; i < 2; ++i) { if constexpr (GATHER) o2[h][i] = last ? nOff[h][i] : cOff[h][i]; else o2[h][i] = cOff[h][i]; }
            PG8_LDB(B0, 0, 0); PG8_LDB(B1, 0, 1); PG8_SCHED; PG8_LDA(At, 0, 0); PG8_STAGEA(PG8_SA(1, 1), a1, cOff, 1);
            PG8_WAIT_V(8); PG8_WAIT_L(0); PG8_BAR; PG8_MMA(0, 0, At, B0); PG8_MMA(0, 1, At, B1); PG8_BAR; PG8_SCHED;
            PG8_LDA(At, 0, 1); PG8_STAGEB(PG8_SB(0, 0), b2); PG8_STAGEB(PG8_SB(0, 1), b2 + hstepB); PG8_STAGEA(PG8_SA(0, 0), a2, o2, 0);
            PG8_WAIT_V(8); PG8_WAIT_L(0); PG8_BAR; PG8_MMA(1, 0, At, B0); PG8_MMA(1, 1, At, B1); PG8_BAR; PG8_SCHED;
            PG8_LDB(B0, 1, 0); PG8_LDB(B1, 1, 1); PG8_SCHED; PG8_LDA(At, 1, 0); PG8_STAGEA(PG8_SA(0, 1), a2, o2, 1);
            PG8_WAIT_V(8); PG8_WAIT_L(0); PG8_BAR; PG8_MMA(0, 0, At, B0); PG8_MMA(0, 1, At, B1); PG8_BAR; PG8_SCHED;
            PG8_LDA(At, 1, 1); PG8_STAGEB(PG8_SB(1, 0), b3); PG8_STAGEB(PG8_SB(1, 1), b3 + hstepB); PG8_STAGEA(PG8_SA(1, 0), a3, o2, 0);
            PG8_WAIT_V(8); PG8_WAIT_L(0); PG8_BAR; PG8_MMA(1, 0, At, B0); PG8_MMA(1, 1, At, B1); PG8_BAR; PG8_SCHED;
        }
        if constexpr (ALIGN_EPI) { if (wr == 0) PG8_BAR; }
        E(acc, cur, wr, wc, fr, fq);
        if (!has_next) break;
#pragma unroll
        for (int a = 0; a < 2; ++a)
#pragma unroll
            for (int b = 0; b < 2; ++b)
#pragma unroll
                for (int m = 0; m < 4; ++m)
#pragma unroll
                    for (int n = 0; n < 2; ++n) acc[a][b][m][n] = (f32x4){0.f, 0.f, 0.f, 0.f};
        cur = nxt; cA = nA; cB = nB; ++ui;
        if constexpr (GATHER) {
#pragma unroll
            for (int h = 0; h < 2; ++h)
#pragma unroll
                for (int i = 0; i < 2; ++i) cOff[h][i] = nOff[h][i];
        }
        if constexpr (ALIGN_EPI) { if (wr == 1) PG8_BAR; }
    }
    PG8_WAIT_V(0);
    if constexpr (!ALIGN_EPI) { if (wr == 0) PG8_BAR; }
    PG8_BAR;
#undef PG8_SA
#undef PG8_SB
#undef PG8_STAGE2
#undef PG8_STAGEA
#undef PG8_STAGEB
#undef PG8_LDA
#undef PG8_LDB
#undef PG8_MMA
#undef PG8_WAIT_V
#undef PG8_WAIT_L
#undef PG8_BAR
#undef PG8_SCHED
}
__host__ __device__ __forceinline__ int lds_byte8(int r, int ch) { const int fr = r & 15; return (r >> 4) * 2048 + (ch >> 2) * 1024 + ((fr * 64 + (ch & 3) * 16) ^ (((fr >> 2) & 1) << 4)); }
__host__ __device__ __forceinline__ void stage_rc8(int b, int& R, int& CH) { const int blk = b >> 11, h2 = (b >> 10) & 1, w = b & 1023, fr = w >> 6; R = blk * 16 + fr; CH = h2 * 4 + (((w ^ (((fr >> 2) & 1) << 4)) >> 4) & 3); }
typedef int v8i __attribute__((ext_vector_type(8)));
typedef int v4i __attribute__((ext_vector_type(4)));
template <class Epi, class Sched, bool GATHER = false, bool ALIGN_EPI = true>
__device__ __forceinline__ void gemm_phase_f8(PG8_LAS unsigned char* lds, const int tid, const int K, const int lda, const int ldb, const Sched& S, const Epi& E) {
    const int wid = __builtin_amdgcn_readfirstlane(tid >> 6), lane = tid & 63, wr = wid >> 2, wc = wid & 3, fr = lane & 15, fq = lane >> 4;
    const int nt = K / 128;
    int RA[2], CA[2]; unsigned voffB[2];
#pragma unroll
    for (int i = 0; i < 2; ++i) { int R, C; stage_rc8(tid * 16 + i * 8192, R, C); const int Rb = Epi::PERM ? ((R & ~31) + perm32(R & 31)) : R;
        RA[i] = R; CA[i] = C * 8; voffB[i] = (unsigned)(Rb * ldb + C * 16); }
    const size_t kstep = (size_t)(BK * 2);
    const size_t hstepB = (size_t)HALF * ldb;
    const unsigned ldsw = (unsigned)wid * 1024u;
    const int aoff0 = lds_byte8(wr * 64 + fr, 2 * fq), aoff1 = lds_byte8(wr * 64 + fr, 2 * fq + 1), boff0 = lds_byte8(wc * 32 + fr, 2 * fq), boff1 = lds_byte8(wc * 32 + fr, 2 * fq + 1);
#define PG8_SA(b, h) (((b) * 2 + (h)) * HTB)
#define PG8_SB(b, h) ((4 + (b) * 2 + (h)) * HTB)
#define PG8_STAGE2(bufoff, gbase, o0, o1) do { \
        __builtin_amdgcn_global_load_lds((const unsigned*)((const char*)(gbase) + (o0)), (PG8_LAS unsigned*)(lds + (bufoff) + ldsw), 16, 0, 0); \
        __builtin_amdgcn_global_load_lds((const unsigned*)((const char*)(gbase) + (o1)), (PG8_LAS unsigned*)(lds + (bufoff) + ldsw + 8192), 16, 0, 0); } while (0)
#define PG8_STAGEB(bufoff, gbase) PG8_STAGE2(bufoff, gbase, voffB[0], voffB[1])
#define PG8_STAGEA(bufoff, gbase, OFF, h) PG8_STAGE2(bufoff, gbase, OFF[h][0], OFF[h][1])
#define PG8_LDA(dst, b, h) do { _Pragma("unroll") for (int m = 0; m < 4; ++m) { dst[m][0] = *(const PG8_LAS v4i*)(lds + PG8_SA(b, h) + aoff0 + m * 2048); dst[m][1] = *(const PG8_LAS v4i*)(lds + PG8_SA(b, h) + aoff1 + m * 2048); } } while (0)
#define PG8_LDB(dst, b, h) do { _Pragma("unroll") for (int n = 0; n < 2; ++n) { dst[n][0] = *(const PG8_LAS v4i*)(lds + PG8_SB(b, h) + boff0 + n * 2048); dst[n][1] = *(const PG8_LAS v4i*)(lds + PG8_SB(b, h) + boff1 + n * 2048); } } while (0)
#define PG8_V8(x) __builtin_shufflevector(x[0], x[1], 0, 1, 2, 3, 4, 5, 6, 7)
#define PG8_MMA(ai, bj, At, Bt) do { __builtin_amdgcn_s_setprio(1); _Pragma("unroll") for (int m = 0; m < 4; ++m) _Pragma("unroll") for (int n = 0; n < 2; ++n) \
        asm volatile("v_mfma_scale_f32_16x16x128_f8f6f4 %0, %1, %2, %0, %3, %3 op_sel_hi:[0,0,0]" : "+v"(acc[ai][bj][m][n]) : "v"(PG8_V8(Bt[n])), "v"(PG8_V8(At[m])), "v"(sc1)); __builtin_amdgcn_s_setprio(0); } while (0)
#define PG8_WAIT_V(n) asm volatile("s_waitcnt vmcnt(" #n ")" ::: "memory")
#define PG8_WAIT_L(n) asm volatile("s_waitcnt lgkmcnt(" #n ")" ::: "memory")
#define PG8_BAR __builtin_amdgcn_s_barrier()
#define PG8_SCHED __builtin_amdgcn_sched_barrier(0)
    int sc1 = 0x7f7f7f7f; asm volatile("" : "+v"(sc1));
    Unit cur, nxt; int ui = 0;
    if (!S.next(0, cur)) return;
    f32x4 acc[2][2][4][2];
#pragma unroll
    for (int a = 0; a < 2; ++a)
#pragma unroll
        for (int b = 0; b < 2; ++b)
#pragma unroll
            for (int m = 0; m < 4; ++m)
#pragma unroll
                for (int n = 0; n < 2; ++n) acc[a][b][m][n] = (f32x4){0.f, 0.f, 0.f, 0.f};
    v4i At[4][2], B0[2][2], B1[2][2];
    unsigned cOff[2][2], nOff[2][2];
#pragma unroll
    for (int h = 0; h < 2; ++h)
#pragma unroll
        for (int i = 0; i < 2; ++i) {
            if constexpr (GATHER) cOff[h][i] = S.row_off(cur, h * HALF + RA[i]) + (unsigned)CA[i] * 2u;
            else cOff[h][i] = (unsigned)((h * HALF + RA[i]) * lda) + (unsigned)CA[i] * 2u;
            nOff[h][i] = cOff[h][i];
        }
    const char* cA = cur.A; const char* cB = cur.B;
    PG8_STAGEB(PG8_SB(0, 0), cB); PG8_STAGEB(PG8_SB(0, 1), cB + hstepB); PG8_STAGEA(PG8_SA(0, 0), cA, cOff, 0); PG8_STAGEA(PG8_SA(0, 1), cA, cOff, 1);
    if (wr == 1) PG8_BAR;
    PG8_WAIT_V(2); PG8_BAR;
    PG8_STAGEB(PG8_SB(1, 0), cB + kstep); PG8_STAGEA(PG8_SA(1, 0), cA + kstep, cOff, 0); PG8_STAGEB(PG8_SB(1, 1), cB + hstepB + kstep);
    PG8_WAIT_V(6); PG8_BAR;
    for (;;) {
        const bool has_next = S.next(ui + 1, nxt);
        const char* nA = has_next ? nxt.A : cA; const char* nB = has_next ? nxt.B : cB;
        if constexpr (GATHER) {
            if (has_next) {
#pragma unroll
                for (int h = 0; h < 2; ++h)
#pragma unroll
                    for (int i = 0; i < 2; ++i) nOff[h][i] = S.row_off(nxt, h * HALF + RA[i]) + (unsigned)CA[i] * 2u;
            }
        }
#pragma clang loop unroll(disable)
        for (int t = 0; t < nt; t += 2) {
            const bool last = (t == nt - 2);
            const char* a1 = cA + (size_t)(t + 1) * kstep;
            const char* a2 = last ? nA : cA + (size_t)(t + 2) * kstep; const char* b2 = last ? nB : cB + (size_t)(t + 2) * kstep;
            const char* a3 = a2 + kstep; const char* b3 = b2 + kstep;
            unsigned o2[2][2];
#pragma unroll
            for (int h = 0; h < 2; ++h)
#pragma unroll
                for (int i = 0; i < 2; ++i) { if constexpr (GATHER) o2[h][i] = last ? nOff[h][i] : cOff[h][i]; else o2[h][i] = cOff[h][i]; }
            PG8_LDB(B0, 0, 0); PG8_LDB(B1, 0, 1); PG8_SCHED; PG8_LDA(At, 0, 0); PG8_STAGEA(PG8_SA(1, 1), a1, cOff, 1);
            PG8_WAIT_V(8); PG8_WAIT_L(0); PG8_BAR; PG8_MMA(0, 0, At, B0); PG8_MMA(0, 1, At, B1); PG8_BAR; PG8_SCHED;
            PG8_LDA(At, 0, 1); PG8_STAGEB(PG8_SB(0, 0), b2); PG8_STAGEB(PG8_SB(0, 1), b2 + hstepB); PG8_STAGEA(PG8_SA(0, 0), a2, o2, 0);
            PG8_WAIT_V(8); PG8_WAIT_L(0); PG8_BAR; PG8_MMA(1, 0, At, B0); PG8_MMA(1, 1, At, B1); PG8_BAR; PG8_SCHED;
            PG8_LDB(B0, 1, 0); PG8_LDB(B1, 1, 1); PG8_SCHED; PG8_LDA(At, 1, 0); PG8_STAGEA(PG8_SA(0, 1), a2, o2, 1);
            PG8_WAIT_V(8); PG8_WAIT_L(0); PG8_BAR; PG8_MMA(0, 0, At, B0); PG8_MMA(0, 1, At, B1); PG8_BAR; PG8_SCHED;
            PG8_LDA(At, 1, 1); PG8_STAGEB(PG8_SB(1, 0), b3); PG8_STAGEB(PG8_SB(1, 1), b3 + hstepB); PG8_STAGEA(PG8_SA(1, 0), a3, o2, 0);
            PG8_WAIT_V(8); PG8_WAIT_L(0); PG8_BAR; PG8_MMA(1, 0, At, B0); PG8_MMA(1, 1, At, B1); PG8_BAR; PG8_SCHED;
        }
        asm volatile("s_nop 15\n\ts_nop 7" ::: "memory");
        if constexpr (ALIGN_EPI) { if (wr == 0) PG8_BAR; }
        E(acc, cur, wr, wc, fr, fq);
        if (!has_next) break;
#pragma unroll
        for (int a = 0; a < 2; ++a)
#pragma unroll
            for (int b = 0; b < 2; ++b)
#pragma unroll
                for (int m = 0; m < 4; ++m)
#pragma unroll
                    for (int n = 0; n < 2; ++n) acc[a][b][m][n] = (f32x4){0.f, 0.f, 0.f, 0.f};
        cur = nxt; cA = nA; cB = nB; ++ui;
        if constexpr (GATHER) {
#pragma unroll
            for (int h = 0; h < 2; ++h)
#pragma unroll
                for (int i = 0; i < 2; ++i) cOff[h][i] = nOff[h][i];
        }
        if constexpr (ALIGN_EPI) { if (wr == 1) PG8_BAR; }
    }
    PG8_WAIT_V(0);
    if constexpr (!ALIGN_EPI) { if (wr == 0) PG8_BAR; }
    PG8_BAR;
#undef PG8_SA
#undef PG8_SB
#undef PG8_STAGE2
#undef PG8_STAGEA
#undef PG8_STAGEB
#undef PG8_LDA
#undef PG8_LDB
#undef PG8_MMA
#undef PG8_V8
#undef PG8_WAIT_V
#undef PG8_WAIT_L
#undef PG8_BAR
#undef PG8_SCHED
}
}

namespace mla {
using bf16=__hip_bfloat16;
using bf16x8=__attribute__((ext_vector_type(8)))short;
using s16x4=__attribute__((ext_vector_type(4)))short;
using f32x16=__attribute__((ext_vector_type(16)))float;
using u32x4=__attribute__((ext_vector_type(4)))unsigned;
constexpr int SEQ=4096,DQK=96,DV=64,NHEAD=8;
constexpr int QP=768,KP=1024,VP=512,OP=512;
constexpr int NW=8,QBLK=32,QB=QBLK*NW,KVBLK=64,NQB=SEQ/QB;
__device__ __forceinline__ int crow(int r,int hi){return (r&3)+8*(r>>2)+4*hi;}
#define SBAR() __builtin_amdgcn_sched_barrier(0)
__device__ __forceinline__ void cmask(f32x16&p0,f32x16&p1,int jb,int qrel,int hi){
  const float NEG=-INFINITY; int kb=64*jb+4*hi;
  #pragma unroll
  for(int r=0;r<16;++r){int kv=kb+(r&3)+8*(r>>2); if(kv>qrel)p0[r]=NEG; if(kv+32>qrel)p1[r]=NEG;}
}
constexpr int NSLOT=3, KSLOT=12288, VSLOT=8192;
constexpr int LDS_K=0, LDS_V=NSLOT*KSLOT, LDS_WS=LDS_V+NSLOT*VSLOT, LDS_OST=LDS_WS+NW*64*4, LDS_BYTES=LDS_OST+NW*4096;
__device__ __forceinline__ void glds16(const char*sbase,unsigned voff,unsigned lds_dst){unsigned keep;
  asm volatile("s_mov_b32 %0, m0\n\ts_mov_b32 m0, %2\n\ts_nop 0\n\tglobal_load_lds_dwordx4 %1, %3\n\ts_mov_b32 m0, %0":"=&s"(keep):"v"(voff),"s"(lds_dst),"s"(sbase):"memory");}
__device__ __forceinline__ const char* uni_ptr(const void*p){ const unsigned long long v=(unsigned long long)(uintptr_t)p; const unsigned lo=__builtin_amdgcn_readfirstlane((unsigned)v),hi=__builtin_amdgcn_readfirstlane((unsigned)(v>>32)); return (const char*)(uintptr_t)(((unsigned long long)hi<<32)|lo); }
__device__ __forceinline__ float max3f(float a,float b,float c){float r;asm("v_max3_f32 %0, %1, %2, %3":"=v"(r):"v"(a),"v"(b),"v"(c));return r;}
__device__ __forceinline__ float max2f(float a,float b){float r;asm("v_max_f32_e32 %0, %1, %2":"=v"(r):"v"(a),"v"(b));return r;}
__device__ __forceinline__ float fadd_s(float a,float b){float r;asm("v_add_f32_e32 %0, %1, %2":"=v"(r):"v"(a),"v"(b));return r;}
__device__ __forceinline__ float fsub_s(float a,float b){float r;asm("v_sub_f32_e32 %0, %1, %2":"=v"(r):"v"(a),"v"(b));return r;}
typedef float f32x2_t __attribute__((ext_vector_type(2))); typedef __bf16 bf16x2_t __attribute__((ext_vector_type(2)));
__device__ __forceinline__ unsigned cvtpk_s(float lo,float hi){f32x2_t v={lo,hi};bf16x2_t b=__builtin_convertvector(v,bf16x2_t);return __builtin_bit_cast(unsigned,b);}
#define WAIT_BAR(N) asm volatile("s_waitcnt vmcnt(" #N ") lgkmcnt(0)\n\ts_barrier":::"memory")

__device__ __forceinline__ void qkt(f32x16&p0,f32x16&p1,const char*Kslot,const bf16x8*qr,int r32,int hi){
  const f32x16 negm=f32x16{};
  const char*kb=Kslot+hi*1024+r32*16;
  #pragma unroll
  for(int d0=0;d0<6;++d0){
    const bf16x8 b0=*reinterpret_cast<const bf16x8*>(kb+d0*2048);
    const bf16x8 b1=*reinterpret_cast<const bf16x8*>(kb+d0*2048+512);
    if(d0==0){p0=__builtin_amdgcn_mfma_f32_32x32x16_bf16(b0,qr[0],negm,0,0,0);p1=__builtin_amdgcn_mfma_f32_32x32x16_bf16(b1,qr[0],negm,0,0,0);}
    else{p0=__builtin_amdgcn_mfma_f32_32x32x16_bf16(b0,qr[d0],p0,0,0,0);p1=__builtin_amdgcn_mfma_f32_32x32x16_bf16(b1,qr[d0],p1,0,0,0);}}
}
typedef __attribute__((address_space(3))) const char* lds_cptr;
typedef short v4i16_t __attribute__((ext_vector_type(4)));
__device__ __forceinline__ void kload12(bf16x8*kf,lds_cptr kp){
  #pragma unroll
  for(int j=0;j<6;++j){ kf[2*j]=*(const __attribute__((address_space(3))) bf16x8*)(kp+j*2048); kf[2*j+1]=*(const __attribute__((address_space(3))) bf16x8*)(kp+j*2048+512); }
}
__device__ __forceinline__ void kload2(bf16x8*kf,lds_cptr kp,int j){ kf[2*j]=*(const __attribute__((address_space(3))) bf16x8*)(kp+j*2048); kf[2*j+1]=*(const __attribute__((address_space(3))) bf16x8*)(kp+j*2048+512); }
__device__ __forceinline__ s16x4 vtr(lds_cptr p){ return __builtin_bit_cast(s16x4,__builtin_amdgcn_ds_read_tr16_b64_v4i16((__attribute__((address_space(3))) v4i16_t*)p)); }
__device__ __forceinline__ float rowmax(const f32x16&p0,const f32x16&p1){
  float a=max3f(p0[0],p0[1],p1[0]),b=max3f(p0[2],p0[3],p1[1]);a=max3f(a,p1[2],p1[3]);
  #pragma unroll
  for(int r=4;r<16;r+=4){a=max3f(a,p0[r],p0[r+1]);b=max3f(b,p0[r+2],p0[r+3]);a=max3f(a,p1[r],p1[r+1]);b=max3f(b,p1[r+2],p1[r+3]);}
  const float m=max2f(a,b);
  auto rr=__builtin_amdgcn_permlane32_swap(__float_as_uint(m),__float_as_uint(m),false,false);
  return max2f(__uint_as_float(rr[0]),__uint_as_float(rr[1]));
}
__device__ __forceinline__ void pv(f32x16*o,int vb,bf16x8 pa0,bf16x8 pa1,bf16x8 pa2,bf16x8 pa3){
  #pragma unroll
  for(int d0=0;d0<2;++d0){s16x4 lo[4],hi[4];
    #pragma unroll
    for(int ks=0;ks<4;++ks){
      asm volatile("ds_read_b64_tr_b16 %0,%1 offset:%c2":"=&v"(lo[ks]):"v"(vb),"i"(d0*4096+ks*1024):"memory");
      asm volatile("ds_read_b64_tr_b16 %0,%1 offset:%c2":"=&v"(hi[ks]):"v"(vb),"i"(d0*4096+ks*1024+512):"memory");}
    asm volatile("s_waitcnt lgkmcnt(0)":::"memory");SBAR();
    #define PK(k) (bf16x8){lo[k][0],lo[k][1],lo[k][2],lo[k][3],hi[k][0],hi[k][1],hi[k][2],hi[k][3]}
    o[d0]=__builtin_amdgcn_mfma_f32_32x32x16_bf16(pa0,PK(0),o[d0],0,0,0);
    o[d0]=__builtin_amdgcn_mfma_f32_32x32x16_bf16(pa1,PK(1),o[d0],0,0,0);
    o[d0]=__builtin_amdgcn_mfma_f32_32x32x16_bf16(pa2,PK(2),o[d0],0,0,0);
    o[d0]=__builtin_amdgcn_mfma_f32_32x32x16_bf16(pa3,PK(3),o[d0],0,0,0);
    #undef PK
  }
}

template<int THRL> __device__ __forceinline__ void attn_unit(const int tid,int b,int h,int qb,const bf16*Q,const bf16*__restrict__ K,const bf16*__restrict__ V,bf16*O,char*shm){
  const int lane=tid&63,r32=lane&31,hi=lane>>5; const int wid=__builtin_amdgcn_readfirstlane(tid>>6);
  const long rowbase=(long)b*SEQ; const int q0=qb*QB;
  const bf16*Qw=Q+(rowbase+q0+wid*QBLK)*QP+h*DQK;
  const bf16*Kh=K+rowbase*KP+h*DQK,*Vh=V+rowbase*VP+h*DV;
  const unsigned lds0=(unsigned)(uintptr_t)shm;
  float*wsf=(float*)(shm+LDS_WS)+wid*64;
  const char*Kb=uni_ptr(Kh); const char*Vb=uni_ptr(Vh);
  const unsigned koffA=(unsigned)(lane*KP+wid*8)*2u, koffB=(unsigned)(lane*KP+(8+(wid&3))*8)*2u;
  const unsigned voffV=(unsigned)((16*(wid&3)+(lane>>2))*VP+(wid>>2)*32+(lane&3)*8)*2u;
  const unsigned kdstA=lds0+LDS_K+wid*1024, kdstB=lds0+LDS_K+(8+(wid&3))*1024, vdst=lds0+LDS_V+wid*1024;
  #define KOF(s) ((s)+((s)>>1))
  #define DMA_K(t,slot) do{ const char*kt_=Kb+(size_t)(t)*(KVBLK*KP*2); glds16(kt_,koffA,(unsigned)__builtin_amdgcn_readfirstlane(kdstA+KOF(slot))); glds16(kt_,koffB,(unsigned)__builtin_amdgcn_readfirstlane(kdstB+KOF(slot))); }while(0)
  #define DMA_V(t,slot) glds16(Vb+(size_t)(t)*(KVBLK*VP*2),voffV,(unsigned)__builtin_amdgcn_readfirstlane(vdst+(slot)))
  const int vb0=(int)(lds0+LDS_V)+((lane>>4)&1)*32+(lane&3)*8+(4*hi+((lane&15)>>2))*64;
  const char*Kbase=shm+LDS_K; bf16x8 kf[12];
  const lds_cptr shm3=(lds_cptr)shm; const lds_cptr kp0=shm3+LDS_K+hi*1024+r32*16; const lds_cptr vp0=shm3+LDS_V+((lane>>4)&1)*32+(lane&3)*8+(4*hi+((lane&15)>>2))*64;
  const int NT=(q0+QB)/KVBLK;
  DMA_K(0,0);DMA_V(0,0);DMA_K(1,VSLOT);
  bf16x8 qr[6];
  { int lq=lane; asm volatile("":"+v"(lq));
    const bf16*qp=Qw+(long)(lq&31)*QP+(lq>>5)*8;
    _Pragma("unroll") for(int d0=0;d0<6;++d0)qr[d0]=*reinterpret_cast<const bf16x8*>(qp+d0*16); }
  float mhat=0.f,l_reg=0.f;f32x16 o[2];o[0]=f32x16{};o[1]=f32x16{};
  const int qrel=wid*QBLK+r32;
  #define CMASK(P0,P1,t) do{int jb_=(t)-(NT-4); if(jb_>=0)cmask(P0,P1,jb_,qrel,hi);}while(0)
  bool resc=false;
  #define START(P0,P1) do{ const float rm=rowmax(P0,P1); resc=false; \
    { const float dl=rm; mhat=fadd_s(mhat,dl); \
      _Pragma("unroll") for(int r=0;r<16;++r){P0[r]=fsub_s(P0[r],dl);P1[r]=fsub_s(P1[r],dl);} } \
    _Pragma("unroll") for(int r=0;r<16;++r)P0[r]=__builtin_amdgcn_exp2f(P0[r]); }while(0)
  #define RESC() do{ if(resc){ asm volatile("s_waitcnt lgkmcnt(0)":::"memory"); \
      _Pragma("unroll") for(int d_=0;d_<2;++d_) _Pragma("unroll") for(int r=0;r<16;++r)o[d_][r]*=wsf[crow(r,hi)]; } }while(0)
  f32x16 pA0,pA1,pB0,pB1;
  int sl_prev=0,sl_cur=0,sl_next=VSLOT;
  #define ROT() do{sl_prev=sl_cur;sl_cur=sl_next;sl_next=(sl_next==(NSLOT-1)*VSLOT)?0:sl_next+VSLOT;}while(0)
  DMA_K(2,2*VSLOT);
  WAIT_BAR(5);
  qkt(pA0,pA1,Kbase,qr,r32,hi);asm volatile("s_nop 15\n\ts_nop 7":"+v"(pA0),"+v"(pA1));CMASK(pA0,pA1,0);
  START(pA0,pA1);
  _Pragma("unroll") for(int r=0;r<16;++r)pA1[r]=__builtin_amdgcn_exp2f(pA1[r]);
  WAIT_BAR(0);
  DMA_K(3,0);DMA_V(1,VSLOT);
  ROT();
  kload12(kf,kp0+KOF(sl_cur));
  WAIT_BAR(3);
  s16x4 vlo[8],vhi[8]; u32x4 pw0,pw1,pw2,pw3;
  #define PKW(P,B) cvtpk_s(P[B],P[B+1])
  #define PAF(k) __builtin_bit_cast(bf16x8,pw##k)
  #define VFR(i) (bf16x8){vlo[i][0],vlo[i][1],vlo[i][2],vlo[i][3],vhi[i][0],vhi[i][1],vhi[i][2],vhi[i][3]}
  #define PIN(x) asm volatile("":"+v"(x))
  #define MX3(a,b,c) __builtin_fmaxf(__builtin_fmaxf((a),(b)),(c))
  #define GAPA(MF,A0,A1,A2,A3,W0,W1,PW) do{ MF; sacc+=A0; sacc+=A1; sacc+=A2; sacc+=A3; PIN(sacc); W0; W1; PIN(PW); SBAR(); }while(0)
  #define EX(v) __builtin_amdgcn_exp2f(v)
  #define GAPB(MF,X,B) do{ MF; X[B]=EX(X[B]); X[B+1]=EX(X[B+1]); X[B+2]=EX(X[B+2]); X[B+3]=EX(X[B+3]); PIN(X); SBAR(); }while(0)
  #define VRD(i) do{ vlo[i]=vtr(vp_+(((i)>>2)*4096+((i)&3)*1024)); vhi[i]=vtr(vp_+(((i)>>2)*4096+((i)&3)*1024+512)); }while(0)
  #define KRD(G,j) do{ if(G){ kload2(kf,kp0+KOF(sl_next),j); SBAR(); } }while(0)
  const f32x16 zero16=f32x16{};
  #define STEP(C0,C1,P0,P1,t,GK,GV,GL) do{ SBAR(); \
    const lds_cptr vp_=vp0+sl_prev; \
    float sacc=(P0[0]+P0[1]); \
    GAPA(C0=__builtin_amdgcn_mfma_f32_32x32x16_bf16(kf[0],qr[0],zero16,0,0,0), P0[2],P0[3],P0[4],P0[5],     pw0[0]=PKW(P0,0), pw0[1]=PKW(P0,2), pw0); \
    GAPA(C1=__builtin_amdgcn_mfma_f32_32x32x16_bf16(kf[1],qr[0],zero16,0,0,0), P0[6],P0[7],P0[8],P0[9],     pw0[2]=PKW(P0,4), pw0[3]=PKW(P0,6), pw0); \
    GAPA(C0=__builtin_amdgcn_mfma_f32_32x32x16_bf16(kf[2],qr[1],C0,0,0,0),   P0[10],P0[11],P0[12],P0[13], pw1[0]=PKW(P0,8), pw1[1]=PKW(P0,10), pw1); \
    GAPA(C1=__builtin_amdgcn_mfma_f32_32x32x16_bf16(kf[3],qr[1],C1,0,0,0),   P0[14],P0[15],P1[0],P1[1],   pw1[2]=PKW(P0,12),pw1[3]=PKW(P0,14), pw1); \
    GAPA(C0=__builtin_amdgcn_mfma_f32_32x32x16_bf16(kf[4],qr[2],C0,0,0,0),   P1[2],P1[3],P1[4],P1[5],     pw2[0]=PKW(P1,0), pw2[1]=PKW(P1,2), pw2); \
    GAPA(C1=__builtin_amdgcn_mfma_f32_32x32x16_bf16(kf[5],qr[2],C1,0,0,0),   P1[6],P1[7],P1[8],P1[9],     pw2[2]=PKW(P1,4), pw2[3]=PKW(P1,6), pw2); \
    GAPA(C0=__builtin_amdgcn_mfma_f32_32x32x16_bf16(kf[6],qr[3],C0,0,0,0),   P1[10],P1[11],P1[12],P1[13], pw3[0]=PKW(P1,8), pw3[1]=PKW(P1,10), pw3); \
    GAPA(C1=__builtin_amdgcn_mfma_f32_32x32x16_bf16(kf[7],qr[3],C1,0,0,0),   P1[14],P1[15],0.f,0.f,       pw3[2]=PKW(P1,12),pw3[3]=PKW(P1,14), pw3); \
    C0=__builtin_amdgcn_mfma_f32_32x32x16_bf16(kf[8],qr[4],C0,0,0,0); C1=__builtin_amdgcn_mfma_f32_32x32x16_bf16(kf[9],qr[4],C1,0,0,0); VRD(0); SBAR(); \
    C0=__builtin_amdgcn_mfma_f32_32x32x16_bf16(kf[10],qr[5],C0,0,0,0); C1=__builtin_amdgcn_mfma_f32_32x32x16_bf16(kf[11],qr[5],C1,0,0,0); VRD(4); SBAR(); \
    l_reg+=sacc; \
    _Pragma("unroll") for(int r=0;r<16;++r){C0[r]-=mhat;C1[r]-=mhat;} \
    if(GK){DMA_K((t)+3,sl_cur);} if(GV){DMA_V((t)+1,sl_next);} \
    CMASK(C0,C1,t); \
    { float a=MX3(C0[0],C0[1],C1[0]),b=MX3(C0[2],C0[3],C1[1]); a=MX3(a,C1[2],C1[3]); \
      _Pragma("unroll") for(int r=4;r<16;r+=4){a=MX3(a,C0[r],C0[r+1]);b=MX3(b,C0[r+2],C0[r+3]);a=MX3(a,C1[r],C1[r+1]);b=MX3(b,C1[r+2],C1[r+3]);} \
      float rm=__builtin_fmaxf(a,b); { auto rr=__builtin_amdgcn_permlane32_swap(__float_as_uint(rm),__float_as_uint(rm),false,false); rm=__builtin_fmaxf(__uint_as_float(rr[0]),__uint_as_float(rr[1])); } \
      resc=false; \
      if(__builtin_expect(__any(rm>(float)THRL),0)){ const float dl=__builtin_fmaxf(rm,0.f); mhat+=dl; \
        _Pragma("unroll") for(int r=0;r<16;++r){C0[r]-=dl;C1[r]-=dl;} \
        const float f=__builtin_amdgcn_exp2f(-dl); l_reg*=f; if(hi==0)wsf[r32]=f; resc=true; } } \
    SBAR(); \
    VRD(1); SBAR(); GAPB(o[0]=__builtin_amdgcn_mfma_f32_32x32x16_bf16(PAF(0),VFR(0),o[0],0,0,0), C0,0); \
    VRD(5); KRD(GL,0); GAPB(o[1]=__builtin_amdgcn_mfma_f32_32x32x16_bf16(PAF(0),VFR(4),o[1],0,0,0), C0,4); \
    VRD(2); KRD(GL,1); GAPB(o[0]=__builtin_amdgcn_mfma_f32_32x32x16_bf16(PAF(1),VFR(1),o[0],0,0,0), C0,8); \
    VRD(6); KRD(GL,2); GAPB(o[1]=__builtin_amdgcn_mfma_f32_32x32x16_bf16(PAF(1),VFR(5),o[1],0,0,0), C0,12); \
    VRD(3); KRD(GL,3); GAPB(o[0]=__builtin_amdgcn_mfma_f32_32x32x16_bf16(PAF(2),VFR(2),o[0],0,0,0), C1,0); \
    VRD(7); KRD(GL,4); GAPB(o[1]=__builtin_amdgcn_mfma_f32_32x32x16_bf16(PAF(2),VFR(6),o[1],0,0,0), C1,4); \
    KRD(GL,5); GAPB(o[0]=__builtin_amdgcn_mfma_f32_32x32x16_bf16(PAF(3),VFR(3),o[0],0,0,0), C1,8); \
    GAPB(o[1]=__builtin_amdgcn_mfma_f32_32x32x16_bf16(PAF(3),VFR(7),o[1],0,0,0), C1,12); \
    }while(0)
  int t=1;
  #undef CMASK
  #define CMASK(P0,P1,t) do{}while(0)
  for(;t+5<NT;t+=2){
    STEP(pB0,pB1,pA0,pA1,t,true,true,true);     WAIT_BAR(3); RESC(); ROT();
    STEP(pA0,pA1,pB0,pB1,t+1,true,true,true);   WAIT_BAR(3); RESC(); ROT();
  }
  #undef CMASK
  #define CMASK(P0,P1,t) do{int jb_=(t)-(NT-4); if(jb_>=0)cmask(P0,P1,jb_,qrel,hi);}while(0)
  #define ENDW(tt) do{ if((tt)+3<NT){WAIT_BAR(3);} else if((tt)+2<NT){WAIT_BAR(1);} else {WAIT_BAR(0);} }while(0)
  for(;t+1<NT;t+=2){
    STEP(pB0,pB1,pA0,pA1,t,(t+3<NT),(t+1<NT),(t+1<NT));       ENDW(t);   RESC(); ROT();
    STEP(pA0,pA1,pB0,pB1,t+1,(t+4<NT),(t+2<NT),(t+2<NT));     ENDW(t+1); RESC(); ROT();
  }
  STEP(pB0,pB1,pA0,pA1,NT-1,false,false,false); RESC();
  { float sacc=pB0[0]+pB0[1]; _Pragma("unroll") for(int r=2;r<16;++r)sacc+=pB0[r]; _Pragma("unroll") for(int r=0;r<16;++r)sacc+=pB1[r]; l_reg+=sacc;
    pw0=(u32x4){PKW(pB0,0),PKW(pB0,2),PKW(pB0,4),PKW(pB0,6)};pw1=(u32x4){PKW(pB0,8),PKW(pB0,10),PKW(pB0,12),PKW(pB0,14)};pw2=(u32x4){PKW(pB1,0),PKW(pB1,2),PKW(pB1,4),PKW(pB1,6)};pw3=(u32x4){PKW(pB1,8),PKW(pB1,10),PKW(pB1,12),PKW(pB1,14)};
    SBAR(); pv(o,vb0+sl_cur,PAF(0),PAF(1),PAF(2),PAF(3)); }
  #undef PKW
  #undef PAF
  #undef VFR
  #undef PIN
  #undef MX3
  #undef GAPA
  #undef GAPB
  #undef EX
  #undef VRD
  #undef KRD
  #undef STEP
  #undef ENDW
  {auto rr=__builtin_amdgcn_permlane32_swap(__float_as_uint(l_reg),__float_as_uint(l_reg),false,false);l_reg=__uint_as_float(rr[0])+__uint_as_float(rr[1]);}
  if(hi==0)wsf[32+r32]=l_reg;asm volatile("s_waitcnt lgkmcnt(0)":::"memory");
  float rli[16];
  #pragma unroll
  for(int r=0;r<16;++r)rli[r]=__builtin_amdgcn_rcpf(wsf[32+crow(r,hi)]);
  bf16*Ow=O+(rowbase+q0+wid*QBLK)*OP+h*DV;
  { bf16*stg=(bf16*)(shm+LDS_OST)+wid*2048;
    #pragma unroll
    for(int r=0;r<16;++r){const int orow=crow(r,hi);
      #pragma unroll
      for(int d0=0;d0<2;++d0)stg[orow*64+d0*32+r32]=__float2bfloat16(o[d0][r]*rli[r]);}
    asm volatile("s_waitcnt lgkmcnt(0)":::"memory");
    int lo_=lane; asm volatile("":"+v"(lo_));
    #pragma unroll
    for(int i=0;i<4;++i){const int row=i*8+(lo_>>3),ch=lo_&7; const u32x4 v=*(const u32x4*)(stg+row*64+ch*8); *(u32x4*)(Ow+(long)row*OP+ch*8)=v;} }
  asm volatile("s_waitcnt lgkmcnt(0)\n\ts_barrier":::"memory");
  #undef DMA_K
  #undef DMA_V
  #undef KOF
  #undef CMASK
  #undef START
  #undef RESC
  #undef ROT
}
#undef WAIT_BAR
}

constexpr int NWAVES = 8;
constexpr int BATCH = 16, SEQ = 4096, D = 1024, T = BATCH * SEQ;
constexpr int IN_COLS = 4768, N1 = 4864;
constexpr int MEM_LEN = 256, MROWS = BATCH * MEM_LEN;
constexpr int NEXP = 32, TOPK = 4, DFF = 1024, LISTCAP = T;
constexpr int ACT_TILES_MAX = (T * TOPK) / 256 + NEXP;
constexpr float EPS = 1e-6f;
constexpr float C2_MLA = 0.10206207261596575f * 1.4426950408889634f;
constexpr float C2_X = 0.08838834764831845f * 1.4426950408889634f;
constexpr float SX8 = 4.0f, SW8 = 64.0f, SA8 = 4.0f;
constexpr int PER_PHASE = 11;
constexpr int N_LAUNCHES = MK_N_LAUNCHES;

constexpr size_t MiB = 1u << 20;
constexpr size_t WS_CTL = 0, CTL_ZERO_BYTES = 1 * MiB;
constexpr size_t WS_LIST = 1 * MiB;
constexpr size_t WS_TOKG = 9 * MiB;
constexpr size_t WS_RSTD2 = 10 * MiB;
constexpr size_t WS_W1T = 9 * MiB;
constexpr size_t WS_WUQ = 19 * MiB;
constexpr size_t WS_WUKV = 20 * MiB;
constexpr size_t WS_WMEM = 21 * MiB;
constexpr size_t WS_WPOOL = 23 * MiB;
constexpr size_t WS_WMO = 24 * MiB, WS_WCO = 25 * MiB;
constexpr size_t WS_WO = 26 * MiB;
constexpr size_t WS_MEMN = 28 * MiB;
constexpr size_t WS_KVMK = 36 * MiB;
constexpr size_t WS_VTG = 40 * MiB;
constexpr size_t WS_HN = 64 * MiB;
constexpr size_t WS_V = 64 * MiB, WS_MIXED = 128 * MiB;
constexpr size_t WS_GATES = 192 * MiB;
constexpr size_t WS_U = 576 * MiB, WS_AO = 576 * MiB;
constexpr size_t WS_CQKV = 640 * MiB, WS_CO = 640 * MiB;
constexpr size_t WS_QX = 736 * MiB;
constexpr size_t WS_Q = 800 * MiB;
constexpr size_t WS_KV = 896 * MiB, WS_MERGED = 896 * MiB;
constexpr size_t WS_HN2 = 16 * MiB;
constexpr size_t WS_WEI = 144 * MiB;
constexpr size_t WS_Y = 16 * MiB;
constexpr size_t WS_ACT = 400 * MiB;
constexpr size_t WS_WEO = 928 * MiB;
constexpr size_t WS_END = 992 * MiB;
static_assert(WS_ACT + (size_t)ACT_TILES_MAX * 256 * 1024 * 2 <= WS_WEO && WS_Y + (size_t)T * 3 * 1024 * 2 <= WS_ACT && WS_WEI + (size_t)NEXP * 2048 * 1024 * 2 <= WS_ACT, "late map");
static_assert(WS_W1T + (size_t)N1 * 1024 * 2 <= WS_WUQ && WS_VTG + 4 * MiB <= WS_HN && WS_GATES + (size_t)T * 3072 * 2 <= WS_U && WS_CQKV + (size_t)T * 768 * 2 <= WS_QX && WS_Q + (size_t)T * 768 * 2 <= WS_KV, "early map");
constexpr int CW_TMO = 0, CW_CODE = 1;
constexpr int CW_BAR = 4096;
constexpr int CW_GCNT = 16384;
constexpr int RING_OFF = 0, RING_BYTES = 131072;
constexpr int LDSCTL_OFF = RING_BYTES, MISC_OFF = LDSCTL_OFF + 320;
constexpr int LX_TSTART = LDSCTL_OFF + 512;
constexpr int LX_CNT = LDSCTL_OFF + 768;
constexpr int LX_LCNT = LDSCTL_OFF + 1024;
constexpr int LX_BASE = LDSCTL_OFF + 1280;
constexpr int LX_XWS = LDSCTL_OFF + 2048;
constexpr int LX_STASH = LDSCTL_OFF + 4096;
constexpr int LX_GATE = LDSCTL_OFF + 8192;
constexpr int LDS_BYTES = 147456;
static_assert(LX_GATE + 4096 <= LDS_BYTES && mla::LDS_BYTES <= RING_BYTES, "LDS map");

#define GAS __attribute__((address_space(1)))
#define LAS __attribute__((address_space(3)))
typedef unsigned short bf16;
typedef unsigned v4u __attribute__((ext_vector_type(4)));
typedef unsigned v2u __attribute__((ext_vector_type(2)));
typedef float f32x4 __attribute__((ext_vector_type(4)));
typedef float f32x16 __attribute__((ext_vector_type(16)));
typedef short bf16x8 __attribute__((ext_vector_type(8)));
typedef GAS unsigned gu32;
#define RLX_AGENT __ATOMIC_RELAXED, __HIP_MEMORY_SCOPE_AGENT
#define LDS_WAIT() asm volatile("s_waitcnt lgkmcnt(0)" ::: "memory")
#define VM_WAIT() asm volatile("s_waitcnt vmcnt(0)" ::: "memory")
__device__ __forceinline__ unsigned f2bf(float f) { unsigned u = __builtin_bit_cast(unsigned, f); return (u + 0x7fffu + ((u >> 16) & 1u)) >> 16; }
__device__ __forceinline__ unsigned pk2(float lo, float hi) { return pg8::cvt_pk_bf16(lo, hi); }
__device__ __forceinline__ float bflo(unsigned w) { return __uint_as_float(w << 16); }
__device__ __forceinline__ float bfhi(unsigned w) { return __uint_as_float(w & 0xffff0000u); }
__device__ __forceinline__ unsigned pk4_fp8(float a, float b, float c, float d) { int w = 0; w = __builtin_amdgcn_cvt_pk_fp8_f32(a, b, w, false); w = __builtin_amdgcn_cvt_pk_fp8_f32(c, d, w, true); return (unsigned)w; }

#define XB_TMO      128
#define XB_XCNT(j)  (256  + 64 * (j))
#define XB_XSUB(j)  (1280 + 64 * (j))
#define XB_XGEN(j)  (2304 + 64 * (j))
#define XB_TOP      3328
#define XB_TOPGEN   3392
#define XCD_BAR_WORDS 3456
#define XB_SPIN_CAP (1u << 18)
__device__ __forceinline__ unsigned xb_ld(unsigned* p)              { return __hip_atomic_load(p, __ATOMIC_RELAXED, __HIP_MEMORY_SCOPE_AGENT); }
__device__ __forceinline__ unsigned xb_add(unsigned* p, unsigned v) { return __hip_atomic_fetch_add(p, v, __ATOMIC_RELAXED, __HIP_MEMORY_SCOPE_AGENT); }
__device__ __forceinline__ unsigned xb_xcc_id() { return (unsigned)__builtin_amdgcn_s_getreg((3 << 11) | 20) & 0xFu; }
#define XB_SPIN(cond, bar) do { unsigned _sp = 0; while (cond) { __builtin_amdgcn_s_sleep(1); \
    if ((++_sp & 255u) == 0u) { if (xb_ld(&(bar)[XB_TMO])) break; if (_sp > XB_SPIN_CAP) { atomicAdd(&(bar)[XB_TMO], 1u); break; } } } } while (0)
struct XcdBarrier { unsigned* bar; unsigned x; volatile LAS unsigned* st; };
__device__ __forceinline__ XcdBarrier xcd_barrier_post(unsigned* bar, volatile LAS unsigned* st, const bool thread0) {
    XcdBarrier b; b.bar = bar; b.x = xb_xcc_id(); b.st = st;
    if (thread0) (void)xb_add(&bar[XB_XCNT(b.x)], 1u);
    return b;
}
__device__ __forceinline__ void xcd_barrier_complete(unsigned* bar, unsigned x, unsigned& nloc, unsigned& nx) {
    const unsigned G = gridDim.x * gridDim.y * gridDim.z;
    unsigned sum, cnt, mine, sp = 0u;
    for (;;) {
        sum = 0u; cnt = 0u; mine = 0u;
#pragma unroll
        for (unsigned j = 0; j < 16; ++j) { const unsigned c = xb_ld(&bar[XB_XCNT(j)]); sum += c; cnt += (c > 0u) ? 1u : 0u; mine = (j == x) ? c : mine; }
        if (sum == G) break;
        __builtin_amdgcn_s_sleep(1);
        if ((++sp & 255u) == 0u) { if (xb_ld(&bar[XB_TMO])) break; if (sp > XB_SPIN_CAP) { atomicAdd(&bar[XB_TMO], 1u); break; } }
    }
    nloc = mine > 0u ? mine : 1u; nx = cnt > 0u ? cnt : 1u;
}
__device__ __forceinline__ void xcd_barrier(const XcdBarrier& b, const bool thread0) {
    asm volatile("s_waitcnt vmcnt(0)" ::: "memory");
    __syncthreads();
    if (thread0) {
        unsigned* bar = b.bar;
        __builtin_amdgcn_s_waitcnt(0);
        unsigned nloc = b.st[0], nx = b.st[1];
        if (nloc == 0u) { xcd_barrier_complete(bar, b.x, nloc, nx); b.st[0] = nloc; b.st[1] = nx; }
        const unsigned old = xb_add(&bar[XB_XSUB(b.x)], 1u);
        const unsigned gen = old / nloc;
        if (old + 1u == (gen + 1u) * nloc) {
            __builtin_amdgcn_fence(__ATOMIC_RELEASE, "agent");
            asm volatile("s_waitcnt vmcnt(0)" ::: "memory");
            const unsigned og = xb_add(&bar[XB_TOP], 1u);
            const unsigned tg = og / nx;
            if (og + 1u == (tg + 1u) * nx) xb_add(&bar[XB_TOPGEN], 1u);
            else XB_SPIN(xb_ld(&bar[XB_TOPGEN]) == tg, bar);
            __builtin_amdgcn_fence(__ATOMIC_ACQUIRE, "agent");
            xb_add(&bar[XB_XGEN(b.x)], 1u);
            asm volatile("s_waitcnt vmcnt(0)" ::: "memory");
        } else {
            XB_SPIN(xb_ld(&bar[XB_XGEN(b.x)]) == gen, bar);
            __builtin_amdgcn_fence(__ATOMIC_ACQUIRE, "agent");
            asm volatile("s_waitcnt vmcnt(0)" ::: "memory");
        }
    }
    __syncthreads();
}

struct Frame {
    LAS unsigned char* lds;
    volatile LAS unsigned* MISC;
    gu32* ctl;
    int tid, lane, wave;
    int vcu, G;
    unsigned char* ws;
    const float* const* in;
    float* out;
};
__device__ __forceinline__ float wave_sum(float v) {
#pragma unroll
    for (int o = 1; o < 64; o <<= 1) v += __shfl_xor(v, o);
    return v;
}
__device__ __forceinline__ float sumsq8(v4u w) {
    float s = 0.f;
#pragma unroll
    for (int i = 0; i < 4; ++i) { const float a = bflo(w[i]), b = bfhi(w[i]); s += a * a + b * b; }
    return s;
}
__device__ __forceinline__ void transpose_item(const float* W, int ldw, int srccol, const float* ks, bf16* WT, int K, int nrow0, int k0, LAS float* scr, int lane) {
    float v[32];
#pragma unroll
    for (int i = 0; i < 32; ++i) { const int kk = 2 * i + (lane >> 5); v[i] = (srccol >= 0) ? W[(size_t)(k0 + kk) * ldw + srccol + (lane & 31)] : 0.f; }
    if (ks) {
#pragma unroll
        for (int i = 0; i < 32; ++i) v[i] *= ks[k0 + 2 * i + (lane >> 5)]; }
#pragma unroll
    for (int i = 0; i < 32; ++i) scr[(2 * i + (lane >> 5)) * 33 + (lane & 31)] = v[i];
    LDS_WAIT(); asm volatile("" ::: "memory");
    const int c = lane & 7;
#pragma unroll
    for (int j = 0; j < 4; ++j) { const int n = (lane >> 3) + 8 * j; const LAS float* s = scr + (8 * c) * 33 + n;
        v4u o; o.x = pk2(s[0 * 33], s[1 * 33]); o.y = pk2(s[2 * 33], s[3 * 33]); o.z = pk2(s[4 * 33], s[5 * 33]); o.w = pk2(s[6 * 33], s[7 * 33]);
        *(GAS v4u*)(WT + (size_t)(nrow0 + n) * K + k0 + 8 * c) = o; }
    LDS_WAIT(); asm volatile("" ::: "memory");
}
__device__ __forceinline__ void transpose_item8(const float* W, int ldw, int srccol, const float* ks, float scale, unsigned char* WT, int K, int nrow0, int k0, LAS float* scr, int lane) {
    float v[32];
#pragma unroll
    for (int i = 0; i < 32; ++i) { const int kk = 2 * i + (lane >> 5); v[i] = W[(size_t)(k0 + kk) * ldw + srccol + (lane & 31)] * scale; }
    if (ks) {
#pragma unroll
        for (int i = 0; i < 32; ++i) v[i] *= ks[k0 + 2 * i + (lane >> 5)]; }
#pragma unroll
    for (int i = 0; i < 32; ++i) scr[(2 * i + (lane >> 5)) * 33 + (lane & 31)] = v[i];
    LDS_WAIT(); asm volatile("" ::: "memory");
    const int c = lane & 7;
#pragma unroll
    for (int j = 0; j < 4; ++j) { const int n = (lane >> 3) + 8 * j; const LAS float* s = scr + (8 * c) * 33 + n;
        v2u o; o.x = pk4_fp8(s[0 * 33], s[1 * 33], s[2 * 33], s[3 * 33]); o.y = pk4_fp8(s[4 * 33], s[5 * 33], s[6 * 33], s[7 * 33]);
        *(GAS v2u*)(WT + (size_t)(nrow0 + n) * K + k0 + 8 * c) = o; }
    LDS_WAIT(); asm volatile("" ::: "memory");
}
template <int NR> __device__ __forceinline__ void rms_rows_to_bf16(int lane, const float* x0, size_t xstride, const f32x4 (&gg)[4], bf16* o0, size_t ostride) {
    f32x4 v[NR][4];
#pragma unroll
    for (int r = 0; r < NR; ++r) { const GAS f32x4* xr = (const GAS f32x4*)(x0 + r * xstride) + lane;
#pragma unroll
        for (int j = 0; j < 4; ++j) v[r][j] = xr[64 * j]; }
#pragma unroll
    for (int r = 0; r < NR; ++r) { float s = 0.f;
#pragma unroll
        for (int j = 0; j < 4; ++j) s += (v[r][j].x * v[r][j].x + v[r][j].y * v[r][j].y) + (v[r][j].z * v[r][j].z + v[r][j].w * v[r][j].w);
        const float rstd = 1.0f / sqrtf(wave_sum(s) * (1.f / 1024.f) + EPS);
        GAS unsigned long long* o8 = (GAS unsigned long long*)(o0 + r * ostride) + lane;
#pragma unroll
        for (int j = 0; j < 4; ++j)
            o8[64 * j] = (unsigned long long)pk2(v[r][j].x * rstd * gg[j].x, v[r][j].y * rstd * gg[j].y) | ((unsigned long long)pk2(v[r][j].z * rstd * gg[j].z, v[r][j].w * rstd * gg[j].w) << 32); }
}
__device__ __forceinline__ void rms_rows_all(int lane, int gw, int NGW, const float* X, const float* g, bf16* O, int nrows) {
    f32x4 gg[4];
#pragma unroll
    for (int j = 0; j < 4; ++j) gg[j] = ((const GAS f32x4*)g + lane)[64 * j];
    int m = gw;
    for (; m + 3 * NGW < nrows; m += 4 * NGW) rms_rows_to_bf16<4>(lane, X + (size_t)m * D, (size_t)NGW * D, gg, O + (size_t)m * D, (size_t)NGW * D);
    for (; m < nrows; m += NGW) rms_rows_to_bf16<1>(lane, X + (size_t)m * D, 0, gg, O + (size_t)m * D, 0);
}

enum { I_X = 0, I_MEM, I_POS, I_GATTN, I_WIN, I_WPOOL, I_PSCALE, I_GQL, I_WUQ, I_GKVL, I_WUKV, I_GQM, I_GKM, I_GMEM, I_WMEMKV, I_GQC, I_GKC, I_WPO, I_WMO, I_WCO, I_WO, I_GFFN,
       I_WR, I_BR, I_WEI, I_BEI, I_WEO, I_BEO, N_IN };

__device__ __forceinline__ int fresh_lane() { int l; asm volatile("v_mbcnt_lo_u32_b32 %0, -1, 0\n\tv_mbcnt_hi_u32_b32 %0, -1, %0" : "=v"(l)); return l; }
#define REFRESH(F) do { int w_ = (F).wave; asm volatile("" : "+s"(w_)); (F).wave = w_; (F).lane = fresh_lane(); (F).tid = w_ * 64 + (F).lane; } while (0)
__device__ __forceinline__ void p0_prologue(Frame& F) {
    LAS float* scr = (LAS float*)(F.lds + RING_OFF + F.wave * 16384);
    const int gw = F.vcu * NWAVES + F.wave, NGW = F.G * NWAVES, lane = F.lane;
    unsigned char* ws = F.ws;
    constexpr int I1 = 16 * (N1 / 32), I2 = 6 * 24, I3 = 4 * 32, I4 = 16 * 32, I5 = 8 * 32, I6 = 8 * 32, I7 = 16 * 32;
    constexpr int NITEMS = I1 + I2 + I3 + I4 + I5 + I6 + I7;
    for (int it = gw; it < NITEMS; it += NGW) {
        int r = it;
        if (r < I1) { const int nnb = N1 / 32, kb = r / nnb, nb = r % nnb, n0 = nb * 32; const int src = n0 < 1184 ? n0 : (n0 < 1280 ? -1 : n0 - 96);
            transpose_item(F.in[I_WIN], IN_COLS, src, nullptr, (bf16*)(ws + WS_W1T), 1024, n0, kb * 64, scr, lane); continue; } r -= I1;
        if (r < I2) { const int kb = r / 24, nb = r % 24; transpose_item(F.in[I_WUQ], 768, nb * 32, F.in[I_GQL], (bf16*)(ws + WS_WUQ), 384, nb * 32, kb * 64, scr, lane); continue; } r -= I2;
        if (r < I3) { const int kb = r / 32, nb = r % 32; transpose_item(F.in[I_WUKV], 1024, nb * 32, F.in[I_GKVL], (bf16*)(ws + WS_WUKV), 256, nb * 32, kb * 64, scr, lane); continue; } r -= I3;
        if (r < I4) { const int kb = r / 32, nb = r % 32; transpose_item(F.in[I_WMEMKV], 1024, nb * 32, nullptr, (bf16*)(ws + WS_WMEM), 1024, nb * 32, kb * 64, scr, lane); continue; } r -= I4;
        if (r < I5) { const int kb = r / 32, nb = r % 32; transpose_item(F.in[I_WMO], 1024, nb * 32, nullptr, (bf16*)(ws + WS_WMO), 512, nb * 32, kb * 64, scr, lane); continue; } r -= I5;
        if (r < I6) { const int kb = r / 32, nb = r % 32; transpose_item(F.in[I_WCO], 1024, nb * 32, nullptr, (bf16*)(ws + WS_WCO), 512, nb * 32, kb * 64, scr, lane); continue; } r -= I6;
        { const int kb = r / 32, nb = r % 32; transpose_item(F.in[I_WO], 1024, nb * 32, nullptr, (bf16*)(ws + WS_WO), 1024, nb * 32, kb * 64, scr, lane); }
    }
    for (int it = gw; it < 2048; it += NGW) {
        const int kc = it >> 2, dq = it & 3, g = kc >> 7; const float* wp = F.in[I_WPOOL] + (size_t)kc * 128; const float* ps = F.in[I_PSCALE] + g * 128; const float* wpo = F.in[I_WPO] + (size_t)(g * 128) * 1024 + dq * 256 + lane;
        float a[4] = {0.f, 0.f, 0.f, 0.f};
#pragma unroll 8
        for (int j = 0; j < 128; ++j) { const float sc = wp[j] * ps[j]; const float* row = wpo + (size_t)j * 1024;
#pragma unroll
            for (int i = 0; i < 4; ++i) a[i] += sc * row[64 * i]; }
        bf16* wt = (bf16*)(ws + WS_WPOOL);
#pragma unroll
        for (int i = 0; i < 4; ++i) wt[(size_t)(dq * 256 + lane + 64 * i) * 512 + kc] = (bf16)f2bf(a[i]);
    }
    rms_rows_all(lane, gw, NGW, F.in[I_X], F.in[I_GATTN], (bf16*)(ws + WS_HN), T);
    rms_rows_all(lane, gw, NGW, F.in[I_MEM], F.in[I_GMEM], (bf16*)(ws + WS_MEMN), MROWS);
}

using pg8::Unit; using pg8::bf16_t;
struct DenseSched {
    int nM, nN, G, c; const char* A; const char* B; size_t tA, tB;
    __device__ __forceinline__ void init(const void* A_, int lda, const void* B_, int ldb, int M, int N, int G_, int c_) { A = (const char*)A_; B = (const char*)B_; nM = M / 256; nN = N / 256; G = G_; c = c_; tA = (size_t)256 * lda * 2; tB = (size_t)256 * ldb * 2; }
    __device__ __forceinline__ bool next(int i, Unit& u) const {
        const long L = (long)i * G + c; if (L >= (long)nM * nN) return false;
        pg8::tile_order((int)L, nM, nN, u.pm, u.pn); u.A = A + (size_t)u.pm * tA; u.B = B + (size_t)u.pn * tB; u.aux = 0; return true; }
};
struct EpiStore {
    static constexpr bool PERM = true;
    bf16_t* O; int ldc;
    __device__ __forceinline__ void operator()(const pg8::f32x4 (&acc)[2][2][4][2], const Unit& u, int wr, int wc, int fr_, int fq_) const {
        int fr = fr_, fq = fq_; asm volatile("" : "+v"(fr), "+v"(fq));
        const int row0 = u.pm * 256 + wr * 64 + fr, col0 = u.pn * 256 + wc * 32 + 8 * fq;
#pragma unroll
        for (int ai = 0; ai < 2; ++ai)
#pragma unroll
            for (int m = 0; m < 4; ++m) { bf16_t* rowp = O + (size_t)(row0 + ai * 128 + m * 16) * ldc + col0;
#pragma unroll
                for (int bj = 0; bj < 2; ++bj) { const pg8::f32x4 v0 = acc[ai][bj][m][0], v1 = acc[ai][bj][m][1]; pg8::u32x4 w;
                    w.x = pg8::cvt_pk_bf16(v0[0], v0[1]); w.y = pg8::cvt_pk_bf16(v0[2], v0[3]); w.z = pg8::cvt_pk_bf16(v1[0], v1[1]); w.w = pg8::cvt_pk_bf16(v1[2], v1[3]);
                    *(pg8::u32x4*)(rowp + bj * 128) = w; } }
    }
};
struct EpiP1 {
    static constexpr bool PERM = true;
    bf16_t *U, *CQKV, *QX, *GATES;
    __device__ __forceinline__ void operator()(const pg8::f32x4 (&acc)[2][2][4][2], const Unit& u, int wr, int wc, int fr_, int fq_) const {
        int fr = fr_, fq = fq_; asm volatile("" : "+v"(fr), "+v"(fq));
        const int pn = u.pn; bf16_t* base; int ldc, colt; bool sg = false;
        if (pn < 2) { base = U; ldc = 512; colt = pn * 256; } else if (pn < 5) { base = CQKV; ldc = 768; colt = (pn - 2) * 256; }
        else if (pn < 7) { base = QX; ldc = 512; colt = (pn - 5) * 256; } else { base = GATES; ldc = 3072; colt = (pn - 7) * 256; sg = true; }
        const int row0 = u.pm * 256 + wr * 64 + fr, col0 = colt + wc * 32 + 8 * fq;
#pragma unroll
        for (int ai = 0; ai < 2; ++ai)
#pragma unroll
            for (int m = 0; m < 4; ++m) { bf16_t* rowp = base + (size_t)(row0 + ai * 128 + m * 16) * ldc + col0;
#pragma unroll
                for (int bj = 0; bj < 2; ++bj) { pg8::f32x4 v0 = acc[ai][bj][m][0], v1 = acc[ai][bj][m][1];
                    if (sg) {
#pragma unroll
                        for (int i = 0; i < 4; ++i) { v0[i] = pg8::sigmoidf_fast(v0[i]); v1[i] = pg8::sigmoidf_fast(v1[i]); } }
                    pg8::u32x4 w; w.x = pg8::cvt_pk_bf16(v0[0], v0[1]); w.y = pg8::cvt_pk_bf16(v0[2], v0[3]); w.z = pg8::cvt_pk_bf16(v1[0], v1[1]); w.w = pg8::cvt_pk_bf16(v1[2], v1[3]);
                    *(pg8::u32x4*)(rowp + bj * 128) = w; } }
    }
};
struct EpiMemKV {
    static constexpr bool PERM = true;
    bf16_t *KVMK, *VTG;
    __device__ __forceinline__ void operator()(const pg8::f32x4 (&acc)[2][2][4][2], const Unit& u, int wr, int wc, int fr_, int fq_) const {
        int fr = fr_, fq = fq_; asm volatile("" : "+v"(fr), "+v"(fq));
        const int row0 = u.pm * 256 + wr * 64 + fr;
        if (u.pn < 2) {
            const int col0 = u.pn * 256 + wc * 32 + 8 * fq;
#pragma unroll
            for (int ai = 0; ai < 2; ++ai)
#pragma unroll
                for (int m = 0; m < 4; ++m) { bf16_t* rowp = KVMK + (size_t)(row0 + ai * 128 + m * 16) * 512 + col0;
#pragma unroll
                    for (int bj = 0; bj < 2; ++bj) { const pg8::f32x4 v0 = acc[ai][bj][m][0], v1 = acc[ai][bj][m][1]; pg8::u32x4 w;
                        w.x = pg8::cvt_pk_bf16(v0[0], v0[1]); w.y = pg8::cvt_pk_bf16(v0[2], v0[3]); w.z = pg8::cvt_pk_bf16(v1[0], v1[1]); w.w = pg8::cvt_pk_bf16(v1[2], v1[3]);
                        *(pg8::u32x4*)(rowp + bj * 128) = w; } }
        } else {
#pragma unroll
            for (int ai = 0; ai < 2; ++ai)
#pragma unroll
                for (int m = 0; m < 4; ++m) { const int row = row0 + ai * 128 + m * 16, b = row >> 8, mm = row & 255;
                    const int pos = (mm & ~12) | ((mm & 4) << 1) | ((mm & 8) >> 1);
#pragma unroll
                    for (int bj = 0; bj < 2; ++bj) { const int hc = (u.pn - 2) * 2 + bj;
                        bf16_t* dst = VTG + ((size_t)(b * 4 + hc) * 128 + wc * 32 + 8 * fq) * 256 + pos;
#pragma unroll
                        for (int n = 0; n < 2; ++n)
#pragma unroll
                            for (int i = 0; i < 4; ++i) dst[(size_t)(4 * n + i) * 256] = (bf16_t)f2bf(acc[ai][bj][m][n][i]); } }
        }
    }
};
struct MergeSched {
    int G, c; const char *A0, *B0; long dA1, dA2, dB1, dB2;
    __device__ __forceinline__ bool next(int i, Unit& u) const {
        const int ti = i / 3, br = i - 3 * ti; const long L = (long)ti * G + c; if (L >= 256 * 4) return false;
        pg8::tile_order((int)L, 256, 4, u.pm, u.pn); u.aux = br;
        const long b1 = br & 1, b2 = br >> 1;
        u.A = A0 + b1 * dA1 + b2 * dA2 + (size_t)u.pm * (256 * 512 * 2); u.B = B0 + b1 * dB1 + b2 * dB2 + (size_t)u.pn * (256 * 512 * 2); return true; }
};
struct EpiMerge {
    static constexpr bool PERM = true;
    const bf16_t* GATES; bf16_t* MERGED;
    __device__ __forceinline__ void operator()(const pg8::f32x4 (&acc)[2][2][4][2], const Unit& u, int wr, int wc, int fr_, int fq_) const {
        int fr = fr_, fq = fq_; asm volatile("" : "+v"(fr), "+v"(fq));
        const int br = u.aux, row0 = u.pm * 256 + wr * 64 + fr, col0 = u.pn * 256 + wc * 32 + 8 * fq;
#pragma unroll
        for (int ai = 0; ai < 2; ++ai)
#pragma unroll
            for (int m = 0; m < 4; ++m) { const size_t row = (size_t)(row0 + ai * 128 + m * 16);
#pragma unroll
                for (int bj = 0; bj < 2; ++bj) { const int c0 = col0 + bj * 128;
                    const pg8::u32x4 g = *(const pg8::u32x4*)(GATES + row * 3072 + br * 1024 + c0);
                    pg8::f32x4 v0 = acc[ai][bj][m][0], v1 = acc[ai][bj][m][1];
                    v0[0] *= bflo(g.x); v0[1] *= bfhi(g.x); v0[2] *= bflo(g.y); v0[3] *= bfhi(g.y); v1[0] *= bflo(g.z); v1[1] *= bfhi(g.z); v1[2] *= bflo(g.w); v1[3] *= bfhi(g.w);
                    bf16_t* dst = MERGED + row * 1024 + c0;
                    if (br > 0) { const pg8::u32x4 p = *(const pg8::u32x4*)dst;
                        v0[0] += bflo(p.x); v0[1] += bfhi(p.x); v0[2] += bflo(p.y); v0[3] += bfhi(p.y); v1[0] += bflo(p.z); v1[1] += bfhi(p.z); v1[2] += bflo(p.w); v1[3] += bfhi(p.w); }
                    pg8::u32x4 w; w.x = pg8::cvt_pk_bf16(v0[0], v0[1]); w.y = pg8::cvt_pk_bf16(v0[2], v0[3]); w.z = pg8::cvt_pk_bf16(v1[0], v1[1]); w.w = pg8::cvt_pk_bf16(v1[2], v1[3]);
                    *(pg8::u32x4*)dst = w; } }
    }
};
struct EpiResF32 {
    static constexpr bool PERM = false;
    const float* X; float* O;
    __device__ __forceinline__ void operator()(const pg8::f32x4 (&acc)[2][2][4][2], const Unit& u, int wr, int wc, int fr_, int fq_) const {
        int fr = fr_, fq = fq_; asm volatile("" : "+v"(fr), "+v"(fq));
        const int row0 = u.pm * 256 + wr * 64 + fr, col0 = u.pn * 256 + wc * 32 + 4 * fq;
#pragma unroll
        for (int ai = 0; ai < 2; ++ai)
#pragma unroll
            for (int m = 0; m < 4; ++m) { const size_t off = (size_t)(row0 + ai * 128 + m * 16) * 1024 + col0;
#pragma unroll
                for (int bj = 0; bj < 2; ++bj)
#pragma unroll
                    for (int n = 0; n < 2; ++n) { const pg8::f32x4 xv = *(const pg8::f32x4*)(X + off + bj * 128 + n * 16); *(pg8::f32x4*)(O + off + bj * 128 + n * 16) = xv + acc[ai][bj][m][n]; } }
    }
};
struct MoeSched {
    int G, c, nM, nN; const LAS int* tstart; const LAS int* cnt; const int* list; const char* A; const char* B; size_t bexp, tB, tA; bool gather;
    __device__ __forceinline__ bool next(int i, Unit& u) const {
        const long L = (long)i * G + c; if (L >= (long)nM * nN) return false;
        int pm, pn; pg8::tile_order((int)L, nM, nN, pm, pn);
        int e = 0; while (e < NEXP - 1 && __builtin_amdgcn_readfirstlane(tstart[e + 1]) <= pm) ++e;
        const int ts = __builtin_amdgcn_readfirstlane(tstart[e]);
        u.pm = pm; u.pn = pn; u.aux = e | ((pm - ts) << 8);
        u.A = gather ? A : A + (size_t)pm * tA; u.B = B + (size_t)e * bexp + (size_t)pn * tB; return true; }
    __device__ __forceinline__ unsigned row_off(const Unit& u, int row) const {
        const int e = u.aux & 255, idx = (u.aux >> 8) * 256 + row; const int ent = idx < cnt[e] ? list[(size_t)e * LISTCAP + idx] : 0; return (unsigned)(ent >> 2) * 1024u; }
};
struct EpiMoeIn {
    static constexpr bool PERM = true;
    const LAS int* cnt; const int* list; const float* rstd2; const float* bin; unsigned char* ACT;
    __device__ __forceinline__ void operator()(const pg8::f32x4 (&acc)[2][2][4][2], const Unit& u, int wr, int wc, int fr_, int fq_) const {
        int fr = fr_, fq = fq_; asm volatile("" : "+v"(fr), "+v"(fq));
        const int e = u.aux & 255, rt = u.aux >> 8, ce = cnt[e], j0 = u.pn * 128 + wc * 32 + 8 * fq;
        const float* bg = bin + (size_t)e * 2048 + j0; const pg8::f32x4 bg0 = *(const pg8::f32x4*)bg, bg1 = *(const pg8::f32x4*)(bg + 4), bl0 = *(const pg8::f32x4*)(bg + 1024), bl1 = *(const pg8::f32x4*)(bg + 1028);
#pragma unroll
        for (int ai = 0; ai < 2; ++ai)
#pragma unroll
            for (int m = 0; m < 4; ++m) { const int rl = ai * 128 + wr * 64 + m * 16 + fr, idx = rt * 256 + rl; float rs = 0.f;
                if (idx < ce) rs = rstd2[list[(size_t)e * LISTCAP + idx] >> 2] * (1.0f / (SX8 * SW8));
                float a[8];
#pragma unroll
                for (int n = 0; n < 2; ++n)
#pragma unroll
                    for (int i = 0; i < 4; ++i) { float gl = acc[ai][0][m][n][i] * rs + (n ? bg1[i] : bg0[i]), li = acc[ai][1][m][n][i] * rs + (n ? bl1[i] : bl0[i]);
                        gl = fminf(gl, 7.0f); li = fminf(fmaxf(li, -7.0f), 7.0f);
                        a[4 * n + i] = gl * pg8::sigmoidf_fast(1.702f * gl) * (li + 1.0f) * SA8; }
                pg8::u32x2 w; w.x = pk4_fp8(a[0], a[1], a[2], a[3]); w.y = pk4_fp8(a[4], a[5], a[6], a[7]);
                *(pg8::u32x2*)(ACT + ((size_t)u.pm * 256 + rl) * 1024 + j0) = w; }
    }
};
struct EpiMoeOut {
    static constexpr bool PERM = true;
    const LAS int* cnt; const int* list; const float* tokg; const float* bout; float* OUT; bf16_t* Y;
    __device__ __forceinline__ void operator()(const pg8::f32x4 (&acc)[2][2][4][2], const Unit& u, int wr, int wc, int fr_, int fq_) const {
        int fr = fr_, fq = fq_; asm volatile("" : "+v"(fr), "+v"(fq));
        const int e = u.aux & 255, rt = u.aux >> 8, ce = cnt[e], c0 = u.pn * 256 + wc * 32 + 8 * fq;
        const float* bo = bout + (size_t)e * 1024 + c0; pg8::f32x4 bv[2][2];
#pragma unroll
        for (int bj = 0; bj < 2; ++bj)
#pragma unroll
            for (int n = 0; n < 2; ++n) bv[bj][n] = *(const pg8::f32x4*)(bo + bj * 128 + 4 * n);
#pragma unroll
        for (int ai = 0; ai < 2; ++ai)
#pragma unroll
            for (int m = 0; m < 4; ++m) { const int rl = ai * 128 + wr * 64 + m * 16 + fr, idx = rt * 256 + rl;
                if (idx < ce) { const int ent = list[(size_t)e * LISTCAP + idx], t = ent >> 2, k = ent & 3; const float g = tokg[ent];
#pragma unroll
                    for (int bj = 0; bj < 2; ++bj) { const pg8::f32x4 v0 = (acc[ai][bj][m][0] * (1.0f / (SA8 * SW8)) + bv[bj][0]) * g, v1 = (acc[ai][bj][m][1] * (1.0f / (SA8 * SW8)) + bv[bj][1]) * g;
                        if (k == 0) { float* p = OUT + (size_t)t * 1024 + c0 + bj * 128; const pg8::f32x4 o0 = *(const pg8::f32x4*)p, o1 = *(const pg8::f32x4*)(p + 4); *(pg8::f32x4*)p = o0 + v0; *(pg8::f32x4*)(p + 4) = o1 + v1; }
                        else { pg8::u32x4 w; w.x = pg8::cvt_pk_bf16(v0[0], v0[1]); w.y = pg8::cvt_pk_bf16(v0[2], v0[3]); w.z = pg8::cvt_pk_bf16(v1[0], v1[1]); w.w = pg8::cvt_pk_bf16(v1[2], v1[3]);
                            *(pg8::u32x4*)(Y + ((size_t)t * 3 + (k - 1)) * 1024 + c0 + bj * 128) = w; } } } }
    }
};

__device__ const float ROPE_INVREV[16] = { 1.591549431e-01f, 8.949940161e-02f, 5.032921210e-02f, 2.830219583e-02f, 1.591549431e-02f, 8.949940161e-03f, 5.032921210e-03f, 2.830219583e-03f,
                                           1.591549431e-03f, 8.949940161e-04f, 5.032921210e-04f, 2.830219583e-04f, 1.591549431e-04f, 8.949940161e-05f, 5.032921210e-05f, 2.830219583e-05f };
struct P3In { v4u cqa, cqb, qn, kn, vv; unsigned pe_lo, pe_hi, ql, qh; int pos; v4u uw[16]; };
__device__ __forceinline__ void p3_load(Frame& F, int t, P3In& I) {
    const int lane = F.lane, h = lane >> 3, sub = lane & 7; unsigned char* ws = F.ws;
    const bf16* cq = (const bf16*)(ws + WS_CQKV) + (size_t)t * 768;
    I.cqa = (v4u){0u, 0u, 0u, 0u}; I.cqb = (v4u){0u, 0u, 0u, 0u};
    if (lane < 48) I.cqa = *(const GAS v4u*)(cq + lane * 8);
    if (lane < 32) I.cqb = *(const GAS v4u*)(cq + 384 + lane * 8);
    I.pe_lo = *(const GAS unsigned*)(cq + 640 + 2 * sub); I.pe_hi = *(const GAS unsigned*)(cq + 656 + 2 * sub);
    I.pos = ((const int*)F.in[I_POS])[t];
    const bf16* qrow = (const bf16*)(ws + WS_Q) + (size_t)t * 768 + h * 96;
    I.qn = *(const GAS v4u*)(qrow + sub * 8); I.ql = *(const GAS unsigned*)(qrow + 64 + 2 * sub); I.qh = *(const GAS unsigned*)(qrow + 80 + 2 * sub);
    const bf16* kvrow = (const bf16*)(ws + WS_KV) + (size_t)t * 1024;
    I.kn = *(const GAS v4u*)(kvrow + h * 128 + sub * 8); I.vv = *(const GAS v4u*)(kvrow + h * 128 + 64 + sub * 8);
    const int s = t & (SEQ - 1), win = 2 << (lane >> 4), cntw = (s + 1 < win) ? s + 1 : win;
    const bf16* urow = (const bf16*)(ws + WS_U) + (size_t)t * 512 + lane * 8;
#pragma unroll
    for (int j = 0; j < 16; ++j) { I.uw[j] = (v4u){0u, 0u, 0u, 0u}; if (j < cntw) I.uw[j] = *(const GAS v4u*)(urow - (size_t)j * 512); }
}
__device__ __forceinline__ void p3_compute(Frame& F, int t, const P3In& I) {
    const int lane = F.lane, h = lane >> 3, sub = lane & 7; unsigned char* ws = F.ws;
    float sq = sumsq8(I.cqa), skv = sumsq8(I.cqb);
    sq = wave_sum(sq); skv = wave_sum(skv);
    const float rs_q = 1.0f / sqrtf(sq * (1.f / 384.f) + EPS), rs_kv = 1.0f / sqrtf(skv * (1.f / 256.f) + EPS);
    const float posf = (float)I.pos;
    float cs[2], sn[2];
#pragma unroll
    for (int p = 0; p < 2; ++p) { float rev = posf * ROPE_INVREV[2 * sub + p]; rev -= floorf(rev); sn[p] = __builtin_amdgcn_sinf(rev); cs[p] = __builtin_amdgcn_cosf(rev); }
    const float* gq = F.in[I_GQM]; const float* gk = F.in[I_GKM];
    {
        bf16* qrow = (bf16*)(ws + WS_Q) + (size_t)t * 768 + h * 96;
        float q[8], a[2], b[2];
#pragma unroll
        for (int i = 0; i < 4; ++i) { q[2 * i] = bflo(I.qn[i]) * rs_q; q[2 * i + 1] = bfhi(I.qn[i]) * rs_q; }
        a[0] = bflo(I.ql) * rs_q; a[1] = bfhi(I.ql) * rs_q; b[0] = bflo(I.qh) * rs_q; b[1] = bfhi(I.qh) * rs_q;
        float ss = a[0] * a[0] + a[1] * a[1] + b[0] * b[0] + b[1] * b[1];
#pragma unroll
        for (int i = 0; i < 8; ++i) ss += q[i] * q[i];
        ss += __shfl_xor(ss, 1); ss += __shfl_xor(ss, 2); ss += __shfl_xor(ss, 4);
        const float rn = C2_MLA / sqrtf(ss * (1.f / 96.f) + EPS);
#pragma unroll
        for (int i = 0; i < 8; ++i) q[i] *= rn * gq[sub * 8 + i];
        float lo[2], hi[2];
#pragma unroll
        for (int p = 0; p < 2; ++p) { const float x1 = a[p] * rn * gq[64 + 2 * sub + p], x2 = b[p] * rn * gq[80 + 2 * sub + p]; lo[p] = x1 * cs[p] - x2 * sn[p]; hi[p] = x2 * cs[p] + x1 * sn[p]; }
        v4u o; o.x = pk2(q[0], q[1]); o.y = pk2(q[2], q[3]); o.z = pk2(q[4], q[5]); o.w = pk2(q[6], q[7]);
        *(GAS v4u*)(qrow + sub * 8) = o; *(GAS unsigned*)(qrow + 64 + 2 * sub) = pk2(lo[0], lo[1]); *(GAS unsigned*)(qrow + 80 + 2 * sub) = pk2(hi[0], hi[1]);
    }
    {
        bf16* kvrow = (bf16*)(ws + WS_KV) + (size_t)t * 1024;
        float k[8], v[8], a[2], b[2];
#pragma unroll
        for (int i = 0; i < 4; ++i) { k[2 * i] = bflo(I.kn[i]) * rs_kv; k[2 * i + 1] = bfhi(I.kn[i]) * rs_kv; v[2 * i] = bflo(I.vv[i]) * rs_kv; v[2 * i + 1] = bfhi(I.vv[i]) * rs_kv; }
        a[0] = bflo(I.pe_lo); a[1] = bfhi(I.pe_lo); b[0] = bflo(I.pe_hi); b[1] = bfhi(I.pe_hi);
        float ss = a[0] * a[0] + a[1] * a[1] + b[0] * b[0] + b[1] * b[1];
#pragma unroll
        for (int i = 0; i < 8; ++i) ss += k[i] * k[i];
        ss += __shfl_xor(ss, 1); ss += __shfl_xor(ss, 2); ss += __shfl_xor(ss, 4);
        const float rn = 1.0f / sqrtf(ss * (1.f / 96.f) + EPS);
#pragma unroll
        for (int i = 0; i < 8; ++i) k[i] *= rn * gk[sub * 8 + i];
        float lo[2], hi[2];
#pragma unroll
        for (int p = 0; p < 2; ++p) { const float x1 = a[p] * rn * gk[64 + 2 * sub + p], x2 = b[p] * rn * gk[80 + 2 * sub + p]; lo[p] = x1 * cs[p] - x2 * sn[p]; hi[p] = x2 * cs[p] + x1 * sn[p]; }
        v4u o; o.x = pk2(k[0], k[1]); o.y = pk2(k[2], k[3]); o.z = pk2(k[4], k[5]); o.w = pk2(k[6], k[7]);
        v4u ov; ov.x = pk2(v[0], v[1]); ov.y = pk2(v[2], v[3]); ov.z = pk2(v[4], v[5]); ov.w = pk2(v[6], v[7]);
        bf16* krow = kvrow + h * 96;
        *(GAS v4u*)(krow + sub * 8) = o; *(GAS unsigned*)(krow + 64 + 2 * sub) = pk2(lo[0], lo[1]); *(GAS unsigned*)(krow + 80 + 2 * sub) = pk2(hi[0], hi[1]);
        *(GAS v4u*)((bf16*)(ws + WS_V) + (size_t)t * 512 + h * 64 + sub * 8) = ov;
    }
    {
        const int s = t & (SEQ - 1), win = 2 << (lane >> 4), cntw = (s + 1 < win) ? s + 1 : win;
        float acc[8];
#pragma unroll
        for (int i = 0; i < 8; ++i) acc[i] = 0.f;
#pragma unroll
        for (int j = 0; j < 16; ++j)
#pragma unroll
            for (int i = 0; i < 4; ++i) { acc[2 * i] += bflo(I.uw[j][i]); acc[2 * i + 1] += bfhi(I.uw[j][i]); }
        const float inv = 1.0f / (float)cntw;
#pragma unroll
        for (int i = 0; i < 4; ++i) { acc[2 * i] = acc[2 * i] * inv - bflo(I.uw[0][i]); acc[2 * i + 1] = acc[2 * i + 1] * inv - bfhi(I.uw[0][i]); }
        v4u o; o.x = pk2(acc[0], acc[1]); o.y = pk2(acc[2], acc[3]); o.z = pk2(acc[4], acc[5]); o.w = pk2(acc[6], acc[7]);
        *(GAS v4u*)((bf16*)(ws + WS_MIXED) + (size_t)t * 512 + lane * 8) = o;
    }
}
template <int NT> __device__ __forceinline__ void p3_tokens(Frame& F, int t0) {
    P3In I[NT];
#pragma unroll
    for (int i = 0; i < NT; ++i) p3_load(F, t0 + i, I[i]);
    asm volatile("" ::: "memory");
#pragma unroll
    for (int i = 0; i < NT; ++i) p3_compute(F, t0 + i, I[i]);
}

namespace xat {
__device__ __forceinline__ int crow(int r, int hi) { return (r & 3) + 8 * (r >> 2) + 4 * hi; }
__device__ __forceinline__ void stage_kv(Frame& F, int b, int hc) {
    const int tid = F.tid; unsigned char* ws = F.ws; LAS unsigned char* lds = F.lds;
    { const int row = tid >> 1, half = tid & 1; const bf16* src = (const bf16*)(ws + WS_KVMK) + (size_t)(b * 256 + row) * 512 + hc * 128 + half * 64;
      v4u v[8]; float ss = 0.f;
#pragma unroll
      for (int c = 0; c < 8; ++c) { v[c] = *(const GAS v4u*)(src + 8 * c); ss += sumsq8(v[c]); }
      ss += __shfl_xor(ss, 1);
      const float rstd = 1.0f / sqrtf(ss * (1.f / 128.f) + EPS); const float* gk = F.in[I_GKC] + half * 64;
#pragma unroll
      for (int c = 0; c < 8; ++c) { v4u o;
#pragma unroll
          for (int i = 0; i < 4; ++i) o[i] = pk2(bflo(v[c][i]) * rstd * gk[8 * c + 2 * i], bfhi(v[c][i]) * rstd * gk[8 * c + 2 * i + 1]);
          *(LAS v4u*)(lds + row * 256 + (((half * 8 + c) ^ (row & 15)) << 4)) = o; } }
    { const bf16* src = (const bf16*)(ws + WS_VTG) + (size_t)(b * 4 + hc) * 128 * 256;
#pragma unroll
      for (int i = 0; i < 8; ++i) { const int q = tid + 512 * i, d = q >> 5, ch = q & 31; const v4u v = *(const GAS v4u*)(src + (size_t)q * 8);
          *(LAS v4u*)(lds + 65536 + d * 512 + ((ch ^ (d & 15)) << 4)) = v; } }
}
__device__ __forceinline__ void unit(Frame& F, int b, int hc, int qb) {
    const int lane = F.lane, r32 = lane & 31, hi = lane >> 5, wid = F.wave; unsigned char* ws = F.ws; LAS unsigned char* lds = F.lds;
    LAS float* wsf = (LAS float*)(lds + LX_XWS) + wid * 64;
    const size_t row = (size_t)b * SEQ + qb * 256 + wid * 32 + r32;
    bf16x8 qr[8];
    { const bf16* qsrc = (const bf16*)(ws + WS_QX) + row * 512 + hc * 128 + hi * 8; v4u qv[8]; float ss = 0.f;
#pragma unroll
      for (int d0 = 0; d0 < 8; ++d0) { qv[d0] = *(const GAS v4u*)(qsrc + 16 * d0); ss += sumsq8(qv[d0]); }
      ss += __shfl_xor(ss, 32);
      const float rn = C2_X / sqrtf(ss * (1.f / 128.f) + EPS); const float* gq = F.in[I_GQC] + hi * 8;
#pragma unroll
      for (int d0 = 0; d0 < 8; ++d0) { v4u o;
#pragma unroll
          for (int i = 0; i < 4; ++i) o[i] = pk2(bflo(qv[d0][i]) * rn * gq[16 * d0 + 2 * i], bfhi(qv[d0][i]) * rn * gq[16 * d0 + 2 * i + 1]);
          qr[d0] = __builtin_bit_cast(bf16x8, o); } }
    f32x16 o[4];
#pragma unroll
    for (int i = 0; i < 4; ++i) o[i] = f32x16{};
    float mrun = -1e30f, lrun = 0.f;
#pragma unroll 1
    for (int tt = 0; tt < 4; ++tt) {
        f32x16 p0 = f32x16{}, p1 = f32x16{};
        const int kr0 = 64 * tt + r32, kr1 = kr0 + 32;
#pragma unroll
        for (int d0 = 0; d0 < 8; ++d0) {
            const bf16x8 k0 = *(const LAS bf16x8*)(lds + kr0 * 256 + (((2 * d0 + hi) ^ (kr0 & 15)) << 4));
            const bf16x8 k1 = *(const LAS bf16x8*)(lds + kr1 * 256 + (((2 * d0 + hi) ^ (kr1 & 15)) << 4));
            p0 = __builtin_amdgcn_mfma_f32_32x32x16_bf16(k0, qr[d0], p0, 0, 0, 0);
            p1 = __builtin_amdgcn_mfma_f32_32x32x16_bf16(k1, qr[d0], p1, 0, 0, 0);
        }
        float rm = fmaxf(p0[0], p1[0]);
#pragma unroll
        for (int r = 1; r < 16; ++r) rm = fmaxf(rm, fmaxf(p0[r], p1[r]));
        rm = fmaxf(rm, __shfl_xor(rm, 32));
        const float mnew = fmaxf(mrun, rm), sc = __builtin_amdgcn_exp2f(mrun - mnew); mrun = mnew;
        float ps = 0.f;
#pragma unroll
        for (int r = 0; r < 16; ++r) { p0[r] = __builtin_amdgcn_exp2f(p0[r] - mnew); p1[r] = __builtin_amdgcn_exp2f(p1[r] - mnew); ps += p0[r] + p1[r]; }
        lrun = lrun * sc + ps;
        if (hi == 0) wsf[r32] = sc;
        LDS_WAIT();
#pragma unroll
        for (int d = 0; d < 4; ++d)
#pragma unroll
            for (int r = 0; r < 16; ++r) o[d][r] *= wsf[crow(r, hi)];
        v4u pw[4];
#pragma unroll
        for (int i = 0; i < 4; ++i) { pw[0][i] = pk2(p0[2 * i], p0[2 * i + 1]); pw[1][i] = pk2(p0[8 + 2 * i], p0[9 + 2 * i]); pw[2][i] = pk2(p1[2 * i], p1[2 * i + 1]); pw[3][i] = pk2(p1[8 + 2 * i], p1[9 + 2 * i]); }
#pragma unroll
        for (int ks = 0; ks < 4; ++ks) { const int ch = 2 * (4 * tt + ks) + hi; const bf16x8 pa = __builtin_bit_cast(bf16x8, pw[ks]);
#pragma unroll
            for (int d = 0; d < 4; ++d) { const int dr = r32 + 32 * d; const bf16x8 vf = *(const LAS bf16x8*)(lds + 65536 + dr * 512 + ((ch ^ (dr & 15)) << 4));
                o[d] = __builtin_amdgcn_mfma_f32_32x32x16_bf16(pa, vf, o[d], 0, 0, 0); } }
        LDS_WAIT();
    }
    lrun += __shfl_xor(lrun, 32);
    if (hi == 0) wsf[32 + r32] = lrun;
    LDS_WAIT();
    bf16* orow = (bf16*)(ws + WS_CO) + ((size_t)b * SEQ + qb * 256 + wid * 32) * 512 + hc * 128 + r32;
#pragma unroll
    for (int r = 0; r < 16; ++r) { const int qrow = crow(r, hi); const float rl = 1.0f / wsf[32 + qrow];
#pragma unroll
        for (int d = 0; d < 4; ++d) orow[(size_t)qrow * 512 + 32 * d] = (bf16)f2bf(o[d][r] * rl); }
    LDS_WAIT();
}
}

__device__ __forceinline__ void router_tile(Frame& F, int t0, int lt0) {
    const int lane = F.lane, tok = lane & 31, kk = lane >> 5; unsigned char* ws = F.ws; LAS unsigned char* lds = F.lds;
    const LAS float* wr = (const LAS float*)(lds + RING_OFF);
    const float* xrow = F.out + (size_t)(t0 + tok) * 1024 + 8 * kk;
    unsigned char* hrow = ws + WS_HN2 + (size_t)(t0 + tok) * 1024 + 8 * kk;
    f32x16 acc = f32x16{}; float ss = 0.f;
    constexpr int PD = 8;
    f32x4 ra[PD], rb[PD];
#pragma unroll
    for (int p = 0; p < PD; ++p) { ra[p] = *(const GAS f32x4*)(xrow + 16 * p); rb[p] = *(const GAS f32x4*)(xrow + 16 * p + 4); }
#pragma unroll 1
    for (int q0 = 0; q0 < 64; q0 += PD) {
#pragma unroll
        for (int p = 0; p < PD; ++p) {
            const int q = q0 + p; const f32x4 a = ra[p], b = rb[p];
            if (q0 + PD < 64) { ra[p] = *(const GAS f32x4*)(xrow + 16 * (q + PD)); rb[p] = *(const GAS f32x4*)(xrow + 16 * (q + PD) + 4); }
            ss += (a.x * a.x + a.y * a.y) + (a.z * a.z + a.w * a.w) + (b.x * b.x + b.y * b.y) + (b.z * b.z + b.w * b.w);
            const LAS float* wq = wr + (16 * q + 8 * kk) * 32 + tok;
            acc = __builtin_amdgcn_mfma_f32_32x32x2f32(wq[0 * 32], a.x, acc, 0, 0, 0); acc = __builtin_amdgcn_mfma_f32_32x32x2f32(wq[1 * 32], a.y, acc, 0, 0, 0);
            acc = __builtin_amdgcn_mfma_f32_32x32x2f32(wq[2 * 32], a.z, acc, 0, 0, 0); acc = __builtin_amdgcn_mfma_f32_32x32x2f32(wq[3 * 32], a.w, acc, 0, 0, 0);
            acc = __builtin_amdgcn_mfma_f32_32x32x2f32(wq[4 * 32], b.x, acc, 0, 0, 0); acc = __builtin_amdgcn_mfma_f32_32x32x2f32(wq[5 * 32], b.y, acc, 0, 0, 0);
            acc = __builtin_amdgcn_mfma_f32_32x32x2f32(wq[6 * 32], b.z, acc, 0, 0, 0); acc = __builtin_amdgcn_mfma_f32_32x32x2f32(wq[7 * 32], b.w, acc, 0, 0, 0);
            v2u o; o.x = pk4_fp8(a.x * SX8, a.y * SX8, a.z * SX8, a.w * SX8); o.y = pk4_fp8(b.x * SX8, b.y * SX8, b.z * SX8, b.w * SX8);
            *(GAS v2u*)(hrow + 16 * q) = o;
        }
    }
    ss += __shfl_xor(ss, 32);
    const float rstd = 1.0f / sqrtf(ss * (1.f / 1024.f) + EPS);
    if (kk == 0) ((float*)(ws + WS_RSTD2))[t0 + tok] = rstd;
    const float* br = F.in[I_BR];
    float lg[16];
#pragma unroll
    for (int r = 0; r < 16; ++r) lg[r] = acc[r] * rstd + br[xat::crow(r, kk)];
    float tv[4]; int ti[4];
#pragma unroll
    for (int k = 0; k < 4; ++k) { float best = lg[0]; int bi = 0;
#pragma unroll
        for (int r = 1; r < 16; ++r) { const bool gt = lg[r] > best; best = gt ? lg[r] : best; bi = gt ? r : bi; }
        tv[k] = best; ti[k] = xat::crow(bi, kk);
#pragma unroll
        for (int r = 0; r < 16; ++r) lg[r] = (r == bi) ? -INFINITY : lg[r]; }
    float cv[8]; int ci[8];
#pragma unroll
    for (int k = 0; k < 4; ++k) { cv[k] = tv[k]; ci[k] = ti[k]; cv[4 + k] = __shfl_xor(tv[k], 32); ci[4 + k] = __shfl_xor(ti[k], 32); }
    float gv[4]; int ge[4];
#pragma unroll
    for (int k = 0; k < 4; ++k) { float best = cv[0]; int be = ci[0], bj = 0;
#pragma unroll
        for (int j = 1; j < 8; ++j) { const bool gt = (cv[j] > best) || (cv[j] == best && ci[j] < be); best = gt ? cv[j] : best; be = gt ? ci[j] : be; bj = gt ? j : bj; }
        gv[k] = best; ge[k] = be;
#pragma unroll
        for (int j = 0; j < 8; ++j) cv[j] = (j == bj) ? -INFINITY : cv[j]; }
    float ex[4], es = 0.f;
#pragma unroll
    for (int k = 0; k < 4; ++k) { ex[k] = __expf(gv[k] - gv[0]); es += ex[k]; }
    const float ies = 1.0f / es;
    if (kk == 0) {
        LAS int* lcnt = (LAS int*)(lds + LX_LCNT); LAS int* stash = (LAS int*)(lds + LX_STASH); LAS float* gst = (LAS float*)(lds + LX_GATE);
#pragma unroll
        for (int k = 0; k < 4; ++k) { const int li = __hip_atomic_fetch_add(lcnt + ge[k], 1, __ATOMIC_RELAXED, __HIP_MEMORY_SCOPE_WORKGROUP);
            stash[(lt0 + tok) * 4 + k] = ge[k] | (li << 8); gst[(lt0 + tok) * 4 + k] = ex[k] * ies; }
    }
}

__device__ __forceinline__ void p7_router(Frame& F) {
    const int lane = F.lane, tid = F.tid; unsigned char* ws = F.ws; LAS unsigned char* lds = F.lds;
    {
        LAS float* scr = (LAS float*)(lds + RING_OFF + F.wave * 16384);
        const int gw = F.vcu * NWAVES + F.wave, NGW = F.G * NWAVES;
        constexpr int IE1 = 16 * 64, IE2 = 16 * 32;
        for (int it = gw; it < NEXP * (IE1 + IE2); it += NGW) {
            const int e = it / (IE1 + IE2); int r = it - e * (IE1 + IE2);
            if (r < IE1) { const int kb = r >> 6, nb = r & 63, n0 = nb * 32, src = ((n0 >> 7) & 1) * 1024 + (n0 >> 8) * 128 + (n0 & 127);
                transpose_item8(F.in[I_WEI] + (size_t)e * 1024 * 2048, 2048, src, F.in[I_GFFN], SW8, ws + WS_WEI + (size_t)e * 2048 * 1024, 1024, n0, kb * 64, scr, lane); }
            else { r -= IE1; const int kb = r >> 5, nb = r & 31;
                transpose_item8(F.in[I_WEO] + (size_t)e * 1024 * 1024, 1024, nb * 32, nullptr, SW8, ws + WS_WEO + (size_t)e * 1024 * 1024, 1024, nb * 32, kb * 64, scr, lane); }
        }
    }
    __syncthreads();
    { const float* wr = F.in[I_WR]; const float* g = F.in[I_GFFN];
      for (int i = tid; i < 8192; i += NWAVES * 64) { const f32x4 v = *(const GAS f32x4*)(wr + 4 * i); const float gg = g[i >> 3]; *(LAS f32x4*)(lds + RING_OFF + 16 * i) = v * gg; } }
    __syncthreads();
    LAS int* lcnt = (LAS int*)(lds + LX_LCNT); LAS int* lbase = (LAS int*)(lds + LX_BASE); LAS int* stash = (LAS int*)(lds + LX_STASH); LAS float* gst = (LAS float*)(lds + LX_GATE);
    for (int chunk = F.vcu; chunk < T / 256; chunk += F.G) {
        if (tid < NEXP) lcnt[tid] = 0;
        __syncthreads();
        router_tile(F, chunk * 256 + F.wave * 32, F.wave * 32);
        __syncthreads();
        if (tid < NEXP) lbase[tid] = (int)__hip_atomic_fetch_add((unsigned*)(F.ctl + CW_GCNT + 64 * tid), (unsigned)lcnt[tid], RLX_AGENT);
        __syncthreads();
        for (int idx = tid; idx < 1024; idx += NWAVES * 64) { const int st = stash[idx], e = st & 255, pos = lbase[e] + (st >> 8), ent = (chunk * 256 + (idx >> 2)) * 4 + (idx & 3);
            if (pos < LISTCAP) ((int*)(ws + WS_LIST))[(size_t)e * LISTCAP + pos] = ent;
            ((float*)(ws + WS_TOKG))[ent] = gst[idx]; }
        __syncthreads();
    }
}
__device__ __forceinline__ int moe_setup(Frame& F) {
    LAS int* tstart = (LAS int*)(F.lds + LX_TSTART); LAS int* cnt = (LAS int*)(F.lds + LX_CNT);
    if (F.tid == 0) { int acc = 0;
        for (int e = 0; e < NEXP; ++e) { int c = (int)__hip_atomic_load((unsigned*)(F.ctl + CW_GCNT + 64 * e), RLX_AGENT); c = c < LISTCAP ? c : LISTCAP; cnt[e] = c; tstart[e] = acc; acc += (c + 255) >> 8; }
        tstart[NEXP] = acc < ACT_TILES_MAX ? acc : ACT_TILES_MAX; }
    __syncthreads();
    return __builtin_amdgcn_readfirstlane(tstart[NEXP]);
}

struct Args { const float* in[N_IN]; float* out; unsigned char* ws; int ph_lo, ph_hi, li, pad; };
__global__ void __launch_bounds__(NWAVES * 64, 2) fwd_kernel(Args args) {
    extern __shared__ __attribute__((aligned(16))) unsigned char lds[];
    Frame F;
    F.lds = (LAS unsigned char*)lds;
    F.MISC = (volatile LAS unsigned*)(F.lds + MISC_OFF);
    F.tid = threadIdx.x; F.lane = F.tid & 63; F.wave = __builtin_amdgcn_readfirstlane(F.tid >> 6);
    F.G = gridDim.x; { const int bx = blockIdx.x; F.vcu = (F.G % 8 == 0) ? (bx % 8) * (F.G / 8) + bx / 8 : bx; }
    F.ws = args.ws; F.out = args.out; F.in = args.in;
    unsigned char* ws = args.ws;
    F.ctl = (gu32*)(ws + WS_CTL);
    for (int u = F.tid; u < (LDS_BYTES - LDSCTL_OFF) / 4; u += NWAVES * 64) ((LAS unsigned*)(F.lds + LDSCTL_OFF))[u] = 0u;
    __syncthreads();
    XcdBarrier bar; bar.bar = (unsigned*)(F.ctl + CW_BAR); bar.x = 0; bar.st = nullptr;
    if (N_LAUNCHES != PER_PHASE) bar = xcd_barrier_post((unsigned*)(F.ctl + CW_BAR), F.MISC + 8, F.tid == 0);
#define GRID_BAR(seam) do { if (N_LAUNCHES == PER_PHASE) { if (F.tid == 0) __hip_atomic_store(F.ctl + CW_TMO, 0xBADBA0u | (unsigned)(seam), RLX_AGENT); } else { xcd_barrier(bar, F.tid == 0); } } while (0)
    const int lo = args.ph_lo, hi = args.ph_hi;
#ifndef MK_PHASE_MASK
#define MK_PHASE_MASK 0x7ff
#endif
#define IN(k) (((MK_PHASE_MASK >> (k)) & 1) && lo <= (k) && (k) < hi)
#define BOTH(k) (IN(k) && IN((k) + 1))
    const int gw = F.vcu * NWAVES + F.wave, NGW = F.G * NWAVES;

    if (IN(0)) { REFRESH(F); for (int rep = 0; rep < MK_REP0; ++rep) p0_prologue(F); if (BOTH(0)) GRID_BAR(0); }

    if (IN(1)) { REFRESH(F);
        DenseSched S; S.init(ws + WS_HN, 1024, ws + WS_W1T, 1024, T, N1, F.G, (int)blockIdx.x);
        EpiP1 E{(bf16_t*)(ws + WS_U), (bf16_t*)(ws + WS_CQKV), (bf16_t*)(ws + WS_QX), (bf16_t*)(ws + WS_GATES)};
        for (int rep = 0; rep < MK_REP1; ++rep) pg8::gemm_phase<EpiP1, DenseSched>(F.lds + RING_OFF, F.tid, 1024, 1024, 1024, S, E);
        if (BOTH(1)) GRID_BAR(1);
    }

    if (IN(2)) { REFRESH(F);
        for (int rep = 0; rep < MK_REP2; ++rep) {
        { DenseSched S; S.init(ws + WS_CQKV, 768, ws + WS_WUQ, 384, T, 768, F.G, (int)blockIdx.x);
          EpiStore E{(bf16_t*)(ws + WS_Q), 768};
          pg8::gemm_phase<EpiStore, DenseSched>(F.lds + RING_OFF, F.tid, 384, 768, 384, S, E); }
        { DenseSched S; S.init(ws + WS_CQKV + 384 * 2, 768, ws + WS_WUKV, 256, T, 1024, F.G, (int)blockIdx.x);
          EpiStore E{(bf16_t*)(ws + WS_KV), 1024};
          pg8::gemm_phase<EpiStore, DenseSched>(F.lds + RING_OFF, F.tid, 256, 768, 256, S, E); }
        { DenseSched S; S.init(ws + WS_MEMN, 1024, ws + WS_WMEM, 1024, MROWS, 1024, F.G, (int)blockIdx.x);
          EpiMemKV E{(bf16_t*)(ws + WS_KVMK), (bf16_t*)(ws + WS_VTG)};
          pg8::gemm_phase<EpiMemKV, DenseSched>(F.lds + RING_OFF, F.tid, 1024, 1024, 1024, S, E); }
        }
        if (BOTH(2)) GRID_BAR(2);
    }

    if (IN(3)) { REFRESH(F);
        const int per = T / NGW;
        if (per * NGW == T && (per & 1) == 0) { for (int i = 0; i < per; i += 2) p3_tokens<2>(F, gw * per + i); }
        else { for (int t = gw; t < T; t += NGW) p3_tokens<1>(F, t); }
        if (BOTH(3)) GRID_BAR(3);
    }

    if (IN(4)) { for (int rep4 = 0; rep4 < MK_REP4; ++rep4) { REFRESH(F);
#ifndef NO_MLA
        for (int vv = F.vcu; vv < 256 * MK_REPMLA; vv += F.G) {
            const int bh = (vv & 255) >> 1, s = vv & 1;
            for (int i = 0; i < 8; ++i) { const int j2 = (i >> 1) * 2 + s, qb = (i & 1) ? 15 - j2 : j2;
                mla::attn_unit<8>(F.tid, bh >> 3, bh & 7, qb, (const mla::bf16*)(ws + WS_Q), (const mla::bf16*)(ws + WS_KV), (const mla::bf16*)(ws + WS_V), (mla::bf16*)(ws + WS_AO), (char*)lds + RING_OFF); }
        }
#endif
        __syncthreads();
        REFRESH(F);
#ifndef NO_XAT
        for (int vv = F.vcu; vv < 256 * MK_REPX; vv += F.G) {
            const int b = (vv & 255) >> 4, hc = (vv >> 2) & 3;
            xat::stage_kv(F, b, hc);
            __syncthreads();
            for (int i = 0; i < 4; ++i) xat::unit(F, b, hc, (vv & 3) * 4 + i);
            __syncthreads();
        }
#endif
        }
        if (BOTH(4)) GRID_BAR(4);
    }

    if (IN(5)) { REFRESH(F);
        MergeSched S; S.G = F.G; S.c = (int)blockIdx.x;
        S.A0 = (const char*)(ws + WS_MIXED); S.dA1 = (long)WS_AO - (long)WS_MIXED; S.dA2 = (long)WS_CO - (long)WS_MIXED;
        S.B0 = (const char*)(ws + WS_WPOOL); S.dB1 = (long)WS_WMO - (long)WS_WPOOL; S.dB2 = (long)WS_WCO - (long)WS_WPOOL;
        EpiMerge E{(const bf16_t*)(ws + WS_GATES), (bf16_t*)(ws + WS_MERGED)};
        for (int rep = 0; rep < MK_REP56; ++rep) pg8::gemm_phase<EpiMerge, MergeSched>(F.lds + RING_OFF, F.tid, 512, 512, 512, S, E);
        if (BOTH(5)) GRID_BAR(5);
    }

    if (IN(6)) { REFRESH(F);
        DenseSched S; S.init(ws + WS_MERGED, 1024, ws + WS_WO, 1024, T, 1024, F.G, (int)blockIdx.x);
        EpiResF32 E{F.in[I_X], F.out};
        for (int rep = 0; rep < MK_REP56; ++rep) pg8::gemm_phase<EpiResF32, DenseSched>(F.lds + RING_OFF, F.tid, 1024, 1024, 1024, S, E);
        if (BOTH(6)) GRID_BAR(6);
    }

    if (IN(7)) { REFRESH(F); p7_router(F); if (BOTH(7)) GRID_BAR(7); }

    if (IN(8)) { REFRESH(F);
        const int ntiles = moe_setup(F);
        MoeSched S; S.G = F.G; S.c = (int)blockIdx.x; S.nM = ntiles; S.nN = 8; S.tstart = (const LAS int*)(F.lds + LX_TSTART); S.cnt = (const LAS int*)(F.lds + LX_CNT);
        S.list = (const int*)(ws + WS_LIST); S.A = (const char*)(ws + WS_HN2); S.B = (const char*)(ws + WS_WEI); S.bexp = (size_t)2048 * 1024; S.tB = (size_t)256 * 1024; S.tA = 0; S.gather = true;
        EpiMoeIn E{S.cnt, S.list, (const float*)(ws + WS_RSTD2), F.in[I_BEI], ws + WS_ACT};
        for (int rep = 0; rep < MK_REP8; ++rep) pg8::gemm_phase_f8<EpiMoeIn, MoeSched, true>(F.lds + RING_OFF, F.tid, 1024, 1024, 1024, S, E);
        if (BOTH(8)) GRID_BAR(8);
    }

    if (IN(9)) { REFRESH(F);
        const int ntiles = moe_setup(F);
        MoeSched S; S.G = F.G; S.c = (int)blockIdx.x; S.nM = ntiles; S.nN = 4; S.tstart = (const LAS int*)(F.lds + LX_TSTART); S.cnt = (const LAS int*)(F.lds + LX_CNT);
        S.list = (const int*)(ws + WS_LIST); S.A = (const char*)(ws + WS_ACT); S.B = (const char*)(ws + WS_WEO); S.bexp = (size_t)1024 * 1024; S.tB = (size_t)256 * 1024; S.tA = (size_t)256 * 1024; S.gather = false;
        EpiMoeOut E{S.cnt, S.list, (const float*)(ws + WS_TOKG), F.in[I_BEO], F.out, (bf16_t*)(ws + WS_Y)};
        pg8::gemm_phase_f8<EpiMoeOut, MoeSched, false>(F.lds + RING_OFF, F.tid, 1024, 1024, 1024, S, E);
        if (BOTH(9)) GRID_BAR(9);
    }

    if (IN(10)) { REFRESH(F);
        for (int t0 = gw; t0 < T; t0 += 2 * NGW) {
            f32x4 v[2][4]; v2u w[2][3][4];
#pragma unroll
            for (int r = 0; r < 2; ++r) { const int t = t0 + r * NGW; if (t < T) {
                const GAS f32x4* o = (const GAS f32x4*)(F.out + (size_t)t * 1024) + F.lane; const GAS v2u* y = (const GAS v2u*)((const bf16*)(ws + WS_Y) + (size_t)t * 3072) + F.lane;
#pragma unroll
                for (int j = 0; j < 4; ++j) { v[r][j] = o[64 * j];
#pragma unroll
                    for (int s3 = 0; s3 < 3; ++s3) w[r][s3][j] = y[s3 * 256 + 64 * j]; } } }
#pragma unroll
            for (int r = 0; r < 2; ++r) { const int t = t0 + r * NGW; if (t < T) {
                GAS f32x4* o = (GAS f32x4*)(F.out + (size_t)t * 1024) + F.lane;
#pragma unroll
                for (int j = 0; j < 4; ++j) { f32x4 x = v[r][j];
#pragma unroll
                    for (int s3 = 0; s3 < 3; ++s3) { const v2u ww = w[r][s3][j]; x.x += bflo(ww.x); x.y += bfhi(ww.x); x.z += bflo(ww.y); x.w += bfhi(ww.y); }
                    o[64 * j] = x; } } }
        }
    }
#undef IN
#undef BOTH
#undef GRID_BAR
}

extern "C" void kernel_launch(void* const* d_in, const int* in_sizes, int n_in, void* d_out, int out_size, void* d_ws, size_t ws_size, hipStream_t stream) {
    static int grid = 0;
    if (grid == 0) {
        if (n_in != N_IN || in_sizes[0] != T * D || out_size != T * D || ws_size < WS_END) { fprintf(stderr, "kernel_launch: unexpected shapes (n_in %d, in0 %d, out %d, ws %zu); nothing launched\n", n_in, n_in > 0 ? in_sizes[0] : -1, out_size, ws_size); grid = -1; return; }
        int dev = 0, cus = 0, per_cu = 0;
        if (hipGetDevice(&dev) != hipSuccess || hipDeviceGetAttribute(&cus, hipDeviceAttributeMultiprocessorCount, dev) != hipSuccess) { grid = -1; return; }
        if (hipFuncSetAttribute((const void*)fwd_kernel, hipFuncAttributeMaxDynamicSharedMemorySize, LDS_BYTES) != hipSuccess) { fprintf(stderr, "kernel_launch: hipFuncSetAttribute failed\n"); grid = -1; return; }
        if (hipOccupancyMaxActiveBlocksPerMultiprocessor(&per_cu, (const void*)fwd_kernel, NWAVES * 64, LDS_BYTES) != hipSuccess || per_cu < 1)
            fprintf(stderr, "kernel_launch: note: occupancy query reports %d workgroups per CU\n", per_cu);
        (void)hipGetLastError();
        grid = cus;
    }
    if (grid < 0) return;
    if (hipMemsetAsync((char*)d_ws + WS_CTL, 0, CTL_ZERO_BYTES, stream) != hipSuccess) { fprintf(stderr, "kernel_launch: hipMemsetAsync failed\n"); return; }
    Args a{};
    for (int i = 0; i < N_IN; ++i) a.in[i] = (const float*)d_in[i];
    a.out = (float*)d_out; a.ws = (unsigned char*)d_ws;
    const int last = MK_LAST_PHASE;
    if (N_LAUNCHES == PER_PHASE) {
        for (int li = 0; li < last; ++li) { a.ph_lo = li; a.ph_hi = li + 1; a.li = li; hipLaunchKernelGGL(fwd_kernel, dim3(grid), dim3(NWAVES * 64), LDS_BYTES, stream, a); }
    } else {
        a.ph_lo = 0; a.ph_hi = last; a.li = 0; hipLaunchKernelGGL(fwd_kernel, dim3(grid), dim3(NWAVES * 64), LDS_BYTES, stream, a);
    }
    const hipError_t le = hipPeekAtLastError();
    if (le != hipSuccess) fprintf(stderr, "kernel_launch: launch failed: %s\n", hipGetErrorName(le));
}
```

```cpp
#include <hip/hip_runtime.h>
#include <hip/hip_bf16.h>
#include <cstdio>
#include <cstdint>

#ifndef MK_N_LAUNCHES
#define MK_N_LAUNCHES 1
#endif
#ifndef MK_REP1
#define MK_REP1 1
#endif
#ifndef MK_REP4
#define MK_REP4 1
#endif
#ifndef MK_REP5
#define MK_REP5 1
#endif
#ifndef MK_REP6
#define MK_REP6 1
#endif
#ifndef MK_REP8
#define MK_REP8 1
#endif
#ifndef MK_REPMLA
#define MK_REPMLA 1
#endif
#ifndef MK_REP0
#define MK_REP0 1
#endif
#ifndef MK_REP2
#define MK_REP2 1
#endif
#ifndef MK_REPX
#define MK_REPX 1
#endif
#ifndef MK_LAST_PHASE
#define MK_LAST_PHASE 11
#endif

namespace pg8 {
#define PG8_LAS __attribute__((address_space(3)))
typedef unsigned short bf16_t;
typedef short bf16x8 __attribute__((ext_vector_type(8)));
typedef float f32x4 __attribute__((ext_vector_type(4)));
typedef unsigned u32x4 __attribute__((ext_vector_type(4)));
typedef unsigned u32x2 __attribute__((ext_vector_type(2)));
constexpr int BM = 256, BK = 64, HALF = 128, HTB = HALF * BK * 2, STAGE_BYTES = 8 * HTB, NXCD = 8, WGM = 8;

__host__ __device__ __forceinline__ int lds_byte(int r, int c) { const int st = (r >> 4) * 2 + (c >> 5), rr = r & 15, cc = c & 31, ob = rr * 64 + cc * 2; return st * 1024 + (ob ^ (((ob >> 9) & 1) << 5)); }
__host__ __device__ __forceinline__ void stage_rc(int b, int& R, int& C) { const int st = b / 1024, sb = b % 1024, swz = sb ^ (((sb >> 9) & 1) << 5); R = (st >> 1) * 16 + swz / 64; C = (st & 1) * 32 + (swz % 64) / 2; }
__host__ __device__ __forceinline__ int perm32(int rho) { const int n = rho >> 4, i = rho & 15; return 8 * (i >> 2) + 4 * n + (i & 3); }

struct Unit { int pm, pn; const char* A; const char* B; int aux; };

__device__ __forceinline__ void tile_order(int L, int nM, int nN, int& pm, int& pn) {
    const int nwg = nM * nN; int wgid = L;
    { const int q = nwg / NXCD, r = nwg % NXCD, xcd = wgid % NXCD, off = wgid / NXCD; wgid = (xcd < r ? xcd * (q + 1) : r * (q + 1) + (xcd - r) * q) + off; }
    const int nig = WGM * nN, gid = wgid / nig, fm = gid * WGM, gsz = (nM - fm) < WGM ? (nM - fm) : WGM;
    pm = fm + ((wgid % nig) % gsz); pn = (wgid % nig) / gsz;
}

__device__ __forceinline__ unsigned cvt_pk_bf16(float lo, float hi) { unsigned r; asm volatile("v_cvt_pk_bf16_f32 %0, %1, %2" : "=v"(r) : "v"(lo), "v"(hi)); return r; }
__device__ __forceinline__ float bf_lo(unsigned w) { return __uint_as_float(w << 16); }
__device__ __forceinline__ float bf_hi(unsigned w) { return __uint_as_float(w & 0xffff0000u); }
__device__ __forceinline__ float sigmoidf_fast(float x) { return __builtin_amdgcn_rcpf(1.0f + __builtin_amdgcn_exp2f(-1.4426950408889634f * x)); }

template <class Epi, class Sched, bool GATHER = false, bool ALIGN_EPI = true>
__device__ __forceinline__ void gemm_phase(PG8_LAS unsigned char* lds, const int tid, const int K, const int lda, const int ldb, const Sched& S, const Epi& E) {
    const int wid = __builtin_amdgcn_readfirstlane(tid >> 6), lane = tid & 63, wr = wid >> 2, wc = wid & 3, fr = lane & 15, fq = lane >> 4;
    const int nt = K / BK;
    int RA[2], CA[2]; unsigned voffB[2];
#pragma unroll
    for (int i = 0; i < 2; ++i) { int R, C; stage_rc(tid * 16 + i * 8192, R, C); const int Rb = Epi::PERM ? ((R & ~31) + perm32(R & 31)) : R;
        RA[i] = R; CA[i] = C; voffB[i] = (unsigned)(Rb * ldb + C) * 2u; }
    const size_t kstep = (size_t)(BK * 2);
    const size_t hstepB = (size_t)HALF * ldb * 2;
    const unsigned ldsw = (unsigned)wid * 1024u;
    const int aoff = lds_byte(wr * 64 + fr, fq * 8), boff = lds_byte(wc * 32 + fr, fq * 8);
#define PG8_SA(b, h) (((b) * 2 + (h)) * HTB)
#define PG8_SB(b, h) ((4 + (b) * 2 + (h)) * HTB)
#define PG8_STAGE2(bufoff, gbase, o0, o1) do { \
        __builtin_amdgcn_global_load_lds((const unsigned*)((const char*)(gbase) + (o0)), (PG8_LAS unsigned*)(lds + (bufoff) + ldsw), 16, 0, 0); \
        __builtin_amdgcn_global_load_lds((const unsigned*)((const char*)(gbase) + (o1)), (PG8_LAS unsigned*)(lds + (bufoff) + ldsw + 8192), 16, 0, 0); } while (0)
#define PG8_STAGEB(bufoff, gbase) PG8_STAGE2(bufoff, gbase, voffB[0], voffB[1])
#define PG8_STAGEA(bufoff, gbase, OFF, h) PG8_STAGE2(bufoff, gbase, OFF[h][0], OFF[h][1])
#define PG8_LDA(dst, b, h) do { _Pragma("unroll") for (int m = 0; m < 4; ++m) _Pragma("unroll") for (int k = 0; k < 2; ++k) dst[m][k] = *(const PG8_LAS bf16x8*)(lds + PG8_SA(b, h) + aoff + m * 2048 + k * 1024); } while (0)
#define PG8_LDB(dst, b, h) do { _Pragma("unroll") for (int n = 0; n < 2; ++n) _Pragma("unroll") for (int k = 0; k < 2; ++k) dst[n][k] = *(const PG8_LAS bf16x8*)(lds + PG8_SB(b, h) + boff + n * 2048 + k * 1024); } while (0)
#define PG8_MMA(ai, bj, At, Bt) do { __builtin_amdgcn_s_setprio(1); _Pragma("unroll") for (int m = 0; m < 4; ++m) _Pragma("unroll") for (int n = 0; n < 2; ++n) _Pragma("unroll") for (int k = 0; k < 2; ++k) \
        acc[ai][bj][m][n] = __builtin_amdgcn_mfma_f32_16x16x32_bf16(Bt[n][k], At[m][k], acc[ai][bj][m][n], 0, 0, 0); __builtin_amdgcn_s_setprio(0); } while (0)
#define PG8_WAIT_V(n) asm volatile("s_waitcnt vmcnt(" #n ")" ::: "memory")
#define PG8_WAIT_L(n) asm volatile("s_waitcnt lgkmcnt(" #n ")" ::: "memory")
#define PG8_BAR __builtin_amdgcn_s_barrier()
#define PG8_SCHED __builtin_amdgcn_sched_barrier(0)
    Unit cur, nxt; int ui = 0;
    if (!S.next(0, cur)) return;
    f32x4 acc[2][2][4][2];
#pragma unroll
    for (int a = 0; a < 2; ++a)
#pragma unroll
        for (int b = 0; b < 2; ++b)
#pragma unroll
            for (int m = 0; m < 4; ++m)
#pragma unroll
                for (int n = 0; n < 2; ++n) acc[a][b][m][n] = (f32x4){0.f, 0.f, 0.f, 0.f};
    bf16x8 At[4][2], B0[2][2], B1[2][2];
    unsigned cOff[2][2], nOff[2][2];
#pragma unroll
    for (int h = 0; h < 2; ++h)
#pragma unroll
        for (int i = 0; i < 2; ++i) {
            if constexpr (GATHER) cOff[h][i] = S.row_off(cur, h * HALF + RA[i]) + (unsigned)CA[i] * 2u;
            else cOff[h][i] = (unsigned)((h * HALF + RA[i]) * lda + CA[i]) * 2u;
            nOff[h][i] = cOff[h][i];
        }
    const char* cA = cur.A; const char* cB = cur.B;
    PG8_STAGEB(PG8_SB(0, 0), cB); PG8_STAGEB(PG8_SB(0, 1), cB + hstepB); PG8_STAGEA(PG8_SA(0, 0), cA, cOff, 0); PG8_STAGEA(PG8_SA(0, 1), cA, cOff, 1);
    if (wr == 1) PG8_BAR;
    PG8_WAIT_V(2); PG8_BAR;
    PG8_STAGEB(PG8_SB(1, 0), cB + kstep); PG8_STAGEA(PG8_SA(1, 0), cA + kstep, cOff, 0); PG8_STAGEB(PG8_SB(1, 1), cB + hstepB + kstep);
    PG8_WAIT_V(6); PG8_BAR;
    for (;;) {
        const bool has_next = S.next(ui + 1, nxt);
        const char* nA = has_next ? nxt.A : cA; const char* nB = has_next ? nxt.B : cB;
        if constexpr (GATHER) {
            if (has_next) {
#pragma unroll
                for (int h = 0; h < 2; ++h)
#pragma unroll
                    for (int i = 0; i < 2; ++i) nOff[h][i] = S.row_off(nxt, h * HALF + RA[i]) + (unsigned)CA[i] * 2u;
            }
        }
        for (int t = 0; t < nt; t += 2) {
            const bool last = (t == nt - 2);
            const char* a1 = cA + (size_t)(t + 1) * kstep;
            const char* a2 = last ? nA : cA + (size_t)(t + 2) * kstep; const char* b2 = last ? nB : cB + (size_t)(t + 2) * kstep;
            const char* a3 = a2 + kstep; const char* b3 = b2 + kstep;
            unsigned o2[2][2];
#pragma unroll
            for (int h = 0; h < 2; ++h)
#pragma unroll
                for (int i = 0; i < 2; ++i) { if constexpr (GATHER) o2[h][i] = last ? nOff[h][i] : cOff[h][i]; else o2[h][i] = cOff[h][i]; }
            PG8_LDB(B0, 0, 0); PG8_LDB(B1, 0, 1); PG8_SCHED; PG8_LDA(At, 0, 0); PG8_STAGEA(PG8_SA(1, 1), a1, cOff, 1);
            PG8_WAIT_V(8); PG8_WAIT_L(0); PG8_BAR; PG8_MMA(0, 0, At, B0); PG8_MMA(0, 1, At, B1); PG8_BAR; PG8_SCHED;
            PG8_LDA(At, 0, 1); PG8_STAGEB(PG8_SB(0, 0), b2); PG8_STAGEB(PG8_SB(0, 1), b2 + hstepB); PG8_STAGEA(PG8_SA(0, 0), a2, o2, 0);
            PG8_WAIT_V(8); PG8_WAIT_L(0); PG8_BAR; PG8_MMA(1, 0, At, B0); PG8_MMA(1, 1, At, B1); PG8_BAR; PG8_SCHED;
            PG8_LDB(B0, 1, 0); PG8_LDB(B1, 1, 1); PG8_SCHED; PG8_LDA(At, 1, 0); PG8_STAGEA(PG8_SA(0, 1), a2, o2, 1);
            PG8_WAIT_V(8); PG8_WAIT_L(0); PG8_BAR; PG8_MMA(0, 0, At, B0); PG8_MMA(0, 1, At, B1); PG8_BAR; PG8_SCHED;
            PG8_LDA(At, 1, 1); PG8_STAGEB(PG8_SB(1, 0), b3); PG8_STAGEB(PG8_SB(1, 1), b3 + hstepB); PG8_STAGEA(PG8_SA(1, 0), a3, o2, 0);
            PG8_WAIT_V(8); PG8_WAIT_L(0); PG8_BAR; PG8_MMA(1, 0, At, B0); PG8_MMA(1, 1, At, B1); PG8_BAR; PG8_SCHED;
        }
        if constexpr (ALIGN_EPI) { if (wr == 0) PG8_BAR; }
        E(acc, cur, wr, wc, fr, fq);
        if (!has_next) break;
#pragma unroll
        for (int a = 0; a < 2; ++a)
#pragma unroll
            for (int b = 0; b < 2; ++b)
#pragma unroll
                for (int m = 0; m < 4; ++m)
#pragma unroll
                    for (int n = 0; n < 2; ++n) acc[a][b][m][n] = (f32x4){0.f, 0.f, 0.f, 0.f};
        cur = nxt; cA = nA; cB = nB; ++ui;
        if constexpr (GATHER) {
#pragma unroll
            for (int h = 0; h < 2; ++h)
#pragma unroll
                for (int i = 0; i < 2; ++i) cOff[h][i] = nOff[h][i];
        }
        if constexpr (ALIGN_EPI) { if (wr == 1) PG8_BAR; }
    }
    PG8_WAIT_V(0);
    if constexpr (!ALIGN_EPI) { if (wr == 0) PG8_BAR; }
    PG8_BAR;
#undef PG8_SA
#undef PG8_SB
#undef PG8_STAGE2
#undef PG8_STAGEA
#undef PG8_STAGEB
#undef PG8_LDA
#undef PG8_LDB
#undef PG8_MMA
#undef PG8_WAIT_V
#undef PG8_WAIT_L
#undef PG8_BAR
#undef PG8_SCHED
}
__host__ __device__ __forceinline__ int lds_byte8(int r, int ch) { const int fr = r & 15; return (r >> 4) * 2048 + (ch >> 2) * 1024 + ((fr * 64 + (ch & 3) * 16) ^ (((fr >> 2) & 1) << 4)); }
__host__ __device__ __forceinline__ void stage_rc8(int b, int& R, int& CH) { const int blk = b >> 11, h2 = (b >> 10) & 1, w = b & 1023, fr = w >> 6; R = blk * 16 + fr; CH = h2 * 4 + (((w ^ (((fr >> 2) & 1) << 4)) >> 4) & 3); }
typedef int v8i __attribute__((ext_vector_type(8)));
typedef int v4i __attribute__((ext_vector_type(4)));
template <class Epi, class Sched, bool GATHER = false, bool ALIGN_EPI = true>
__device__ __forceinline__ void gemm_phase_f8(PG8_LAS unsigned char* lds, const int tid, const int K, const int lda, const int ldb, const Sched& S, const Epi& E) {
    const int wid = __builtin_amdgcn_readfirstlane(tid >> 6), lane = tid & 63, wr = wid >> 2, wc = wid & 3, fr = lane & 15, fq = lane >> 4;
    const int nt = K / 128;
    int RA[2], CA[2]; unsigned voffB[2];
#pragma unroll
    for (int i = 0; i < 2; ++i) { int R, C; stage_rc8(tid * 16 + i * 8192, R, C); const int Rb = Epi::PERM ? ((R & ~31) + perm32(R & 31)) : R;
        RA[i] = R; CA[i] = C * 8; voffB[i] = (unsigned)(Rb * ldb + C * 16); }
    const size_t kstep = (size_t)(BK * 2);
    const size_t hstepB = (size_t)HALF * ldb;
    const unsigned ldsw = (unsigned)wid * 1024u;
    const int aoff0 = lds_byte8(wr * 64 + fr, 2 * fq), aoff1 = lds_byte8(wr * 64 + fr, 2 * fq + 1), boff0 = lds_byte8(wc * 32 + fr, 2 * fq), boff1 = lds_byte8(wc * 32 + fr, 2 * fq + 1);
#define PG8_SA(b, h) (((b) * 2 + (h)) * HTB)
#define PG8_SB(b, h) ((4 + (b) * 2 + (h)) * HTB)
#define PG8_STAGE2(bufoff, gbase, o0, o1) do { \
        __builtin_amdgcn_global_load_lds((const unsigned*)((const char*)(gbase) + (o0)), (PG8_LAS unsigned*)(lds + (bufoff) + ldsw), 16, 0, 0); \
        __builtin_amdgcn_global_load_lds((const unsigned*)((const char*)(gbase) + (o1)), (PG8_LAS unsigned*)(lds + (bufoff) + ldsw + 8192), 16, 0, 0); } while (0)
#define PG8_STAGEB(bufoff, gbase) PG8_STAGE2(bufoff, gbase, voffB[0], voffB[1])
#define PG8_STAGEA(bufoff, gbase, OFF, h) PG8_STAGE2(bufoff, gbase, OFF[h][0], OFF[h][1])
#define PG8_LDA(dst, b, h) do { _Pragma("unroll") for (int m = 0; m < 4; ++m) { dst[m][0] = *(const PG8_LAS v4i*)(lds + PG8_SA(b, h) + aoff0 + m * 2048); dst[m][1] = *(const PG8_LAS v4i*)(lds + PG8_SA(b, h) + aoff1 + m * 2048); } } while (0)
#define PG8_LDB(dst, b, h) do { _Pragma("unroll") for (int n = 0; n < 2; ++n) { dst[n][0] = *(const PG8_LAS v4i*)(lds + PG8_SB(b, h) + boff0 + n * 2048); dst[n][1] = *(const PG8_LAS v4i*)(lds + PG8_SB(b, h) + boff1 + n * 2048); } } while (0)
#define PG8_V8(x) __builtin_shufflevector(x[0], x[1], 0, 1, 2, 3, 4, 5, 6, 7)
#define PG8_MMA(ai, bj, At, Bt) do { __builtin_amdgcn_s_setprio(1); _Pragma("unroll") for (int m = 0; m < 4; ++m) _Pragma("unroll") for (int n = 0; n < 2; ++n) \
        asm volatile("v_mfma_scale_f32_16x16x128_f8f6f4 %0, %1, %2, %0, %3, %3 op_sel_hi:[0,0,0]" : "+v"(acc[ai][bj][m][n]) : "v"(PG8_V8(Bt[n])), "v"(PG8_V8(At[m])), "v"(sc1)); __builtin_amdgcn_s_setprio(0); } while (0)
#define PG8_WAIT_V(n) asm volatile("s_waitcnt vmcnt(" #n ")" ::: "memory")
#define PG8_WAIT_L(n) asm volatile("s_waitcnt lgkmcnt(" #n ")" ::: "memory")
#define PG8_BAR __builtin_amdgcn_s_barrier()
#define PG8_SCHED __builtin_amdgcn_sched_barrier(0)
    int sc1 = 0x7f7f7f7f; asm volatile("" : "+v"(sc1));
    Unit cur, nxt; int ui = 0;
    if (!S.next(0, cur)) return;
    f32x4 acc[2][2][4][2];
#pragma unroll
    for (int a = 0; a < 2; ++a)
#pragma unroll
        for (int b = 0; b < 2; ++b)
#pragma unroll
            for (int m = 0; m < 4; ++m)
#pragma unroll
                for (int n = 0; n < 2; ++n) acc[a][b][m][n] = (f32x4){0.f, 0.f, 0.f, 0.f};
    v4i At[4][2], B0[2][2], B1[2][2];
    unsigned cOff[2][2], nOff[2][2];
#pragma unroll
    for (int h = 0; h < 2; ++h)
#pragma unroll
        for (int i = 0; i < 2; ++i) {
            if constexpr (GATHER) cOff[h][i] = S.row_off(cur, h * HALF + RA[i]) + (unsigned)CA[i] * 2u;
            else cOff[h][i] = (unsigned)((h * HALF + RA[i]) * lda) + (unsigned)CA[i] * 2u;
            nOff[h][i] = cOff[h][i];
        }
    const char* cA = cur.A; const char* cB = cur.B;
    PG8_STAGEB(PG8_SB(0, 0), cB); PG8_STAGEB(PG8_SB(0, 1), cB + hstepB); PG8_STAGEA(PG8_SA(0, 0), cA, cOff, 0); PG8_STAGEA(PG8_SA(0, 1), cA, cOff, 1);
    if (wr == 1) PG8_BAR;
    PG8_WAIT_V(2); PG8_BAR;
    PG8_STAGEB(PG8_SB(1, 0), cB + kstep); PG8_STAGEA(PG8_SA(1, 0), cA + kstep, cOff, 0); PG8_STAGEB(PG8_SB(1, 1), cB + hstepB + kstep);
    PG8_WAIT_V(6); PG8_BAR;
    for (;;) {
        const bool has_next = S.next(ui + 1, nxt);
        const char* nA = has_next ? nxt.A : cA; const char* nB = has_next ? nxt.B : cB;
        if constexpr (GATHER) {
            if (has_next) {
#pragma unroll
                for (int h = 0; h < 2; ++h)
#pragma unroll
                    for (int i = 0; i < 2; ++i) nOff[h][i] = S.row_off(nxt, h * HALF + RA[i]) + (unsigned)CA[i] * 2u;
            }
        }
#pragma clang loop unroll(disable)
        for (int t = 0; t < nt; t += 2) {
            const bool last = (t == nt - 2);
            const char* a1 = cA + (size_t)(t + 1) * kstep;
            const char* a2 = last ? nA : cA + (size_t)(t + 2) * kstep; const char* b2 = last ? nB : cB + (size_t)(t + 2) * kstep;
            const char* a3 = a2 + kstep; const char* b3 = b2 + kstep;
            unsigned o2[2][2];
#pragma unroll
            for (int h = 0; h < 2; ++h)
#pragma unroll
                for (int i = 0; i < 2; ++i) { if constexpr (GATHER) o2[h][i] = last ? nOff[h][i] : cOff[h][i]; else o2[h][i] = cOff[h][i]; }
            PG8_LDB(B0, 0, 0); PG8_LDB(B1, 0, 1); PG8_SCHED; PG8_LDA(At, 0, 0); PG8_STAGEA(PG8_SA(1, 1), a1, cOff, 1);
            PG8_WAIT_V(8); PG8_WAIT_L(0); PG8_BAR; PG8_MMA(0, 0, At, B0); PG8_MMA(0, 1, At, B1); PG8_BAR; PG8_SCHED;
            PG8_LDA(At, 0, 1); PG8_STAGEB(PG8_SB(0, 0), b2); PG8_STAGEB(PG8_SB(0, 1), b2 + hstepB); PG8_STAGEA(PG8_SA(0, 0), a2, o2, 0);
            PG8_WAIT_V(8); PG8_WAIT_L(0); PG8_BAR; PG8_MMA(1, 0, At, B0); PG8_MMA(1, 1, At, B1); PG8_BAR; PG8_SCHED;
            PG8_LDB(B0, 1, 0); PG8_LDB(B1, 1, 1); PG8_SCHED; PG8_LDA(At, 1, 0); PG8_STAGEA(PG8_SA(0, 1), a2, o2, 1);
            PG8_WAIT_V(8); PG8_WAIT_L(0); PG8_BAR; PG8_MMA(0, 0, At, B0); PG8_MMA(0, 1, At, B1); PG8_BAR; PG8_SCHED;
            PG8_LDA(At, 1, 1); PG8_STAGEB(PG8_SB(1, 0), b3); PG8_STAGEB(PG8_SB(1, 1), b3 + hstepB); PG8_STAGEA(PG8_SA(1, 0), a3, o2, 0);
            PG8_WAIT_V(8); PG8_WAIT_L(0); PG8_BAR; PG8_MMA(1, 0, At, B0); PG8_MMA(1, 1, At, B1); PG8_BAR; PG8_SCHED;
        }
        asm volatile("s_nop 15\n\ts_nop 7" ::: "memory");
        if constexpr (ALIGN_EPI) { if (wr == 0) PG8_BAR; }
        E(acc, cur, wr, wc, fr, fq);
        if (!has_next) break;
#pragma unroll
        for (int a = 0; a < 2; ++a)
#pragma unroll
            for (int b = 0; b < 2; ++b)
#pragma unroll
                for (int m = 0; m < 4; ++m)
#pragma unroll
                    for (int n = 0; n < 2; ++n) acc[a][b][m][n] = (f32x4){0.f, 0.f, 0.f, 0.f};
        cur = nxt; cA = nA; cB = nB; ++ui;
        if constexpr (GATHER) {
#pragma unroll
            for (int h = 0; h < 2; ++h)
#pragma unroll
                for (int i = 0; i < 2; ++i) cOff[h][i] = nOff[h][i];
        }
        if constexpr (ALIGN_EPI) { if (wr == 1) PG8_BAR; }
    }
    PG8_WAIT_V(0);
    if constexpr (!ALIGN_EPI) { if (wr == 0) PG8_BAR; }
    PG8_BAR;
#undef PG8_SA
#undef PG8_SB
#undef PG8_STAGE2
#undef PG8_STAGEA
#undef PG8_STAGEB
#undef PG8_LDA
#undef PG8_LDB
#undef PG8_MMA
#undef PG8_V8
#undef PG8_WAIT_V
#undef PG8_WAIT_L
#undef PG8_BAR
#undef PG8_SCHED
}
}

namespace mla {
using bf16=__hip_bfloat16;
using bf16x8=__attribute__((ext_vector_type(8)))short;
using s16x4=__attribute__((ext_vector_type(4)))short;
using f32x16=__attribute__((ext_vector_type(16)))float;
using u32x4=__attribute__((ext_vector_type(4)))unsigned;
constexpr int SEQ=4096,DQK=96,DV=64,NHEAD=8;
constexpr int QP=768,KP=1024,VP=512,OP=512;
constexpr int NW=8,QBLK=32,QB=QBLK*NW,KVBLK=64,NQB=SEQ/QB;
__device__ __forceinline__ int crow(int r,int hi){return (r&3)+8*(r>>2)+4*hi;}
#define SBAR() __builtin_amdgcn_sched_barrier(0)
__device__ __forceinline__ void cmask(f32x16&p0,f32x16&p1,int jb,int qrel,int hi){
  const float NEG=-INFINITY; int kb=64*jb+4*hi;
  #pragma unroll
  for(int r=0;r<16;++r){int kv=kb+(r&3)+8*(r>>2); if(kv>qrel)p0[r]=NEG; if(kv+32>qrel)p1[r]=NEG;}
}
constexpr int NSLOT=3, KSLOT=12288, VSLOT=8192;
constexpr int LDS_K=0, LDS_V=NSLOT*KSLOT, LDS_WS=LDS_V+NSLOT*VSLOT, LDS_OST=LDS_WS+NW*64*4, LDS_BYTES=LDS_OST+NW*4096;
__device__ __forceinline__ void glds16(const char*sbase,unsigned voff,unsigned lds_dst){unsigned keep;
  asm volatile("s_mov_b32 %0, m0\n\ts_mov_b32 m0, %2\n\ts_nop 0\n\tglobal_load_lds_dwordx4 %1, %3\n\ts_mov_b32 m0, %0":"=&s"(keep):"v"(voff),"s"(lds_dst),"s"(sbase):"memory");}
__device__ __forceinline__ const char* uni_ptr(const void*p){ const unsigned long long v=(unsigned long long)(uintptr_t)p; const unsigned lo=__builtin_amdgcn_readfirstlane((unsigned)v),hi=__builtin_amdgcn_readfirstlane((unsigned)(v>>32)); return (const char*)(uintptr_t)(((unsigned long long)hi<<32)|lo); }
__device__ __forceinline__ float max3f(float a,float b,float c){float r;asm("v_max3_f32 %0, %1, %2, %3":"=v"(r):"v"(a),"v"(b),"v"(c));return r;}
__device__ __forceinline__ float max2f(float a,float b){float r;asm("v_max_f32_e32 %0, %1, %2":"=v"(r):"v"(a),"v"(b));return r;}
__device__ __forceinline__ float fadd_s(float a,float b){float r;asm("v_add_f32_e32 %0, %1, %2":"=v"(r):"v"(a),"v"(b));return r;}
__device__ __forceinline__ float fsub_s(float a,float b){float r;asm("v_sub_f32_e32 %0, %1, %2":"=v"(r):"v"(a),"v"(b));return r;}
typedef float f32x2_t __attribute__((ext_vector_type(2))); typedef __bf16 bf16x2_t __attribute__((ext_vector_type(2)));
__device__ __forceinline__ unsigned cvtpk_s(float lo,float hi){f32x2_t v={lo,hi};bf16x2_t b=__builtin_convertvector(v,bf16x2_t);return __builtin_bit_cast(unsigned,b);}
#define WAIT_BAR(N) asm volatile("s_waitcnt vmcnt(" #N ") lgkmcnt(0)\n\ts_barrier":::"memory")

__device__ __forceinline__ void qkt(f32x16&p0,f32x16&p1,const char*Kslot,const bf16x8*qr,int r32,int hi){
  const f32x16 negm=f32x16{};
  const char*kb=Kslot+hi*1024+r32*16;
  #pragma unroll
  for(int d0=0;d0<6;++d0){
    const bf16x8 b0=*reinterpret_cast<const bf16x8*>(kb+d0*2048);
    const bf16x8 b1=*reinterpret_cast<const bf16x8*>(kb+d0*2048+512);
    if(d0==0){p0=__builtin_amdgcn_mfma_f32_32x32x16_bf16(b0,qr[0],negm,0,0,0);p1=__builtin_amdgcn_mfma_f32_32x32x16_bf16(b1,qr[0],negm,0,0,0);}
    else{p0=__builtin_amdgcn_mfma_f32_32x32x16_bf16(b0,qr[d0],p0,0,0,0);p1=__builtin_amdgcn_mfma_f32_32x32x16_bf16(b1,qr[d0],p1,0,0,0);}}
}
typedef __attribute__((address_space(3))) const char* lds_cptr;
typedef short v4i16_t __attribute__((ext_vector_type(4)));
__device__ __forceinline__ void kload12(bf16x8*kf,lds_cptr kp){
  #pragma unroll
  for(int j=0;j<6;++j){ kf[2*j]=*(const __attribute__((address_space(3))) bf16x8*)(kp+j*2048); kf[2*j+1]=*(const __attribute__((address_space(3))) bf16x8*)(kp+j*2048+512); }
}
__device__ __forceinline__ void kload2(bf16x8*kf,lds_cptr kp,int j){ kf[2*j]=*(const __attribute__((address_space(3))) bf16x8*)(kp+j*2048); kf[2*j+1]=*(const __attribute__((address_space(3))) bf16x8*)(kp+j*2048+512); }
__device__ __forceinline__ s16x4 vtr(lds_cptr p){ return __builtin_bit_cast(s16x4,__builtin_amdgcn_ds_read_tr16_b64_v4i16((__attribute__((address_space(3))) v4i16_t*)p)); }
__device__ __forceinline__ float rowmax(const f32x16&p0,const f32x16&p1){
  float a=max3f(p0[0],p0[1],p1[0]),b=max3f(p0[2],p0[3],p1[1]);a=max3f(a,p1[2],p1[3]);
  #pragma unroll
  for(int r=4;r<16;r+=4){a=max3f(a,p0[r],p0[r+1]);b=max3f(b,p0[r+2],p0[r+3]);a=max3f(a,p1[r],p1[r+1]);b=max3f(b,p1[r+2],p1[r+3]);}
  const float m=max2f(a,b);
  auto rr=__builtin_amdgcn_permlane32_swap(__float_as_uint(m),__float_as_uint(m),false,false);
  return max2f(__uint_as_float(rr[0]),__uint_as_float(rr[1]));
}
__device__ __forceinline__ void pv(f32x16*o,int vb,bf16x8 pa0,bf16x8 pa1,bf16x8 pa2,bf16x8 pa3){
  #pragma unroll
  for(int d0=0;d0<2;++d0){s16x4 lo[4],hi[4];
    #pragma unroll
    for(int ks=0;ks<4;++ks){
      asm volatile("ds_read_b64_tr_b16 %0,%1 offset:%c2":"=&v"(lo[ks]):"v"(vb),"i"(d0*4096+ks*1024):"memory");
      asm volatile("ds_read_b64_tr_b16 %0,%1 offset:%c2":"=&v"(hi[ks]):"v"(vb),"i"(d0*4096+ks*1024+512):"memory");}
    asm volatile("s_waitcnt lgkmcnt(0)":::"memory");SBAR();
    #define PK(k) (bf16x8){lo[k][0],lo[k][1],lo[k][2],lo[k][3],hi[k][0],hi[k][1],hi[k][2],hi[k][3]}
    o[d0]=__builtin_amdgcn_mfma_f32_32x32x16_bf16(pa0,PK(0),o[d0],0,0,0);
    o[d0]=__builtin_amdgcn_mfma_f32_32x32x16_bf16(pa1,PK(1),o[d0],0,0,0);
    o[d0]=__builtin_amdgcn_mfma_f32_32x32x16_bf16(pa2,PK(2),o[d0],0,0,0);
    o[d0]=__builtin_amdgcn_mfma_f32_32x32x16_bf16(pa3,PK(3),o[d0],0,0,0);
    #undef PK
  }
}

template<int THRL> __device__ __forceinline__ void attn_unit(const int tid,int b,int h,int qb,const bf16*Q,const bf16*__restrict__ K,const bf16*__restrict__ V,bf16*O,char*shm){
  const int lane=tid&63,r32=lane&31,hi=lane>>5; const int wid=__builtin_amdgcn_readfirstlane(tid>>6);
  const long rowbase=(long)b*SEQ; const int q0=qb*QB;
  const bf16*Qw=Q+(rowbase+q0+wid*QBLK)*QP+h*DQK;
  const bf16*Kh=K+rowbase*KP+h*DQK,*Vh=V+rowbase*VP+h*DV;
  const unsigned lds0=(unsigned)(uintptr_t)shm;
  float*wsf=(float*)(shm+LDS_WS)+wid*64;
  const char*Kb=uni_ptr(Kh); const char*Vb=uni_ptr(Vh);
  const unsigned koffA=(unsigned)(lane*KP+wid*8)*2u, koffB=(unsigned)(lane*KP+(8+(wid&3))*8)*2u;
  const unsigned voffV=(unsigned)((16*(wid&3)+(lane>>2))*VP+(wid>>2)*32+(lane&3)*8)*2u;
  const unsigned kdstA=lds0+LDS_K+wid*1024, kdstB=lds0+LDS_K+(8+(wid&3))*1024, vdst=lds0+LDS_V+wid*1024;
  #define KOF(s) ((s)+((s)>>1))
  #define DMA_K(t,slot) do{ const char*kt_=Kb+(size_t)(t)*(KVBLK*KP*2); glds16(kt_,koffA,(unsigned)__builtin_amdgcn_readfirstlane(kdstA+KOF(slot))); glds16(kt_,koffB,(unsigned)__builtin_amdgcn_readfirstlane(kdstB+KOF(slot))); }while(0)
  #define DMA_V(t,slot) glds16(Vb+(size_t)(t)*(KVBLK*VP*2),voffV,(unsigned)__builtin_amdgcn_readfirstlane(vdst+(slot)))
  const int vb0=(int)(lds0+LDS_V)+((lane>>4)&1)*32+(lane&3)*8+(4*hi+((lane&15)>>2))*64;
  const char*Kbase=shm+LDS_K; bf16x8 kf[12];
  const lds_cptr shm3=(lds_cptr)shm; const lds_cptr kp0=shm3+LDS_K+hi*1024+r32*16; const lds_cptr vp0=shm3+LDS_V+((lane>>4)&1)*32+(lane&3)*8+(4*hi+((lane&15)>>2))*64;
  const int NT=(q0+QB)/KVBLK;
  DMA_K(0,0);DMA_V(0,0);DMA_K(1,VSLOT);
  bf16x8 qr[6];
  { int lq=lane; asm volatile("":"+v"(lq));
    const bf16*qp=Qw+(long)(lq&31)*QP+(lq>>5)*8;
    _Pragma("unroll") for(int d0=0;d0<6;++d0)qr[d0]=*reinterpret_cast<const bf16x8*>(qp+d0*16); }
  float mhat=0.f,l_reg=0.f;f32x16 o[2];o[0]=f32x16{};o[1]=f32x16{};
  const int qrel=wid*QBLK+r32;
  #define CMASK(P0,P1,t) do{int jb_=(t)-(NT-4); if(jb_>=0)cmask(P0,P1,jb_,qrel,hi);}while(0)
  bool resc=false;
  #define START(P0,P1) do{ const float rm=rowmax(P0,P1); resc=false; \
    { const float dl=rm; mhat=fadd_s(mhat,dl); \
      _Pragma("unroll") for(int r=0;r<16;++r){P0[r]=fsub_s(P0[r],dl);P1[r]=fsub_s(P1[r],dl);} } \
    _Pragma("unroll") for(int r=0;r<16;++r)P0[r]=__builtin_amdgcn_exp2f(P0[r]); }while(0)
  #define RESC() do{ if(resc){ asm volatile("s_waitcnt lgkmcnt(0)":::"memory"); \
      _Pragma("unroll") for(int d_=0;d_<2;++d_) _Pragma("unroll") for(int r=0;r<16;++r)o[d_][r]*=wsf[crow(r,hi)]; } }while(0)
  f32x16 pA0,pA1,pB0,pB1;
  int sl_prev=0,sl_cur=0,sl_next=VSLOT;
  #define ROT() do{sl_prev=sl_cur;sl_cur=sl_next;sl_next=(sl_next==(NSLOT-1)*VSLOT)?0:sl_next+VSLOT;}while(0)
  DMA_K(2,2*VSLOT);
  WAIT_BAR(5);
  qkt(pA0,pA1,Kbase,qr,r32,hi);asm volatile("s_nop 15\n\ts_nop 7":"+v"(pA0),"+v"(pA1));CMASK(pA0,pA1,0);
  START(pA0,pA1);
  _Pragma("unroll") for(int r=0;r<16;++r)pA1[r]=__builtin_amdgcn_exp2f(pA1[r]);
  WAIT_BAR(0);
  DMA_K(3,0);DMA_V(1,VSLOT);
  ROT();
  kload12(kf,kp0+KOF(sl_cur));
  WAIT_BAR(3);
  s16x4 vlo[8],vhi[8]; u32x4 pw0,pw1,pw2,pw3;
  #define PKW(P,B) cvtpk_s(P[B],P[B+1])
  #define PAF(k) __builtin_bit_cast(bf16x8,pw##k)
  #define VFR(i) (bf16x8){vlo[i][0],vlo[i][1],vlo[i][2],vlo[i][3],vhi[i][0],vhi[i][1],vhi[i][2],vhi[i][3]}
  #define PIN(x) asm volatile("":"+v"(x))
  #define MX3(a,b,c) __builtin_fmaxf(__builtin_fmaxf((a),(b)),(c))
  #define GAPA(MF,A0,A1,A2,A3,W0,W1,PW) do{ MF; sacc+=A0; sacc+=A1; sacc+=A2; sacc+=A3; PIN(sacc); W0; W1; PIN(PW); SBAR(); }while(0)
  #define EX(v) __builtin_amdgcn_exp2f(v)
  #define GAPB(MF,X,B) do{ MF; X[B]=EX(X[B]); X[B+1]=EX(X[B+1]); X[B+2]=EX(X[B+2]); X[B+3]=EX(X[B+3]); PIN(X); SBAR(); }while(0)
  #define VRD(i) do{ vlo[i]=vtr(vp_+(((i)>>2)*4096+((i)&3)*1024)); vhi[i]=vtr(vp_+(((i)>>2)*4096+((i)&3)*1024+512)); }while(0)
  #define KRD(G,j) do{ if(G){ kload2(kf,kp0+KOF(sl_next),j); SBAR(); } }while(0)
  const f32x16 zero16=f32x16{};
  #define STEP(C0,C1,P0,P1,t,GK,GV,GL) do{ SBAR(); \
    const lds_cptr vp_=vp0+sl_prev; \
    float sacc=(P0[0]+P0[1]); \
    GAPA(C0=__builtin_amdgcn_mfma_f32_32x32x16_bf16(kf[0],qr[0],zero16,0,0,0), P0[2],P0[3],P0[4],P0[5],     pw0[0]=PKW(P0,0), pw0[1]=PKW(P0,2), pw0); \
    GAPA(C1=__builtin_amdgcn_mfma_f32_32x32x16_bf16(kf[1],qr[0],zero16,0,0,0), P0[6],P0[7],P0[8],P0[9],     pw0[2]=PKW(P0,4), pw0[3]=PKW(P0,6), pw0); \
    GAPA(C0=__builtin_amdgcn_mfma_f32_32x32x16_bf16(kf[2],qr[1],C0,0,0,0),   P0[10],P0[11],P0[12],P0[13], pw1[0]=PKW(P0,8), pw1[1]=PKW(P0,10), pw1); \
    GAPA(C1=__builtin_amdgcn_mfma_f32_32x32x16_bf16(kf[3],qr[1],C1,0,0,0),   P0[14],P0[15],P1[0],P1[1],   pw1[2]=PKW(P0,12),pw1[3]=PKW(P0,14), pw1); \
    GAPA(C0=__builtin_amdgcn_mfma_f32_32x32x16_bf16(kf[4],qr[2],C0,0,0,0),   P1[2],P1[3],P1[4],P1[5],     pw2[0]=PKW(P1,0), pw2[1]=PKW(P1,2), pw2); \
    GAPA(C1=__builtin_amdgcn_mfma_f32_32x32x16_bf16(kf[5],qr[2],C1,0,0,0),   P1[6],P1[7],P1[8],P1[9],     pw2[2]=PKW(P1,4), pw2[3]=PKW(P1,6), pw2); \
    GAPA(C0=__builtin_amdgcn_mfma_f32_32x32x16_bf16(kf[6],qr[3],C0,0,0,0),   P1[10],P1[11],P1[12],P1[13], pw3[0]=PKW(P1,8), pw3[1]=PKW(P1,10), pw3); \
    GAPA(C1=__builtin_amdgcn_mfma_f32_32x32x16_bf16(kf[7],qr[3],C1,0,0,0),   P1[14],P1[15],0.f,0.f,       pw3[2]=PKW(P1,12),pw3[3]=PKW(P1,14), pw3); \
    C0=__builtin_amdgcn_mfma_f32_32x32x16_bf16(kf[8],qr[4],C0,0,0,0); C1=__builtin_amdgcn_mfma_f32_32x32x16_bf16(kf[9],qr[4],C1,0,0,0); VRD(0); SBAR(); \
    C0=__builtin_amdgcn_mfma_f32_32x32x16_bf16(kf[10],qr[5],C0,0,0,0); C1=__builtin_amdgcn_mfma_f32_32x32x16_bf16(kf[11],qr[5],C1,0,0,0); VRD(4); SBAR(); \
    l_reg+=sacc; \
    _Pragma("unroll") for(int r=0;r<16;++r){C0[r]-=mhat;C1[r]-=mhat;} \
    if(GK){DMA_K((t)+3,sl_cur);} if(GV){DMA_V((t)+1,sl_next);} \
    CMASK(C0,C1,t); \
    { float a=MX3(C0[0],C0[1],C1[0]),b=MX3(C0[2],C0[3],C1[1]); a=MX3(a,C1[2],C1[3]); \
      _Pragma("unroll") for(int r=4;r<16;r+=4){a=MX3(a,C0[r],C0[r+1]);b=MX3(b,C0[r+2],C0[r+3]);a=MX3(a,C1[r],C1[r+1]);b=MX3(b,C1[r+2],C1[r+3]);} \
      float rm=__builtin_fmaxf(a,b); { auto rr=__builtin_amdgcn_permlane32_swap(__float_as_uint(rm),__float_as_uint(rm),false,false); rm=__builtin_fmaxf(__uint_as_float(rr[0]),__uint_as_float(rr[1])); } \
      resc=false; \
      if(__builtin_expect(__any(rm>(float)THRL),0)){ const float dl=__builtin_fmaxf(rm,0.f); mhat+=dl; \
        _Pragma("unroll") for(int r=0;r<16;++r){C0[r]-=dl;C1[r]-=dl;} \
        const float f=__builtin_amdgcn_exp2f(-dl); l_reg*=f; if(hi==0)wsf[r32]=f; resc=true; } } \
    SBAR(); \
    VRD(1); SBAR(); GAPB(o[0]=__builtin_amdgcn_mfma_f32_32x32x16_bf16(PAF(0),VFR(0),o[0],0,0,0), C0,0); \
    VRD(5); KRD(GL,0); GAPB(o[1]=__builtin_amdgcn_mfma_f32_32x32x16_bf16(PAF(0),VFR(4),o[1],0,0,0), C0,4); \
    VRD(2); KRD(GL,1); GAPB(o[0]=__builtin_amdgcn_mfma_f32_32x32x16_bf16(PAF(1),VFR(1),o[0],0,0,0), C0,8); \
    VRD(6); KRD(GL,2); GAPB(o[1]=__builtin_amdgcn_mfma_f32_32x32x16_bf16(PAF(1),VFR(5),o[1],0,0,0), C0,12); \
    VRD(3); KRD(GL,3); GAPB(o[0]=__builtin_amdgcn_mfma_f32_32x32x16_bf16(PAF(2),VFR(2),o[0],0,0,0), C1,0); \
    VRD(7); KRD(GL,4); GAPB(o[1]=__builtin_amdgcn_mfma_f32_32x32x16_bf16(PAF(2),VFR(6),o[1],0,0,0), C1,4); \
    KRD(GL,5); GAPB(o[0]=__builtin_amdgcn_mfma_f32_32x32x16_bf16(PAF(3),VFR(3),o[0],0,0,0), C1,8); \
    GAPB(o[1]=__builtin_amdgcn_mfma_f32_32x32x16_bf16(PAF(3),VFR(7),o[1],0,0,0), C1,12); \
    }while(0)
  int t=1;
  #undef CMASK
  #define CMASK(P0,P1,t) do{}while(0)
  for(;t+5<NT;t+=2){
    STEP(pB0,pB1,pA0,pA1,t,true,true,true);     WAIT_BAR(3); RESC(); ROT();
    STEP(pA0,pA1,pB0,pB1,t+1,true,true,true);   WAIT_BAR(3); RESC(); ROT();
  }
  #undef CMASK
  #define CMASK(P0,P1,t) do{int jb_=(t)-(NT-4); if(jb_>=0)cmask(P0,P1,jb_,qrel,hi);}while(0)
  #define ENDW(tt) do{ if((tt)+3<NT){WAIT_BAR(3);} else if((tt)+2<NT){WAIT_BAR(1);} else {WAIT_BAR(0);} }while(0)
  for(;t+1<NT;t+=2){
    STEP(pB0,pB1,pA0,pA1,t,(t+3<NT),(t+1<NT),(t+1<NT));       ENDW(t);   RESC(); ROT();
    STEP(pA0,pA1,pB0,pB1,t+1,(t+4<NT),(t+2<NT),(t+2<NT));     ENDW(t+1); RESC(); ROT();
  }
  STEP(pB0,pB1,pA0,pA1,NT-1,false,false,false); RESC();
  { float sacc=pB0[0]+pB0[1]; _Pragma("unroll") for(int r=2;r<16;++r)sacc+=pB0[r]; _Pragma("unroll") for(int r=0;r<16;++r)sacc+=pB1[r]; l_reg+=sacc;
    pw0=(u32x4){PKW(pB0,0),PKW(pB0,2),PKW(pB0,4),PKW(pB0,6)};pw1=(u32x4){PKW(pB0,8),PKW(pB0,10),PKW(pB0,12),PKW(pB0,14)};pw2=(u32x4){PKW(pB1,0),PKW(pB1,2),PKW(pB1,4),PKW(pB1,6)};pw3=(u32x4){PKW(pB1,8),PKW(pB1,10),PKW(pB1,12),PKW(pB1,14)};
    SBAR(); pv(o,vb0+sl_cur,PAF(0),PAF(1),PAF(2),PAF(3)); }
  #undef PKW
  #undef PAF
  #undef VFR
  #undef PIN
  #undef MX3
  #undef GAPA
  #undef GAPB
  #undef EX
  #undef VRD
  #undef KRD
  #undef STEP
  #undef ENDW
  {auto rr=__builtin_amdgcn_permlane32_swap(__float_as_uint(l_reg),__float_as_uint(l_reg),false,false);l_reg=__uint_as_float(rr[0])+__uint_as_float(rr[1]);}
  if(hi==0)wsf[32+r32]=l_reg;asm volatile("s_waitcnt lgkmcnt(0)":::"memory");
  float rli[16];
  #pragma unroll
  for(int r=0;r<16;++r)rli[r]=__builtin_amdgcn_rcpf(wsf[32+crow(r,hi)]);
  bf16*Ow=O+(rowbase+q0+wid*QBLK)*OP+h*DV;
  { bf16*stg=(bf16*)(shm+LDS_OST)+wid*2048;
    #pragma unroll
    for(int r=0;r<16;++r){const int orow=crow(r,hi);
      #pragma unroll
      for(int d0=0;d0<2;++d0)stg[orow*64+d0*32+r32]=__float2bfloat16(o[d0][r]*rli[r]);}
    asm volatile("s_waitcnt lgkmcnt(0)":::"memory");
    int lo_=lane; asm volatile("":"+v"(lo_));
    #pragma unroll
    for(int i=0;i<4;++i){const int row=i*8+(lo_>>3),ch=lo_&7; const u32x4 v=*(const u32x4*)(stg+row*64+ch*8); *(u32x4*)(Ow+(long)row*OP+ch*8)=v;} }
  asm volatile("s_waitcnt lgkmcnt(0)\n\ts_barrier":::"memory");
  #undef DMA_K
  #undef DMA_V
  #undef KOF
  #undef CMASK
  #undef START
  #undef RESC
  #undef ROT
}
#undef WAIT_BAR
}

constexpr int NWAVES = 8;
constexpr int BATCH = 16, SEQ = 4096, D = 1024, T = BATCH * SEQ;
constexpr int IN_COLS = 4768, N1 = 4864;
constexpr int MEM_LEN = 256, MROWS = BATCH * MEM_LEN;
constexpr int NEXP = 32, TOPK = 4, DFF = 1024, LISTCAP = T;
constexpr int ACT_TILES_MAX = (T * TOPK) / 256 + NEXP;
constexpr float EPS = 1e-6f;
constexpr float C2_MLA = 0.10206207261596575f * 1.4426950408889634f;
constexpr float C2_X = 0.08838834764831845f * 1.4426950408889634f;
constexpr float SX8 = 4.0f, SW8 = 64.0f, SA8 = 4.0f;
constexpr int PER_PHASE = 11;
constexpr int N_LAUNCHES = MK_N_LAUNCHES;

constexpr size_t MiB = 1u << 20;
constexpr size_t WS_CTL = 0, CTL_ZERO_BYTES = 1 * MiB;
constexpr size_t WS_LIST = 1 * MiB;
constexpr size_t WS_TOKG = 9 * MiB;
constexpr size_t WS_RSTD2 = 10 * MiB;
constexpr size_t WS_W1T = 9 * MiB;
constexpr size_t WS_WUQ = 19 * MiB;
constexpr size_t WS_WUKV = 20 * MiB;
constexpr size_t WS_WMEM = 21 * MiB;
constexpr size_t WS_WPOOL = 23 * MiB;
constexpr size_t WS_WMO = 24 * MiB, WS_WCO = 25 * MiB;
constexpr size_t WS_WO = 26 * MiB;
constexpr size_t WS_MEMN = 28 * MiB;
constexpr size_t WS_KVMK = 36 * MiB;
constexpr size_t WS_VTG = 40 * MiB;
constexpr size_t WS_HN = 64 * MiB;
constexpr size_t WS_V = 64 * MiB, WS_MIXED = 128 * MiB;
constexpr size_t WS_GATES = 192 * MiB;
constexpr size_t WS_U = 576 * MiB, WS_AO = 576 * MiB;
constexpr size_t WS_CQKV = 640 * MiB, WS_CO = 640 * MiB;
constexpr size_t WS_QX = 736 * MiB;
constexpr size_t WS_Q = 800 * MiB;
constexpr size_t WS_KV = 896 * MiB, WS_MERGED = 896 * MiB;
constexpr size_t WS_HN2 = 16 * MiB;
constexpr size_t WS_WEI = 144 * MiB;
constexpr size_t WS_Y = 16 * MiB;
constexpr size_t WS_DELTA = 528 * MiB;
constexpr size_t WS_ACT = 656 * MiB;
constexpr size_t WS_WEO = 928 * MiB;
constexpr size_t WS_END = 992 * MiB;
static_assert(WS_ACT + (size_t)ACT_TILES_MAX * 256 * 1024 <= WS_WEO && WS_Y + (size_t)T * 4 * 1024 * 2 <= WS_DELTA && WS_DELTA + (size_t)T * 1024 * 2 <= WS_ACT && WS_WEI + (size_t)NEXP * 2048 * 1024 <= WS_DELTA && WS_DELTA + (size_t)T * 1024 * 2 <= WS_MERGED, "late map");
static_assert(WS_W1T + (size_t)N1 * 1024 * 2 <= WS_WUQ && WS_VTG + 4 * MiB <= WS_HN && WS_GATES + (size_t)T * 3072 * 2 <= WS_U && WS_CQKV + (size_t)T * 768 * 2 <= WS_QX && WS_Q + (size_t)T * 768 * 2 <= WS_KV, "early map");
constexpr int CW_TMO = 0, CW_CODE = 1;
constexpr int CW_BAR = 4096;
constexpr int CW_GCNT = 16384;
constexpr int RING_OFF = 0, RING_BYTES = 131072;
constexpr int LDSCTL_OFF = RING_BYTES, MISC_OFF = LDSCTL_OFF + 320;
constexpr int LX_TSTART = LDSCTL_OFF + 512;
constexpr int LX_CNT = LDSCTL_OFF + 768;
constexpr int LX_LCNT = LDSCTL_OFF + 1024;
constexpr int LX_BASE = LDSCTL_OFF + 1280;
constexpr int LX_XWS = LDSCTL_OFF + 2048;
constexpr int LX_STASH = LDSCTL_OFF + 4096;
constexpr int LX_GATE = LDSCTL_OFF + 8192;
constexpr int LDS_BYTES = 147456;
static_assert(LX_GATE + 4096 <= LDS_BYTES && mla::LDS_BYTES <= RING_BYTES, "LDS map");

#define GAS __attribute__((address_space(1)))
#define LAS __attribute__((address_space(3)))
typedef unsigned short bf16;
typedef unsigned v4u __attribute__((ext_vector_type(4)));
typedef unsigned v2u __attribute__((ext_vector_type(2)));
typedef float f32x4 __attribute__((ext_vector_type(4)));
typedef float f32x16 __attribute__((ext_vector_type(16)));
typedef short bf16x8 __attribute__((ext_vector_type(8)));
typedef GAS unsigned gu32;
#define RLX_AGENT __ATOMIC_RELAXED, __HIP_MEMORY_SCOPE_AGENT
#define LDS_WAIT() asm volatile("s_waitcnt lgkmcnt(0)" ::: "memory")
#define VM_WAIT() asm volatile("s_waitcnt vmcnt(0)" ::: "memory")
__device__ __forceinline__ unsigned f2bf(float f) { unsigned u = __builtin_bit_cast(unsigned, f); return (u + 0x7fffu + ((u >> 16) & 1u)) >> 16; }
__device__ __forceinline__ unsigned pk2(float lo, float hi) { return pg8::cvt_pk_bf16(lo, hi); }
__device__ __forceinline__ float bflo(unsigned w) { return __uint_as_float(w << 16); }
__device__ __forceinline__ float bfhi(unsigned w) { return __uint_as_float(w & 0xffff0000u); }
__device__ __forceinline__ unsigned pk4_fp8(float a, float b, float c, float d) { int w = 0; w = __builtin_amdgcn_cvt_pk_fp8_f32(a, b, w, false); w = __builtin_amdgcn_cvt_pk_fp8_f32(c, d, w, true); return (unsigned)w; }

#define XB_TMO      128
#define XB_XCNT(j)  (256  + 64 * (j))
#define XB_XSUB(j)  (1280 + 64 * (j))
#define XB_XGEN(j)  (2304 + 64 * (j))
#define XB_TOP      3328
#define XB_TOPGEN   3392
#define XCD_BAR_WORDS 3456
#define XB_SPIN_CAP (1u << 18)
__device__ __forceinline__ unsigned xb_ld(unsigned* p)              { return __hip_atomic_load(p, __ATOMIC_RELAXED, __HIP_MEMORY_SCOPE_AGENT); }
__device__ __forceinline__ unsigned xb_add(unsigned* p, unsigned v) { return __hip_atomic_fetch_add(p, v, __ATOMIC_RELAXED, __HIP_MEMORY_SCOPE_AGENT); }
__device__ __forceinline__ unsigned xb_xcc_id() { return (unsigned)__builtin_amdgcn_s_getreg((3 << 11) | 20) & 0xFu; }
#define XB_SPIN(cond, bar) do { unsigned _sp = 0; while (cond) { __builtin_amdgcn_s_sleep(1); \
    if ((++_sp & 255u) == 0u) { if (xb_ld(&(bar)[XB_TMO])) break; if (_sp > XB_SPIN_CAP) { atomicAdd(&(bar)[XB_TMO], 1u); break; } } } } while (0)
struct XcdBarrier { unsigned* bar; unsigned x; volatile LAS unsigned* st; };
__device__ __forceinline__ XcdBarrier xcd_barrier_post(unsigned* bar, volatile LAS unsigned* st, const bool thread0) {
    XcdBarrier b; b.bar = bar; b.x = xb_xcc_id(); b.st = st;
    if (thread0) (void)xb_add(&bar[XB_XCNT(b.x)], 1u);
    return b;
}
__device__ __forceinline__ void xcd_barrier_complete(unsigned* bar, unsigned x, unsigned& nloc, unsigned& nx) {
    const unsigned G = gridDim.x * gridDim.y * gridDim.z;
    unsigned sum, cnt, mine, sp = 0u;
    for (;;) {
        sum = 0u; cnt = 0u; mine = 0u;
#pragma unroll
        for (unsigned j = 0; j < 16; ++j) { const unsigned c = xb_ld(&bar[XB_XCNT(j)]); sum += c; cnt += (c > 0u) ? 1u : 0u; mine = (j == x) ? c : mine; }
        if (sum == G) break;
        __builtin_amdgcn_s_sleep(1);
        if ((++sp & 255u) == 0u) { if (xb_ld(&bar[XB_TMO])) break; if (sp > XB_SPIN_CAP) { atomicAdd(&bar[XB_TMO], 1u); break; } }
    }
    nloc = mine > 0u ? mine : 1u; nx = cnt > 0u ? cnt : 1u;
}
__device__ __forceinline__ void xcd_barrier(const XcdBarrier& b, const bool thread0) {
    asm volatile("s_waitcnt vmcnt(0)" ::: "memory");
    __syncthreads();
    if (thread0) {
        unsigned* bar = b.bar;
        __builtin_amdgcn_s_waitcnt(0);
        unsigned nloc = b.st[0], nx = b.st[1];
        if (nloc == 0u) { xcd_barrier_complete(bar, b.x, nloc, nx); b.st[0] = nloc; b.st[1] = nx; }
        const unsigned old = xb_add(&bar[XB_XSUB(b.x)], 1u);
        const unsigned gen = old / nloc;
        if (old + 1u == (gen + 1u) * nloc) {
            __builtin_amdgcn_fence(__ATOMIC_RELEASE, "agent");
            asm volatile("s_waitcnt vmcnt(0)" ::: "memory");
            const unsigned og = xb_add(&bar[XB_TOP], 1u);
            const unsigned tg = og / nx;
            if (og + 1u == (tg + 1u) * nx) xb_add(&bar[XB_TOPGEN], 1u);
            else XB_SPIN(xb_ld(&bar[XB_TOPGEN]) == tg, bar);
            __builtin_amdgcn_fence(__ATOMIC_ACQUIRE, "agent");
            xb_add(&bar[XB_XGEN(b.x)], 1u);
            asm volatile("s_waitcnt vmcnt(0)" ::: "memory");
        } else {
            XB_SPIN(xb_ld(&bar[XB_XGEN(b.x)]) == gen, bar);
            __builtin_amdgcn_fence(__ATOMIC_ACQUIRE, "agent");
            asm volatile("s_waitcnt vmcnt(0)" ::: "memory");
        }
    }
    __syncthreads();
}

struct Frame {
    LAS unsigned char* lds;
    volatile LAS unsigned* MISC;
    gu32* ctl;
    int tid, lane, wave;
    int vcu, G;
    unsigned char* ws;
    const float* const* in;
    float* out;
};
__device__ __forceinline__ float wave_sum(float v) {
#pragma unroll
    for (int o = 1; o < 64; o <<= 1) v += __shfl_xor(v, o);
    return v;
}
__device__ __forceinline__ float sumsq8(v4u w) {
    float s = 0.f;
#pragma unroll
    for (int i = 0; i < 4; ++i) { const float a = bflo(w[i]), b = bfhi(w[i]); s += a * a + b * b; }
    return s;
}
__device__ __forceinline__ void transpose_item(const float* W, int ldw, int srccol, const float* ks, bf16* WT, int K, int nrow0, int k0, LAS float* scr, int lane) {
    float v[32];
#pragma unroll
    for (int i = 0; i < 32; ++i) { const int kk = 2 * i + (lane >> 5); v[i] = (srccol >= 0) ? W[(size_t)(k0 + kk) * ldw + srccol + (lane & 31)] : 0.f; }
    if (ks) {
#pragma unroll
        for (int i = 0; i < 32; ++i) v[i] *= ks[k0 + 2 * i + (lane >> 5)]; }
#pragma unroll
    for (int i = 0; i < 32; ++i) scr[(2 * i + (lane >> 5)) * 33 + (lane & 31)] = v[i];
    LDS_WAIT(); asm volatile("" ::: "memory");
    const int c = lane & 7;
#pragma unroll
    for (int j = 0; j < 4; ++j) { const int n = (lane >> 3) + 8 * j; const LAS float* s = scr + (8 * c) * 33 + n;
        v4u o; o.x = pk2(s[0 * 33], s[1 * 33]); o.y = pk2(s[2 * 33], s[3 * 33]); o.z = pk2(s[4 * 33], s[5 * 33]); o.w = pk2(s[6 * 33], s[7 * 33]);
        *(GAS v4u*)(WT + (size_t)(nrow0 + n) * K + k0 + 8 * c) = o; }
    LDS_WAIT(); asm volatile("" ::: "memory");
}
__device__ __forceinline__ void transpose_item8(const float* W, int ldw, int srccol, const float* ks, float scale, unsigned char* WT, int K, int nrow0, int k0, LAS float* scr, int lane) {
    float v[32];
#pragma unroll
    for (int i = 0; i < 32; ++i) { const int kk = 2 * i + (lane >> 5); v[i] = W[(size_t)(k0 + kk) * ldw + srccol + (lane & 31)] * scale; }
    if (ks) {
#pragma unroll
        for (int i = 0; i < 32; ++i) v[i] *= ks[k0 + 2 * i + (lane >> 5)]; }
#pragma unroll
    for (int i = 0; i < 32; ++i) scr[(2 * i + (lane >> 5)) * 33 + (lane & 31)] = v[i];
    LDS_WAIT(); asm volatile("" ::: "memory");
    const int c = lane & 7;
#pragma unroll
    for (int j = 0; j < 4; ++j) { const int n = (lane >> 3) + 8 * j; const LAS float* s = scr + (8 * c) * 33 + n;
        v2u o; o.x = pk4_fp8(s[0 * 33], s[1 * 33], s[2 * 33], s[3 * 33]); o.y = pk4_fp8(s[4 * 33], s[5 * 33], s[6 * 33], s[7 * 33]);
        *(GAS v2u*)(WT + (size_t)(nrow0 + n) * K + k0 + 8 * c) = o; }
    LDS_WAIT(); asm volatile("" ::: "memory");
}
template <int NR> __device__ __forceinline__ void rms_rows_to_bf16(int lane, const float* x0, size_t xstride, const f32x4 (&gg)[4], bf16* o0, size_t ostride) {
    f32x4 v[NR][4];
#pragma unroll
    for (int r = 0; r < NR; ++r) { const GAS f32x4* xr = (const GAS f32x4*)(x0 + r * xstride) + lane;
#pragma unroll
        for (int j = 0; j < 4; ++j) v[r][j] = xr[64 * j]; }
#pragma unroll
    for (int r = 0; r < NR; ++r) { float s = 0.f;
#pragma unroll
        for (int j = 0; j < 4; ++j) s += (v[r][j].x * v[r][j].x + v[r][j].y * v[r][j].y) + (v[r][j].z * v[r][j].z + v[r][j].w * v[r][j].w);
        const float rstd = 1.0f / sqrtf(wave_sum(s) * (1.f / 1024.f) + EPS);
        GAS unsigned long long* o8 = (GAS unsigned long long*)(o0 + r * ostride) + lane;
#pragma unroll
        for (int j = 0; j < 4; ++j)
            o8[64 * j] = (unsigned long long)pk2(v[r][j].x * rstd * gg[j].x, v[r][j].y * rstd * gg[j].y) | ((unsigned long long)pk2(v[r][j].z * rstd * gg[j].z, v[r][j].w * rstd * gg[j].w) << 32); }
}
__device__ __forceinline__ void rms_rows_all(int lane, int gw, int NGW, const float* X, const float* g, bf16* O, int nrows) {
    f32x4 gg[4];
#pragma unroll
    for (int j = 0; j < 4; ++j) gg[j] = ((const GAS f32x4*)g + lane)[64 * j];
    int m = gw;
    for (; m + 3 * NGW < nrows; m += 4 * NGW) rms_rows_to_bf16<4>(lane, X + (size_t)m * D, (size_t)NGW * D, gg, O + (size_t)m * D, (size_t)NGW * D);
    for (; m < nrows; m += NGW) rms_rows_to_bf16<1>(lane, X + (size_t)m * D, 0, gg, O + (size_t)m * D, 0);
}

enum { I_X = 0, I_MEM, I_POS, I_GATTN, I_WIN, I_WPOOL, I_PSCALE, I_GQL, I_WUQ, I_GKVL, I_WUKV, I_GQM, I_GKM, I_GMEM, I_WMEMKV, I_GQC, I_GKC, I_WPO, I_WMO, I_WCO, I_WO, I_GFFN,
       I_WR, I_BR, I_WEI, I_BEI, I_WEO, I_BEO, N_IN };

__device__ __forceinline__ int fresh_lane() { int l; asm volatile("v_mbcnt_lo_u32_b32 %0, -1, 0\n\tv_mbcnt_hi_u32_b32 %0, -1, %0" : "=v"(l)); return l; }
#define REFRESH(F) do { int w_ = (F).wave; asm volatile("" : "+s"(w_)); (F).wave = w_; (F).lane = fresh_lane(); (F).tid = w_ * 64 + (F).lane; } while (0)
__device__ __forceinline__ void p0_prologue(Frame& F) {
    LAS float* scr = (LAS float*)(F.lds + RING_OFF + F.wave * 16384);
    const int gw = F.vcu * NWAVES + F.wave, NGW = F.G * NWAVES, lane = F.lane;
    unsigned char* ws = F.ws;
    constexpr int I1 = 16 * (N1 / 32), I2 = 6 * 24, I3 = 4 * 32, I4 = 16 * 32, I5 = 8 * 32, I6 = 8 * 32, I7 = 16 * 32;
    constexpr int NITEMS = I1 + I2 + I3 + I4 + I5 + I6 + I7;
    for (int it = gw; it < NITEMS; it += NGW) {
        int r = it;
        if (r < I1) { const int nnb = N1 / 32, kb = r / nnb, nb = r % nnb, n0 = nb * 32; const int src = n0 < 1184 ? n0 : (n0 < 1280 ? -1 : n0 - 96);
            transpose_item(F.in[I_WIN], IN_COLS, src, nullptr, (bf16*)(ws + WS_W1T), 1024, n0, kb * 64, scr, lane); continue; } r -= I1;
        if (r < I2) { const int kb = r / 24, nb = r % 24; transpose_item(F.in[I_WUQ], 768, nb * 32, F.in[I_GQL], (bf16*)(ws + WS_WUQ), 384, nb * 32, kb * 64, scr, lane); continue; } r -= I2;
        if (r < I3) { const int kb = r / 32, nb = r % 32; transpose_item(F.in[I_WUKV], 1024, nb * 32, F.in[I_GKVL], (bf16*)(ws + WS_WUKV), 256, nb * 32, kb * 64, scr, lane); continue; } r -= I3;
        if (r < I4) { const int kb = r / 32, nb = r % 32; transpose_item(F.in[I_WMEMKV], 1024, nb * 32, nullptr, (bf16*)(ws + WS_WMEM), 1024, nb * 32, kb * 64, scr, lane); continue; } r -= I4;
        if (r < I5) { const int kb = r / 32, nb = r % 32; transpose_item(F.in[I_WMO], 1024, nb * 32, nullptr, (bf16*)(ws + WS_WMO), 512, nb * 32, kb * 64, scr, lane); continue; } r -= I5;
        if (r < I6) { const int kb = r / 32, nb = r % 32; transpose_item(F.in[I_WCO], 1024, nb * 32, nullptr, (bf16*)(ws + WS_WCO), 512, nb * 32, kb * 64, scr, lane); continue; } r -= I6;
        { const int kb = r / 32, nb = r % 32; transpose_item(F.in[I_WO], 1024, nb * 32, nullptr, (bf16*)(ws + WS_WO), 1024, nb * 32, kb * 64, scr, lane); }
    }
    for (int it = gw; it < 2048; it += NGW) {
        const int kc = it >> 2, dq = it & 3, g = kc >> 7; const float* wp = F.in[I_WPOOL] + (size_t)kc * 128; const float* ps = F.in[I_PSCALE] + g * 128; const float* wpo = F.in[I_WPO] + (size_t)(g * 128) * 1024 + dq * 256 + lane;
        float a[4] = {0.f, 0.f, 0.f, 0.f};
#pragma unroll 8
        for (int j = 0; j < 128; ++j) { const float sc = wp[j] * ps[j]; const float* row = wpo + (size_t)j * 1024;
#pragma unroll
            for (int i = 0; i < 4; ++i) a[i] += sc * row[64 * i]; }
        bf16* wt = (bf16*)(ws + WS_WPOOL);
#pragma unroll
        for (int i = 0; i < 4; ++i) wt[(size_t)(dq * 256 + lane + 64 * i) * 512 + kc] = (bf16)f2bf(a[i]);
    }
    rms_rows_all(lane, gw, NGW, F.in[I_X], F.in[I_GATTN], (bf16*)(ws + WS_HN), T);
    rms_rows_all(lane, gw, NGW, F.in[I_MEM], F.in[I_GMEM], (bf16*)(ws + WS_MEMN), MROWS);
}

using pg8::Unit; using pg8::bf16_t;
struct DenseSched {
    int nM, nN, G, c; const char* A; const char* B; size_t tA, tB;
    __device__ __forceinline__ void init(const void* A_, int lda, const void* B_, int ldb, int M, int N, int G_, int c_) { A = (const char*)A_; B = (const char*)B_; nM = M / 256; nN = N / 256; G = G_; c = c_; tA = (size_t)256 * lda * 2; tB = (size_t)256 * ldb * 2; }
    __device__ __forceinline__ bool next(int i, Unit& u) const {
        const long L = (long)i * G + c; if (L >= (long)nM * nN) return false;
        pg8::tile_order((int)L, nM, nN, u.pm, u.pn); u.A = A + (size_t)u.pm * tA; u.B = B + (size_t)u.pn * tB; u.aux = 0; return true; }
};
struct EpiStore {
    static constexpr bool PERM = true;
    bf16_t* O; int ldc;
    __device__ __forceinline__ void operator()(const pg8::f32x4 (&acc)[2][2][4][2], const Unit& u, int wr, int wc, int fr_, int fq_) const {
        int fr = fr_, fq = fq_; asm volatile("" : "+v"(fr), "+v"(fq));
        const int row0 = u.pm * 256 + wr * 64 + fr, col0 = u.pn * 256 + wc * 32 + 8 * fq;
#pragma unroll
        for (int ai = 0; ai < 2; ++ai)
#pragma unroll
            for (int m = 0; m < 4; ++m) { bf16_t* rowp = O + (size_t)(row0 + ai * 128 + m * 16) * ldc + col0;
#pragma unroll
                for (int bj = 0; bj < 2; ++bj) { const pg8::f32x4 v0 = acc[ai][bj][m][0], v1 = acc[ai][bj][m][1]; pg8::u32x4 w;
                    w.x = pg8::cvt_pk_bf16(v0[0], v0[1]); w.y = pg8::cvt_pk_bf16(v0[2], v0[3]); w.z = pg8::cvt_pk_bf16(v1[0], v1[1]); w.w = pg8::cvt_pk_bf16(v1[2], v1[3]);
                    *(pg8::u32x4*)(rowp + bj * 128) = w; } }
    }
};
struct EpiP1 {
    static constexpr bool PERM = true;
    bf16_t *U, *CQKV, *QX, *GATES;
    __device__ __forceinline__ void operator()(const pg8::f32x4 (&acc)[2][2][4][2], const Unit& u, int wr, int wc, int fr_, int fq_) const {
        int fr = fr_, fq = fq_; asm volatile("" : "+v"(fr), "+v"(fq));
        const int pn = u.pn; bf16_t* base; int ldc, colt; bool sg = false;
        if (pn < 2) { base = U; ldc = 512; colt = pn * 256; } else if (pn < 5) { base = CQKV; ldc = 768; colt = (pn - 2) * 256; }
        else if (pn < 7) { base = QX; ldc = 512; colt = (pn - 5) * 256; } else { base = GATES; ldc = 3072; colt = (pn - 7) * 256; sg = true; }
        const int row0 = u.pm * 256 + wr * 64 + fr, col0 = colt + wc * 32 + 8 * fq;
#pragma unroll
        for (int ai = 0; ai < 2; ++ai)
#pragma unroll
            for (int m = 0; m < 4; ++m) { bf16_t* rowp = base + (size_t)(row0 + ai * 128 + m * 16) * ldc + col0;
#pragma unroll
                for (int bj = 0; bj < 2; ++bj) { pg8::f32x4 v0 = acc[ai][bj][m][0], v1 = acc[ai][bj][m][1];
                    if (sg) {
#pragma unroll
                        for (int i = 0; i < 4; ++i) { v0[i] = pg8::sigmoidf_fast(v0[i]); v1[i] = pg8::sigmoidf_fast(v1[i]); } }
                    pg8::u32x4 w; w.x = pg8::cvt_pk_bf16(v0[0], v0[1]); w.y = pg8::cvt_pk_bf16(v0[2], v0[3]); w.z = pg8::cvt_pk_bf16(v1[0], v1[1]); w.w = pg8::cvt_pk_bf16(v1[2], v1[3]);
                    *(pg8::u32x4*)(rowp + bj * 128) = w; } }
    }
};
struct EpiMemKV {
    static constexpr bool PERM = true;
    bf16_t *KVMK, *VTG;
    __device__ __forceinline__ void operator()(const pg8::f32x4 (&acc)[2][2][4][2], const Unit& u, int wr, int wc, int fr_, int fq_) const {
        int fr = fr_, fq = fq_; asm volatile("" : "+v"(fr), "+v"(fq));
        const int row0 = u.pm * 256 + wr * 64 + fr;
        if (u.pn < 2) {
            const int col0 = u.pn * 256 + wc * 32 + 8 * fq;
#pragma unroll
            for (int ai = 0; ai < 2; ++ai)
#pragma unroll
                for (int m = 0; m < 4; ++m) { bf16_t* rowp = KVMK + (size_t)(row0 + ai * 128 + m * 16) * 512 + col0;
#pragma unroll
                    for (int bj = 0; bj < 2; ++bj) { const pg8::f32x4 v0 = acc[ai][bj][m][0], v1 = acc[ai][bj][m][1]; pg8::u32x4 w;
                        w.x = pg8::cvt_pk_bf16(v0[0], v0[1]); w.y = pg8::cvt_pk_bf16(v0[2], v0[3]); w.z = pg8::cvt_pk_bf16(v1[0], v1[1]); w.w = pg8::cvt_pk_bf16(v1[2], v1[3]);
                        *(pg8::u32x4*)(rowp + bj * 128) = w; } }
        } else {
#pragma unroll
            for (int ai = 0; ai < 2; ++ai)
#pragma unroll
                for (int m = 0; m < 4; ++m) { const int row = row0 + ai * 128 + m * 16, b = row >> 8, mm = row & 255;
                    const int pos = (mm & ~12) | ((mm & 4) << 1) | ((mm & 8) >> 1);
#pragma unroll
                    for (int bj = 0; bj < 2; ++bj) { const int hc = (u.pn - 2) * 2 + bj;
                        bf16_t* dst = VTG + ((size_t)(b * 4 + hc) * 128 + wc * 32 + 8 * fq) * 256 + pos;
#pragma unroll
                        for (int n = 0; n < 2; ++n)
#pragma unroll
                            for (int i = 0; i < 4; ++i) dst[(size_t)(4 * n + i) * 256] = (bf16_t)f2bf(acc[ai][bj][m][n][i]); } }
        }
    }
};
struct MergeSched {
    int G, c; const char *A0, *B0; long dA1, dA2, dB1, dB2;
    __device__ __forceinline__ bool next(int i, Unit& u) const {
        const int ti = i / 3, br = i - 3 * ti; const long L = (long)ti * G + c; if (L >= 256 * 4) return false;
        pg8::tile_order((int)L, 256, 4, u.pm, u.pn); u.aux = br;
        const long b1 = br & 1, b2 = br >> 1;
        u.A = A0 + b1 * dA1 + b2 * dA2 + (size_t)u.pm * (256 * 512 * 2); u.B = B0 + b1 * dB1 + b2 * dB2 + (size_t)u.pn * (256 * 512 * 2); return true; }
};
struct EpiMerge {
    static constexpr bool PERM = true;
    const bf16_t* GATES; bf16_t* MERGED;
    __device__ __forceinline__ void operator()(const pg8::f32x4 (&acc)[2][2][4][2], const Unit& u, int wr, int wc, int fr_, int fq_) const {
        int fr = fr_, fq = fq_; asm volatile("" : "+v"(fr), "+v"(fq));
        const int br = u.aux, row0 = u.pm * 256 + wr * 64 + fr, col0 = u.pn * 256 + wc * 32 + 8 * fq;
#pragma unroll
        for (int ai = 0; ai < 2; ++ai)
#pragma unroll
            for (int m = 0; m < 4; ++m) { const size_t row = (size_t)(row0 + ai * 128 + m * 16);
#pragma unroll
                for (int bj = 0; bj < 2; ++bj) { const int c0 = col0 + bj * 128;
                    const pg8::u32x4 g = *(const pg8::u32x4*)(GATES + row * 3072 + br * 1024 + c0);
                    pg8::f32x4 v0 = acc[ai][bj][m][0], v1 = acc[ai][bj][m][1];
                    v0[0] *= bflo(g.x); v0[1] *= bfhi(g.x); v0[2] *= bflo(g.y); v0[3] *= bfhi(g.y); v1[0] *= bflo(g.z); v1[1] *= bfhi(g.z); v1[2] *= bflo(g.w); v1[3] *= bfhi(g.w);
                    bf16_t* dst = MERGED + row * 1024 + c0;
                    if (br > 0) { const pg8::u32x4 p = *(const pg8::u32x4*)dst;
                        v0[0] += bflo(p.x); v0[1] += bfhi(p.x); v0[2] += bflo(p.y); v0[3] += bfhi(p.y); v1[0] += bflo(p.z); v1[1] += bfhi(p.z); v1[2] += bflo(p.w); v1[3] += bfhi(p.w); }
                    pg8::u32x4 w; w.x = pg8::cvt_pk_bf16(v0[0], v0[1]); w.y = pg8::cvt_pk_bf16(v0[2], v0[3]); w.z = pg8::cvt_pk_bf16(v1[0], v1[1]); w.w = pg8::cvt_pk_bf16(v1[2], v1[3]);
                    *(pg8::u32x4*)dst = w; } }
    }
};
struct EpiResF32 {
    static constexpr bool PERM = false;
    const float* X; float* O;
    __device__ __forceinline__ void operator()(const pg8::f32x4 (&acc)[2][2][4][2], const Unit& u, int wr, int wc, int fr_, int fq_) const {
        int fr = fr_, fq = fq_; asm volatile("" : "+v"(fr), "+v"(fq));
        const int row0 = u.pm * 256 + wr * 64 + fr, col0 = u.pn * 256 + wc * 32 + 4 * fq;
#pragma unroll
        for (int ai = 0; ai < 2; ++ai)
#pragma unroll
            for (int m = 0; m < 4; ++m) { const size_t off = (size_t)(row0 + ai * 128 + m * 16) * 1024 + col0;
#pragma unroll
                for (int bj = 0; bj < 2; ++bj)
#pragma unroll
                    for (int n = 0; n < 2; ++n) { const pg8::f32x4 xv = *(const pg8::f32x4*)(X + off + bj * 128 + n * 16); *(pg8::f32x4*)(O + off + bj * 128 + n * 16) = xv + acc[ai][bj][m][n]; } }
    }
};
struct MoeSched {
    int G, c, nM, nN; const LAS int* tstart; const LAS int* cnt; const int* list; const char* A; const char* B; size_t bexp, tB, tA; bool gather;
    __device__ __forceinline__ bool next(int i, Unit& u) const {
        const long L = (long)i * G + c; if (L >= (long)nM * nN) return false;
        int pm, pn; pg8::tile_order((int)L, nM, nN, pm, pn);
        int e = 0; while (e < NEXP - 1 && __builtin_amdgcn_readfirstlane(tstart[e + 1]) <= pm) ++e;
        const int ts = __builtin_amdgcn_readfirstlane(tstart[e]);
        u.pm = pm; u.pn = pn; u.aux = e | ((pm - ts) << 8);
        u.A = gather ? A : A + (size_t)pm * tA; u.B = B + (size_t)e * bexp + (size_t)pn * tB; return true; }
    __device__ __forceinline__ unsigned row_off(const Unit& u, int row) const {
        const int e = u.aux & 255, idx = (u.aux >> 8) * 256 + row; const int ent = idx < cnt[e] ? list[(size_t)e * LISTCAP + idx] : 0; return (unsigned)(ent >> 2) * 1024u; }
};
struct EpiMoeIn {
    static constexpr bool PERM = true;
    const LAS int* cnt; const int* list; const float* rstd2; const float* bin; unsigned char* ACT;
    __device__ __forceinline__ void operator()(const pg8::f32x4 (&acc)[2][2][4][2], const Unit& u, int wr, int wc, int fr_, int fq_) const {
        int fr = fr_, fq = fq_; asm volatile("" : "+v"(fr), "+v"(fq));
        const int e = u.aux & 255, rt = u.aux >> 8, ce = cnt[e], j0 = u.pn * 128 + wc * 32 + 8 * fq;
        const float* bg = bin + (size_t)e * 2048 + j0; const pg8::f32x4 bg0 = *(const pg8::f32x4*)bg, bg1 = *(const pg8::f32x4*)(bg + 4), bl0 = *(const pg8::f32x4*)(bg + 1024), bl1 = *(const pg8::f32x4*)(bg + 1028);
#pragma unroll
        for (int ai = 0; ai < 2; ++ai)
#pragma unroll
            for (int m = 0; m < 4; ++m) { const int rl = ai * 128 + wr * 64 + m * 16 + fr, idx = rt * 256 + rl; float rs = 0.f;
                if (idx < ce) rs = rstd2[list[(size_t)e * LISTCAP + idx] >> 2] * (1.0f / (SX8 * SW8));
                float a[8];
#pragma unroll
                for (int n = 0; n < 2; ++n)
#pragma unroll
                    for (int i = 0; i < 4; ++i) { float gl = acc[ai][0][m][n][i] * rs + (n ? bg1[i] : bg0[i]), li = acc[ai][1][m][n][i] * rs + (n ? bl1[i] : bl0[i]);
                        gl = fminf(gl, 7.0f); li = fminf(fmaxf(li, -7.0f), 7.0f);
                        a[4 * n + i] = gl * pg8::sigmoidf_fast(1.702f * gl) * (li + 1.0f) * SA8; }
                pg8::u32x2 w; w.x = pk4_fp8(a[0], a[1], a[2], a[3]); w.y = pk4_fp8(a[4], a[5], a[6], a[7]);
                *(pg8::u32x2*)(ACT + ((size_t)u.pm * 256 + rl) * 1024 + j0) = w; }
    }
};
struct EpiMoeOut {
    static constexpr bool PERM = true;
    const LAS int* cnt; const int* list; const float* tokg; const float* bout; bf16_t* Y;
    __device__ __forceinline__ void operator()(const pg8::f32x4 (&acc)[2][2][4][2], const Unit& u, int wr, int wc, int fr_, int fq_) const {
        int fr = fr_, fq = fq_; asm volatile("" : "+v"(fr), "+v"(fq));
        const int e = u.aux & 255, rt = u.aux >> 8, ce = cnt[e], c0 = u.pn * 256 + wc * 32 + 8 * fq;
        const float* bo = bout + (size_t)e * 1024 + c0; pg8::f32x4 bv[2][2];
#pragma unroll
        for (int bj = 0; bj < 2; ++bj)
#pragma unroll
            for (int n = 0; n < 2; ++n) bv[bj][n] = *(const pg8::f32x4*)(bo + bj * 128 + 4 * n);
        int ent[8]; float g[8];
#pragma unroll
        for (int i = 0; i < 8; ++i) { const int idx = rt * 256 + (i >> 2) * 128 + wr * 64 + (i & 3) * 16 + fr; ent[i] = idx < ce ? list[(size_t)e * LISTCAP + idx] : -1; }
#pragma unroll
        for (int i = 0; i < 8; ++i) g[i] = ent[i] >= 0 ? tokg[ent[i]] * (1.0f / (SA8 * SW8)) : 0.f;
#pragma unroll
        for (int ai = 0; ai < 2; ++ai)
#pragma unroll
            for (int m = 0; m < 4; ++m) { const int i = ai * 4 + m;
                if (ent[i] >= 0) { const float gs = g[i], gb = gs * (SA8 * SW8);
#pragma unroll
                    for (int bj = 0; bj < 2; ++bj) { const pg8::f32x4 v0 = acc[ai][bj][m][0] * gs + bv[bj][0] * gb, v1 = acc[ai][bj][m][1] * gs + bv[bj][1] * gb;
                        pg8::u32x4 w; w.x = pg8::cvt_pk_bf16(v0[0], v0[1]); w.y = pg8::cvt_pk_bf16(v0[2], v0[3]); w.z = pg8::cvt_pk_bf16(v1[0], v1[1]); w.w = pg8::cvt_pk_bf16(v1[2], v1[3]);
                        *(pg8::u32x4*)(Y + (size_t)ent[i] * 1024 + c0 + bj * 128) = w; } } }
    }
};
__device__ const float ROPE_INVREV[16] = { 1.591549431e-01f, 8.949940161e-02f, 5.032921210e-02f, 2.830219583e-02f, 1.591549431e-02f, 8.949940161e-03f, 5.032921210e-03f, 2.830219583e-03f,
                                           1.591549431e-03f, 8.949940161e-04f, 5.032921210e-04f, 2.830219583e-04f, 1.591549431e-04f, 8.949940161e-05f, 5.032921210e-05f, 2.830219583e-05f };
struct P3In { v4u cqa, cqb, qn, kn, vv; unsigned pe_lo, pe_hi, ql, qh; int pos; v4u uw[16]; };
__device__ __forceinline__ void p3_load(Frame& F, int t, P3In& I) {
    const int lane = F.lane, h = lane >> 3, sub = lane & 7; unsigned char* ws = F.ws;
    const bf16* cq = (const bf16*)(ws + WS_CQKV) + (size_t)t * 768;
    I.cqa = (v4u){0u, 0u, 0u, 0u}; I.cqb = (v4u){0u, 0u, 0u, 0u};
    if (lane < 48) I.cqa = *(const GAS v4u*)(cq + lane * 8);
    if (lane < 32) I.cqb = *(const GAS v4u*)(cq + 384 + lane * 8);
    I.pe_lo = *(const GAS unsigned*)(cq + 640 + 2 * sub); I.pe_hi = *(const GAS unsigned*)(cq + 656 + 2 * sub);
    I.pos = ((const int*)F.in[I_POS])[t];
    const bf16* qrow = (const bf16*)(ws + WS_Q) + (size_t)t * 768 + h * 96;
    I.qn = *(const GAS v4u*)(qrow + sub * 8); I.ql = *(const GAS unsigned*)(qrow + 64 + 2 * sub); I.qh = *(const GAS unsigned*)(qrow + 80 + 2 * sub);
    const bf16* kvrow = (const bf16*)(ws + WS_KV) + (size_t)t * 1024;
    I.kn = *(const GAS v4u*)(kvrow + h * 128 + sub * 8); I.vv = *(const GAS v4u*)(kvrow + h * 128 + 64 + sub * 8);
    const int s = t & (SEQ - 1), win = 2 << (lane >> 4), cntw = (s + 1 < win) ? s + 1 : win;
    const bf16* urow = (const bf16*)(ws + WS_U) + (size_t)t * 512 + lane * 8;
#pragma unroll
    for (int j = 0; j < 16; ++j) { I.uw[j] = (v4u){0u, 0u, 0u, 0u}; if (j < cntw) I.uw[j] = *(const GAS v4u*)(urow - (size_t)j * 512); }
}
__device__ __forceinline__ void p3_compute(Frame& F, int t, const P3In& I) {
    const int lane = F.lane, h = lane >> 3, sub = lane & 7; unsigned char* ws = F.ws;
    float sq = sumsq8(I.cqa), skv = sumsq8(I.cqb);
    sq = wave_sum(sq); skv = wave_sum(skv);
    const float rs_q = 1.0f / sqrtf(sq * (1.f / 384.f) + EPS), rs_kv = 1.0f / sqrtf(skv * (1.f / 256.f) + EPS);
    const float posf = (float)I.pos;
    float cs[2], sn[2];
#pragma unroll
    for (int p = 0; p < 2; ++p) { float rev = posf * ROPE_INVREV[2 * sub + p]; rev -= floorf(rev); sn[p] = __builtin_amdgcn_sinf(rev); cs[p] = __builtin_amdgcn_cosf(rev); }
    const float* gq = F.in[I_GQM]; const float* gk = F.in[I_GKM];
    {
        bf16* qrow = (bf16*)(ws + WS_Q) + (size_t)t * 768 + h * 96;
        float q[8], a[2], b[2];
#pragma unroll
        for (int i = 0; i < 4; ++i) { q[2 * i] = bflo(I.qn[i]) * rs_q; q[2 * i + 1] = bfhi(I.qn[i]) * rs_q; }
        a[0] = bflo(I.ql) * rs_q; a[1] = bfhi(I.ql) * rs_q; b[0] = bflo(I.qh) * rs_q; b[1] = bfhi(I.qh) * rs_q;
        float ss = a[0] * a[0] + a[1] * a[1] + b[0] * b[0] + b[1] * b[1];
#pragma unroll
        for (int i = 0; i < 8; ++i) ss += q[i] * q[i];
        ss += __shfl_xor(ss, 1); ss += __shfl_xor(ss, 2); ss += __shfl_xor(ss, 4);
        const float rn = C2_MLA / sqrtf(ss * (1.f / 96.f) + EPS);
#pragma unroll
        for (int i = 0; i < 8; ++i) q[i] *= rn * gq[sub * 8 + i];
        float lo[2], hi[2];
#pragma unroll
        for (int p = 0; p < 2; ++p) { const float x1 = a[p] * rn * gq[64 + 2 * sub + p], x2 = b[p] * rn * gq[80 + 2 * sub + p]; lo[p] = x1 * cs[p] - x2 * sn[p]; hi[p] = x2 * cs[p] + x1 * sn[p]; }
        v4u o; o.x = pk2(q[0], q[1]); o.y = pk2(q[2], q[3]); o.z = pk2(q[4], q[5]); o.w = pk2(q[6], q[7]);
        *(GAS v4u*)(qrow + sub * 8) = o; *(GAS unsigned*)(qrow + 64 + 2 * sub) = pk2(lo[0], lo[1]); *(GAS unsigned*)(qrow + 80 + 2 * sub) = pk2(hi[0], hi[1]);
    }
    {
        bf16* kvrow = (bf16*)(ws + WS_KV) + (size_t)t * 1024;
        float k[8], v[8], a[2], b[2];
#pragma unroll
        for (int i = 0; i < 4; ++i) { k[2 * i] = bflo(I.kn[i]) * rs_kv; k[2 * i + 1] = bfhi(I.kn[i]) * rs_kv; v[2 * i] = bflo(I.vv[i]) * rs_kv; v[2 * i + 1] = bfhi(I.vv[i]) * rs_kv; }
        a[0] = bflo(I.pe_lo); a[1] = bfhi(I.pe_lo); b[0] = bflo(I.pe_hi); b[1] = bfhi(I.pe_hi);
        float ss = a[0] * a[0] + a[1] * a[1] + b[0] * b[0] + b[1] * b[1];
#pragma unroll
        for (int i = 0; i < 8; ++i) ss += k[i] * k[i];
        ss += __shfl_xor(ss, 1); ss += __shfl_xor(ss, 2); ss += __shfl_xor(ss, 4);
        const float rn = 1.0f / sqrtf(ss * (1.f / 96.f) + EPS);
#pragma unroll
        for (int i = 0; i < 8; ++i) k[i] *= rn * gk[sub * 8 + i];
        float lo[2], hi[2];
#pragma unroll
        for (int p = 0; p < 2; ++p) { const float x1 = a[p] * rn * gk[64 + 2 * sub + p], x2 = b[p] * rn * gk[80 + 2 * sub + p]; lo[p] = x1 * cs[p] - x2 * sn[p]; hi[p] = x2 * cs[p] + x1 * sn[p]; }
        v4u o; o.x = pk2(k[0], k[1]); o.y = pk2(k[2], k[3]); o.z = pk2(k[4], k[5]); o.w = pk2(k[6], k[7]);
        v4u ov; ov.x = pk2(v[0], v[1]); ov.y = pk2(v[2], v[3]); ov.z = pk2(v[4], v[5]); ov.w = pk2(v[6], v[7]);
        bf16* krow = kvrow + h * 96;
        *(GAS v4u*)(krow + sub * 8) = o; *(GAS unsigned*)(krow + 64 + 2 * sub) = pk2(lo[0], lo[1]); *(GAS unsigned*)(krow + 80 + 2 * sub) = pk2(hi[0], hi[1]);
        *(GAS v4u*)((bf16*)(ws + WS_V) + (size_t)t * 512 + h * 64 + sub * 8) = ov;
    }
    {
        const int s = t & (SEQ - 1), win = 2 << (lane >> 4), cntw = (s + 1 < win) ? s + 1 : win;
        float acc[8];
#pragma unroll
        for (int i = 0; i < 8; ++i) acc[i] = 0.f;
#pragma unroll
        for (int j = 0; j < 16; ++j)
#pragma unroll
            for (int i = 0; i < 4; ++i) { acc[2 * i] += bflo(I.uw[j][i]); acc[2 * i + 1] += bfhi(I.uw[j][i]); }
        const float inv = 1.0f / (float)cntw;
#pragma unroll
        for (int i = 0; i < 4; ++i) { acc[2 * i] = acc[2 * i] * inv - bflo(I.uw[0][i]); acc[2 * i + 1] = acc[2 * i + 1] * inv - bfhi(I.uw[0][i]); }
        v4u o; o.x = pk2(acc[0], acc[1]); o.y = pk2(acc[2], acc[3]); o.z = pk2(acc[4], acc[5]); o.w = pk2(acc[6], acc[7]);
        *(GAS v4u*)((bf16*)(ws + WS_MIXED) + (size_t)t * 512 + lane * 8) = o;
    }
}
template <int NT> __device__ __forceinline__ void p3_tokens(Frame& F, int t0) {
    P3In I[NT];
#pragma unroll
    for (int i = 0; i < NT; ++i) p3_load(F, t0 + i, I[i]);
    asm volatile("" ::: "memory");
#pragma unroll
    for (int i = 0; i < NT; ++i) p3_compute(F, t0 + i, I[i]);
}

namespace xat {
__device__ __forceinline__ int crow(int r, int hi) { return (r & 3) + 8 * (r >> 2) + 4 * hi; }
__device__ __forceinline__ void stage_kv(Frame& F, int b, int hc) {
    const int tid = F.tid; unsigned char* ws = F.ws; LAS unsigned char* lds = F.lds;
    { const int row = tid >> 1, half = tid & 1; const bf16* src = (const bf16*)(ws + WS_KVMK) + (size_t)(b * 256 + row) * 512 + hc * 128 + half * 64;
      v4u v[8]; float ss = 0.f;
#pragma unroll
      for (int c = 0; c < 8; ++c) { v[c] = *(const GAS v4u*)(src + 8 * c); ss += sumsq8(v[c]); }
      ss += __shfl_xor(ss, 1);
      const float rstd = 1.0f / sqrtf(ss * (1.f / 128.f) + EPS); const float* gk = F.in[I_GKC] + half * 64;
#pragma unroll
      for (int c = 0; c < 8; ++c) { v4u o;
#pragma unroll
          for (int i = 0; i < 4; ++i) o[i] = pk2(bflo(v[c][i]) * rstd * gk[8 * c + 2 * i], bfhi(v[c][i]) * rstd * gk[8 * c + 2 * i + 1]);
          *(LAS v4u*)(lds + row * 256 + (((half * 8 + c) ^ (row & 15)) << 4)) = o; } }
    { const bf16* src = (const bf16*)(ws + WS_VTG) + (size_t)(b * 4 + hc) * 128 * 256;
#pragma unroll
      for (int i = 0; i < 8; ++i) { const int q = tid + 512 * i, d = q >> 5, ch = q & 31; const v4u v = *(const GAS v4u*)(src + (size_t)q * 8);
          *(LAS v4u*)(lds + 65536 + d * 512 + ((ch ^ (d & 15)) << 4)) = v; } }
}
__device__ __forceinline__ void unit(Frame& F, int b, int hc, int qb) {
    const int lane = F.lane, r32 = lane & 31, hi = lane >> 5, wid = F.wave; unsigned char* ws = F.ws; LAS unsigned char* lds = F.lds;
    LAS float* wsf = (LAS float*)(lds + LX_XWS) + wid * 64;
    const size_t row = (size_t)b * SEQ + qb * 256 + wid * 32 + r32;
    bf16x8 qr[8];
    { const bf16* qsrc = (const bf16*)(ws + WS_QX) + row * 512 + hc * 128 + hi * 8; v4u qv[8]; float ss = 0.f;
#pragma unroll
      for (int d0 = 0; d0 < 8; ++d0) { qv[d0] = *(const GAS v4u*)(qsrc + 16 * d0); ss += sumsq8(qv[d0]); }
      ss += __shfl_xor(ss, 32);
      const float rn = C2_X / sqrtf(ss * (1.f / 128.f) + EPS); const float* gq = F.in[I_GQC] + hi * 8;
#pragma unroll
      for (int d0 = 0; d0 < 8; ++d0) { v4u o;
#pragma unroll
          for (int i = 0; i < 4; ++i) o[i] = pk2(bflo(qv[d0][i]) * rn * gq[16 * d0 + 2 * i], bfhi(qv[d0][i]) * rn * gq[16 * d0 + 2 * i + 1]);
          qr[d0] = __builtin_bit_cast(bf16x8, o); } }
    f32x16 o[4];
#pragma unroll
    for (int i = 0; i < 4; ++i) o[i] = f32x16{};
    float mrun = -1e30f, lrun = 0.f;
#pragma unroll 1
    for (int tt = 0; tt < 4; ++tt) {
        f32x16 p0 = f32x16{}, p1 = f32x16{};
        const int kr0 = 64 * tt + r32, kr1 = kr0 + 32;
#pragma unroll
        for (int d0 = 0; d0 < 8; ++d0) {
            const bf16x8 k0 = *(const LAS bf16x8*)(lds + kr0 * 256 + (((2 * d0 + hi) ^ (kr0 & 15)) << 4));
            const bf16x8 k1 = *(const LAS bf16x8*)(lds + kr1 * 256 + (((2 * d0 + hi) ^ (kr1 & 15)) << 4));
            p0 = __builtin_amdgcn_mfma_f32_32x32x16_bf16(k0, qr[d0], p0, 0, 0, 0);
            p1 = __builtin_amdgcn_mfma_f32_32x32x16_bf16(k1, qr[d0], p1, 0, 0, 0);
        }
        float rm = fmaxf(p0[0], p1[0]);
#pragma unroll
        for (int r = 1; r < 16; ++r) rm = fmaxf(rm, fmaxf(p0[r], p1[r]));
        rm = fmaxf(rm, __shfl_xor(rm, 32));
        const float mnew = fmaxf(mrun, rm), sc = __builtin_amdgcn_exp2f(mrun - mnew); mrun = mnew;
        float ps = 0.f;
#pragma unroll
        for (int r = 0; r < 16; ++r) { p0[r] = __builtin_amdgcn_exp2f(p0[r] - mnew); p1[r] = __builtin_amdgcn_exp2f(p1[r] - mnew); ps += p0[r] + p1[r]; }
        lrun = lrun * sc + ps;
        if (hi == 0) wsf[r32] = sc;
        LDS_WAIT();
#pragma unroll
        for (int d = 0; d < 4; ++d)
#pragma unroll
            for (int r = 0; r < 16; ++r) o[d][r] *= wsf[crow(r, hi)];
        v4u pw[4];
#pragma unroll
        for (int i = 0; i < 4; ++i) { pw[0][i] = pk2(p0[2 * i], p0[2 * i + 1]); pw[1][i] = pk2(p0[8 + 2 * i], p0[9 + 2 * i]); pw[2][i] = pk2(p1[2 * i], p1[2 * i + 1]); pw[3][i] = pk2(p1[8 + 2 * i], p1[9 + 2 * i]); }
#pragma unroll
        for (int ks = 0; ks < 4; ++ks) { const int ch = 2 * (4 * tt + ks) + hi; const bf16x8 pa = __builtin_bit_cast(bf16x8, pw[ks]);
#pragma unroll
            for (int d = 0; d < 4; ++d) { const int dr = r32 + 32 * d; const bf16x8 vf = *(const LAS bf16x8*)(lds + 65536 + dr * 512 + ((ch ^ (dr & 15)) << 4));
                o[d] = __builtin_amdgcn_mfma_f32_32x32x16_bf16(pa, vf, o[d], 0, 0, 0); } }
        LDS_WAIT();
    }
    lrun += __shfl_xor(lrun, 32);
    if (hi == 0) wsf[32 + r32] = lrun;
    LDS_WAIT();
    bf16* orow = (bf16*)(ws + WS_CO) + ((size_t)b * SEQ + qb * 256 + wid * 32) * 512 + hc * 128 + r32;
#pragma unroll
    for (int r = 0; r < 16; ++r) { const int qrow = crow(r, hi); const float rl = 1.0f / wsf[32 + qrow];
#pragma unroll
        for (int d = 0; d < 4; ++d) orow[(size_t)qrow * 512 + 32 * d] = (bf16)f2bf(o[d][r] * rl); }
    LDS_WAIT();
}
}

__device__ __forceinline__ void router_tile(Frame& F, int t0, int lt0) {
    const int lane = F.lane, tok = lane & 31, kk = lane >> 5; unsigned char* ws = F.ws; LAS unsigned char* lds = F.lds;
    const LAS float* wr = (const LAS float*)(lds + RING_OFF);
    const float* xrow = F.in[I_X] + (size_t)(t0 + tok) * 1024 + 8 * kk;
    const bf16* drow = (const bf16*)(ws + WS_DELTA) + (size_t)(t0 + tok) * 1024 + 8 * kk;
    unsigned char* hrow = ws + WS_HN2 + (size_t)(t0 + tok) * 1024 + 8 * kk;
    f32x16 acc = f32x16{}; float ss = 0.f;
    constexpr int PD = 8;
    f32x4 ra[PD], rb[PD]; v4u rd[PD];
#pragma unroll
    for (int p = 0; p < PD; ++p) { ra[p] = *(const GAS f32x4*)(xrow + 16 * p); rb[p] = *(const GAS f32x4*)(xrow + 16 * p + 4); rd[p] = *(const GAS v4u*)(drow + 16 * p); }
#pragma unroll 1
    for (int q0 = 0; q0 < 64; q0 += PD) {
#pragma unroll
        for (int p = 0; p < PD; ++p) {
            const int q = q0 + p; f32x4 a = ra[p], b = rb[p]; const v4u dd = rd[p];
            a.x += bflo(dd.x); a.y += bfhi(dd.x); a.z += bflo(dd.y); a.w += bfhi(dd.y); b.x += bflo(dd.z); b.y += bfhi(dd.z); b.z += bflo(dd.w); b.w += bfhi(dd.w);
            if (q0 + PD < 64) { ra[p] = *(const GAS f32x4*)(xrow + 16 * (q + PD)); rb[p] = *(const GAS f32x4*)(xrow + 16 * (q + PD) + 4); rd[p] = *(const GAS v4u*)(drow + 16 * (q + PD)); }
            ss += (a.x * a.x + a.y * a.y) + (a.z * a.z + a.w * a.w) + (b.x * b.x + b.y * b.y) + (b.z * b.z + b.w * b.w);
            const LAS float* wq = wr + (16 * q + 8 * kk) * 32 + tok;
            acc = __builtin_amdgcn_mfma_f32_32x32x2f32(wq[0 * 32], a.x, acc, 0, 0, 0); acc = __builtin_amdgcn_mfma_f32_32x32x2f32(wq[1 * 32], a.y, acc, 0, 0, 0);
            acc = __builtin_amdgcn_mfma_f32_32x32x2f32(wq[2 * 32], a.z, acc, 0, 0, 0); acc = __builtin_amdgcn_mfma_f32_32x32x2f32(wq[3 * 32], a.w, acc, 0, 0, 0);
            acc = __builtin_amdgcn_mfma_f32_32x32x2f32(wq[4 * 32], b.x, acc, 0, 0, 0); acc = __builtin_amdgcn_mfma_f32_32x32x2f32(wq[5 * 32], b.y, acc, 0, 0, 0);
            acc = __builtin_amdgcn_mfma_f32_32x32x2f32(wq[6 * 32], b.z, acc, 0, 0, 0); acc = __builtin_amdgcn_mfma_f32_32x32x2f32(wq[7 * 32], b.w, acc, 0, 0, 0);
            v2u o; o.x = pk4_fp8(a.x * SX8, a.y * SX8, a.z * SX8, a.w * SX8); o.y = pk4_fp8(b.x * SX8, b.y * SX8, b.z * SX8, b.w * SX8);
            *(GAS v2u*)(hrow + 16 * q) = o;
        }
    }
    ss += __shfl_xor(ss, 32);
    const float rstd = 1.0f / sqrtf(ss * (1.f / 1024.f) + EPS);
    if (kk == 0) ((float*)(ws + WS_RSTD2))[t0 + tok] = rstd;
    const float* br = F.in[I_BR];
    float lg[16];
#pragma unroll
    for (int r = 0; r < 16; ++r) lg[r] = acc[r] * rstd + br[xat::crow(r, kk)];
    float tv[4]; int ti[4];
#pragma unroll
    for (int k = 0; k < 4; ++k) { float best = lg[0]; int bi = 0;
#pragma unroll
        for (int r = 1; r < 16; ++r) { const bool gt = lg[r] > best; best = gt ? lg[r] : best; bi = gt ? r : bi; }
        tv[k] = best; ti[k] = xat::crow(bi, kk);
#pragma unroll
        for (int r = 0; r < 16; ++r) lg[r] = (r == bi) ? -INFINITY : lg[r]; }
    float cv[8]; int ci[8];
#pragma unroll
    for (int k = 0; k < 4; ++k) { cv[k] = tv[k]; ci[k] = ti[k]; cv[4 + k] = __shfl_xor(tv[k], 32); ci[4 + k] = __shfl_xor(ti[k], 32); }
    float gv[4]; int ge[4];
#pragma unroll
    for (int k = 0; k < 4; ++k) { float best = cv[0]; int be = ci[0], bj = 0;
#pragma unroll
        for (int j = 1; j < 8; ++j) { const bool gt = (cv[j] > best) || (cv[j] == best && ci[j] < be); best = gt ? cv[j] : best; be = gt ? ci[j] : be; bj = gt ? j : bj; }
        gv[k] = best; ge[k] = be;
#pragma unroll
        for (int j = 0; j < 8; ++j) cv[j] = (j == bj) ? -INFINITY : cv[j]; }
    float ex[4], es = 0.f;
#pragma unroll
    for (int k = 0; k < 4; ++k) { ex[k] = __expf(gv[k] - gv[0]); es += ex[k]; }
    const float ies = 1.0f / es;
    if (kk == 0) {
        LAS int* lcnt = (LAS int*)(lds + LX_LCNT); LAS int* stash = (LAS int*)(lds + LX_STASH); LAS float* gst = (LAS float*)(lds + LX_GATE);
#pragma unroll
        for (int k = 0; k < 4; ++k) { const int li = __hip_atomic_fetch_add(lcnt + ge[k], 1, __ATOMIC_RELAXED, __HIP_MEMORY_SCOPE_WORKGROUP);
            stash[(lt0 + tok) * 4 + k] = ge[k] | (li << 8); gst[(lt0 + tok) * 4 + k] = ex[k] * ies; }
    }
}

__device__ __forceinline__ void p7_router(Frame& F) {
    const int lane = F.lane, tid = F.tid; unsigned char* ws = F.ws; LAS unsigned char* lds = F.lds;
    {
        LAS float* scr = (LAS float*)(lds + RING_OFF + F.wave * 16384);
        const int gw = F.vcu * NWAVES + F.wave, NGW = F.G * NWAVES;
        constexpr int IE1 = 16 * 64, IE2 = 16 * 32;
        for (int it = gw; it < NEXP * (IE1 + IE2); it += NGW) {
            const int e = it / (IE1 + IE2); int r = it - e * (IE1 + IE2);
            if (r < IE1) { const int kb = r >> 6, nb = r & 63, n0 = nb * 32, src = ((n0 >> 7) & 1) * 1024 + (n0 >> 8) * 128 + (n0 & 127);
                transpose_item8(F.in[I_WEI] + (size_t)e * 1024 * 2048, 2048, src, F.in[I_GFFN], SW8, ws + WS_WEI + (size_t)e * 2048 * 1024, 1024, n0, kb * 64, scr, lane); }
            else { r -= IE1; const int kb = r >> 5, nb = r & 31;
                transpose_item8(F.in[I_WEO] + (size_t)e * 1024 * 1024, 1024, nb * 32, nullptr, SW8, ws + WS_WEO + (size_t)e * 1024 * 1024, 1024, nb * 32, kb * 64, scr, lane); }
        }
    }
    __syncthreads();
    { const float* wr = F.in[I_WR]; const float* g = F.in[I_GFFN];
      for (int i = tid; i < 8192; i += NWAVES * 64) { const f32x4 v = *(const GAS f32x4*)(wr + 4 * i); const float gg = g[i >> 3]; *(LAS f32x4*)(lds + RING_OFF + 16 * i) = v * gg; } }
    __syncthreads();
    LAS int* lcnt = (LAS int*)(lds + LX_LCNT); LAS int* lbase = (LAS int*)(lds + LX_BASE); LAS int* stash = (LAS int*)(lds + LX_STASH); LAS float* gst = (LAS float*)(lds + LX_GATE);
    for (int chunk = F.vcu; chunk < T / 256; chunk += F.G) {
        if (tid < NEXP) lcnt[tid] = 0;
        __syncthreads();
        router_tile(F, chunk * 256 + F.wave * 32, F.wave * 32);
        __syncthreads();
        if (tid < NEXP) lbase[tid] = (int)__hip_atomic_fetch_add((unsigned*)(F.ctl + CW_GCNT + 64 * tid), (unsigned)lcnt[tid], RLX_AGENT);
        __syncthreads();
        for (int idx = tid; idx < 1024; idx += NWAVES * 64) { const int st = stash[idx], e = st & 255, pos = lbase[e] + (st >> 8), ent = (chunk * 256 + (idx >> 2)) * 4 + (idx & 3);
            if (pos < LISTCAP) ((int*)(ws + WS_LIST))[(size_t)e * LISTCAP + pos] = ent;
            ((float*)(ws + WS_TOKG))[ent] = gst[idx]; }
        __syncthreads();
    }
}
__device__ __forceinline__ int moe_setup(Frame& F) {
    LAS int* tstart = (LAS int*)(F.lds + LX_TSTART); LAS int* cnt = (LAS int*)(F.lds + LX_CNT);
    if (F.tid == 0) { int acc = 0;
        for (int e = 0; e < NEXP; ++e) { int c = (int)__hip_atomic_load((unsigned*)(F.ctl + CW_GCNT + 64 * e), RLX_AGENT); c = c < LISTCAP ? c : LISTCAP; cnt[e] = c; tstart[e] = acc; acc += (c + 255) >> 8; }
        tstart[NEXP] = acc < ACT_TILES_MAX ? acc : ACT_TILES_MAX; }
    __syncthreads();
    return __builtin_amdgcn_readfirstlane(tstart[NEXP]);
}

struct Args { const float* in[N_IN]; float* out; unsigned char* ws; int ph_lo, ph_hi, li, pad; };
__global__ void __launch_bounds__(NWAVES * 64, 2) fwd_kernel(Args args) {
    extern __shared__ __attribute__((aligned(16))) unsigned char lds[];
    Frame F;
    F.lds = (LAS unsigned char*)lds;
    F.MISC = (volatile LAS unsigned*)(F.lds + MISC_OFF);
    F.tid = threadIdx.x; F.lane = F.tid & 63; F.wave = __builtin_amdgcn_readfirstlane(F.tid >> 6);
    F.G = gridDim.x; { const int bx = blockIdx.x; F.vcu = (F.G % 8 == 0) ? (bx % 8) * (F.G / 8) + bx / 8 : bx; }
    F.ws = args.ws; F.out = args.out; F.in = args.in;
    unsigned char* ws = args.ws;
    F.ctl = (gu32*)(ws + WS_CTL);
    for (int u = F.tid; u < (LDS_BYTES - LDSCTL_OFF) / 4; u += NWAVES * 64) ((LAS unsigned*)(F.lds + LDSCTL_OFF))[u] = 0u;
    __syncthreads();
    XcdBarrier bar; bar.bar = (unsigned*)(F.ctl + CW_BAR); bar.x = 0; bar.st = nullptr;
    if (N_LAUNCHES != PER_PHASE) bar = xcd_barrier_post((unsigned*)(F.ctl + CW_BAR), F.MISC + 8, F.tid == 0);
#define GRID_BAR(seam) do { if (N_LAUNCHES == PER_PHASE) { if (F.tid == 0) __hip_atomic_store(F.ctl + CW_TMO, 0xBADBA0u | (unsigned)(seam), RLX_AGENT); } else { xcd_barrier(bar, F.tid == 0); } } while (0)
    const int lo = args.ph_lo, hi = args.ph_hi;
#ifndef MK_PHASE_MASK
#define MK_PHASE_MASK 0x7ff
#endif
#define IN(k) (((MK_PHASE_MASK >> (k)) & 1) && lo <= (k) && (k) < hi)
#define BOTH(k) (IN(k) && IN((k) + 1))
    const int gw = F.vcu * NWAVES + F.wave, NGW = F.G * NWAVES;

    if (IN(0)) { REFRESH(F); for (int rep = 0; rep < MK_REP0; ++rep) p0_prologue(F); if (BOTH(0)) GRID_BAR(0); }

    if (IN(1)) { REFRESH(F);
        DenseSched S; S.init(ws + WS_HN, 1024, ws + WS_W1T, 1024, T, N1, F.G, (int)blockIdx.x);
        EpiP1 E{(bf16_t*)(ws + WS_U), (bf16_t*)(ws + WS_CQKV), (bf16_t*)(ws + WS_QX), (bf16_t*)(ws + WS_GATES)};
        for (int rep = 0; rep < MK_REP1; ++rep) pg8::gemm_phase<EpiP1, DenseSched>(F.lds + RING_OFF, F.tid, 1024, 1024, 1024, S, E);
        if (BOTH(1)) GRID_BAR(1);
    }

    if (IN(2)) { REFRESH(F);
        for (int rep = 0; rep < MK_REP2; ++rep) {
        { DenseSched S; S.init(ws + WS_CQKV, 768, ws + WS_WUQ, 384, T, 768, F.G, (int)blockIdx.x);
          EpiStore E{(bf16_t*)(ws + WS_Q), 768};
          pg8::gemm_phase<EpiStore, DenseSched>(F.lds + RING_OFF, F.tid, 384, 768, 384, S, E); }
        { DenseSched S; S.init(ws + WS_CQKV + 384 * 2, 768, ws + WS_WUKV, 256, T, 1024, F.G, (int)blockIdx.x);
          EpiStore E{(bf16_t*)(ws + WS_KV), 1024};
          pg8::gemm_phase<EpiStore, DenseSched>(F.lds + RING_OFF, F.tid, 256, 768, 256, S, E); }
        { DenseSched S; S.init(ws + WS_MEMN, 1024, ws + WS_WMEM, 1024, MROWS, 1024, F.G, (int)blockIdx.x);
          EpiMemKV E{(bf16_t*)(ws + WS_KVMK), (bf16_t*)(ws + WS_VTG)};
          pg8::gemm_phase<EpiMemKV, DenseSched>(F.lds + RING_OFF, F.tid, 1024, 1024, 1024, S, E); }
        }
        if (BOTH(2)) GRID_BAR(2);
    }

    if (IN(3)) { REFRESH(F);
        const int per = T / NGW;
        if (per * NGW == T && (per & 1) == 0) { for (int i = 0; i < per; i += 2) p3_tokens<2>(F, gw * per + i); }
        else { for (int t = gw; t < T; t += NGW) p3_tokens<1>(F, t); }
        if (BOTH(3)) GRID_BAR(3);
    }

    if (IN(4)) { for (int rep4 = 0; rep4 < MK_REP4; ++rep4) { REFRESH(F);
#ifndef NO_MLA
        for (int vv = F.vcu; vv < 256 * MK_REPMLA; vv += F.G) {
            const int bh = (vv & 255) >> 1, s = vv & 1;
            for (int i = 0; i < 8; ++i) { const int j2 = (i >> 1) * 2 + s, qb = (i & 1) ? 15 - j2 : j2;
                mla::attn_unit<8>(F.tid, bh >> 3, bh & 7, qb, (const mla::bf16*)(ws + WS_Q), (const mla::bf16*)(ws + WS_KV), (const mla::bf16*)(ws + WS_V), (mla::bf16*)(ws + WS_AO), (char*)lds + RING_OFF); }
        }
#endif
        __syncthreads();
        REFRESH(F);
#ifndef NO_XAT
        for (int vv = F.vcu; vv < 256 * MK_REPX; vv += F.G) {
            const int b = (vv & 255) >> 4, hc = (vv >> 2) & 3;
            xat::stage_kv(F, b, hc);
            __syncthreads();
            for (int i = 0; i < 4; ++i) xat::unit(F, b, hc, (vv & 3) * 4 + i);
            __syncthreads();
        }
#endif
        }
        if (BOTH(4)) GRID_BAR(4);
    }

    if (IN(5)) { REFRESH(F);
        MergeSched S; S.G = F.G; S.c = (int)blockIdx.x;
        S.A0 = (const char*)(ws + WS_MIXED); S.dA1 = (long)WS_AO - (long)WS_MIXED; S.dA2 = (long)WS_CO - (long)WS_MIXED;
        S.B0 = (const char*)(ws + WS_WPOOL); S.dB1 = (long)WS_WMO - (long)WS_WPOOL; S.dB2 = (long)WS_WCO - (long)WS_WPOOL;
        EpiMerge E{(const bf16_t*)(ws + WS_GATES), (bf16_t*)(ws + WS_MERGED)};
        for (int rep = 0; rep < MK_REP5; ++rep) pg8::gemm_phase<EpiMerge, MergeSched>(F.lds + RING_OFF, F.tid, 512, 512, 512, S, E);
        if (BOTH(5)) GRID_BAR(5);
    }

    if (IN(6)) { REFRESH(F);
        DenseSched S; S.init(ws + WS_MERGED, 1024, ws + WS_WO, 1024, T, 1024, F.G, (int)blockIdx.x);
        EpiStore E{(bf16_t*)(ws + WS_DELTA), 1024};
        for (int rep = 0; rep < MK_REP6; ++rep) pg8::gemm_phase<EpiStore, DenseSched>(F.lds + RING_OFF, F.tid, 1024, 1024, 1024, S, E);
        if (BOTH(6)) GRID_BAR(6);
    }

    if (IN(7)) { REFRESH(F); p7_router(F); if (BOTH(7)) GRID_BAR(7); }

    if (IN(8)) { REFRESH(F);
        const int ntiles = moe_setup(F);
        MoeSched S; S.G = F.G; S.c = (int)blockIdx.x; S.nM = ntiles; S.nN = 8; S.tstart = (const LAS int*)(F.lds + LX_TSTART); S.cnt = (const LAS int*)(F.lds + LX_CNT);
        S.list = (const int*)(ws + WS_LIST); S.A = (const char*)(ws + WS_HN2); S.B = (const char*)(ws + WS_WEI); S.bexp = (size_t)2048 * 1024; S.tB = (size_t)256 * 1024; S.tA = 0; S.gather = true;
        EpiMoeIn E{S.cnt, S.list, (const float*)(ws + WS_RSTD2), F.in[I_BEI], ws + WS_ACT};
        for (int rep = 0; rep < MK_REP8; ++rep) pg8::gemm_phase_f8<EpiMoeIn, MoeSched, true>(F.lds + RING_OFF, F.tid, 1024, 1024, 1024, S, E);
        if (BOTH(8)) GRID_BAR(8);
    }

    if (IN(9)) { REFRESH(F);
        const int ntiles = moe_setup(F);
        MoeSched S; S.G = F.G; S.c = (int)blockIdx.x; S.nM = ntiles; S.nN = 4; S.tstart = (const LAS int*)(F.lds + LX_TSTART); S.cnt = (const LAS int*)(F.lds + LX_CNT);
        S.list = (const int*)(ws + WS_LIST); S.A = (const char*)(ws + WS_ACT); S.B = (const char*)(ws + WS_WEO); S.bexp = (size_t)1024 * 1024; S.tB = (size_t)256 * 1024; S.tA = (size_t)256 * 1024; S.gather = false;
        EpiMoeOut E{S.cnt, S.list, (const float*)(ws + WS_TOKG), F.in[I_BEO], (bf16_t*)(ws + WS_Y)};
        pg8::gemm_phase_f8<EpiMoeOut, MoeSched, false>(F.lds + RING_OFF, F.tid, 1024, 1024, 1024, S, E);
        if (BOTH(9)) GRID_BAR(9);
    }

    if (IN(10)) { REFRESH(F);
        for (int t0 = gw; t0 < T; t0 += 2 * NGW) {
            f32x4 v[2][4]; v2u w[2][5][4];
#pragma unroll
            for (int r = 0; r < 2; ++r) { const int t = t0 + r * NGW; if (t < T) {
                const GAS f32x4* xi = (const GAS f32x4*)(F.in[I_X] + (size_t)t * 1024) + F.lane; const GAS v2u* y = (const GAS v2u*)((const bf16*)(ws + WS_Y) + (size_t)t * 4096) + F.lane;
                const GAS v2u* dl = (const GAS v2u*)((const bf16*)(ws + WS_DELTA) + (size_t)t * 1024) + F.lane;
#pragma unroll
                for (int j = 0; j < 4; ++j) { v[r][j] = xi[64 * j]; w[r][4][j] = dl[64 * j];
#pragma unroll
                    for (int s4 = 0; s4 < 4; ++s4) w[r][s4][j] = y[s4 * 256 + 64 * j]; } } }
#pragma unroll
            for (int r = 0; r < 2; ++r) { const int t = t0 + r * NGW; if (t < T) {
                GAS f32x4* o = (GAS f32x4*)(F.out + (size_t)t * 1024) + F.lane;
#pragma unroll
                for (int j = 0; j < 4; ++j) { f32x4 x = v[r][j];
#pragma unroll
                    for (int s5 = 0; s5 < 5; ++s5) { const v2u ww = w[r][s5][j]; x.x += bflo(ww.x); x.y += bfhi(ww.x); x.z += bflo(ww.y); x.w += bfhi(ww.y); }
                    o[64 * j] = x; } } }
        }
    }
#undef IN
#undef BOTH
#undef GRID_BAR
}

extern "C" void kernel_launch(void* const* d_in, const int* in_sizes, int n_in, void* d_out, int out_size, void* d_ws, size_t ws_size, hipStream_t stream) {
    static int grid = 0;
    if (grid == 0) {
        if (n_in != N_IN || in_sizes[0] != T * D || out_size != T * D || ws_size < WS_END) { fprintf(stderr, "kernel_launch: unexpected shapes (n_in %d, in0 %d, out %d, ws %zu); nothing launched\n", n_in, n_in > 0 ? in_sizes[0] : -1, out_size, ws_size); grid = -1; return; }
        int dev = 0, cus = 0, per_cu = 0;
        if (hipGetDevice(&dev) != hipSuccess || hipDeviceGetAttribute(&cus, hipDeviceAttributeMultiprocessorCount, dev) != hipSuccess) { grid = -1; return; }
        if (hipFuncSetAttribute((const void*)fwd_kernel, hipFuncAttributeMaxDynamicSharedMemorySize, LDS_BYTES) != hipSuccess) { fprintf(stderr, "kernel_launch: hipFuncSetAttribute failed\n"); grid = -1; return; }
        if (hipOccupancyMaxActiveBlocksPerMultiprocessor(&per_cu, (const void*)fwd_kernel, NWAVES * 64, LDS_BYTES) != hipSuccess || per_cu < 1)
            fprintf(stderr, "kernel_launch: note: occupancy query reports %d workgroups per CU\n", per_cu);
        (void)hipGetLastError();
        grid = cus;
    }
    if (grid < 0) return;
    if (hipMemsetAsync((char*)d_ws + WS_CTL, 0, CTL_ZERO_BYTES, stream) != hipSuccess) { fprintf(stderr, "kernel_launch: hipMemsetAsync failed\n"); return; }
    Args a{};
    for (int i = 0; i < N_IN; ++i) a.in[i] = (const float*)d_in[i];
    a.out = (float*)d_out; a.ws = (unsigned char*)d_ws;
    const int last = MK_LAST_PHASE;
    if (N_LAUNCHES == PER_PHASE) {
        for (int li = 0; li < last; ++li) { a.ph_lo = li; a.ph_hi = li + 1; a.li = li; hipLaunchKernelGGL(fwd_kernel, dim3(grid), dim3(NWAVES * 64), LDS_BYTES, stream, a); }
    } else {
        a.ph_lo = 0; a.ph_hi = last; a.li = 0; hipLaunchKernelGGL(fwd_kernel, dim3(grid), dim3(NWAVES * 64), LDS_BYTES, stream, a);
    }
    const hipError_t le = hipPeekAtLastError();
    if (le != hipSuccess) fprintf(stderr, "kernel_launch: launch failed: %s\n", hipGetErrorName(le));
}
```

```cpp
#include <hip/hip_runtime.h>
#include <hip/hip_bf16.h>
#include <cstdio>
#include <cstdint>

#ifndef MK_N_LAUNCHES
#define MK_N_LAUNCHES 1
#endif
#ifndef MK_REP1
#define MK_REP1 1
#endif
#ifndef MK_REP4
#define MK_REP4 1
#endif
#ifndef MK_REP5
#define MK_REP5 1
#endif
#ifndef MK_REP6
#define MK_REP6 1
#endif
#ifndef MK_REP8
#define MK_REP8 1
#endif
#ifndef MK_REPMLA
#define MK_REPMLA 1
#endif
#ifndef MK_REP0
#define MK_REP0 1
#endif
#ifndef MK_REP2
#define MK_REP2 1
#endif
#ifndef MK_REPX
#define MK_REPX 1
#endif
#ifndef MK_LAST_PHASE
#define MK_LAST_PHASE 11
#endif

namespace pg8 {
#define PG8_LAS __attribute__((address_space(3)))
typedef unsigned short bf16_t;
typedef short bf16x8 __attribute__((ext_vector_type(8)));
typedef float f32x4 __attribute__((ext_vector_type(4)));
typedef unsigned u32x4 __attribute__((ext_vector_type(4)));
typedef unsigned u32x2 __attribute__((ext_vector_type(2)));
constexpr int BM = 256, BK = 64, HALF = 128, HTB = HALF * BK * 2, STAGE_BYTES = 8 * HTB, NXCD = 8, WGM = 8;

__host__ __device__ __forceinline__ int lds_byte(int r, int c) { const int st = (r >> 4) * 2 + (c >> 5), rr = r & 15, cc = c & 31, ob = rr * 64 + cc * 2; return st * 1024 + (ob ^ (((ob >> 9) & 1) << 5)); }
__host__ __device__ __forceinline__ void stage_rc(int b, int& R, int& C) { const int st = b / 1024, sb = b % 1024, swz = sb ^ (((sb >> 9) & 1) << 5); R = (st >> 1) * 16 + swz / 64; C = (st & 1) * 32 + (swz % 64) / 2; }
__host__ __device__ __forceinline__ int perm32(int rho) { const int n = rho >> 4, i = rho & 15; return 8 * (i >> 2) + 4 * n + (i & 3); }

struct Unit { int pm, pn; const char* A; const char* B; int aux; };

__device__ __forceinline__ void tile_order(int L, int nM, int nN, int& pm, int& pn) {
    const int nwg = nM * nN; int wgid = L;
    { const int q = nwg / NXCD, r = nwg % NXCD, xcd = wgid % NXCD, off = wgid / NXCD; wgid = (xcd < r ? xcd * (q + 1) : r * (q + 1) + (xcd - r) * q) + off; }
    const int nig = WGM * nN, gid = wgid / nig, fm = gid * WGM, gsz = (nM - fm) < WGM ? (nM - fm) : WGM;
    pm = fm + ((wgid % nig) % gsz); pn = (wgid % nig) / gsz;
}

__device__ __forceinline__ unsigned cvt_pk_bf16(float lo, float hi) { unsigned r; asm volatile("v_cvt_pk_bf16_f32 %0, %1, %2" : "=v"(r) : "v"(lo), "v"(hi)); return r; }
__device__ __forceinline__ float bf_lo(unsigned w) { return __uint_as_float(w << 16); }
__device__ __forceinline__ float bf_hi(unsigned w) { return __uint_as_float(w & 0xffff0000u); }
__device__ __forceinline__ float sigmoidf_fast(float x) { return __builtin_amdgcn_rcpf(1.0f + __builtin_amdgcn_exp2f(-1.4426950408889634f * x)); }

template <class Epi, class Sched, bool GATHER = false, bool ALIGN_EPI = true>
__device__ __forceinline__ void gemm_phase(PG8_LAS unsigned char* lds, const int tid, const int K, const int lda, const int ldb, const Sched& S, const Epi& E) {
    const int wid = __builtin_amdgcn_readfirstlane(tid >> 6), lane = tid & 63, wr = wid >> 2, wc = wid & 3, fr = lane & 15, fq = lane >> 4;
    const int nt = K / BK;
    int RA[2], CA[2]; unsigned voffB[2];
#pragma unroll
    for (int i = 0; i < 2; ++i) { int R, C; stage_rc(tid * 16 + i * 8192, R, C); const int Rb = Epi::PERM ? ((R & ~31) + perm32(R & 31)) : R;
        RA[i] = R; CA[i] = C; voffB[i] = (unsigned)(Rb * ldb + C) * 2u; }
    const size_t kstep = (size_t)(BK * 2);
    const size_t hstepB = (size_t)HALF * ldb * 2;
    const unsigned ldsw = (unsigned)wid * 1024u;
    const int aoff = lds_byte(wr * 64 + fr, fq * 8), boff = lds_byte(wc * 32 + fr, fq * 8);
#define PG8_SA(b, h) (((b) * 2 + (h)) * HTB)
#define PG8_SB(b, h) ((4 + (b) * 2 + (h)) * HTB)
#define PG8_STAGE2(bufoff, gbase, o0, o1) do { \
        __builtin_amdgcn_global_load_lds((const unsigned*)((const char*)(gbase) + (o0)), (PG8_LAS unsigned*)(lds + (bufoff) + ldsw), 16, 0, 0); \
        __builtin_amdgcn_global_load_lds((const unsigned*)((const char*)(gbase) + (o1)), (PG8_LAS unsigned*)(lds + (bufoff) + ldsw + 8192), 16, 0, 0); } while (0)
#define PG8_STAGEB(bufoff, gbase) PG8_STAGE2(bufoff, gbase, voffB[0], voffB[1])
#define PG8_STAGEA(bufoff, gbase, OFF, h) PG8_STAGE2(bufoff, gbase, OFF[h][0], OFF[h][1])
#define PG8_LDA(dst, b, h) do { _Pragma("unroll") for (int m = 0; m < 4; ++m) _Pragma("unroll") for (int k = 0; k < 2; ++k) dst[m][k] = *(const PG8_LAS bf16x8*)(lds + PG8_SA(b, h) + aoff + m * 2048 + k * 1024); } while (0)
#define PG8_LDB(dst, b, h) do { _Pragma("unroll") for (int n = 0; n < 2; ++n) _Pragma("unroll") for (int k = 0; k < 2; ++k) dst[n][k] = *(const PG8_LAS bf16x8*)(lds + PG8_SB(b, h) + boff + n * 2048 + k * 1024); } while (0)
#define PG8_MMA(ai, bj, At, Bt) do { __builtin_amdgcn_s_setprio(1); _Pragma("unroll") for (int m = 0; m < 4; ++m) _Pragma("unroll") for (int n = 0; n < 2; ++n) _Pragma("unroll") for (int k = 0; k < 2; ++k) \
        acc[ai][bj][m][n] = __builtin_amdgcn_mfma_f32_16x16x32_bf16(Bt[n][k], At[m][k], acc[ai][bj][m][n], 0, 0, 0); __builtin_amdgcn_s_setprio(0); } while (0)
#define PG8_WAIT_V(n) asm volatile("s_waitcnt vmcnt(" #n ")" ::: "memory")
#define PG8_WAIT_L(n) asm volatile("s_waitcnt lgkmcnt(" #n ")" ::: "memory")
#define PG8_BAR __builtin_amdgcn_s_barrier()
#define PG8_SCHED __builtin_amdgcn_sched_barrier(0)
    Unit cur, nxt; int ui = 0;
    if (!S.next(0, cur)) return;
    f32x4 acc[2][2][4][2];
#pragma unroll
    for (int a = 0; a < 2; ++a)
#pragma unroll
        for (int b = 0; b < 2; ++b)
#pragma unroll
            for (int m = 0; m < 4; ++m)
#pragma unroll
                for (int n = 0; n < 2; ++n) acc[a][b][m][n] = (f32x4){0.f, 0.f, 0.f, 0.f};
    bf16x8 At[4][2], B0[2][2], B1[2][2];
    unsigned cOff[2][2], nOff[2][2];
#pragma unroll
    for (int h = 0; h < 2; ++h)
#pragma unroll
        for (int i = 0; i < 2; ++i) {
            if constexpr (GATHER) cOff[h][i] = S.row_off(cur, h * HALF + RA[i]) + (unsigned)CA[i] * 2u;
            else cOff[h][i] = (unsigned)((h * HALF + RA[i]) * lda + CA[i]) * 2u;
            nOff[h][i] = cOff[h][i];
        }
    const char* cA = cur.A; const char* cB = cur.B;
    PG8_STAGEB(PG8_SB(0, 0), cB); PG8_STAGEB(PG8_SB(0, 1), cB + hstepB); PG8_STAGEA(PG8_SA(0, 0), cA, cOff, 0); PG8_STAGEA(PG8_SA(0, 1), cA, cOff, 1);
    if (wr == 1) PG8_BAR;
    PG8_WAIT_V(2); PG8_BAR;
    PG8_STAGEB(PG8_SB(1, 0), cB + kstep); PG8_STAGEA(PG8_SA(1, 0), cA + kstep, cOff, 0); PG8_STAGEB(PG8_SB(1, 1), cB + hstepB + kstep);
    PG8_WAIT_V(6); PG8_BAR;
    for (;;) {
        const bool has_next = S.next(ui + 1, nxt);
        const char* nA = has_next ? nxt.A : cA; const char* nB = has_next ? nxt.B : cB;
        if constexpr (GATHER) {
            if (has_next) {
#pragma unroll
                for (int h = 0; h < 2; ++h)
#pragma unroll
                    for (int i = 0; i < 2; ++i) nOff[h][i] = S.row_off(nxt, h * HALF + RA[i]) + (unsigned)CA[i] * 2u;
            }
        }
        for (int t = 0; t < nt; t += 2) {
            const bool last = (t == nt - 2);
            const char* a1 = cA + (size_t)(t + 1) * kstep;
            const char* a2 = last ? nA : cA + (size_t)(t + 2) * kstep; const char* b2 = last ? nB : cB + (size_t)(t + 2) * kstep;
            const char* a3 = a2 + kstep; const char* b3 = b2 + kstep;
            unsigned o2[2][2];
#pragma unroll
            for (int h = 0; h < 2; ++h)
#pragma unroll
                for (int i = 0; i < 2; ++i) { if constexpr (GATHER) o2[h][i] = last ? nOff[h][i] : cOff[h][i]; else o2[h][i] = cOff[h][i]; }
            PG8_LDB(B0, 0, 0); PG8_LDB(B1, 0, 1); PG8_SCHED; PG8_LDA(At, 0, 0); PG8_STAGEA(PG8_SA(1, 1), a1, cOff, 1);
            PG8_WAIT_V(8); PG8_WAIT_L(0); PG8_BAR; PG8_MMA(0, 0, At, B0); PG8_MMA(0, 1, At, B1); PG8_BAR; PG8_SCHED;
            PG8_LDA(At, 0, 1); PG8_STAGEB(PG8_SB(0, 0), b2); PG8_STAGEB(PG8_SB(0, 1), b2 + hstepB); PG8_STAGEA(PG8_SA(0, 0), a2, o2, 0);
            PG8_WAIT_V(8); PG8_WAIT_L(0); PG8_BAR; PG8_MMA(1, 0, At, B0); PG8_MMA(1, 1, At, B1); PG8_BAR; PG8_SCHED;
            PG8_LDB(B0, 1, 0); PG8_LDB(B1, 1, 1); PG8_SCHED; PG8_LDA(At, 1, 0); PG8_STAGEA(PG8_SA(0, 1), a2, o2, 1);
            PG8_WAIT_V(8); PG8_WAIT_L(0); PG8_BAR; PG8_MMA(0, 0, At, B0); PG8_MMA(0, 1, At, B1); PG8_BAR; PG8_SCHED;
            PG8_LDA(At, 1, 1); PG8_STAGEB(PG8_SB(1, 0), b3); PG8_STAGEB(PG8_SB(1, 1), b3 + hstepB); PG8_STAGEA(PG8_SA(1, 0), a3, o2, 0);
            PG8_WAIT_V(8); PG8_WAIT_L(0); PG8_BAR; PG8_MMA(1, 0, At, B0); PG8_MMA(1, 1, At, B1); PG8_BAR; PG8_SCHED;
        }
        if constexpr (ALIGN_EPI) { if (wr == 0) PG8_BAR; }
        bool keep = false;
        if constexpr (Epi::ACCUM) keep = E.merge(acc, cur, wr, wc, fr, fq); else E(acc, cur, wr, wc, fr, fq);
        if (!has_next) break;
        if (!keep) {
#pragma unroll
        for (int a = 0; a < 2; ++a)
#pragma unroll
            for (int b = 0; b < 2; ++b)
#pragma unroll
                for (int m = 0; m < 4; ++m)
#pragma unroll
                    for (int n = 0; n < 2; ++n) acc[a][b][m][n] = (f32x4){0.f, 0.f, 0.f, 0.f};
        }
        cur = nxt; cA = nA; cB = nB; ++ui;
        if constexpr (GATHER) {
#pragma unroll
            for (int h = 0; h < 2; ++h)
#pragma unroll
                for (int i = 0; i < 2; ++i) cOff[h][i] = nOff[h][i];
        }
        if constexpr (ALIGN_EPI) { if (wr == 1) PG8_BAR; }
    }
    PG8_WAIT_V(0);
    if constexpr (!ALIGN_EPI) { if (wr == 0) PG8_BAR; }
    PG8_BAR;
#undef PG8_SA
#undef PG8_SB
#undef PG8_STAGE2
#undef PG8_STAGEA
#undef PG8_STAGEB
#undef PG8_LDA
#undef PG8_LDB
#undef PG8_MMA
#undef PG8_WAIT_V
#undef PG8_WAIT_L
#undef PG8_BAR
#undef PG8_SCHED
}
__host__ __device__ __forceinline__ int lds_byte8(int r, int ch) { const int fr = r & 15; return (r >> 4) * 2048 + (ch >> 2) * 1024 + ((fr * 64 + (ch & 3) * 16) ^ (((fr >> 2) & 1) << 4)); }
__host__ __device__ __forceinline__ void stage_rc8(int b, int& R, int& CH) { const int blk = b >> 11, h2 = (b >> 10) & 1, w = b & 1023, fr = w >> 6; R = blk * 16 + fr; CH = h2 * 4 + (((w ^ (((fr >> 2) & 1) << 4)) >> 4) & 3); }
typedef int v8i __attribute__((ext_vector_type(8)));
typedef int v4i __attribute__((ext_vector_type(4)));
template <class Epi, class Sched, bool GATHER = false, bool ALIGN_EPI = true>
__device__ __forceinline__ void gemm_phase_f8(PG8_LAS unsigned char* lds, const int tid, const int K, const int lda, const int ldb, const Sched& S, const Epi& E) {
    const int wid = __builtin_amdgcn_readfirstlane(tid >> 6), lane = tid & 63, wr = wid >> 2, wc = wid & 3, fr = lane & 15, fq = lane >> 4;
    const int nt = K / 128;
    int RA[2], CA[2]; unsigned voffB[2];
#pragma unroll
    for (int i = 0; i < 2; ++i) { int R, C; stage_rc8(tid * 16 + i * 8192, R, C); const int Rb = Epi::PERM ? ((R & ~31) + perm32(R & 31)) : R;
        RA[i] = R; CA[i] = C * 8; voffB[i] = (unsigned)(Rb * ldb + C * 16); }
    const size_t kstep = (size_t)(BK * 2);
    const size_t hstepB = (size_t)HALF * ldb;
    const unsigned ldsw = (unsigned)wid * 1024u;
    const int aoff0 = lds_byte8(wr * 64 + fr, 2 * fq), aoff1 = lds_byte8(wr * 64 + fr, 2 * fq + 1), boff0 = lds_byte8(wc * 32 + fr, 2 * fq), boff1 = lds_byte8(wc * 32 + fr, 2 * fq + 1);
#define PG8_SA(b, h) (((b) * 2 + (h)) * HTB)
#define PG8_SB(b, h) ((4 + (b) * 2 + (h)) * HTB)
#define PG8_STAGE2(bufoff, gbase, o0, o1) do { \
        __builtin_amdgcn_global_load_lds((const unsigned*)((const char*)(gbase) + (o0)), (PG8_LAS unsigned*)(lds + (bufoff) + ldsw), 16, 0, 0); \
        __builtin_amdgcn_global_load_lds((const unsigned*)((const char*)(gbase) + (o1)), (PG8_LAS unsigned*)(lds + (bufoff) + ldsw + 8192), 16, 0, 0); } while (0)
#define PG8_STAGEB(bufoff, gbase) PG8_STAGE2(bufoff, gbase, voffB[0], voffB[1])
#define PG8_STAGEA(bufoff, gbase, OFF, h) PG8_STAGE2(bufoff, gbase, OFF[h][0], OFF[h][1])
#define PG8_LDA(dst, b, h) do { _Pragma("unroll") for (int m = 0; m < 4; ++m) { dst[m][0] = *(const PG8_LAS v4i*)(lds + PG8_SA(b, h) + aoff0 + m * 2048); dst[m][1] = *(const PG8_LAS v4i*)(lds + PG8_SA(b, h) + aoff1 + m * 2048); } } while (0)
#define PG8_LDB(dst, b, h) do { _Pragma("unroll") for (int n = 0; n < 2; ++n) { dst[n][0] = *(const PG8_LAS v4i*)(lds + PG8_SB(b, h) + boff0 + n * 2048); dst[n][1] = *(const PG8_LAS v4i*)(lds + PG8_SB(b, h) + boff1 + n * 2048); } } while (0)
#define PG8_V8(x) __builtin_shufflevector(x[0], x[1], 0, 1, 2, 3, 4, 5, 6, 7)
#define PG8_MMA(ai, bj, At, Bt) do { __builtin_amdgcn_s_setprio(1); _Pragma("unroll") for (int m = 0; m < 4; ++m) _Pragma("unroll") for (int n = 0; n < 2; ++n) \
        asm volatile("v_mfma_scale_f32_16x16x128_f8f6f4 %0, %1, %2, %0, %3, %3 op_sel_hi:[0,0,0]" : "+v"(acc[ai][bj][m][n]) : "v"(PG8_V8(Bt[n])), "v"(PG8_V8(At[m])), "v"(sc1)); __builtin_amdgcn_s_setprio(0); } while (0)
#define PG8_WAIT_V(n) asm volatile("s_waitcnt vmcnt(" #n ")" ::: "memory")
#define PG8_WAIT_L(n) asm volatile("s_waitcnt lgkmcnt(" #n ")" ::: "memory")
#define PG8_BAR __builtin_amdgcn_s_barrier()
#define PG8_SCHED __builtin_amdgcn_sched_barrier(0)
    int sc1 = 0x7f7f7f7f; asm volatile("" : "+v"(sc1));
    Unit cur, nxt; int ui = 0;
    if (!S.next(0, cur)) return;
    f32x4 acc[2][2][4][2];
#pragma unroll
    for (int a = 0; a < 2; ++a)
#pragma unroll
        for (int b = 0; b < 2; ++b)
#pragma unroll
            for (int m = 0; m < 4; ++m)
#pragma unroll
                for (int n = 0; n < 2; ++n) acc[a][b][m][n] = (f32x4){0.f, 0.f, 0.f, 0.f};
    v4i At[4][2], B0[2][2], B1[2][2];
    unsigned cOff[2][2], nOff[2][2];
#pragma unroll
    for (int h = 0; h < 2; ++h)
#pragma unroll
        for (int i = 0; i < 2; ++i) {
            if constexpr (GATHER) cOff[h][i] = S.row_off(cur, h * HALF + RA[i]) + (unsigned)CA[i] * 2u;
            else cOff[h][i] = (unsigned)((h * HALF + RA[i]) * lda) + (unsigned)CA[i] * 2u;
            nOff[h][i] = cOff[h][i];
        }
    const char* cA = cur.A; const char* cB = cur.B;
    PG8_STAGEB(PG8_SB(0, 0), cB); PG8_STAGEB(PG8_SB(0, 1), cB + hstepB); PG8_STAGEA(PG8_SA(0, 0), cA, cOff, 0); PG8_STAGEA(PG8_SA(0, 1), cA, cOff, 1);
    if (wr == 1) PG8_BAR;
    PG8_WAIT_V(2); PG8_BAR;
    PG8_STAGEB(PG8_SB(1, 0), cB + kstep); PG8_STAGEA(PG8_SA(1, 0), cA + kstep, cOff, 0); PG8_STAGEB(PG8_SB(1, 1), cB + hstepB + kstep);
    PG8_WAIT_V(6); PG8_BAR;
    for (;;) {
        const bool has_next = S.next(ui + 1, nxt);
        const char* nA = has_next ? nxt.A : cA; const char* nB = has_next ? nxt.B : cB;
        if constexpr (GATHER) {
            if (has_next) {
#pragma unroll
                for (int h = 0; h < 2; ++h)
#pragma unroll
                    for (int i = 0; i < 2; ++i) nOff[h][i] = S.row_off(nxt, h * HALF + RA[i]) + (unsigned)CA[i] * 2u;
            }
        }
#pragma clang loop unroll(disable)
        for (int t = 0; t < nt; t += 2) {
            const bool last = (t == nt - 2);
            const char* a1 = cA + (size_t)(t + 1) * kstep;
            const char* a2 = last ? nA : cA + (size_t)(t + 2) * kstep; const char* b2 = last ? nB : cB + (size_t)(t + 2) * kstep;
            const char* a3 = a2 + kstep; const char* b3 = b2 + kstep;
            unsigned o2[2][2];
#pragma unroll
            for (int h = 0; h < 2; ++h)
#pragma unroll
                for (int i = 0; i < 2; ++i) { if constexpr (GATHER) o2[h][i] = last ? nOff[h][i] : cOff[h][i]; else o2[h][i] = cOff[h][i]; }
            PG8_LDB(B0, 0, 0); PG8_LDB(B1, 0, 1); PG8_SCHED; PG8_LDA(At, 0, 0); PG8_STAGEA(PG8_SA(1, 1), a1, cOff, 1);
            PG8_WAIT_V(8); PG8_WAIT_L(0); PG8_BAR; PG8_MMA(0, 0, At, B0); PG8_MMA(0, 1, At, B1); PG8_BAR; PG8_SCHED;
            PG8_LDA(At, 0, 1); PG8_STAGEB(PG8_SB(0, 0), b2); PG8_STAGEB(PG8_SB(0, 1), b2 + hstepB); PG8_STAGEA(PG8_SA(0, 0), a2, o2, 0);
            PG8_WAIT_V(8); PG8_WAIT_L(0); PG8_BAR; PG8_MMA(1, 0, At, B0); PG8_MMA(1, 1, At, B1); PG8_BAR; PG8_SCHED;
            PG8_LDB(B0, 1, 0); PG8_LDB(B1, 1, 1); PG8_SCHED; PG8_LDA(At, 1, 0); PG8_STAGEA(PG8_SA(0, 1), a2, o2, 1);
            PG8_WAIT_V(8); PG8_WAIT_L(0); PG8_BAR; PG8_MMA(0, 0, At, B0); PG8_MMA(0, 1, At, B1); PG8_BAR; PG8_SCHED;
            PG8_LDA(At, 1, 1); PG8_STAGEB(PG8_SB(1, 0), b3); PG8_STAGEB(PG8_SB(1, 1), b3 + hstepB); PG8_STAGEA(PG8_SA(1, 0), a3, o2, 0);
            PG8_WAIT_V(8); PG8_WAIT_L(0); PG8_BAR; PG8_MMA(1, 0, At, B0); PG8_MMA(1, 1, At, B1); PG8_BAR; PG8_SCHED;
        }
        asm volatile("s_nop 15\n\ts_nop 7" ::: "memory");
        if constexpr (ALIGN_EPI) { if (wr == 0) PG8_BAR; }
        E(acc, cur, wr, wc, fr, fq);
        if (!has_next) break;
#pragma unroll
        for (int a = 0; a < 2; ++a)
#pragma unroll
            for (int b = 0; b < 2; ++b)
#pragma unroll
                for (int m = 0; m < 4; ++m)
#pragma unroll
                    for (int n = 0; n < 2; ++n) acc[a][b][m][n] = (f32x4){0.f, 0.f, 0.f, 0.f};
        cur = nxt; cA = nA; cB = nB; ++ui;
        if constexpr (GATHER) {
#pragma unroll
            for (int h = 0; h < 2; ++h)
#pragma unroll
                for (int i = 0; i < 2; ++i) cOff[h][i] = nOff[h][i];
        }
        if constexpr (ALIGN_EPI) { if (wr == 1) PG8_BAR; }
    }
    PG8_WAIT_V(0);
    if constexpr (!ALIGN_EPI) { if (wr == 0) PG8_BAR; }
    PG8_BAR;
#undef PG8_SA
#undef PG8_SB
#undef PG8_STAGE2
#undef PG8_STAGEA
#undef PG8_STAGEB
#undef PG8_LDA
#undef PG8_LDB
#undef PG8_MMA
#undef PG8_V8
#undef PG8_WAIT_V
#undef PG8_WAIT_L
#undef PG8_BAR
#undef PG8_SCHED
}
}

namespace mla {
using bf16=__hip_bfloat16;
using bf16x8=__attribute__((ext_vector_type(8)))short;
using s16x4=__attribute__((ext_vector_type(4)))short;
using f32x16=__attribute__((ext_vector_type(16)))float;
using u32x4=__attribute__((ext_vector_type(4)))unsigned;
constexpr int SEQ=4096,DQK=96,DV=64,NHEAD=8;
constexpr int QP=768,KP=1024,VP=512,OP=512;
constexpr int NW=8,QBLK=32,QB=QBLK*NW,KVBLK=64,NQB=SEQ/QB;
__device__ __forceinline__ int crow(int r,int hi){return (r&3)+8*(r>>2)+4*hi;}
#define SBAR() __builtin_amdgcn_sched_barrier(0)
__device__ __forceinline__ void cmask(f32x16&p0,f32x16&p1,int jb,int qrel,int hi){
  const float NEG=-INFINITY; int kb=64*jb+4*hi;
  #pragma unroll
  for(int r=0;r<16;++r){int kv=kb+(r&3)+8*(r>>2); if(kv>qrel)p0[r]=NEG; if(kv+32>qrel)p1[r]=NEG;}
}
constexpr int NSLOT=3, KSLOT=12288, VSLOT=8192;
constexpr int LDS_K=0, LDS_V=NSLOT*KSLOT, LDS_WS=LDS_V+NSLOT*VSLOT, LDS_OST=LDS_WS+NW*64*4, LDS_BYTES=LDS_OST+NW*4096;
__device__ __forceinline__ void glds16(const char*sbase,unsigned voff,unsigned lds_dst){unsigned keep;
  asm volatile("s_mov_b32 %0, m0\n\ts_mov_b32 m0, %2\n\ts_nop 0\n\tglobal_load_lds_dwordx4 %1, %3\n\ts_mov_b32 m0, %0":"=&s"(keep):"v"(voff),"s"(lds_dst),"s"(sbase):"memory");}
__device__ __forceinline__ const char* uni_ptr(const void*p){ const unsigned long long v=(unsigned long long)(uintptr_t)p; const unsigned lo=__builtin_amdgcn_readfirstlane((unsigned)v),hi=__builtin_amdgcn_readfirstlane((unsigned)(v>>32)); return (const char*)(uintptr_t)(((unsigned long long)hi<<32)|lo); }
__device__ __forceinline__ float max3f(float a,float b,float c){float r;asm("v_max3_f32 %0, %1, %2, %3":"=v"(r):"v"(a),"v"(b),"v"(c));return r;}
__device__ __forceinline__ float max2f(float a,float b){float r;asm("v_max_f32_e32 %0, %1, %2":"=v"(r):"v"(a),"v"(b));return r;}
__device__ __forceinline__ float fadd_s(float a,float b){float r;asm("v_add_f32_e32 %0, %1, %2":"=v"(r):"v"(a),"v"(b));return r;}
__device__ __forceinline__ float fsub_s(float a,float b){float r;asm("v_sub_f32_e32 %0, %1, %2":"=v"(r):"v"(a),"v"(b));return r;}
typedef float f32x2_t __attribute__((ext_vector_type(2))); typedef __bf16 bf16x2_t __attribute__((ext_vector_type(2)));
__device__ __forceinline__ unsigned cvtpk_s(float lo,float hi){f32x2_t v={lo,hi};bf16x2_t b=__builtin_convertvector(v,bf16x2_t);return __builtin_bit_cast(unsigned,b);}
#define WAIT_BAR(N) asm volatile("s_waitcnt vmcnt(" #N ") lgkmcnt(0)\n\ts_barrier":::"memory")

__device__ __forceinline__ void qkt(f32x16&p0,f32x16&p1,const char*Kslot,const bf16x8*qr,int r32,int hi){
  const f32x16 negm=f32x16{};
  const char*kb=Kslot+hi*1024+r32*16;
  #pragma unroll
  for(int d0=0;d0<6;++d0){
    const bf16x8 b0=*reinterpret_cast<const bf16x8*>(kb+d0*2048);
    const bf16x8 b1=*reinterpret_cast<const bf16x8*>(kb+d0*2048+512);
    if(d0==0){p0=__builtin_amdgcn_mfma_f32_32x32x16_bf16(b0,qr[0],negm,0,0,0);p1=__builtin_amdgcn_mfma_f32_32x32x16_bf16(b1,qr[0],negm,0,0,0);}
    else{p0=__builtin_amdgcn_mfma_f32_32x32x16_bf16(b0,qr[d0],p0,0,0,0);p1=__builtin_amdgcn_mfma_f32_32x32x16_bf16(b1,qr[d0],p1,0,0,0);}}
}
typedef __attribute__((address_space(3))) const char* lds_cptr;
typedef short v4i16_t __attribute__((ext_vector_type(4)));
__device__ __forceinline__ void kload12(bf16x8*kf,lds_cptr kp){
  #pragma unroll
  for(int j=0;j<6;++j){ kf[2*j]=*(const __attribute__((address_space(3))) bf16x8*)(kp+j*2048); kf[2*j+1]=*(const __attribute__((address_space(3))) bf16x8*)(kp+j*2048+512); }
}
__device__ __forceinline__ void kload2(bf16x8*kf,lds_cptr kp,int j){ kf[2*j]=*(const __attribute__((address_space(3))) bf16x8*)(kp+j*2048); kf[2*j+1]=*(const __attribute__((address_space(3))) bf16x8*)(kp+j*2048+512); }
__device__ __forceinline__ s16x4 vtr(lds_cptr p){ return __builtin_bit_cast(s16x4,__builtin_amdgcn_ds_read_tr16_b64_v4i16((__attribute__((address_space(3))) v4i16_t*)p)); }
__device__ __forceinline__ float rowmax(const f32x16&p0,const f32x16&p1){
  float a=max3f(p0[0],p0[1],p1[0]),b=max3f(p0[2],p0[3],p1[1]);a=max3f(a,p1[2],p1[3]);
  #pragma unroll
  for(int r=4;r<16;r+=4){a=max3f(a,p0[r],p0[r+1]);b=max3f(b,p0[r+2],p0[r+3]);a=max3f(a,p1[r],p1[r+1]);b=max3f(b,p1[r+2],p1[r+3]);}
  const float m=max2f(a,b);
  auto rr=__builtin_amdgcn_permlane32_swap(__float_as_uint(m),__float_as_uint(m),false,false);
  return max2f(__uint_as_float(rr[0]),__uint_as_float(rr[1]));
}
__device__ __forceinline__ void pv(f32x16*o,int vb,bf16x8 pa0,bf16x8 pa1,bf16x8 pa2,bf16x8 pa3){
  #pragma unroll
  for(int d0=0;d0<2;++d0){s16x4 lo[4],hi[4];
    #pragma unroll
    for(int ks=0;ks<4;++ks){
      asm volatile("ds_read_b64_tr_b16 %0,%1 offset:%c2":"=&v"(lo[ks]):"v"(vb),"i"(d0*4096+ks*1024):"memory");
      asm volatile("ds_read_b64_tr_b16 %0,%1 offset:%c2":"=&v"(hi[ks]):"v"(vb),"i"(d0*4096+ks*1024+512):"memory");}
    asm volatile("s_waitcnt lgkmcnt(0)":::"memory");SBAR();
    #define PK(k) (bf16x8){lo[k][0],lo[k][1],lo[k][2],lo[k][3],hi[k][0],hi[k][1],hi[k][2],hi[k][3]}
    o[d0]=__builtin_amdgcn_mfma_f32_32x32x16_bf16(pa0,PK(0),o[d0],0,0,0);
    o[d0]=__builtin_amdgcn_mfma_f32_32x32x16_bf16(pa1,PK(1),o[d0],0,0,0);
    o[d0]=__builtin_amdgcn_mfma_f32_32x32x16_bf16(pa2,PK(2),o[d0],0,0,0);
    o[d0]=__builtin_amdgcn_mfma_f32_32x32x16_bf16(pa3,PK(3),o[d0],0,0,0);
    #undef PK
  }
}

template<int THRL> __device__ __forceinline__ void attn_unit(const int tid,int b,int h,int qb,const bf16*Q,const bf16*__restrict__ K,const bf16*__restrict__ V,bf16*O,char*shm){
  const int lane=tid&63,r32=lane&31,hi=lane>>5; const int wid=__builtin_amdgcn_readfirstlane(tid>>6);
  const long rowbase=(long)b*SEQ; const int q0=qb*QB;
  const bf16*Qw=Q+(rowbase+q0+wid*QBLK)*QP+h*DQK;
  const bf16*Kh=K+rowbase*KP+h*DQK,*Vh=V+rowbase*VP+h*DV;
  const unsigned lds0=(unsigned)(uintptr_t)shm;
  float*wsf=(float*)(shm+LDS_WS)+wid*64;
  const char*Kb=uni_ptr(Kh); const char*Vb=uni_ptr(Vh);
  const unsigned koffA=(unsigned)(lane*KP+wid*8)*2u, koffB=(unsigned)(lane*KP+(8+(wid&3))*8)*2u;
  const unsigned voffV=(unsigned)((16*(wid&3)+(lane>>2))*VP+(wid>>2)*32+(lane&3)*8)*2u;
  const unsigned kdstA=lds0+LDS_K+wid*1024, kdstB=lds0+LDS_K+(8+(wid&3))*1024, vdst=lds0+LDS_V+wid*1024;
  #define KOF(s) ((s)+((s)>>1))
  #define DMA_K(t,slot) do{ const char*kt_=Kb+(size_t)(t)*(KVBLK*KP*2); glds16(kt_,koffA,(unsigned)__builtin_amdgcn_readfirstlane(kdstA+KOF(slot))); glds16(kt_,koffB,(unsigned)__builtin_amdgcn_readfirstlane(kdstB+KOF(slot))); }while(0)
  #define DMA_V(t,slot) glds16(Vb+(size_t)(t)*(KVBLK*VP*2),voffV,(unsigned)__builtin_amdgcn_readfirstlane(vdst+(slot)))
  const int vb0=(int)(lds0+LDS_V)+((lane>>4)&1)*32+(lane&3)*8+(4*hi+((lane&15)>>2))*64;
  const char*Kbase=shm+LDS_K; bf16x8 kf[12];
  const lds_cptr shm3=(lds_cptr)shm; const lds_cptr kp0=shm3+LDS_K+hi*1024+r32*16; const lds_cptr vp0=shm3+LDS_V+((lane>>4)&1)*32+(lane&3)*8+(4*hi+((lane&15)>>2))*64;
  const int NT=(q0+QB)/KVBLK;
  DMA_K(0,0);DMA_V(0,0);DMA_K(1,VSLOT);
  bf16x8 qr[6];
  { int lq=lane; asm volatile("":"+v"(lq));
    const bf16*qp=Qw+(long)(lq&31)*QP+(lq>>5)*8;
    _Pragma("unroll") for(int d0=0;d0<6;++d0)qr[d0]=*reinterpret_cast<const bf16x8*>(qp+d0*16); }
  float mhat=0.f,l_reg=0.f;f32x16 o[2];o[0]=f32x16{};o[1]=f32x16{};
  const int qrel=wid*QBLK+r32;
  #define CMASK(P0,P1,t) do{int jb_=(t)-(NT-4); if(jb_>=0)cmask(P0,P1,jb_,qrel,hi);}while(0)
  bool resc=false;
  #define START(P0,P1) do{ const float rm=rowmax(P0,P1); resc=false; \
    { const float dl=rm; mhat=fadd_s(mhat,dl); \
      _Pragma("unroll") for(int r=0;r<16;++r){P0[r]=fsub_s(P0[r],dl);P1[r]=fsub_s(P1[r],dl);} } \
    _Pragma("unroll") for(int r=0;r<16;++r)P0[r]=__builtin_amdgcn_exp2f(P0[r]); }while(0)
  #define RESC() do{ if(resc){ asm volatile("s_waitcnt lgkmcnt(0)":::"memory"); \
      _Pragma("unroll") for(int d_=0;d_<2;++d_) _Pragma("unroll") for(int r=0;r<16;++r)o[d_][r]*=wsf[crow(r,hi)]; } }while(0)
  f32x16 pA0,pA1,pB0,pB1;
  int sl_prev=0,sl_cur=0,sl_next=VSLOT;
  #define ROT() do{sl_prev=sl_cur;sl_cur=sl_next;sl_next=(sl_next==(NSLOT-1)*VSLOT)?0:sl_next+VSLOT;}while(0)
  DMA_K(2,2*VSLOT);
  WAIT_BAR(5);
  qkt(pA0,pA1,Kbase,qr,r32,hi);asm volatile("s_nop 15\n\ts_nop 7":"+v"(pA0),"+v"(pA1));CMASK(pA0,pA1,0);
  START(pA0,pA1);
  _Pragma("unroll") for(int r=0;r<16;++r)pA1[r]=__builtin_amdgcn_exp2f(pA1[r]);
  WAIT_BAR(0);
  DMA_K(3,0);DMA_V(1,VSLOT);
  ROT();
  kload12(kf,kp0+KOF(sl_cur));
  WAIT_BAR(3);
  s16x4 vlo[8],vhi[8]; u32x4 pw0,pw1,pw2,pw3;
  #define PKW(P,B) cvtpk_s(P[B],P[B+1])
  #define PAF(k) __builtin_bit_cast(bf16x8,pw##k)
  #define VFR(i) (bf16x8){vlo[i][0],vlo[i][1],vlo[i][2],vlo[i][3],vhi[i][0],vhi[i][1],vhi[i][2],vhi[i][3]}
  #define PIN(x) asm volatile("":"+v"(x))
  #define MX3(a,b,c) __builtin_fmaxf(__builtin_fmaxf((a),(b)),(c))
  #define GAPA(MF,A0,A1,A2,A3,W0,W1,PW) do{ MF; sacc+=A0; sacc+=A1; sacc+=A2; sacc+=A3; PIN(sacc); W0; W1; PIN(PW); SBAR(); }while(0)
  #define EX(v) __builtin_amdgcn_exp2f(v)
  #define GAPB(MF,X,B) do{ MF; X[B]=EX(X[B]); X[B+1]=EX(X[B+1]); X[B+2]=EX(X[B+2]); X[B+3]=EX(X[B+3]); PIN(X); SBAR(); }while(0)
  #define VRD(i) do{ vlo[i]=vtr(vp_+(((i)>>2)*4096+((i)&3)*1024)); vhi[i]=vtr(vp_+(((i)>>2)*4096+((i)&3)*1024+512)); }while(0)
  #define KRD(G,j) do{ if(G){ kload2(kf,kp0+KOF(sl_next),j); SBAR(); } }while(0)
  const f32x16 zero16=f32x16{};
  #define STEP(C0,C1,P0,P1,t,GK,GV,GL) do{ SBAR(); \
    const lds_cptr vp_=vp0+sl_prev; \
    float sacc=(P0[0]+P0[1]); \
    GAPA(C0=__builtin_amdgcn_mfma_f32_32x32x16_bf16(kf[0],qr[0],zero16,0,0,0), P0[2],P0[3],P0[4],P0[5],     pw0[0]=PKW(P0,0), pw0[1]=PKW(P0,2), pw0); \
    GAPA(C1=__builtin_amdgcn_mfma_f32_32x32x16_bf16(kf[1],qr[0],zero16,0,0,0), P0[6],P0[7],P0[8],P0[9],     pw0[2]=PKW(P0,4), pw0[3]=PKW(P0,6), pw0); \
    GAPA(C0=__builtin_amdgcn_mfma_f32_32x32x16_bf16(kf[2],qr[1],C0,0,0,0),   P0[10],P0[11],P0[12],P0[13], pw1[0]=PKW(P0,8), pw1[1]=PKW(P0,10), pw1); \
    GAPA(C1=__builtin_amdgcn_mfma_f32_32x32x16_bf16(kf[3],qr[1],C1,0,0,0),   P0[14],P0[15],P1[0],P1[1],   pw1[2]=PKW(P0,12),pw1[3]=PKW(P0,14), pw1); \
    GAPA(C0=__builtin_amdgcn_mfma_f32_32x32x16_bf16(kf[4],qr[2],C0,0,0,0),   P1[2],P1[3],P1[4],P1[5],     pw2[0]=PKW(P1,0), pw2[1]=PKW(P1,2), pw2); \
    GAPA(C1=__builtin_amdgcn_mfma_f32_32x32x16_bf16(kf[5],qr[2],C1,0,0,0),   P1[6],P1[7],P1[8],P1[9],     pw2[2]=PKW(P1,4), pw2[3]=PKW(P1,6), pw2); \
    GAPA(C0=__builtin_amdgcn_mfma_f32_32x32x16_bf16(kf[6],qr[3],C0,0,0,0),   P1[10],P1[11],P1[12],P1[13], pw3[0]=PKW(P1,8), pw3[1]=PKW(P1,10), pw3); \
    GAPA(C1=__builtin_amdgcn_mfma_f32_32x32x16_bf16(kf[7],qr[3],C1,0,0,0),   P1[14],P1[15],0.f,0.f,       pw3[2]=PKW(P1,12),pw3[3]=PKW(P1,14), pw3); \
    C0=__builtin_amdgcn_mfma_f32_32x32x16_bf16(kf[8],qr[4],C0,0,0,0); C1=__builtin_amdgcn_mfma_f32_32x32x16_bf16(kf[9],qr[4],C1,0,0,0); VRD(0); SBAR(); \
    C0=__builtin_amdgcn_mfma_f32_32x32x16_bf16(kf[10],qr[5],C0,0,0,0); C1=__builtin_amdgcn_mfma_f32_32x32x16_bf16(kf[11],qr[5],C1,0,0,0); VRD(4); SBAR(); \
    l_reg+=sacc; \
    _Pragma("unroll") for(int r=0;r<16;++r){C0[r]-=mhat;C1[r]-=mhat;} \
    if(GK){DMA_K((t)+3,sl_cur);} if(GV){DMA_V((t)+1,sl_next);} \
    CMASK(C0,C1,t); \
    { float a=MX3(C0[0],C0[1],C1[0]),b=MX3(C0[2],C0[3],C1[1]); a=MX3(a,C1[2],C1[3]); \
      _Pragma("unroll") for(int r=4;r<16;r+=4){a=MX3(a,C0[r],C0[r+1]);b=MX3(b,C0[r+2],C0[r+3]);a=MX3(a,C1[r],C1[r+1]);b=MX3(b,C1[r+2],C1[r+3]);} \
      float rm=__builtin_fmaxf(a,b); { auto rr=__builtin_amdgcn_permlane32_swap(__float_as_uint(rm),__float_as_uint(rm),false,false); rm=__builtin_fmaxf(__uint_as_float(rr[0]),__uint_as_float(rr[1])); } \
      resc=false; \
      if(__builtin_expect(__any(rm>(float)THRL),0)){ const float dl=__builtin_fmaxf(rm,0.f); mhat+=dl; \
        _Pragma("unroll") for(int r=0;r<16;++r){C0[r]-=dl;C1[r]-=dl;} \
        const float f=__builtin_amdgcn_exp2f(-dl); l_reg*=f; if(hi==0)wsf[r32]=f; resc=true; } } \
    SBAR(); \
    VRD(1); SBAR(); GAPB(o[0]=__builtin_amdgcn_mfma_f32_32x32x16_bf16(PAF(0),VFR(0),o[0],0,0,0), C0,0); \
    VRD(5); KRD(GL,0); GAPB(o[1]=__builtin_amdgcn_mfma_f32_32x32x16_bf16(PAF(0),VFR(4),o[1],0,0,0), C0,4); \
    VRD(2); KRD(GL,1); GAPB(o[0]=__builtin_amdgcn_mfma_f32_32x32x16_bf16(PAF(1),VFR(1),o[0],0,0,0), C0,8); \
    VRD(6); KRD(GL,2); GAPB(o[1]=__builtin_amdgcn_mfma_f32_32x32x16_bf16(PAF(1),VFR(5),o[1],0,0,0), C0,12); \
    VRD(3); KRD(GL,3); GAPB(o[0]=__builtin_amdgcn_mfma_f32_32x32x16_bf16(PAF(2),VFR(2),o[0],0,0,0), C1,0); \
    VRD(7); KRD(GL,4); GAPB(o[1]=__builtin_amdgcn_mfma_f32_32x32x16_bf16(PAF(2),VFR(6),o[1],0,0,0), C1,4); \
    KRD(GL,5); GAPB(o[0]=__builtin_amdgcn_mfma_f32_32x32x16_bf16(PAF(3),VFR(3),o[0],0,0,0), C1,8); \
    GAPB(o[1]=__builtin_amdgcn_mfma_f32_32x32x16_bf16(PAF(3),VFR(7),o[1],0,0,0), C1,12); \
    }while(0)
  int t=1;
  #undef CMASK
  #define CMASK(P0,P1,t) do{}while(0)
  for(;t+5<NT;t+=2){
    STEP(pB0,pB1,pA0,pA1,t,true,true,true);     WAIT_BAR(3); RESC(); ROT();
    STEP(pA0,pA1,pB0,pB1,t+1,true,true,true);   WAIT_BAR(3); RESC(); ROT();
  }
  #undef CMASK
  #define CMASK(P0,P1,t) do{int jb_=(t)-(NT-4); if(jb_>=0)cmask(P0,P1,jb_,qrel,hi);}while(0)
  #define ENDW(tt) do{ if((tt)+3<NT){WAIT_BAR(3);} else if((tt)+2<NT){WAIT_BAR(1);} else {WAIT_BAR(0);} }while(0)
  for(;t+1<NT;t+=2){
    STEP(pB0,pB1,pA0,pA1,t,(t+3<NT),(t+1<NT),(t+1<NT));       ENDW(t);   RESC(); ROT();
    STEP(pA0,pA1,pB0,pB1,t+1,(t+4<NT),(t+2<NT),(t+2<NT));     ENDW(t+1); RESC(); ROT();
  }
  STEP(pB0,pB1,pA0,pA1,NT-1,false,false,false); RESC();
  { float sacc=pB0[0]+pB0[1]; _Pragma("unroll") for(int r=2;r<16;++r)sacc+=pB0[r]; _Pragma("unroll") for(int r=0;r<16;++r)sacc+=pB1[r]; l_reg+=sacc;
    pw0=(u32x4){PKW(pB0,0),PKW(pB0,2),PKW(pB0,4),PKW(pB0,6)};pw1=(u32x4){PKW(pB0,8),PKW(pB0,10),PKW(pB0,12),PKW(pB0,14)};pw2=(u32x4){PKW(pB1,0),PKW(pB1,2),PKW(pB1,4),PKW(pB1,6)};pw3=(u32x4){PKW(pB1,8),PKW(pB1,10),PKW(pB1,12),PKW(pB1,14)};
    SBAR(); pv(o,vb0+sl_cur,PAF(0),PAF(1),PAF(2),PAF(3)); }
  #undef PKW
  #undef PAF
  #undef VFR
  #undef PIN
  #undef MX3
  #undef GAPA
  #undef GAPB
  #undef EX
  #undef VRD
  #undef KRD
  #undef STEP
  #undef ENDW
  {auto rr=__builtin_amdgcn_permlane32_swap(__float_as_uint(l_reg),__float_as_uint(l_reg),false,false);l_reg=__uint_as_float(rr[0])+__uint_as_float(rr[1]);}
  if(hi==0)wsf[32+r32]=l_reg;asm volatile("s_waitcnt lgkmcnt(0)":::"memory");
  float rli[16];
  #pragma unroll
  for(int r=0;r<16;++r)rli[r]=__builtin_amdgcn_rcpf(wsf[32+crow(r,hi)]);
  bf16*Ow=O+(rowbase+q0+wid*QBLK)*OP+h*DV;
  { bf16*stg=(bf16*)(shm+LDS_OST)+wid*2048;
    #pragma unroll
    for(int r=0;r<16;++r){const int orow=crow(r,hi);
      #pragma unroll
      for(int d0=0;d0<2;++d0)stg[orow*64+d0*32+r32]=__float2bfloat16(o[d0][r]*rli[r]);}
    asm volatile("s_waitcnt lgkmcnt(0)":::"memory");
    int lo_=lane; asm volatile("":"+v"(lo_));
    #pragma unroll
    for(int i=0;i<4;++i){const int row=i*8+(lo_>>3),ch=lo_&7; const u32x4 v=*(const u32x4*)(stg+row*64+ch*8); *(u32x4*)(Ow+(long)row*OP+ch*8)=v;} }
  asm volatile("s_waitcnt lgkmcnt(0)\n\ts_barrier":::"memory");
  #undef DMA_K
  #undef DMA_V
  #undef KOF
  #undef CMASK
  #undef START
  #undef RESC
  #undef ROT
}
#undef WAIT_BAR
}

constexpr int NWAVES = 8;
constexpr int BATCH = 16, SEQ = 4096, D = 1024, T = BATCH * SEQ;
constexpr int IN_COLS = 4768, N1 = 4864;
constexpr int MEM_LEN = 256, MROWS = BATCH * MEM_LEN;
constexpr int NEXP = 32, TOPK = 4, DFF = 1024, LISTCAP = T;
constexpr int ACT_TILES_MAX = (T * TOPK) / 256 + NEXP;
constexpr float EPS = 1e-6f;
constexpr float C2_MLA = 0.10206207261596575f * 1.4426950408889634f;
constexpr float C2_X = 0.08838834764831845f * 1.4426950408889634f;
constexpr float SX8 = 4.0f, SW8 = 64.0f, SA8 = 4.0f;
constexpr int PER_PHASE = 11;
constexpr int N_LAUNCHES = MK_N_LAUNCHES;

constexpr size_t MiB = 1u << 20;
constexpr size_t WS_CTL = 0, CTL_ZERO_BYTES = 1 * MiB;
constexpr size_t WS_LIST = 1 * MiB;
constexpr size_t WS_TOKG = 9 * MiB;
constexpr size_t WS_RSTD2 = 10 * MiB;
constexpr size_t WS_W1T = 9 * MiB;
constexpr size_t WS_WUQ = 19 * MiB;
constexpr size_t WS_WUKV = 20 * MiB;
constexpr size_t WS_WMEM = 21 * MiB;
constexpr size_t WS_WPOOL = 23 * MiB;
constexpr size_t WS_WMO = 24 * MiB, WS_WCO = 25 * MiB;
constexpr size_t WS_WO = 26 * MiB;
constexpr size_t WS_MEMN = 28 * MiB;
constexpr size_t WS_KVMK = 36 * MiB;
constexpr size_t WS_VTG = 40 * MiB;
constexpr size_t WS_HN = 64 * MiB;
constexpr size_t WS_V = 64 * MiB, WS_MIXED = 128 * MiB;
constexpr size_t WS_GATES = 192 * MiB;
constexpr size_t WS_U = 576 * MiB, WS_AO = 576 * MiB;
constexpr size_t WS_CQKV = 640 * MiB, WS_CO = 640 * MiB;
constexpr size_t WS_QX = 736 * MiB;
constexpr size_t WS_Q = 800 * MiB;
constexpr size_t WS_KV = 896 * MiB, WS_MERGED = 896 * MiB;
constexpr size_t WS_HN2 = 16 * MiB;
constexpr size_t WS_WEI = 144 * MiB;
constexpr size_t WS_Y = 16 * MiB;
constexpr size_t WS_DELTA = 528 * MiB;
constexpr size_t WS_ACT = 656 * MiB;
constexpr size_t WS_WEO = 928 * MiB;
constexpr size_t WS_END = 992 * MiB;
static_assert(WS_ACT + (size_t)ACT_TILES_MAX * 256 * 1024 <= WS_WEO && WS_Y + (size_t)T * 4 * 1024 * 2 <= WS_DELTA && WS_DELTA + (size_t)T * 1024 * 2 <= WS_ACT && WS_WEI + (size_t)NEXP * 2048 * 1024 <= WS_DELTA && WS_DELTA + (size_t)T * 1024 * 2 <= WS_MERGED, "late map");
static_assert(WS_W1T + (size_t)N1 * 1024 * 2 <= WS_WUQ && WS_VTG + 4 * MiB <= WS_HN && WS_GATES + (size_t)T * 3072 * 2 <= WS_U && WS_CQKV + (size_t)T * 768 * 2 <= WS_QX && WS_Q + (size_t)T * 768 * 2 <= WS_KV, "early map");
constexpr int CW_TMO = 0, CW_CODE = 1;
constexpr int CW_BAR = 4096;
constexpr int CW_GCNT = 16384;
constexpr int RING_OFF = 0, RING_BYTES = 131072;
constexpr int LDSCTL_OFF = RING_BYTES, MISC_OFF = LDSCTL_OFF + 320;
constexpr int LX_TSTART = LDSCTL_OFF + 512;
constexpr int LX_CNT = LDSCTL_OFF + 768;
constexpr int LX_LCNT = LDSCTL_OFF + 1024;
constexpr int LX_BASE = LDSCTL_OFF + 1280;
constexpr int LX_XWS = LDSCTL_OFF + 2048;
constexpr int LX_STASH = LDSCTL_OFF + 4096;
constexpr int LX_GATE = LDSCTL_OFF + 8192;
constexpr int LDS_BYTES = 147456;
static_assert(LX_GATE + 4096 <= LDS_BYTES && mla::LDS_BYTES <= RING_BYTES, "LDS map");

#define GAS __attribute__((address_space(1)))
#define LAS __attribute__((address_space(3)))
typedef unsigned short bf16;
typedef unsigned v4u __attribute__((ext_vector_type(4)));
typedef unsigned v2u __attribute__((ext_vector_type(2)));
typedef float f32x4 __attribute__((ext_vector_type(4)));
typedef float f32x16 __attribute__((ext_vector_type(16)));
typedef short bf16x8 __attribute__((ext_vector_type(8)));
typedef GAS unsigned gu32;
#define RLX_AGENT __ATOMIC_RELAXED, __HIP_MEMORY_SCOPE_AGENT
#define LDS_WAIT() asm volatile("s_waitcnt lgkmcnt(0)" ::: "memory")
#define VM_WAIT() asm volatile("s_waitcnt vmcnt(0)" ::: "memory")
__device__ __forceinline__ unsigned f2bf(float f) { unsigned u = __builtin_bit_cast(unsigned, f); return (u + 0x7fffu + ((u >> 16) & 1u)) >> 16; }
__device__ __forceinline__ unsigned pk2(float lo, float hi) { return pg8::cvt_pk_bf16(lo, hi); }
__device__ __forceinline__ float bflo(unsigned w) { return __uint_as_float(w << 16); }
__device__ __forceinline__ float bfhi(unsigned w) { return __uint_as_float(w & 0xffff0000u); }
__device__ __forceinline__ unsigned pk4_fp8(float a, float b, float c, float d) { int w = 0; w = __builtin_amdgcn_cvt_pk_fp8_f32(a, b, w, false); w = __builtin_amdgcn_cvt_pk_fp8_f32(c, d, w, true); return (unsigned)w; }

#define XB_TMO      128
#define XB_XCNT(j)  (256  + 64 * (j))
#define XB_XSUB(j)  (1280 + 64 * (j))
#define XB_XGEN(j)  (2304 + 64 * (j))
#define XB_TOP      3328
#define XB_TOPGEN   3392
#define XCD_BAR_WORDS 3456
#define XB_SPIN_CAP (1u << 18)
__device__ __forceinline__ unsigned xb_ld(unsigned* p)              { return __hip_atomic_load(p, __ATOMIC_RELAXED, __HIP_MEMORY_SCOPE_AGENT); }
__device__ __forceinline__ unsigned xb_add(unsigned* p, unsigned v) { return __hip_atomic_fetch_add(p, v, __ATOMIC_RELAXED, __HIP_MEMORY_SCOPE_AGENT); }
__device__ __forceinline__ unsigned xb_xcc_id() { return (unsigned)__builtin_amdgcn_s_getreg((3 << 11) | 20) & 0xFu; }
#define XB_SPIN(cond, bar) do { unsigned _sp = 0; while (cond) { __builtin_amdgcn_s_sleep(1); \
    if ((++_sp & 255u) == 0u) { if (xb_ld(&(bar)[XB_TMO])) break; if (_sp > XB_SPIN_CAP) { atomicAdd(&(bar)[XB_TMO], 1u); break; } } } } while (0)
struct XcdBarrier { unsigned* bar; unsigned x; volatile LAS unsigned* st; };
__device__ __forceinline__ XcdBarrier xcd_barrier_post(unsigned* bar, volatile LAS unsigned* st, const bool thread0) {
    XcdBarrier b; b.bar = bar; b.x = xb_xcc_id(); b.st = st;
    if (thread0) (void)xb_add(&bar[XB_XCNT(b.x)], 1u);
    return b;
}
__device__ __forceinline__ void xcd_barrier_complete(unsigned* bar, unsigned x, unsigned& nloc, unsigned& nx) {
    const unsigned G = gridDim.x * gridDim.y * gridDim.z;
    unsigned sum, cnt, mine, sp = 0u;
    for (;;) {
        sum = 0u; cnt = 0u; mine = 0u;
#pragma unroll
        for (unsigned j = 0; j < 16; ++j) { const unsigned c = xb_ld(&bar[XB_XCNT(j)]); sum += c; cnt += (c > 0u) ? 1u : 0u; mine = (j == x) ? c : mine; }
        if (sum == G) break;
        __builtin_amdgcn_s_sleep(1);
        if ((++sp & 255u) == 0u) { if (xb_ld(&bar[XB_TMO])) break; if (sp > XB_SPIN_CAP) { atomicAdd(&bar[XB_TMO], 1u); break; } }
    }
    nloc = mine > 0u ? mine : 1u; nx = cnt > 0u ? cnt : 1u;
}
__device__ __forceinline__ void xcd_barrier(const XcdBarrier& b, const bool thread0) {
    asm volatile("s_waitcnt vmcnt(0)" ::: "memory");
    __syncthreads();
    if (thread0) {
        unsigned* bar = b.bar;
        __builtin_amdgcn_s_waitcnt(0);
        unsigned nloc = b.st[0], nx = b.st[1];
        if (nloc == 0u) { xcd_barrier_complete(bar, b.x, nloc, nx); b.st[0] = nloc; b.st[1] = nx; }
        const unsigned old = xb_add(&bar[XB_XSUB(b.x)], 1u);
        const unsigned gen = old / nloc;
        if (old + 1u == (gen + 1u) * nloc) {
            __builtin_amdgcn_fence(__ATOMIC_RELEASE, "agent");
            asm volatile("s_waitcnt vmcnt(0)" ::: "memory");
            const unsigned og = xb_add(&bar[XB_TOP], 1u);
            const unsigned tg = og / nx;
            if (og + 1u == (tg + 1u) * nx) xb_add(&bar[XB_TOPGEN], 1u);
            else XB_SPIN(xb_ld(&bar[XB_TOPGEN]) == tg, bar);
            __builtin_amdgcn_fence(__ATOMIC_ACQUIRE, "agent");
            xb_add(&bar[XB_XGEN(b.x)], 1u);
            asm volatile("s_waitcnt vmcnt(0)" ::: "memory");
        } else {
            XB_SPIN(xb_ld(&bar[XB_XGEN(b.x)]) == gen, bar);
            __builtin_amdgcn_fence(__ATOMIC_ACQUIRE, "agent");
            asm volatile("s_waitcnt vmcnt(0)" ::: "memory");
        }
    }
    __syncthreads();
}

struct Frame {
    LAS unsigned char* lds;
    volatile LAS unsigned* MISC;
    gu32* ctl;
    int tid, lane, wave;
    int vcu, G;
    unsigned char* ws;
    const float* const* in;
    float* out;
};
__device__ __forceinline__ float wave_sum(float v) {
#pragma unroll
    for (int o = 1; o < 64; o <<= 1) v += __shfl_xor(v, o);
    return v;
}
__device__ __forceinline__ float sumsq8(v4u w) {
    float s = 0.f;
#pragma unroll
    for (int i = 0; i < 4; ++i) { const float a = bflo(w[i]), b = bfhi(w[i]); s += a * a + b * b; }
    return s;
}
__device__ __forceinline__ void transpose_item(const float* W, int ldw, int srccol, const float* ks, bf16* WT, int K, int nrow0, int k0, LAS float* scr, int lane) {
    float v[32];
#pragma unroll
    for (int i = 0; i < 32; ++i) { const int kk = 2 * i + (lane >> 5); v[i] = (srccol >= 0) ? W[(size_t)(k0 + kk) * ldw + srccol + (lane & 31)] : 0.f; }
    if (ks) {
#pragma unroll
        for (int i = 0; i < 32; ++i) v[i] *= ks[k0 + 2 * i + (lane >> 5)]; }
#pragma unroll
    for (int i = 0; i < 32; ++i) scr[(2 * i + (lane >> 5)) * 33 + (lane & 31)] = v[i];
    LDS_WAIT(); asm volatile("" ::: "memory");
    const int c = lane & 7;
#pragma unroll
    for (int j = 0; j < 4; ++j) { const int n = (lane >> 3) + 8 * j; const LAS float* s = scr + (8 * c) * 33 + n;
        v4u o; o.x = pk2(s[0 * 33], s[1 * 33]); o.y = pk2(s[2 * 33], s[3 * 33]); o.z = pk2(s[4 * 33], s[5 * 33]); o.w = pk2(s[6 * 33], s[7 * 33]);
        *(GAS v4u*)(WT + (size_t)(nrow0 + n) * K + k0 + 8 * c) = o; }
    LDS_WAIT(); asm volatile("" ::: "memory");
}
__device__ __forceinline__ void transpose_item8(const float* W, int ldw, int srccol, const float* ks, float scale, unsigned char* WT, int K, int nrow0, int k0, LAS float* scr, int lane) {
    float v[32];
#pragma unroll
    for (int i = 0; i < 32; ++i) { const int kk = 2 * i + (lane >> 5); v[i] = W[(size_t)(k0 + kk) * ldw + srccol + (lane & 31)] * scale; }
    if (ks) {
#pragma unroll
        for (int i = 0; i < 32; ++i) v[i] *= ks[k0 + 2 * i + (lane >> 5)]; }
#pragma unroll
    for (int i = 0; i < 32; ++i) scr[(2 * i + (lane >> 5)) * 33 + (lane & 31)] = v[i];
    LDS_WAIT(); asm volatile("" ::: "memory");
    const int c = lane & 7;
#pragma unroll
    for (int j = 0; j < 4; ++j) { const int n = (lane >> 3) + 8 * j; const LAS float* s = scr + (8 * c) * 33 + n;
        v2u o; o.x = pk4_fp8(s[0 * 33], s[1 * 33], s[2 * 33], s[3 * 33]); o.y = pk4_fp8(s[4 * 33], s[5 * 33], s[6 * 33], s[7 * 33]);
        *(GAS v2u*)(WT + (size_t)(nrow0 + n) * K + k0 + 8 * c) = o; }
    LDS_WAIT(); asm volatile("" ::: "memory");
}
template <int NR> __device__ __forceinline__ void rms_rows_to_bf16(int lane, const float* x0, size_t xstride, const f32x4 (&gg)[4], bf16* o0, size_t ostride) {
    f32x4 v[NR][4];
#pragma unroll
    for (int r = 0; r < NR; ++r) { const GAS f32x4* xr = (const GAS f32x4*)(x0 + r * xstride) + lane;
#pragma unroll
        for (int j = 0; j < 4; ++j) v[r][j] = xr[64 * j]; }
#pragma unroll
    for (int r = 0; r < NR; ++r) { float s = 0.f;
#pragma unroll
        for (int j = 0; j < 4; ++j) s += (v[r][j].x * v[r][j].x + v[r][j].y * v[r][j].y) + (v[r][j].z * v[r][j].z + v[r][j].w * v[r][j].w);
        const float rstd = 1.0f / sqrtf(wave_sum(s) * (1.f / 1024.f) + EPS);
        GAS unsigned long long* o8 = (GAS unsigned long long*)(o0 + r * ostride) + lane;
#pragma unroll
        for (int j = 0; j < 4; ++j)
            o8[64 * j] = (unsigned long long)pk2(v[r][j].x * rstd * gg[j].x, v[r][j].y * rstd * gg[j].y) | ((unsigned long long)pk2(v[r][j].z * rstd * gg[j].z, v[r][j].w * rstd * gg[j].w) << 32); }
}
__device__ __forceinline__ void rms_rows_all(int lane, int gw, int NGW, const float* X, const float* g, bf16* O, int nrows) {
    f32x4 gg[4];
#pragma unroll
    for (int j = 0; j < 4; ++j) gg[j] = ((const GAS f32x4*)g + lane)[64 * j];
    int m = gw;
    for (; m + 3 * NGW < nrows; m += 4 * NGW) rms_rows_to_bf16<4>(lane, X + (size_t)m * D, (size_t)NGW * D, gg, O + (size_t)m * D, (size_t)NGW * D);
    for (; m < nrows; m += NGW) rms_rows_to_bf16<1>(lane, X + (size_t)m * D, 0, gg, O + (size_t)m * D, 0);
}

enum { I_X = 0, I_MEM, I_POS, I_GATTN, I_WIN, I_WPOOL, I_PSCALE, I_GQL, I_WUQ, I_GKVL, I_WUKV, I_GQM, I_GKM, I_GMEM, I_WMEMKV, I_GQC, I_GKC, I_WPO, I_WMO, I_WCO, I_WO, I_GFFN,
       I_WR, I_BR, I_WEI, I_BEI, I_WEO, I_BEO, N_IN };

__device__ __forceinline__ int fresh_lane() { int l; asm volatile("v_mbcnt_lo_u32_b32 %0, -1, 0\n\tv_mbcnt_hi_u32_b32 %0, -1, %0" : "=v"(l)); return l; }
#define REFRESH(F) do { int w_ = (F).wave; asm volatile("" : "+s"(w_)); (F).wave = w_; (F).lane = fresh_lane(); (F).tid = w_ * 64 + (F).lane; } while (0)
__device__ __forceinline__ void p0_prologue(Frame& F) {
    LAS float* scr = (LAS float*)(F.lds + RING_OFF + F.wave * 16384);
    const int gw = F.vcu * NWAVES + F.wave, NGW = F.G * NWAVES, lane = F.lane;
    unsigned char* ws = F.ws;
    constexpr int I1 = 16 * (N1 / 32), I2 = 6 * 24, I3 = 4 * 32, I4 = 16 * 32, I5 = 8 * 32, I6 = 8 * 32, I7 = 16 * 32;
    constexpr int NITEMS = I1 + I2 + I3 + I4 + I5 + I6 + I7;
    for (int it = gw; it < NITEMS; it += NGW) {
        int r = it;
        if (r < I1) { const int nnb = N1 / 32, kb = r / nnb, nb = r % nnb, n0 = nb * 32; const int src = n0 < 1184 ? n0 : (n0 < 1280 ? -1 : n0 - 96);
            transpose_item(F.in[I_WIN], IN_COLS, src, nullptr, (bf16*)(ws + WS_W1T), 1024, n0, kb * 64, scr, lane); continue; } r -= I1;
        if (r < I2) { const int kb = r / 24, nb = r % 24; transpose_item(F.in[I_WUQ], 768, nb * 32, F.in[I_GQL], (bf16*)(ws + WS_WUQ), 384, nb * 32, kb * 64, scr, lane); continue; } r -= I2;
        if (r < I3) { const int kb = r / 32, nb = r % 32; transpose_item(F.in[I_WUKV], 1024, nb * 32, F.in[I_GKVL], (bf16*)(ws + WS_WUKV), 256, nb * 32, kb * 64, scr, lane); continue; } r -= I3;
        if (r < I4) { const int kb = r / 32, nb = r % 32; transpose_item(F.in[I_WMEMKV], 1024, nb * 32, nullptr, (bf16*)(ws + WS_WMEM), 1024, nb * 32, kb * 64, scr, lane); continue; } r -= I4;
        if (r < I5) { const int kb = r / 32, nb = r % 32; transpose_item(F.in[I_WMO], 1024, nb * 32, nullptr, (bf16*)(ws + WS_WMO), 512, nb * 32, kb * 64, scr, lane); continue; } r -= I5;
        if (r < I6) { const int kb = r / 32, nb = r % 32; transpose_item(F.in[I_WCO], 1024, nb * 32, nullptr, (bf16*)(ws + WS_WCO), 512, nb * 32, kb * 64, scr, lane); continue; } r -= I6;
        { const int kb = r / 32, nb = r % 32; transpose_item(F.in[I_WO], 1024, nb * 32, nullptr, (bf16*)(ws + WS_WO), 1024, nb * 32, kb * 64, scr, lane); }
    }
    for (int it = gw; it < 2048; it += NGW) {
        const int kc = it >> 2, dq = it & 3, g = kc >> 7; const float* wp = F.in[I_WPOOL] + (size_t)kc * 128; const float* ps = F.in[I_PSCALE] + g * 128; const float* wpo = F.in[I_WPO] + (size_t)(g * 128) * 1024 + dq * 256 + lane;
        float a[4] = {0.f, 0.f, 0.f, 0.f};
#pragma unroll 8
        for (int j = 0; j < 128; ++j) { const float sc = wp[j] * ps[j]; const float* row = wpo + (size_t)j * 1024;
#pragma unroll
            for (int i = 0; i < 4; ++i) a[i] += sc * row[64 * i]; }
        bf16* wt = (bf16*)(ws + WS_WPOOL);
#pragma unroll
        for (int i = 0; i < 4; ++i) wt[(size_t)(dq * 256 + lane + 64 * i) * 512 + kc] = (bf16)f2bf(a[i]);
    }
    rms_rows_all(lane, gw, NGW, F.in[I_X], F.in[I_GATTN], (bf16*)(ws + WS_HN), T);
    rms_rows_all(lane, gw, NGW, F.in[I_MEM], F.in[I_GMEM], (bf16*)(ws + WS_MEMN), MROWS);
}

using pg8::Unit; using pg8::bf16_t;
struct DenseSched {
    int nM, nN, G, c; const char* A; const char* B; size_t tA, tB;
    __device__ __forceinline__ void init(const void* A_, int lda, const void* B_, int ldb, int M, int N, int G_, int c_) { A = (const char*)A_; B = (const char*)B_; nM = M / 256; nN = N / 256; G = G_; c = c_; tA = (size_t)256 * lda * 2; tB = (size_t)256 * ldb * 2; }
    __device__ __forceinline__ bool next(int i, Unit& u) const {
        const long L = (long)i * G + c; if (L >= (long)nM * nN) return false;
        pg8::tile_order((int)L, nM, nN, u.pm, u.pn); u.A = A + (size_t)u.pm * tA; u.B = B + (size_t)u.pn * tB; u.aux = 0; return true; }
};
struct EpiStore {
    static constexpr bool PERM = true, ACCUM = false;
    bf16_t* O; int ldc;
    __device__ __forceinline__ void operator()(const pg8::f32x4 (&acc)[2][2][4][2], const Unit& u, int wr, int wc, int fr_, int fq_) const {
        int fr = fr_, fq = fq_; asm volatile("" : "+v"(fr), "+v"(fq));
        const int row0 = u.pm * 256 + wr * 64 + fr, col0 = u.pn * 256 + wc * 32 + 8 * fq;
#pragma unroll
        for (int ai = 0; ai < 2; ++ai)
#pragma unroll
            for (int m = 0; m < 4; ++m) { bf16_t* rowp = O + (size_t)(row0 + ai * 128 + m * 16) * ldc + col0;
#pragma unroll
                for (int bj = 0; bj < 2; ++bj) { const pg8::f32x4 v0 = acc[ai][bj][m][0], v1 = acc[ai][bj][m][1]; pg8::u32x4 w;
                    w.x = pg8::cvt_pk_bf16(v0[0], v0[1]); w.y = pg8::cvt_pk_bf16(v0[2], v0[3]); w.z = pg8::cvt_pk_bf16(v1[0], v1[1]); w.w = pg8::cvt_pk_bf16(v1[2], v1[3]);
                    *(pg8::u32x4*)(rowp + bj * 128) = w; } }
    }
};
struct EpiP1 {
    static constexpr bool PERM = true, ACCUM = false;
    bf16_t *U, *CQKV, *QX; unsigned char* GATES;
    __device__ __forceinline__ void operator()(const pg8::f32x4 (&acc)[2][2][4][2], const Unit& u, int wr, int wc, int fr_, int fq_) const {
        int fr = fr_, fq = fq_; asm volatile("" : "+v"(fr), "+v"(fq));
        const int pn = u.pn;
        if (pn >= 7) {
            const int row0 = u.pm * 256 + wr * 64 + fr, col0 = (pn - 7) * 256 + wc * 32 + 8 * fq;
#pragma unroll
            for (int ai = 0; ai < 2; ++ai)
#pragma unroll
                for (int m = 0; m < 4; ++m) { unsigned char* rowp = GATES + (size_t)(row0 + ai * 128 + m * 16) * 3072 + col0;
#pragma unroll
                    for (int bj = 0; bj < 2; ++bj) { unsigned q[8];
#pragma unroll
                        for (int n = 0; n < 2; ++n)
#pragma unroll
                            for (int i = 0; i < 4; ++i) { const float g = pg8::sigmoidf_fast(acc[ai][bj][m][n][i]) * 256.0f; const unsigned qi = (unsigned)g; q[4 * n + i] = qi < 255u ? qi : 255u; }
                        pg8::u32x2 w; w.x = q[0] | (q[1] << 8) | (q[2] << 16) | (q[3] << 24); w.y = q[4] | (q[5] << 8) | (q[6] << 16) | (q[7] << 24);
                        *(pg8::u32x2*)(rowp + bj * 128) = w; } }
            return;
        }
        bf16_t* base; int ldc, colt;
        if (pn < 2) { base = U; ldc = 512; colt = pn * 256; } else if (pn < 5) { base = CQKV; ldc = 768; colt = (pn - 2) * 256; }
        else { base = QX; ldc = 512; colt = (pn - 5) * 256; }
        const int row0 = u.pm * 256 + wr * 64 + fr, col0 = colt + wc * 32 + 8 * fq;
#pragma unroll
        for (int ai = 0; ai < 2; ++ai)
#pragma unroll
            for (int m = 0; m < 4; ++m) { bf16_t* rowp = base + (size_t)(row0 + ai * 128 + m * 16) * ldc + col0;
#pragma unroll
                for (int bj = 0; bj < 2; ++bj) { const pg8::f32x4 v0 = acc[ai][bj][m][0], v1 = acc[ai][bj][m][1];
                    pg8::u32x4 w; w.x = pg8::cvt_pk_bf16(v0[0], v0[1]); w.y = pg8::cvt_pk_bf16(v0[2], v0[3]); w.z = pg8::cvt_pk_bf16(v1[0], v1[1]); w.w = pg8::cvt_pk_bf16(v1[2], v1[3]);
                    *(pg8::u32x4*)(rowp + bj * 128) = w; } }
    }
};
struct EpiMemKV {
    static constexpr bool PERM = true, ACCUM = false;
    bf16_t *KVMK, *VTG;
    __device__ __forceinline__ void operator()(const pg8::f32x4 (&acc)[2][2][4][2], const Unit& u, int wr, int wc, int fr_, int fq_) const {
        int fr = fr_, fq = fq_; asm volatile("" : "+v"(fr), "+v"(fq));
        const int row0 = u.pm * 256 + wr * 64 + fr;
        if (u.pn < 2) {
            const int col0 = u.pn * 256 + wc * 32 + 8 * fq;
#pragma unroll
            for (int ai = 0; ai < 2; ++ai)
#pragma unroll
                for (int m = 0; m < 4; ++m) { bf16_t* rowp = KVMK + (size_t)(row0 + ai * 128 + m * 16) * 512 + col0;
#pragma unroll
                    for (int bj = 0; bj < 2; ++bj) { const pg8::f32x4 v0 = acc[ai][bj][m][0], v1 = acc[ai][bj][m][1]; pg8::u32x4 w;
                        w.x = pg8::cvt_pk_bf16(v0[0], v0[1]); w.y = pg8::cvt_pk_bf16(v0[2], v0[3]); w.z = pg8::cvt_pk_bf16(v1[0], v1[1]); w.w = pg8::cvt_pk_bf16(v1[2], v1[3]);
                        *(pg8::u32x4*)(rowp + bj * 128) = w; } }
        } else {
#pragma unroll
            for (int ai = 0; ai < 2; ++ai)
#pragma unroll
                for (int m = 0; m < 4; ++m) { const int row = row0 + ai * 128 + m * 16, b = row >> 8, mm = row & 255;
                    const int pos = (mm & ~12) | ((mm & 4) << 1) | ((mm & 8) >> 1);
#pragma unroll
                    for (int bj = 0; bj < 2; ++bj) { const int hc = (u.pn - 2) * 2 + bj;
                        bf16_t* dst = VTG + ((size_t)(b * 4 + hc) * 128 + wc * 32 + 8 * fq) * 256 + pos;
#pragma unroll
                        for (int n = 0; n < 2; ++n)
#pragma unroll
                            for (int i = 0; i < 4; ++i) dst[(size_t)(4 * n + i) * 256] = (bf16_t)f2bf(acc[ai][bj][m][n][i]); } }
        }
    }
};
struct MergeSched {
    int G, c; const char *A0, *B0; long dA1, dA2, dB1, dB2;
    __device__ __forceinline__ bool next(int i, Unit& u) const {
        const int ti = i / 3, br = i - 3 * ti; const long L = (long)ti * G + c; if (L >= 256 * 4) return false;
        pg8::tile_order((int)L, 256, 4, u.pm, u.pn); u.aux = br;
        const long b1 = br & 1, b2 = br >> 1;
        u.A = A0 + b1 * dA1 + b2 * dA2 + (size_t)u.pm * (256 * 512 * 2); u.B = B0 + b1 * dB1 + b2 * dB2 + (size_t)u.pn * (256 * 512 * 2); return true; }
};
struct EpiMerge {
    static constexpr bool PERM = true, ACCUM = true;
    const unsigned char* GATES; bf16_t* MERGED;
    __device__ __forceinline__ void operator()(const pg8::f32x4 (&acc)[2][2][4][2], const Unit& u, int wr, int wc, int fr_, int fq_) const {}
    __device__ __forceinline__ bool merge(pg8::f32x4 (&acc)[2][2][4][2], const Unit& u, int wr, int wc, int fr_, int fq_) const {
        int fr = fr_, fq = fq_; asm volatile("" : "+v"(fr), "+v"(fq));
        const int br = u.aux, row0 = u.pm * 256 + wr * 64 + fr, col0 = u.pn * 256 + wc * 32 + 8 * fq;
#pragma unroll
        for (int ai = 0; ai < 2; ++ai)
#pragma unroll
            for (int m = 0; m < 4; ++m) { const size_t row = (size_t)(row0 + ai * 128 + m * 16);
#pragma unroll
                for (int bj = 0; bj < 2; ++bj) { const int c0 = col0 + bj * 128;
                    const pg8::u32x2 ga = *(const pg8::u32x2*)(GATES + row * 3072 + br * 1024 + c0);
                    float f[8];
#pragma unroll
                    for (int i = 0; i < 4; ++i) { f[i] = (float)((ga.x >> (8 * i)) & 255u) + 0.5f; f[4 + i] = (float)((ga.y >> (8 * i)) & 255u) + 0.5f; }
                    if (br < 2) { const pg8::u32x2 gb = *(const pg8::u32x2*)(GATES + row * 3072 + (br + 1) * 1024 + c0);
#pragma unroll
                        for (int i = 0; i < 4; ++i) { f[i] *= __builtin_amdgcn_rcpf((float)((gb.x >> (8 * i)) & 255u) + 0.5f); f[4 + i] *= __builtin_amdgcn_rcpf((float)((gb.y >> (8 * i)) & 255u) + 0.5f); } }
                    else {
#pragma unroll
                        for (int i = 0; i < 8; ++i) f[i] *= (1.0f / 256.0f); }
#pragma unroll
                    for (int i = 0; i < 4; ++i) { acc[ai][bj][m][0][i] *= f[i]; acc[ai][bj][m][1][i] *= f[4 + i]; }
                    if (br == 2) { const pg8::f32x4 v0 = acc[ai][bj][m][0], v1 = acc[ai][bj][m][1];
                        pg8::u32x4 w; w.x = pg8::cvt_pk_bf16(v0[0], v0[1]); w.y = pg8::cvt_pk_bf16(v0[2], v0[3]); w.z = pg8::cvt_pk_bf16(v1[0], v1[1]); w.w = pg8::cvt_pk_bf16(v1[2], v1[3]);
                        *(pg8::u32x4*)(MERGED + row * 1024 + c0) = w; } } }
        return br < 2;
    }
};
struct EpiResF32 {
    static constexpr bool PERM = false, ACCUM = false;
    const float* X; float* O;
    __device__ __forceinline__ void operator()(const pg8::f32x4 (&acc)[2][2][4][2], const Unit& u, int wr, int wc, int fr_, int fq_) const {
        int fr = fr_, fq = fq_; asm volatile("" : "+v"(fr), "+v"(fq));
        const int row0 = u.pm * 256 + wr * 64 + fr, col0 = u.pn * 256 + wc * 32 + 4 * fq;
#pragma unroll
        for (int ai = 0; ai < 2; ++ai)
#pragma unroll
            for (int m = 0; m < 4; ++m) { const size_t off = (size_t)(row0 + ai * 128 + m * 16) * 1024 + col0;
#pragma unroll
                for (int bj = 0; bj < 2; ++bj)
#pragma unroll
                    for (int n = 0; n < 2; ++n) { const pg8::f32x4 xv = *(const pg8::f32x4*)(X + off + bj * 128 + n * 16); *(pg8::f32x4*)(O + off + bj * 128 + n * 16) = xv + acc[ai][bj][m][n]; } }
    }
};
struct MoeSched {
    int G, c, nM, nN; const LAS int* tstart; const LAS int* cnt; const int* list; const char* A; const char* B; size_t bexp, tB, tA; bool gather;
    __device__ __forceinline__ bool next(int i, Unit& u) const {
        const long L = (long)i * G + c; if (L >= (long)nM * nN) return false;
        int pm, pn; pg8::tile_order((int)L, nM, nN, pm, pn);
        int e = 0; while (e < NEXP - 1 && __builtin_amdgcn_readfirstlane(tstart[e + 1]) <= pm) ++e;
        const int ts = __builtin_amdgcn_readfirstlane(tstart[e]);
        u.pm = pm; u.pn = pn; u.aux = e | ((pm - ts) << 8);
        u.A = gather ? A : A + (size_t)pm * tA; u.B = B + (size_t)e * bexp + (size_t)pn * tB; return true; }
    __device__ __forceinline__ unsigned row_off(const Unit& u, int row) const {
        const int e = u.aux & 255, idx = (u.aux >> 8) * 256 + row; const int ent = idx < cnt[e] ? list[(size_t)e * LISTCAP + idx] : 0; return (unsigned)(ent >> 2) * 1024u; }
};
struct EpiMoeIn {
    static constexpr bool PERM = true, ACCUM = false;
    const LAS int* cnt; const int* list; const float* rstd2; const float* bin; unsigned char* ACT;
    __device__ __forceinline__ void operator()(const pg8::f32x4 (&acc)[2][2][4][2], const Unit& u, int wr, int wc, int fr_, int fq_) const {
        int fr = fr_, fq = fq_; asm volatile("" : "+v"(fr), "+v"(fq));
        const int e = u.aux & 255, rt = u.aux >> 8, ce = cnt[e], j0 = u.pn * 128 + wc * 32 + 8 * fq;
        const float* bg = bin + (size_t)e * 2048 + j0; const pg8::f32x4 bg0 = *(const pg8::f32x4*)bg, bg1 = *(const pg8::f32x4*)(bg + 4), bl0 = *(const pg8::f32x4*)(bg + 1024), bl1 = *(const pg8::f32x4*)(bg + 1028);
#pragma unroll
        for (int ai = 0; ai < 2; ++ai)
#pragma unroll
            for (int m = 0; m < 4; ++m) { const int rl = ai * 128 + wr * 64 + m * 16 + fr, idx = rt * 256 + rl; float rs = 0.f;
                if (idx < ce) rs = rstd2[list[(size_t)e * LISTCAP + idx] >> 2] * (1.0f / (SX8 * SW8));
                float a[8];
#pragma unroll
                for (int n = 0; n < 2; ++n)
#pragma unroll
                    for (int i = 0; i < 4; ++i) { float gl = acc[ai][0][m][n][i] * rs + (n ? bg1[i] : bg0[i]), li = acc[ai][1][m][n][i] * rs + (n ? bl1[i] : bl0[i]);
                        gl = fminf(gl, 7.0f); li = fminf(fmaxf(li, -7.0f), 7.0f);
                        a[4 * n + i] = gl * pg8::sigmoidf_fast(1.702f * gl) * (li + 1.0f) * SA8; }
                pg8::u32x2 w; w.x = pk4_fp8(a[0], a[1], a[2], a[3]); w.y = pk4_fp8(a[4], a[5], a[6], a[7]);
                *(pg8::u32x2*)(ACT + ((size_t)u.pm * 256 + rl) * 1024 + j0) = w; }
    }
};
struct EpiMoeOut {
    static constexpr bool PERM = true, ACCUM = false;
    const LAS int* cnt; const int* list; const float* tokg; const float* bout; bf16_t* Y;
    __device__ __forceinline__ void operator()(const pg8::f32x4 (&acc)[2][2][4][2], const Unit& u, int wr, int wc, int fr_, int fq_) const {
        int fr = fr_, fq = fq_; asm volatile("" : "+v"(fr), "+v"(fq));
        const int e = u.aux & 255, rt = u.aux >> 8, ce = cnt[e], c0 = u.pn * 256 + wc * 32 + 8 * fq;
        const float* bo = bout + (size_t)e * 1024 + c0; pg8::f32x4 bv[2][2];
#pragma unroll
        for (int bj = 0; bj < 2; ++bj)
#pragma unroll
            for (int n = 0; n < 2; ++n) bv[bj][n] = *(const pg8::f32x4*)(bo + bj * 128 + 4 * n);
        int ent[8]; float g[8];
#pragma unroll
        for (int i = 0; i < 8; ++i) { const int idx = rt * 256 + (i >> 2) * 128 + wr * 64 + (i & 3) * 16 + fr; ent[i] = idx < ce ? list[(size_t)e * LISTCAP + idx] : -1; }
#pragma unroll
        for (int i = 0; i < 8; ++i) g[i] = ent[i] >= 0 ? tokg[ent[i]] * (1.0f / (SA8 * SW8)) : 0.f;
#pragma unroll
        for (int ai = 0; ai < 2; ++ai)
#pragma unroll
            for (int m = 0; m < 4; ++m) { const int i = ai * 4 + m;
                if (ent[i] >= 0) { const float gs = g[i], gb = gs * (SA8 * SW8);
#pragma unroll
                    for (int bj = 0; bj < 2; ++bj) { const pg8::f32x4 v0 = acc[ai][bj][m][0] * gs + bv[bj][0] * gb, v1 = acc[ai][bj][m][1] * gs + bv[bj][1] * gb;
                        pg8::u32x4 w; w.x = pg8::cvt_pk_bf16(v0[0], v0[1]); w.y = pg8::cvt_pk_bf16(v0[2], v0[3]); w.z = pg8::cvt_pk_bf16(v1[0], v1[1]); w.w = pg8::cvt_pk_bf16(v1[2], v1[3]);
                        *(pg8::u32x4*)(Y + (size_t)ent[i] * 1024 + c0 + bj * 128) = w; } } }
    }
};
__device__ const float ROPE_INVREV[16] = { 1.591549431e-01f, 8.949940161e-02f, 5.032921210e-02f, 2.830219583e-02f, 1.591549431e-02f, 8.949940161e-03f, 5.032921210e-03f, 2.830219583e-03f,
                                           1.591549431e-03f, 8.949940161e-04f, 5.032921210e-04f, 2.830219583e-04f, 1.591549431e-04f, 8.949940161e-05f, 5.032921210e-05f, 2.830219583e-05f };
struct P3In { v4u cqa, cqb, qn, kn, vv; unsigned pe_lo, pe_hi, ql, qh; int pos; v4u uw[16]; };
__device__ __forceinline__ void p3_load(Frame& F, int t, P3In& I) {
    const int lane = F.lane, h = lane >> 3, sub = lane & 7; unsigned char* ws = F.ws;
    const bf16* cq = (const bf16*)(ws + WS_CQKV) + (size_t)t * 768;
    I.cqa = (v4u){0u, 0u, 0u, 0u}; I.cqb = (v4u){0u, 0u, 0u, 0u};
    if (lane < 48) I.cqa = *(const GAS v4u*)(cq + lane * 8);
    if (lane < 32) I.cqb = *(const GAS v4u*)(cq + 384 + lane * 8);
    I.pe_lo = *(const GAS unsigned*)(cq + 640 + 2 * sub); I.pe_hi = *(const GAS unsigned*)(cq + 656 + 2 * sub);
    I.pos = ((const int*)F.in[I_POS])[t];
    const bf16* qrow = (const bf16*)(ws + WS_Q) + (size_t)t * 768 + h * 96;
    I.qn = *(const GAS v4u*)(qrow + sub * 8); I.ql = *(const GAS unsigned*)(qrow + 64 + 2 * sub); I.qh = *(const GAS unsigned*)(qrow + 80 + 2 * sub);
    const bf16* kvrow = (const bf16*)(ws + WS_KV) + (size_t)t * 1024;
    I.kn = *(const GAS v4u*)(kvrow + h * 128 + sub * 8); I.vv = *(const GAS v4u*)(kvrow + h * 128 + 64 + sub * 8);
    const int s = t & (SEQ - 1), win = 2 << (lane >> 4), cntw = (s + 1 < win) ? s + 1 : win;
    const bf16* urow = (const bf16*)(ws + WS_U) + (size_t)t * 512 + lane * 8;
#pragma unroll
    for (int j = 0; j < 16; ++j) { I.uw[j] = (v4u){0u, 0u, 0u, 0u}; if (j < cntw) I.uw[j] = *(const GAS v4u*)(urow - (size_t)j * 512); }
}
__device__ __forceinline__ void p3_compute(Frame& F, int t, const P3In& I) {
    const int lane = F.lane, h = lane >> 3, sub = lane & 7; unsigned char* ws = F.ws;
    float sq = sumsq8(I.cqa), skv = sumsq8(I.cqb);
    sq = wave_sum(sq); skv = wave_sum(skv);
    const float rs_q = 1.0f / sqrtf(sq * (1.f / 384.f) + EPS), rs_kv = 1.0f / sqrtf(skv * (1.f / 256.f) + EPS);
    const float posf = (float)I.pos;
    float cs[2], sn[2];
#pragma unroll
    for (int p = 0; p < 2; ++p) { float rev = posf * ROPE_INVREV[2 * sub + p]; rev -= floorf(rev); sn[p] = __builtin_amdgcn_sinf(rev); cs[p] = __builtin_amdgcn_cosf(rev); }
    const float* gq = F.in[I_GQM]; const float* gk = F.in[I_GKM];
    {
        bf16* qrow = (bf16*)(ws + WS_Q) + (size_t)t * 768 + h * 96;
        float q[8], a[2], b[2];
#pragma unroll
        for (int i = 0; i < 4; ++i) { q[2 * i] = bflo(I.qn[i]) * rs_q; q[2 * i + 1] = bfhi(I.qn[i]) * rs_q; }
        a[0] = bflo(I.ql) * rs_q; a[1] = bfhi(I.ql) * rs_q; b[0] = bflo(I.qh) * rs_q; b[1] = bfhi(I.qh) * rs_q;
        float ss = a[0] * a[0] + a[1] * a[1] + b[0] * b[0] + b[1] * b[1];
#pragma unroll
        for (int i = 0; i < 8; ++i) ss += q[i] * q[i];
        ss += __shfl_xor(ss, 1); ss += __shfl_xor(ss, 2); ss += __shfl_xor(ss, 4);
        const float rn = C2_MLA / sqrtf(ss * (1.f / 96.f) + EPS);
#pragma unroll
        for (int i = 0; i < 8; ++i) q[i] *= rn * gq[sub * 8 + i];
        float lo[2], hi[2];
#pragma unroll
        for (int p = 0; p < 2; ++p) { const float x1 = a[p] * rn * gq[64 + 2 * sub + p], x2 = b[p] * rn * gq[80 + 2 * sub + p]; lo[p] = x1 * cs[p] - x2 * sn[p]; hi[p] = x2 * cs[p] + x1 * sn[p]; }
        v4u o; o.x = pk2(q[0], q[1]); o.y = pk2(q[2], q[3]); o.z = pk2(q[4], q[5]); o.w = pk2(q[6], q[7]);
        *(GAS v4u*)(qrow + sub * 8) = o; *(GAS unsigned*)(qrow + 64 + 2 * sub) = pk2(lo[0], lo[1]); *(GAS unsigned*)(qrow + 80 + 2 * sub) = pk2(hi[0], hi[1]);
    }
    {
        bf16* kvrow = (bf16*)(ws + WS_KV) + (size_t)t * 1024;
        float k[8], v[8], a[2], b[2];
#pragma unroll
        for (int i = 0; i < 4; ++i) { k[2 * i] = bflo(I.kn[i]) * rs_kv; k[2 * i + 1] = bfhi(I.kn[i]) * rs_kv; v[2 * i] = bflo(I.vv[i]) * rs_kv; v[2 * i + 1] = bfhi(I.vv[i]) * rs_kv; }
        a[0] = bflo(I.pe_lo); a[1] = bfhi(I.pe_lo); b[0] = bflo(I.pe_hi); b[1] = bfhi(I.pe_hi);
        float ss = a[0] * a[0] + a[1] * a[1] + b[0] * b[0] + b[1] * b[1];
#pragma unroll
        for (int i = 0; i < 8; ++i) ss += k[i] * k[i];
        ss += __shfl_xor(ss, 1); ss += __shfl_xor(ss, 2); ss += __shfl_xor(ss, 4);
        const float rn = 1.0f / sqrtf(ss * (1.f / 96.f) + EPS);
#pragma unroll
        for (int i = 0; i < 8; ++i) k[i] *= rn * gk[sub * 8 + i];
        float lo[2], hi[2];
#pragma unroll
        for (int p = 0; p < 2; ++p) { const float x1 = a[p] * rn * gk[64 + 2 * sub + p], x2 = b[p] * rn * gk[80 + 2 * sub + p]; lo[p] = x1 * cs[p] - x2 * sn[p]; hi[p] = x2 * cs[p] + x1 * sn[p]; }
        v4u o; o.x = pk2(k[0], k[1]); o.y = pk2(k[2], k[3]); o.z = pk2(k[4], k[5]); o.w = pk2(k[6], k[7]);
        v4u ov; ov.x = pk2(v[0], v[1]); ov.y = pk2(v[2], v[3]); ov.z = pk2(v[4], v[5]); ov.w = pk2(v[6], v[7]);
        bf16* krow = kvrow + h * 96;
        *(GAS v4u*)(krow + sub * 8) = o; *(GAS unsigned*)(krow + 64 + 2 * sub) = pk2(lo[0], lo[1]); *(GAS unsigned*)(krow + 80 + 2 * sub) = pk2(hi[0], hi[1]);
        *(GAS v4u*)((bf16*)(ws + WS_V) + (size_t)t * 512 + h * 64 + sub * 8) = ov;
    }
    {
        const int s = t & (SEQ - 1), win = 2 << (lane >> 4), cntw = (s + 1 < win) ? s + 1 : win;
        float acc[8];
#pragma unroll
        for (int i = 0; i < 8; ++i) acc[i] = 0.f;
#pragma unroll
        for (int j = 0; j < 16; ++j)
#pragma unroll
            for (int i = 0; i < 4; ++i) { acc[2 * i] += bflo(I.uw[j][i]); acc[2 * i + 1] += bfhi(I.uw[j][i]); }
        const float inv = 1.0f / (float)cntw;
#pragma unroll
        for (int i = 0; i < 4; ++i) { acc[2 * i] = acc[2 * i] * inv - bflo(I.uw[0][i]); acc[2 * i + 1] = acc[2 * i + 1] * inv - bfhi(I.uw[0][i]); }
        v4u o; o.x = pk2(acc[0], acc[1]); o.y = pk2(acc[2], acc[3]); o.z = pk2(acc[4], acc[5]); o.w = pk2(acc[6], acc[7]);
        *(GAS v4u*)((bf16*)(ws + WS_MIXED) + (size_t)t * 512 + lane * 8) = o;
    }
}
template <int NT> __device__ __forceinline__ void p3_tokens(Frame& F, int t0) {
    P3In I[NT];
#pragma unroll
    for (int i = 0; i < NT; ++i) p3_load(F, t0 + i, I[i]);
    asm volatile("" ::: "memory");
#pragma unroll
    for (int i = 0; i < NT; ++i) p3_compute(F, t0 + i, I[i]);
}

namespace xat {
__device__ __forceinline__ int crow(int r, int hi) { return (r & 3) + 8 * (r >> 2) + 4 * hi; }
__device__ __forceinline__ void stage_kv(Frame& F, int b, int hc) {
    const int tid = F.tid; unsigned char* ws = F.ws; LAS unsigned char* lds = F.lds;
    { const int row = tid >> 1, half = tid & 1; const bf16* src = (const bf16*)(ws + WS_KVMK) + (size_t)(b * 256 + row) * 512 + hc * 128 + half * 64;
      v4u v[8]; float ss = 0.f;
#pragma unroll
      for (int c = 0; c < 8; ++c) { v[c] = *(const GAS v4u*)(src + 8 * c); ss += sumsq8(v[c]); }
      ss += __shfl_xor(ss, 1);
      const float rstd = 1.0f / sqrtf(ss * (1.f / 128.f) + EPS); const float* gk = F.in[I_GKC] + half * 64;
#pragma unroll
      for (int c = 0; c < 8; ++c) { v4u o;
#pragma unroll
          for (int i = 0; i < 4; ++i) o[i] = pk2(bflo(v[c][i]) * rstd * gk[8 * c + 2 * i], bfhi(v[c][i]) * rstd * gk[8 * c + 2 * i + 1]);
          *(LAS v4u*)(lds + row * 256 + (((half * 8 + c) ^ (row & 15)) << 4)) = o; } }
    { const bf16* src = (const bf16*)(ws + WS_VTG) + (size_t)(b * 4 + hc) * 128 * 256;
#pragma unroll
      for (int i = 0; i < 8; ++i) { const int q = tid + 512 * i, d = q >> 5, ch = q & 31; const v4u v = *(const GAS v4u*)(src + (size_t)q * 8);
          *(LAS v4u*)(lds + 65536 + d * 512 + ((ch ^ (d & 15)) << 4)) = v; } }
}
__device__ __forceinline__ void unit(Frame& F, int b, int hc, int qb) {
    const int lane = F.lane, r32 = lane & 31, hi = lane >> 5, wid = F.wave; unsigned char* ws = F.ws; LAS unsigned char* lds = F.lds;
    LAS float* wsf = (LAS float*)(lds + LX_XWS) + wid * 64;
    const size_t row = (size_t)b * SEQ + qb * 256 + wid * 32 + r32;
    bf16x8 qr[8];
    { const bf16* qsrc = (const bf16*)(ws + WS_QX) + row * 512 + hc * 128 + hi * 8; v4u qv[8]; float ss = 0.f;
#pragma unroll
      for (int d0 = 0; d0 < 8; ++d0) { qv[d0] = *(const GAS v4u*)(qsrc + 16 * d0); ss += sumsq8(qv[d0]); }
      ss += __shfl_xor(ss, 32);
      const float rn = C2_X / sqrtf(ss * (1.f / 128.f) + EPS); const float* gq = F.in[I_GQC] + hi * 8;
#pragma unroll
      for (int d0 = 0; d0 < 8; ++d0) { v4u o;
#pragma unroll
          for (int i = 0; i < 4; ++i) o[i] = pk2(bflo(qv[d0][i]) * rn * gq[16 * d0 + 2 * i], bfhi(qv[d0][i]) * rn * gq[16 * d0 + 2 * i + 1]);
          qr[d0] = __builtin_bit_cast(bf16x8, o); } }
    f32x16 o[4];
#pragma unroll
    for (int i = 0; i < 4; ++i) o[i] = f32x16{};
    float mrun = -1e30f, lrun = 0.f;
#pragma unroll 1
    for (int tt = 0; tt < 4; ++tt) {
        f32x16 p0 = f32x16{}, p1 = f32x16{};
        const int kr0 = 64 * tt + r32, kr1 = kr0 + 32;
#pragma unroll
        for (int d0 = 0; d0 < 8; ++d0) {
            const bf16x8 k0 = *(const LAS bf16x8*)(lds + kr0 * 256 + (((2 * d0 + hi) ^ (kr0 & 15)) << 4));
            const bf16x8 k1 = *(const LAS bf16x8*)(lds + kr1 * 256 + (((2 * d0 + hi) ^ (kr1 & 15)) << 4));
            p0 = __builtin_amdgcn_mfma_f32_32x32x16_bf16(k0, qr[d0], p0, 0, 0, 0);
            p1 = __builtin_amdgcn_mfma_f32_32x32x16_bf16(k1, qr[d0], p1, 0, 0, 0);
        }
        float rm = fmaxf(p0[0], p1[0]);
#pragma unroll
        for (int r = 1; r < 16; ++r) rm = fmaxf(rm, fmaxf(p0[r], p1[r]));
        rm = fmaxf(rm, __shfl_xor(rm, 32));
        const float mnew = fmaxf(mrun, rm), sc = __builtin_amdgcn_exp2f(mrun - mnew); mrun = mnew;
        float ps = 0.f;
#pragma unroll
        for (int r = 0; r < 16; ++r) { p0[r] = __builtin_amdgcn_exp2f(p0[r] - mnew); p1[r] = __builtin_amdgcn_exp2f(p1[r] - mnew); ps += p0[r] + p1[r]; }
        lrun = lrun * sc + ps;
        if (hi == 0) wsf[r32] = sc;
        LDS_WAIT();
#pragma unroll
        for (int d = 0; d < 4; ++d)
#pragma unroll
            for (int r = 0; r < 16; ++r) o[d][r] *= wsf[crow(r, hi)];
        v4u pw[4];
#pragma unroll
        for (int i = 0; i < 4; ++i) { pw[0][i] = pk2(p0[2 * i], p0[2 * i + 1]); pw[1][i] = pk2(p0[8 + 2 * i], p0[9 + 2 * i]); pw[2][i] = pk2(p1[2 * i], p1[2 * i + 1]); pw[3][i] = pk2(p1[8 + 2 * i], p1[9 + 2 * i]); }
#pragma unroll
        for (int ks = 0; ks < 4; ++ks) { const int ch = 2 * (4 * tt + ks) + hi; const bf16x8 pa = __builtin_bit_cast(bf16x8, pw[ks]);
#pragma unroll
            for (int d = 0; d < 4; ++d) { const int dr = r32 + 32 * d; const bf16x8 vf = *(const LAS bf16x8*)(lds + 65536 + dr * 512 + ((ch ^ (dr & 15)) << 4));
                o[d] = __builtin_amdgcn_mfma_f32_32x32x16_bf16(pa, vf, o[d], 0, 0, 0); } }
        LDS_WAIT();
    }
    lrun += __shfl_xor(lrun, 32);
    if (hi == 0) wsf[32 + r32] = lrun;
    LDS_WAIT();
    bf16* orow = (bf16*)(ws + WS_CO) + ((size_t)b * SEQ + qb * 256 + wid * 32) * 512 + hc * 128 + r32;
#pragma unroll
    for (int r = 0; r < 16; ++r) { const int qrow = crow(r, hi); const float rl = 1.0f / wsf[32 + qrow];
#pragma unroll
        for (int d = 0; d < 4; ++d) orow[(size_t)qrow * 512 + 32 * d] = (bf16)f2bf(o[d][r] * rl); }
    LDS_WAIT();
}
}

__device__ __forceinline__ void router_tile(Frame& F, int t0, int lt0) {
    const int lane = F.lane, tok = lane & 31, kk = lane >> 5; unsigned char* ws = F.ws; LAS unsigned char* lds = F.lds;
    const LAS float* wr = (const LAS float*)(lds + RING_OFF);
    const float* xrow = F.in[I_X] + (size_t)(t0 + tok) * 1024 + 8 * kk;
    const bf16* drow = (const bf16*)(ws + WS_DELTA) + (size_t)(t0 + tok) * 1024 + 8 * kk;
    unsigned char* hrow = ws + WS_HN2 + (size_t)(t0 + tok) * 1024 + 8 * kk;
    f32x16 acc = f32x16{}; float ss = 0.f;
    constexpr int PD = 8;
    f32x4 ra[PD], rb[PD]; v4u rd[PD];
#pragma unroll
    for (int p = 0; p < PD; ++p) { ra[p] = *(const GAS f32x4*)(xrow + 16 * p); rb[p] = *(const GAS f32x4*)(xrow + 16 * p + 4); rd[p] = *(const GAS v4u*)(drow + 16 * p); }
#pragma unroll 1
    for (int q0 = 0; q0 < 64; q0 += PD) {
#pragma unroll
        for (int p = 0; p < PD; ++p) {
            const int q = q0 + p; f32x4 a = ra[p], b = rb[p]; const v4u dd = rd[p];
            a.x += bflo(dd.x); a.y += bfhi(dd.x); a.z += bflo(dd.y); a.w += bfhi(dd.y); b.x += bflo(dd.z); b.y += bfhi(dd.z); b.z += bflo(dd.w); b.w += bfhi(dd.w);
            if (q0 + PD < 64) { ra[p] = *(const GAS f32x4*)(xrow + 16 * (q + PD)); rb[p] = *(const GAS f32x4*)(xrow + 16 * (q + PD) + 4); rd[p] = *(const GAS v4u*)(drow + 16 * (q + PD)); }
            ss += (a.x * a.x + a.y * a.y) + (a.z * a.z + a.w * a.w) + (b.x * b.x + b.y * b.y) + (b.z * b.z + b.w * b.w);
            const LAS float* wq = wr + (16 * q + 8 * kk) * 32 + tok;
            acc = __builtin_amdgcn_mfma_f32_32x32x2f32(wq[0 * 32], a.x, acc, 0, 0, 0); acc = __builtin_amdgcn_mfma_f32_32x32x2f32(wq[1 * 32], a.y, acc, 0, 0, 0);
            acc = __builtin_amdgcn_mfma_f32_32x32x2f32(wq[2 * 32], a.z, acc, 0, 0, 0); acc = __builtin_amdgcn_mfma_f32_32x32x2f32(wq[3 * 32], a.w, acc, 0, 0, 0);
            acc = __builtin_amdgcn_mfma_f32_32x32x2f32(wq[4 * 32], b.x, acc, 0, 0, 0); acc = __builtin_amdgcn_mfma_f32_32x32x2f32(wq[5 * 32], b.y, acc, 0, 0, 0);
            acc = __builtin_amdgcn_mfma_f32_32x32x2f32(wq[6 * 32], b.z, acc, 0, 0, 0); acc = __builtin_amdgcn_mfma_f32_32x32x2f32(wq[7 * 32], b.w, acc, 0, 0, 0);
            v2u o; o.x = pk4_fp8(a.x * SX8, a.y * SX8, a.z * SX8, a.w * SX8); o.y = pk4_fp8(b.x * SX8, b.y * SX8, b.z * SX8, b.w * SX8);
            *(GAS v2u*)(hrow + 16 * q) = o;
        }
    }
    ss += __shfl_xor(ss, 32);
    const float rstd = 1.0f / sqrtf(ss * (1.f / 1024.f) + EPS);
    if (kk == 0) ((float*)(ws + WS_RSTD2))[t0 + tok] = rstd;
    const float* br = F.in[I_BR];
    float lg[16];
#pragma unroll
    for (int r = 0; r < 16; ++r) lg[r] = acc[r] * rstd + br[xat::crow(r, kk)];
    float tv[4]; int ti[4];
#pragma unroll
    for (int k = 0; k < 4; ++k) { float best = lg[0]; int bi = 0;
#pragma unroll
        for (int r = 1; r < 16; ++r) { const bool gt = lg[r] > best; best = gt ? lg[r] : best; bi = gt ? r : bi; }
        tv[k] = best; ti[k] = xat::crow(bi, kk);
#pragma unroll
        for (int r = 0; r < 16; ++r) lg[r] = (r == bi) ? -INFINITY : lg[r]; }
    float cv[8]; int ci[8];
#pragma unroll
    for (int k = 0; k < 4; ++k) { cv[k] = tv[k]; ci[k] = ti[k]; cv[4 + k] = __shfl_xor(tv[k], 32); ci[4 + k] = __shfl_xor(ti[k], 32); }
    float gv[4]; int ge[4];
#pragma unroll
    for (int k = 0; k < 4; ++k) { float best = cv[0]; int be = ci[0], bj = 0;
#pragma unroll
        for (int j = 1; j < 8; ++j) { const bool gt = (cv[j] > best) || (cv[j] == best && ci[j] < be); best = gt ? cv[j] : best; be = gt ? ci[j] : be; bj = gt ? j : bj; }
        gv[k] = best; ge[k] = be;
#pragma unroll
        for (int j = 0; j < 8; ++j) cv[j] = (j == bj) ? -INFINITY : cv[j]; }
    float ex[4], es = 0.f;
#pragma unroll
    for (int k = 0; k < 4; ++k) { ex[k] = __expf(gv[k] - gv[0]); es += ex[k]; }
    const float ies = 1.0f / es;
    if (kk == 0) {
        LAS int* lcnt = (LAS int*)(lds + LX_LCNT); LAS int* stash = (LAS int*)(lds + LX_STASH); LAS float* gst = (LAS float*)(lds + LX_GATE);
#pragma unroll
        for (int k = 0; k < 4; ++k) { const int li = __hip_atomic_fetch_add(lcnt + ge[k], 1, __ATOMIC_RELAXED, __HIP_MEMORY_SCOPE_WORKGROUP);
            stash[(lt0 + tok) * 4 + k] = ge[k] | (li << 8); gst[(lt0 + tok) * 4 + k] = ex[k] * ies; }
    }
}

__device__ __forceinline__ void p7_router(Frame& F) {
    const int lane = F.lane, tid = F.tid; unsigned char* ws = F.ws; LAS unsigned char* lds = F.lds;
    {
        LAS float* scr = (LAS float*)(lds + RING_OFF + F.wave * 16384);
        const int gw = F.vcu * NWAVES + F.wave, NGW = F.G * NWAVES;
        constexpr int IE1 = 16 * 64, IE2 = 16 * 32;
        for (int it = gw; it < NEXP * (IE1 + IE2); it += NGW) {
            const int e = it / (IE1 + IE2); int r = it - e * (IE1 + IE2);
            if (r < IE1) { const int kb = r >> 6, nb = r & 63, n0 = nb * 32, src = ((n0 >> 7) & 1) * 1024 + (n0 >> 8) * 128 + (n0 & 127);
                transpose_item8(F.in[I_WEI] + (size_t)e * 1024 * 2048, 2048, src, F.in[I_GFFN], SW8, ws + WS_WEI + (size_t)e * 2048 * 1024, 1024, n0, kb * 64, scr, lane); }
            else { r -= IE1; const int kb = r >> 5, nb = r & 31;
                transpose_item8(F.in[I_WEO] + (size_t)e * 1024 * 1024, 1024, nb * 32, nullptr, SW8, ws + WS_WEO + (size_t)e * 1024 * 1024, 1024, nb * 32, kb * 64, scr, lane); }
        }
    }
    __syncthreads();
    { const float* wr = F.in[I_WR]; const float* g = F.in[I_GFFN];
      for (int i = tid; i < 8192; i += NWAVES * 64) { const f32x4 v = *(const GAS f32x4*)(wr + 4 * i); const float gg = g[i >> 3]; *(LAS f32x4*)(lds + RING_OFF + 16 * i) = v * gg; } }
    __syncthreads();
    LAS int* lcnt = (LAS int*)(lds + LX_LCNT); LAS int* lbase = (LAS int*)(lds + LX_BASE); LAS int* stash = (LAS int*)(lds + LX_STASH); LAS float* gst = (LAS float*)(lds + LX_GATE);
    for (int chunk = F.vcu; chunk < T / 256; chunk += F.G) {
        if (tid < NEXP) lcnt[tid] = 0;
        __syncthreads();
        router_tile(F, chunk * 256 + F.wave * 32, F.wave * 32);
        __syncthreads();
        if (tid < NEXP) lbase[tid] = (int)__hip_atomic_fetch_add((unsigned*)(F.ctl + CW_GCNT + 64 * tid), (unsigned)lcnt[tid], RLX_AGENT);
        __syncthreads();
        for (int idx = tid; idx < 1024; idx += NWAVES * 64) { const int st = stash[idx], e = st & 255, pos = lbase[e] + (st >> 8), ent = (chunk * 256 + (idx >> 2)) * 4 + (idx & 3);
            if (pos < LISTCAP) ((int*)(ws + WS_LIST))[(size_t)e * LISTCAP + pos] = ent;
            ((float*)(ws + WS_TOKG))[ent] = gst[idx]; }
        __syncthreads();
    }
}
__device__ __forceinline__ int moe_setup(Frame& F) {
    LAS int* tstart = (LAS int*)(F.lds + LX_TSTART); LAS int* cnt = (LAS int*)(F.lds + LX_CNT);
    if (F.tid == 0) { int acc = 0;
        for (int e = 0; e < NEXP; ++e) { int c = (int)__hip_atomic_load((unsigned*)(F.ctl + CW_GCNT + 64 * e), RLX_AGENT); c = c < LISTCAP ? c : LISTCAP; cnt[e] = c; tstart[e] = acc; acc += (c + 255) >> 8; }
        tstart[NEXP] = acc < ACT_TILES_MAX ? acc : ACT_TILES_MAX; }
    __syncthreads();
    return __builtin_amdgcn_readfirstlane(tstart[NEXP]);
}

struct Args { const float* in[N_IN]; float* out; unsigned char* ws; int ph_lo, ph_hi, li, pad; };
__global__ void __launch_bounds__(NWAVES * 64, 2) fwd_kernel(Args args) {
    extern __shared__ __attribute__((aligned(16))) unsigned char lds[];
    Frame F;
    F.lds = (LAS unsigned char*)lds;
    F.MISC = (volatile LAS unsigned*)(F.lds + MISC_OFF);
    F.tid = threadIdx.x; F.lane = F.tid & 63; F.wave = __builtin_amdgcn_readfirstlane(F.tid >> 6);
    F.G = gridDim.x; { const int bx = blockIdx.x; F.vcu = (F.G % 8 == 0) ? (bx % 8) * (F.G / 8) + bx / 8 : bx; }
    F.ws = args.ws; F.out = args.out; F.in = args.in;
    unsigned char* ws = args.ws;
    F.ctl = (gu32*)(ws + WS_CTL);
    for (int u = F.tid; u < (LDS_BYTES - LDSCTL_OFF) / 4; u += NWAVES * 64) ((LAS unsigned*)(F.lds + LDSCTL_OFF))[u] = 0u;
    __syncthreads();
    XcdBarrier bar; bar.bar = (unsigned*)(F.ctl + CW_BAR); bar.x = 0; bar.st = nullptr;
    if (N_LAUNCHES != PER_PHASE) bar = xcd_barrier_post((unsigned*)(F.ctl + CW_BAR), F.MISC + 8, F.tid == 0);
#define GRID_BAR(seam) do { if (N_LAUNCHES == PER_PHASE) { if (F.tid == 0) __hip_atomic_store(F.ctl + CW_TMO, 0xBADBA0u | (unsigned)(seam), RLX_AGENT); } else { xcd_barrier(bar, F.tid == 0); } } while (0)
    const int lo = args.ph_lo, hi = args.ph_hi;
#ifndef MK_PHASE_MASK
#define MK_PHASE_MASK 0x7ff
#endif
#define IN(k) (((MK_PHASE_MASK >> (k)) & 1) && lo <= (k) && (k) < hi)
#define BOTH(k) (IN(k) && IN((k) + 1))
    const int gw = F.vcu * NWAVES + F.wave, NGW = F.G * NWAVES;

    if (IN(0)) { REFRESH(F); for (int rep = 0; rep < MK_REP0; ++rep) p0_prologue(F); if (BOTH(0)) GRID_BAR(0); }

    if (IN(1)) { REFRESH(F);
        DenseSched S; S.init(ws + WS_HN, 1024, ws + WS_W1T, 1024, T, N1, F.G, (int)blockIdx.x);
        EpiP1 E{(bf16_t*)(ws + WS_U), (bf16_t*)(ws + WS_CQKV), (bf16_t*)(ws + WS_QX), ws + WS_GATES};
        for (int rep = 0; rep < MK_REP1; ++rep) pg8::gemm_phase<EpiP1, DenseSched>(F.lds + RING_OFF, F.tid, 1024, 1024, 1024, S, E);
        if (BOTH(1)) GRID_BAR(1);
    }

    if (IN(2)) { REFRESH(F);
        for (int rep = 0; rep < MK_REP2; ++rep) {
        { DenseSched S; S.init(ws + WS_CQKV, 768, ws + WS_WUQ, 384, T, 768, F.G, (int)blockIdx.x);
          EpiStore E{(bf16_t*)(ws + WS_Q), 768};
          pg8::gemm_phase<EpiStore, DenseSched>(F.lds + RING_OFF, F.tid, 384, 768, 384, S, E); }
        { DenseSched S; S.init(ws + WS_CQKV + 384 * 2, 768, ws + WS_WUKV, 256, T, 1024, F.G, (int)blockIdx.x);
          EpiStore E{(bf16_t*)(ws + WS_KV), 1024};
          pg8::gemm_phase<EpiStore, DenseSched>(F.lds + RING_OFF, F.tid, 256, 768, 256, S, E); }
        { DenseSched S; S.init(ws + WS_MEMN, 1024, ws + WS_WMEM, 1024, MROWS, 1024, F.G, (int)blockIdx.x);
          EpiMemKV E{(bf16_t*)(ws + WS_KVMK), (bf16_t*)(ws + WS_VTG)};
          pg8::gemm_phase<EpiMemKV, DenseSched>(F.lds + RING_OFF, F.tid, 1024, 1024, 1024, S, E); }
        }
        if (BOTH(2)) GRID_BAR(2);
    }

    if (IN(3)) { REFRESH(F);
        const int per = T / NGW;
        if (per * NGW == T && (per & 1) == 0) { for (int i = 0; i < per; i += 2) p3_tokens<2>(F, gw * per + i); }
        else { for (int t = gw; t < T; t += NGW) p3_tokens<1>(F, t); }
        if (BOTH(3)) GRID_BAR(3);
    }

    if (IN(4)) { for (int rep4 = 0; rep4 < MK_REP4; ++rep4) { REFRESH(F);
#ifndef NO_MLA
        for (int vv = F.vcu; vv < 256 * MK_REPMLA; vv += F.G) {
            const int bh = (vv & 255) >> 1, s = vv & 1;
            for (int i = 0; i < 8; ++i) { const int j2 = (i >> 1) * 2 + s, qb = (i & 1) ? 15 - j2 : j2;
                mla::attn_unit<8>(F.tid, bh >> 3, bh & 7, qb, (const mla::bf16*)(ws + WS_Q), (const mla::bf16*)(ws + WS_KV), (const mla::bf16*)(ws + WS_V), (mla::bf16*)(ws + WS_AO), (char*)lds + RING_OFF); }
        }
#endif
        __syncthreads();
        REFRESH(F);
#ifndef NO_XAT
        for (int vv = F.vcu; vv < 256 * MK_REPX; vv += F.G) {
            const int b = (vv & 255) >> 4, hc = (vv >> 2) & 3;
            xat::stage_kv(F, b, hc);
            __syncthreads();
            for (int i = 0; i < 4; ++i) xat::unit(F, b, hc, (vv & 3) * 4 + i);
            __syncthreads();
        }
#endif
        }
        if (BOTH(4)) GRID_BAR(4);
    }

    if (IN(5)) { REFRESH(F);
        MergeSched S; S.G = F.G; S.c = (int)blockIdx.x;
        S.A0 = (const char*)(ws + WS_MIXED); S.dA1 = (long)WS_AO - (long)WS_MIXED; S.dA2 = (long)WS_CO - (long)WS_MIXED;
        S.B0 = (const char*)(ws + WS_WPOOL); S.dB1 = (long)WS_WMO - (long)WS_WPOOL; S.dB2 = (long)WS_WCO - (long)WS_WPOOL;
        EpiMerge E{ws + WS_GATES, (bf16_t*)(ws + WS_MERGED)};
        for (int rep = 0; rep < MK_REP5; ++rep) pg8::gemm_phase<EpiMerge, MergeSched>(F.lds + RING_OFF, F.tid, 512, 512, 512, S, E);
        if (BOTH(5)) GRID_BAR(5);
    }

    if (IN(6)) { REFRESH(F);
        DenseSched S; S.init(ws + WS_MERGED, 1024, ws + WS_WO, 1024, T, 1024, F.G, (int)blockIdx.x);
        EpiStore E{(bf16_t*)(ws + WS_DELTA), 1024};
        for (int rep = 0; rep < MK_REP6; ++rep) pg8::gemm_phase<EpiStore, DenseSched>(F.lds + RING_OFF, F.tid, 1024, 1024, 1024, S, E);
        if (BOTH(6)) GRID_BAR(6);
    }

    if (IN(7)) { REFRESH(F); p7_router(F); if (BOTH(7)) GRID_BAR(7); }

    if (IN(8)) { REFRESH(F);
        const int ntiles = moe_setup(F);
        MoeSched S; S.G = F.G; S.c = (int)blockIdx.x; S.nM = ntiles; S.nN = 8; S.tstart = (const LAS int*)(F.lds + LX_TSTART); S.cnt = (const LAS int*)(F.lds + LX_CNT);
        S.list = (const int*)(ws + WS_LIST); S.A = (const char*)(ws + WS_HN2); S.B = (const char*)(ws + WS_WEI); S.bexp = (size_t)2048 * 1024; S.tB = (size_t)256 * 1024; S.tA = 0; S.gather = true;
        EpiMoeIn E{S.cnt, S.list, (const float*)(ws + WS_RSTD2), F.in[I_BEI], ws + WS_ACT};
        for (int rep = 0; rep < MK_REP8; ++rep) pg8::gemm_phase_f8<EpiMoeIn, MoeSched, true>(F.lds + RING_OFF, F.tid, 1024, 1024, 1024, S, E);
        if (BOTH(8)) GRID_BAR(8);
    }

    if (IN(9)) { REFRESH(F);
        const int ntiles = moe_setup(F);
        MoeSched S; S.G = F.G; S.c = (int)blockIdx.x; S.nM = ntiles; S.nN = 4; S.tstart = (const LAS int*)(F.lds + LX_TSTART); S.cnt = (const LAS int*)(F.lds + LX_CNT);
        S.list = (const int*)(ws + WS_LIST); S.A = (const char*)(ws + WS_ACT); S.B = (const char*)(ws + WS_WEO); S.bexp = (size_t)1024 * 1024; S.tB = (size_t)256 * 1024; S.tA = (size_t)256 * 1024; S.gather = false;
        EpiMoeOut E{S.cnt, S.list, (const float*)(ws + WS_TOKG), F.in[I_BEO], (bf16_t*)(ws + WS_Y)};
        pg8::gemm_phase_f8<EpiMoeOut, MoeSched, false>(F.lds + RING_OFF, F.tid, 1024, 1024, 1024, S, E);
        if (BOTH(9)) GRID_BAR(9);
    }

    if (IN(10)) { REFRESH(F);
        for (int t0 = gw; t0 < T; t0 += 2 * NGW) {
            f32x4 v[2][4]; v2u w[2][5][4];
#pragma unroll
            for (int r = 0; r < 2; ++r) { const int t = t0 + r * NGW; if (t < T) {
                const GAS f32x4* xi = (const GAS f32x4*)(F.in[I_X] + (size_t)t * 1024) + F.lane; const GAS v2u* y = (const GAS v2u*)((const bf16*)(ws + WS_Y) + (size_t)t * 4096) + F.lane;
                const GAS v2u* dl = (const GAS v2u*)((const bf16*)(ws + WS_DELTA) + (size_t)t * 1024) + F.lane;
#pragma unroll
                for (int j = 0; j < 4; ++j) { v[r][j] = xi[64 * j]; w[r][4][j] = dl[64 * j];
#pragma unroll
                    for (int s4 = 0; s4 < 4; ++s4) w[r][s4][j] = y[s4 * 256 + 64 * j]; } } }
#pragma unroll
            for (int r = 0; r < 2; ++r) { const int t = t0 + r * NGW; if (t < T) {
                GAS f32x4* o = (GAS f32x4*)(F.out + (size_t)t * 1024) + F.lane;
#pragma unroll
                for (int j = 0; j < 4; ++j) { f32x4 x = v[r][j];
#pragma unroll
                    for (int s5 = 0; s5 < 5; ++s5) { const v2u ww = w[r][s5][j]; x.x += bflo(ww.x); x.y += bfhi(ww.x); x.z += bflo(ww.y); x.w += bfhi(ww.y); }
                    o[64 * j] = x; } } }
        }
    }
#undef IN
#undef BOTH
#undef GRID_BAR
}

extern "C" void kernel_launch(void* const* d_in, const int* in_sizes, int n_in, void* d_out, int out_size, void* d_ws, size_t ws_size, hipStream_t stream) {
    static int grid = 0;
    if (grid == 0) {
        if (n_in != N_IN || in_sizes[0] != T * D || out_size != T * D || ws_size < WS_END) { fprintf(stderr, "kernel_launch: unexpected shapes (n_in %d, in0 %d, out %d, ws %zu); nothing launched\n", n_in, n_in > 0 ? in_sizes[0] : -1, out_size, ws_size); grid = -1; return; }
        int dev = 0, cus = 0, per_cu = 0;
        if (hipGetDevice(&dev) != hipSuccess || hipDeviceGetAttribute(&cus, hipDeviceAttributeMultiprocessorCount, dev) != hipSuccess) { grid = -1; return; }
        if (hipFuncSetAttribute((const void*)fwd_kernel, hipFuncAttributeMaxDynamicSharedMemorySize, LDS_BYTES) != hipSuccess) { fprintf(stderr, "kernel_launch: hipFuncSetAttribute failed\n"); grid = -1; return; }
        if (hipOccupancyMaxActiveBlocksPerMultiprocessor(&per_cu, (const void*)fwd_kernel, NWAVES * 64, LDS_BYTES) != hipSuccess || per_cu < 1)
            fprintf(stderr, "kernel_launch: note: occupancy query reports %d workgroups per CU\n", per_cu);
        (void)hipGetLastError();
        grid = cus;
    }
    if (grid < 0) return;
    if (hipMemsetAsync((char*)d_ws + WS_CTL, 0, CTL_ZERO_BYTES, stream) != hipSuccess) { fprintf(stderr, "kernel_launch: hipMemsetAsync failed\n"); return; }
    Args a{};
    for (int i = 0; i < N_IN; ++i) a.in[i] = (const float*)d_in[i];
    a.out = (float*)d_out; a.ws = (unsigned char*)d_ws;
    const int last = MK_LAST_PHASE;
    if (N_LAUNCHES == PER_PHASE) {
        for (int li = 0; li < last; ++li) { a.ph_lo = li; a.ph_hi = li + 1; a.li = li; hipLaunchKernelGGL(fwd_kernel, dim3(grid), dim3(NWAVES * 64), LDS_BYTES, stream, a); }
    } else {
        a.ph_lo = 0; a.ph_hi = last; a.li = 0; hipLaunchKernelGGL(fwd_kernel, dim3(grid), dim3(NWAVES * 64), LDS_BYTES, stream, a);
    }
    const hipError_t le = hipPeekAtLastError();
    if (le != hipSuccess) fprintf(stderr, "kernel_launch: launch failed: %s\n", hipGetErrorName(le));
}
```

```cpp
#include <hip/hip_runtime.h>
#include <hip/hip_bf16.h>
#include <cstdio>
#include <cstdint>

#ifndef MK_N_LAUNCHES
#define MK_N_LAUNCHES 1
#endif
#ifndef MK_REP1
#define MK_REP1 1
#endif
#ifndef MK_REP4
#define MK_REP4 1
#endif
#ifndef MK_REP5
#define MK_REP5 1
#endif
#ifndef MK_REP6
#define MK_REP6 1
#endif
#ifndef MK_REP8
#define MK_REP8 1
#endif
#ifndef MK_REP9
#define MK_REP9 1
#endif
#ifndef MK_REP10
#define MK_REP10 1
#endif
#ifndef MK_REPCV
#define MK_REPCV 1
#endif
#ifndef MK_REPMLA
#define MK_REPMLA 1
#endif
#ifndef MK_REP0
#define MK_REP0 1
#endif
#ifndef MK_REP2
#define MK_REP2 1
#endif
#ifndef MK_REPX
#define MK_REPX 1
#endif
#ifndef MK_MMAPRIO
#define MK_MMAPRIO 0
#endif
#ifndef MK_LAST_PHASE
#define MK_LAST_PHASE 11
#endif

namespace pg8 {
#define PG8_LAS __attribute__((address_space(3)))
typedef unsigned short bf16_t;
typedef short bf16x8 __attribute__((ext_vector_type(8)));
typedef float f32x4 __attribute__((ext_vector_type(4)));
typedef unsigned u32x4 __attribute__((ext_vector_type(4)));
typedef unsigned u32x2 __attribute__((ext_vector_type(2)));
constexpr int BM = 256, BK = 64, HALF = 128, HTB = HALF * BK * 2, STAGE_BYTES = 8 * HTB, NXCD = 8, WGM = 8;

__host__ __device__ __forceinline__ int lds_byte(int r, int c) { const int st = (r >> 4) * 2 + (c >> 5), rr = r & 15, cc = c & 31, ob = rr * 64 + cc * 2; return st * 1024 + (ob ^ (((ob >> 9) & 1) << 5)); }
__host__ __device__ __forceinline__ void stage_rc(int b, int& R, int& C) { const int st = b / 1024, sb = b % 1024, swz = sb ^ (((sb >> 9) & 1) << 5); R = (st >> 1) * 16 + swz / 64; C = (st & 1) * 32 + (swz % 64) / 2; }
__host__ __device__ __forceinline__ int perm32(int rho) { const int n = rho >> 4, i = rho & 15; return 8 * (i >> 2) + 4 * n + (i & 3); }

struct Unit { int pm, pn; const char* A; const char* B; int aux; };

__device__ __forceinline__ void tile_order(int L, int nM, int nN, int& pm, int& pn) {
    const int nwg = nM * nN; int wgid = L;
    { const int q = nwg / NXCD, r = nwg % NXCD, xcd = wgid % NXCD, off = wgid / NXCD; wgid = (xcd < r ? xcd * (q + 1) : r * (q + 1) + (xcd - r) * q) + off; }
    const int nig = WGM * nN, gid = wgid / nig, fm = gid * WGM, gsz = (nM - fm) < WGM ? (nM - fm) : WGM;
    pm = fm + ((wgid % nig) % gsz); pn = (wgid % nig) / gsz;
}

__device__ __forceinline__ unsigned cvt_pk_bf16(float lo, float hi) { unsigned r; asm volatile("v_cvt_pk_bf16_f32 %0, %1, %2" : "=v"(r) : "v"(lo), "v"(hi)); return r; }
__device__ __forceinline__ float bf_lo(unsigned w) { return __uint_as_float(w << 16); }
__device__ __forceinline__ float bf_hi(unsigned w) { return __uint_as_float(w & 0xffff0000u); }
__device__ __forceinline__ float sigmoidf_fast(float x) { return __builtin_amdgcn_rcpf(1.0f + __builtin_amdgcn_exp2f(-1.4426950408889634f * x)); }

template <class Epi, class Sched, bool GATHER = false, bool ALIGN_EPI = true>
__device__ __forceinline__ void gemm_phase(PG8_LAS unsigned char* lds, const int tid, const int K, const int lda, const int ldb, const Sched& S, const Epi& E) {
    const int wid = __builtin_amdgcn_readfirstlane(tid >> 6), lane = tid & 63, wr = wid >> 2, wc = wid & 3, fr = lane & 15, fq = lane >> 4;
    const int nt = K / BK;
    int RA[2], CA[2]; unsigned voffB[2];
#pragma unroll
    for (int i = 0; i < 2; ++i) { int R, C; stage_rc(tid * 16 + i * 8192, R, C); const int Rb = Epi::PERM ? ((R & ~31) + perm32(R & 31)) : R;
        RA[i] = R; CA[i] = C; voffB[i] = (unsigned)(Rb * ldb + C) * 2u; }
    const size_t kstep = (size_t)(BK * 2);
    const size_t hstepB = (size_t)HALF * ldb * 2;
    const unsigned ldsw = (unsigned)wid * 1024u;
    const int aoff = lds_byte(wr * 64 + fr, fq * 8), boff = lds_byte(wc * 32 + fr, fq * 8);
#define PG8_SA(b, h) (((b) * 2 + (h)) * HTB)
#define PG8_SB(b, h) ((4 + (b) * 2 + (h)) * HTB)
#define PG8_STAGE2(bufoff, gbase, o0, o1) do { \
        __builtin_amdgcn_global_load_lds((const unsigned*)((const char*)(gbase) + (o0)), (PG8_LAS unsigned*)(lds + (bufoff) + ldsw), 16, 0, 0); \
        __builtin_amdgcn_global_load_lds((const unsigned*)((const char*)(gbase) + (o1)), (PG8_LAS unsigned*)(lds + (bufoff) + ldsw + 8192), 16, 0, 0); } while (0)
#define PG8_STAGEB(bufoff, gbase) PG8_STAGE2(bufoff, gbase, voffB[0], voffB[1])
#define PG8_STAGEA(bufoff, gbase, OFF, h) PG8_STAGE2(bufoff, gbase, OFF[h][0], OFF[h][1])
#define PG8_LDA(dst, b, h) do { _Pragma("unroll") for (int m = 0; m < 4; ++m) _Pragma("unroll") for (int k = 0; k < 2; ++k) dst[m][k] = *(const PG8_LAS bf16x8*)(lds + PG8_SA(b, h) + aoff + m * 2048 + k * 1024); } while (0)
#define PG8_LDB(dst, b, h) do { _Pragma("unroll") for (int n = 0; n < 2; ++n) _Pragma("unroll") for (int k = 0; k < 2; ++k) dst[n][k] = *(const PG8_LAS bf16x8*)(lds + PG8_SB(b, h) + boff + n * 2048 + k * 1024); } while (0)
#define PG8_MMA(ai, bj, At, Bt) do { __builtin_amdgcn_s_setprio(MK_MMAPRIO); _Pragma("unroll") for (int m = 0; m < 4; ++m) _Pragma("unroll") for (int n = 0; n < 2; ++n) _Pragma("unroll") for (int k = 0; k < 2; ++k) \
        acc[ai][bj][m][n] = __builtin_amdgcn_mfma_f32_16x16x32_bf16(Bt[n][k], At[m][k], acc[ai][bj][m][n], 0, 0, 0); __builtin_amdgcn_s_setprio(0); } while (0)
#define PG8_WAIT_V(n) asm volatile("s_waitcnt vmcnt(" #n ")" ::: "memory")
#define PG8_WAIT_L(n) asm volatile("s_waitcnt lgkmcnt(" #n ")" ::: "memory")
#define PG8_BAR __builtin_amdgcn_s_barrier()
#define PG8_SCHED __builtin_amdgcn_sched_barrier(0)
    Unit cur, nxt; int ui = 0;
    if (!S.next(0, cur)) return;
    f32x4 acc[2][2][4][2];
#pragma unroll
    for (int a = 0; a < 2; ++a)
#pragma unroll
        for (int b = 0; b < 2; ++b)
#pragma unroll
            for (int m = 0; m < 4; ++m)
#pragma unroll
                for (int n = 0; n < 2; ++n) acc[a][b][m][n] = (f32x4){0.f, 0.f, 0.f, 0.f};
    bf16x8 At[4][2], B0[2][2], B1[2][2];
    unsigned cOff[2][2], nOff[2][2];
#pragma unroll
    for (int h = 0; h < 2; ++h)
#pragma unroll
        for (int i = 0; i < 2; ++i) {
            if constexpr (GATHER) cOff[h][i] = S.row_off(cur, h * HALF + RA[i]) + (unsigned)CA[i] * 2u;
            else cOff[h][i] = (unsigned)((h * HALF + RA[i]) * lda + CA[i]) * 2u;
            nOff[h][i] = cOff[h][i];
        }
    const char* cA = cur.A; const char* cB = cur.B;
    PG8_STAGEB(PG8_SB(0, 0), cB); PG8_STAGEB(PG8_SB(0, 1), cB + hstepB); PG8_STAGEA(PG8_SA(0, 0), cA, cOff, 0); PG8_STAGEA(PG8_SA(0, 1), cA, cOff, 1);
    if (wr == 1) PG8_BAR;
    PG8_WAIT_V(2); PG8_BAR;
    PG8_STAGEB(PG8_SB(1, 0), cB + kstep); PG8_STAGEA(PG8_SA(1, 0), cA + kstep, cOff, 0); PG8_STAGEB(PG8_SB(1, 1), cB + hstepB + kstep);
    PG8_WAIT_V(6); PG8_BAR;
    for (;;) {
        const bool has_next = S.next(ui + 1, nxt);
        const char* nA = has_next ? nxt.A : cA; const char* nB = has_next ? nxt.B : cB;
        if constexpr (GATHER) {
            if (has_next) {
#pragma unroll
                for (int h = 0; h < 2; ++h)
#pragma unroll
                    for (int i = 0; i < 2; ++i) nOff[h][i] = S.row_off(nxt, h * HALF + RA[i]) + (unsigned)CA[i] * 2u;
            }
        }
        for (int t = 0; t < nt; t += 2) {
            const bool last = (t == nt - 2);
            const char* a1 = cA + (size_t)(t + 1) * kstep;
            const char* a2 = last ? nA : cA + (size_t)(t + 2) * kstep; const char* b2 = last ? nB : cB + (size_t)(t + 2) * kstep;
            const char* a3 = a2 + kstep; const char* b3 = b2 + kstep;
            unsigned o2[2][2];
#pragma unroll
            for (int h = 0; h < 2; ++h)
#pragma unroll
                for (int i = 0; i < 2; ++i) { if constexpr (GATHER) o2[h][i] = last ? nOff[h][i] : cOff[h][i]; else o2[h][i] = cOff[h][i]; }
            PG8_STAGEA(PG8_SA(1, 1), a1, cOff, 1); PG8_LDB(B0, 0, 0); PG8_LDB(B1, 0, 1); PG8_SCHED; PG8_LDA(At, 0, 0);
            PG8_WAIT_V(8); PG8_WAIT_L(0); PG8_BAR; PG8_MMA(0, 0, At, B0); PG8_MMA(0, 1, At, B1); PG8_BAR; PG8_SCHED;
            PG8_STAGEB(PG8_SB(0, 0), b2); PG8_STAGEB(PG8_SB(0, 1), b2 + hstepB); PG8_STAGEA(PG8_SA(0, 0), a2, o2, 0); PG8_LDA(At, 0, 1);
            PG8_WAIT_V(8); PG8_WAIT_L(0); PG8_BAR; PG8_MMA(1, 0, At, B0); PG8_MMA(1, 1, At, B1); PG8_BAR; PG8_SCHED;
            PG8_STAGEA(PG8_SA(0, 1), a2, o2, 1); PG8_LDB(B0, 1, 0); PG8_LDB(B1, 1, 1); PG8_SCHED; PG8_LDA(At, 1, 0);
            PG8_WAIT_V(8); PG8_WAIT_L(0); PG8_BAR; PG8_MMA(0, 0, At, B0); PG8_MMA(0, 1, At, B1); PG8_BAR; PG8_SCHED;
            PG8_STAGEB(PG8_SB(1, 0), b3); PG8_STAGEB(PG8_SB(1, 1), b3 + hstepB); PG8_STAGEA(PG8_SA(1, 0), a3, o2, 0); PG8_LDA(At, 1, 1);
            PG8_WAIT_V(8); PG8_WAIT_L(0); PG8_BAR; PG8_MMA(1, 0, At, B0); PG8_MMA(1, 1, At, B1); PG8_BAR; PG8_SCHED;
        }
        if constexpr (ALIGN_EPI) { if (wr == 0) PG8_BAR; }
        bool keep = false;
        if constexpr (Epi::ACCUM) keep = E.merge(acc, cur, wr, wc, fr, fq); else E(acc, cur, wr, wc, fr, fq);
        if (!has_next) break;
        if (!keep) {
#pragma unroll
        for (int a = 0; a < 2; ++a)
#pragma unroll
            for (int b = 0; b < 2; ++b)
#pragma unroll
                for (int m = 0; m < 4; ++m)
#pragma unroll
                    for (int n = 0; n < 2; ++n) acc[a][b][m][n] = (f32x4){0.f, 0.f, 0.f, 0.f};
        }
        cur = nxt; cA = nA; cB = nB; ++ui;
        if constexpr (GATHER) {
#pragma unroll
            for (int h = 0; h < 2; ++h)
#pragma unroll
                for (int i = 0; i < 2; ++i) cOff[h][i] = nOff[h][i];
        }
        if constexpr (ALIGN_EPI) { if (wr == 1) PG8_BAR; }
    }
    PG8_WAIT_V(0);
    if constexpr (!ALIGN_EPI) { if (wr == 0) PG8_BAR; }
    PG8_BAR;
#undef PG8_SA
#undef PG8_SB
#undef PG8_STAGE2
#undef PG8_STAGEA
#undef PG8_STAGEB
#undef PG8_LDA
#undef PG8_LDB
#undef PG8_MMA
#undef PG8_WAIT_V
#undef PG8_WAIT_L
#undef PG8_BAR
#undef PG8_SCHED
}
typedef int i32x4_t __attribute__((ext_vector_type(4)));
template <class Epi, class Sched, bool GATHER = false, bool ALIGN_EPI = true>
__device__ __forceinline__ void gemm_phase_i8(PG8_LAS unsigned char* lds, const int tid, const int K, const int lda, const int ldb, const Sched& S, const Epi& E) {
    const int wid = __builtin_amdgcn_readfirstlane(tid >> 6), lane = tid & 63, wr = wid >> 2, wc = wid & 3, fr = lane & 15, fq = lane >> 4;
    const int nt = K / 128;
    int RA[2], CA[2]; unsigned voffB[2];
#pragma unroll
    for (int i = 0; i < 2; ++i) { int R, C; stage_rc(tid * 16 + i * 8192, R, C); const int Rb = Epi::PERM ? ((R & ~31) + perm32(R & 31)) : R;
        RA[i] = R; CA[i] = C; voffB[i] = (unsigned)(Rb * ldb + C * 2); }
    const size_t kstep = (size_t)(BK * 2);
    const size_t hstepB = (size_t)HALF * ldb;
    const unsigned ldsw = (unsigned)wid * 1024u;
    const int aoff = lds_byte(wr * 64 + fr, fq * 8), boff = lds_byte(wc * 32 + fr, fq * 8);
#define PG8_SA(b, h) (((b) * 2 + (h)) * HTB)
#define PG8_SB(b, h) ((4 + (b) * 2 + (h)) * HTB)
#define PG8_STAGE2(bufoff, gbase, o0, o1) do { \
        __builtin_amdgcn_global_load_lds((const unsigned*)((const char*)(gbase) + (o0)), (PG8_LAS unsigned*)(lds + (bufoff) + ldsw), 16, 0, 0); \
        __builtin_amdgcn_global_load_lds((const unsigned*)((const char*)(gbase) + (o1)), (PG8_LAS unsigned*)(lds + (bufoff) + ldsw + 8192), 16, 0, 0); } while (0)
#define PG8_STAGEB(bufoff, gbase) PG8_STAGE2(bufoff, gbase, voffB[0], voffB[1])
#define PG8_STAGEA(bufoff, gbase, OFF, h) PG8_STAGE2(bufoff, gbase, OFF[h][0], OFF[h][1])
#define PG8_LDA(dst, b, h) do { _Pragma("unroll") for (int m = 0; m < 4; ++m) _Pragma("unroll") for (int k = 0; k < 2; ++k) dst[m][k] = *(const PG8_LAS bf16x8*)(lds + PG8_SA(b, h) + aoff + m * 2048 + k * 1024); } while (0)
#define PG8_LDB(dst, b, h) do { _Pragma("unroll") for (int n = 0; n < 2; ++n) _Pragma("unroll") for (int k = 0; k < 2; ++k) dst[n][k] = *(const PG8_LAS bf16x8*)(lds + PG8_SB(b, h) + boff + n * 2048 + k * 1024); } while (0)
#define PG8_MMA(ai, bj, At, Bt) do { __builtin_amdgcn_s_setprio(MK_MMAPRIO); _Pragma("unroll") for (int m = 0; m < 4; ++m) _Pragma("unroll") for (int n = 0; n < 2; ++n) _Pragma("unroll") for (int k = 0; k < 2; ++k) \
        acc[ai][bj][m][n] = __builtin_bit_cast(f32x4, __builtin_amdgcn_mfma_i32_16x16x64_i8(__builtin_bit_cast(i32x4_t, Bt[n][k]), __builtin_bit_cast(i32x4_t, At[m][k]), __builtin_bit_cast(i32x4_t, acc[ai][bj][m][n]), 0, 0, 0)); __builtin_amdgcn_s_setprio(0); } while (0)
#define PG8_WAIT_V(n) asm volatile("s_waitcnt vmcnt(" #n ")" ::: "memory")
#define PG8_WAIT_L(n) asm volatile("s_waitcnt lgkmcnt(" #n ")" ::: "memory")
#define PG8_BAR __builtin_amdgcn_s_barrier()
#define PG8_SCHED __builtin_amdgcn_sched_barrier(0)
    Unit cur, nxt; int ui = 0;
    if (!S.next(0, cur)) return;
    f32x4 acc[2][2][4][2];
#pragma unroll
    for (int a = 0; a < 2; ++a)
#pragma unroll
        for (int b = 0; b < 2; ++b)
#pragma unroll
            for (int m = 0; m < 4; ++m)
#pragma unroll
                for (int n = 0; n < 2; ++n) acc[a][b][m][n] = (f32x4){0.f, 0.f, 0.f, 0.f};
    bf16x8 At[4][2], B0[2][2], B1[2][2];
    unsigned cOff[2][2], nOff[2][2];
#pragma unroll
    for (int h = 0; h < 2; ++h)
#pragma unroll
        for (int i = 0; i < 2; ++i) {
            if constexpr (GATHER) cOff[h][i] = S.row_off(cur, h * HALF + RA[i]) + (unsigned)CA[i] * 2u;
            else cOff[h][i] = (unsigned)((h * HALF + RA[i]) * lda) + (unsigned)CA[i] * 2u;
            nOff[h][i] = cOff[h][i];
        }
    const char* cA = cur.A; const char* cB = cur.B;
    PG8_STAGEB(PG8_SB(0, 0), cB); PG8_STAGEB(PG8_SB(0, 1), cB + hstepB); PG8_STAGEA(PG8_SA(0, 0), cA, cOff, 0); PG8_STAGEA(PG8_SA(0, 1), cA, cOff, 1);
    if (wr == 1) PG8_BAR;
    PG8_WAIT_V(2); PG8_BAR;
    PG8_STAGEB(PG8_SB(1, 0), cB + kstep); PG8_STAGEA(PG8_SA(1, 0), cA + kstep, cOff, 0); PG8_STAGEB(PG8_SB(1, 1), cB + hstepB + kstep);
    PG8_WAIT_V(6); PG8_BAR;
    for (;;) {
        const bool has_next = S.next(ui + 1, nxt);
        const char* nA = has_next ? nxt.A : cA; const char* nB = has_next ? nxt.B : cB;
        if constexpr (GATHER) {
            if (has_next) {
#pragma unroll
                for (int h = 0; h < 2; ++h)
#pragma unroll
                    for (int i = 0; i < 2; ++i) nOff[h][i] = S.row_off(nxt, h * HALF + RA[i]) + (unsigned)CA[i] * 2u;
            }
        }
#pragma clang loop unroll(disable)
        for (int t = 0; t < nt; t += 2) {
            const bool last = (t == nt - 2);
            const char* a1 = cA + (size_t)(t + 1) * kstep;
            const char* a2 = last ? nA : cA + (size_t)(t + 2) * kstep; const char* b2 = last ? nB : cB + (size_t)(t + 2) * kstep;
            const char* a3 = a2 + kstep; const char* b3 = b2 + kstep;
            unsigned o2[2][2];
#pragma unroll
            for (int h = 0; h < 2; ++h)
#pragma unroll
                for (int i = 0; i < 2; ++i) { if constexpr (GATHER) o2[h][i] = last ? nOff[h][i] : cOff[h][i]; else o2[h][i] = cOff[h][i]; }
            PG8_STAGEA(PG8_SA(1, 1), a1, cOff, 1); PG8_LDB(B0, 0, 0); PG8_LDB(B1, 0, 1); PG8_SCHED; PG8_LDA(At, 0, 0);
            PG8_WAIT_V(8); PG8_WAIT_L(0); PG8_BAR; PG8_MMA(0, 0, At, B0); PG8_MMA(0, 1, At, B1); PG8_BAR; PG8_SCHED;
            PG8_STAGEB(PG8_SB(0, 0), b2); PG8_STAGEB(PG8_SB(0, 1), b2 + hstepB); PG8_STAGEA(PG8_SA(0, 0), a2, o2, 0); PG8_LDA(At, 0, 1);
            PG8_WAIT_V(8); PG8_WAIT_L(0); PG8_BAR; PG8_MMA(1, 0, At, B0); PG8_MMA(1, 1, At, B1); PG8_BAR; PG8_SCHED;
            PG8_STAGEA(PG8_SA(0, 1), a2, o2, 1); PG8_LDB(B0, 1, 0); PG8_LDB(B1, 1, 1); PG8_SCHED; PG8_LDA(At, 1, 0);
            PG8_WAIT_V(8); PG8_WAIT_L(0); PG8_BAR; PG8_MMA(0, 0, At, B0); PG8_MMA(0, 1, At, B1); PG8_BAR; PG8_SCHED;
            PG8_STAGEB(PG8_SB(1, 0), b3); PG8_STAGEB(PG8_SB(1, 1), b3 + hstepB); PG8_STAGEA(PG8_SA(1, 0), a3, o2, 0); PG8_LDA(At, 1, 1);
            PG8_WAIT_V(8); PG8_WAIT_L(0); PG8_BAR; PG8_MMA(1, 0, At, B0); PG8_MMA(1, 1, At, B1); PG8_BAR; PG8_SCHED;
        }
        if constexpr (ALIGN_EPI) { if (wr == 0) PG8_BAR; }
        bool keep = false;
#pragma unroll
        for (int a_ = 0; a_ < 2; ++a_)
#pragma unroll
            for (int b_ = 0; b_ < 2; ++b_)
#pragma unroll
                for (int m_ = 0; m_ < 4; ++m_)
#pragma unroll
                    for (int n_ = 0; n_ < 2; ++n_) { const i32x4_t iv = __builtin_bit_cast(i32x4_t, acc[a_][b_][m_][n_]); acc[a_][b_][m_][n_] = (f32x4){(float)iv[0], (float)iv[1], (float)iv[2], (float)iv[3]}; }
        E(acc, cur, wr, wc, fr, fq);
        if (!has_next) break;
        if (!keep) {
#pragma unroll
        for (int a = 0; a < 2; ++a)
#pragma unroll
            for (int b = 0; b < 2; ++b)
#pragma unroll
                for (int m = 0; m < 4; ++m)
#pragma unroll
                    for (int n = 0; n < 2; ++n) acc[a][b][m][n] = (f32x4){0.f, 0.f, 0.f, 0.f};
        }
        cur = nxt; cA = nA; cB = nB; ++ui;
        if constexpr (GATHER) {
#pragma unroll
            for (int h = 0; h < 2; ++h)
#pragma unroll
                for (int i = 0; i < 2; ++i) cOff[h][i] = nOff[h][i];
        }
        if constexpr (ALIGN_EPI) { if (wr == 1) PG8_BAR; }
    }
    PG8_WAIT_V(0);
    if constexpr (!ALIGN_EPI) { if (wr == 0) PG8_BAR; }
    PG8_BAR;
#undef PG8_SA
#undef PG8_SB
#undef PG8_STAGE2
#undef PG8_STAGEA
#undef PG8_STAGEB
#undef PG8_LDA
#undef PG8_LDB
#undef PG8_MMA
#undef PG8_WAIT_V
#undef PG8_WAIT_L
#undef PG8_BAR
#undef PG8_SCHED
}
__host__ __device__ __forceinline__ int lds_byte8(int r, int ch) { const int fr = r & 15; return (r >> 4) * 2048 + (ch >> 2) * 1024 + ((fr * 64 + (ch & 3) * 16) ^ (((fr >> 2) & 1) << 4)); }
__host__ __device__ __forceinline__ void stage_rc8(int b, int& R, int& CH) { const int blk = b >> 11, h2 = (b >> 10) & 1, w = b & 1023, fr = w >> 6; R = blk * 16 + fr; CH = h2 * 4 + (((w ^ (((fr >> 2) & 1) << 4)) >> 4) & 3); }
typedef int v8i __attribute__((ext_vector_type(8)));
typedef int v4i __attribute__((ext_vector_type(4)));
template <class Epi, class Sched, bool GATHER = false, bool ALIGN_EPI = true>
__device__ __forceinline__ void gemm_phase_f8(PG8_LAS unsigned char* lds, const int tid, const int K, const int lda, const int ldb, const Sched& S, const Epi& E) {
    const int wid = __builtin_amdgcn_readfirstlane(tid >> 6), lane = tid & 63, wr = wid >> 2, wc = wid & 3, fr = lane & 15, fq = lane >> 4;
    const int nt = K / 128;
    int RA[2], CA[2]; unsigned voffB[2];
#pragma unroll
    for (int i = 0; i < 2; ++i) { int R, C; stage_rc8(tid * 16 + i * 8192, R, C); const int Rb = Epi::PERM ? ((R & ~31) + perm32(R & 31)) : R;
        RA[i] = R; CA[i] = C * 8; voffB[i] = (unsigned)(Rb * ldb + C * 16); }
    const size_t kstep = (size_t)(BK * 2);
    const size_t hstepB = (size_t)HALF * ldb;
    const unsigned ldsw = (unsigned)wid * 1024u;
    const int aoff0 = lds_byte8(wr * 64 + fr, 2 * fq), aoff1 = lds_byte8(wr * 64 + fr, 2 * fq + 1), boff0 = lds_byte8(wc * 32 + fr, 2 * fq), boff1 = lds_byte8(wc * 32 + fr, 2 * fq + 1);
#define PG8_SA(b, h) (((b) * 2 + (h)) * HTB)
#define PG8_SB(b, h) ((4 + (b) * 2 + (h)) * HTB)
#define PG8_STAGE2(bufoff, gbase, o0, o1) do { \
        __builtin_amdgcn_global_load_lds((const unsigned*)((const char*)(gbase) + (o0)), (PG8_LAS unsigned*)(lds + (bufoff) + ldsw), 16, 0, 0); \
        __builtin_amdgcn_global_load_lds((const unsigned*)((const char*)(gbase) + (o1)), (PG8_LAS unsigned*)(lds + (bufoff) + ldsw + 8192), 16, 0, 0); } while (0)
#define PG8_STAGEB(bufoff, gbase) PG8_STAGE2(bufoff, gbase, voffB[0], voffB[1])
#define PG8_STAGEA(bufoff, gbase, OFF, h) PG8_STAGE2(bufoff, gbase, OFF[h][0], OFF[h][1])
#define PG8_LDA(dst, b, h) do { _Pragma("unroll") for (int m = 0; m < 4; ++m) { dst[m][0] = *(const PG8_LAS v4i*)(lds + PG8_SA(b, h) + aoff0 + m * 2048); dst[m][1] = *(const PG8_LAS v4i*)(lds + PG8_SA(b, h) + aoff1 + m * 2048); } } while (0)
#define PG8_LDB(dst, b, h) do { _Pragma("unroll") for (int n = 0; n < 2; ++n) { dst[n][0] = *(const PG8_LAS v4i*)(lds + PG8_SB(b, h) + boff0 + n * 2048); dst[n][1] = *(const PG8_LAS v4i*)(lds + PG8_SB(b, h) + boff1 + n * 2048); } } while (0)
#define PG8_V8(x) __builtin_shufflevector(x[0], x[1], 0, 1, 2, 3, 4, 5, 6, 7)
#define PG8_MMA(ai, bj, At, Bt) do { __builtin_amdgcn_s_setprio(MK_MMAPRIO); _Pragma("unroll") for (int m = 0; m < 4; ++m) _Pragma("unroll") for (int n = 0; n < 2; ++n) \
        asm volatile("v_mfma_scale_f32_16x16x128_f8f6f4 %0, %1, %2, %0, %3, %3 op_sel_hi:[0,0,0]" : "+v"(acc[ai][bj][m][n]) : "v"(PG8_V8(Bt[n])), "v"(PG8_V8(At[m])), "v"(sc1)); __builtin_amdgcn_s_setprio(0); } while (0)
#define PG8_WAIT_V(n) asm volatile("s_waitcnt vmcnt(" #n ")" ::: "memory")
#define PG8_WAIT_L(n) asm volatile("s_waitcnt lgkmcnt(" #n ")" ::: "memory")
#define PG8_BAR __builtin_amdgcn_s_barrier()
#define PG8_SCHED __builtin_amdgcn_sched_barrier(0)
    int sc1 = 0x7f7f7f7f; asm volatile("" : "+v"(sc1));
    Unit cur, nxt; int ui = 0;
    if (!S.next(0, cur)) return;
    f32x4 acc[2][2][4][2];
#pragma unroll
    for (int a = 0; a < 2; ++a)
#pragma unroll
        for (int b = 0; b < 2; ++b)
#pragma unroll
            for (int m = 0; m < 4; ++m)
#pragma unroll
                for (int n = 0; n < 2; ++n) acc[a][b][m][n] = (f32x4){0.f, 0.f, 0.f, 0.f};
    v4i At[4][2], B0[2][2], B1[2][2];
    unsigned cOff[2][2], nOff[2][2];
#pragma unroll
    for (int h = 0; h < 2; ++h)
#pragma unroll
        for (int i = 0; i < 2; ++i) {
            if constexpr (GATHER) cOff[h][i] = S.row_off(cur, h * HALF + RA[i]) + (unsigned)CA[i] * 2u;
            else cOff[h][i] = (unsigned)((h * HALF + RA[i]) * lda) + (unsigned)CA[i] * 2u;
            nOff[h][i] = cOff[h][i];
        }
    const char* cA = cur.A; const char* cB = cur.B;
    PG8_STAGEB(PG8_SB(0, 0), cB); PG8_STAGEB(PG8_SB(0, 1), cB + hstepB); PG8_STAGEA(PG8_SA(0, 0), cA, cOff, 0); PG8_STAGEA(PG8_SA(0, 1), cA, cOff, 1);
    if (wr == 1) PG8_BAR;
    PG8_WAIT_V(2); PG8_BAR;
    PG8_STAGEB(PG8_SB(1, 0), cB + kstep); PG8_STAGEA(PG8_SA(1, 0), cA + kstep, cOff, 0); PG8_STAGEB(PG8_SB(1, 1), cB + hstepB + kstep);
    PG8_WAIT_V(6); PG8_BAR;
    for (;;) {
        const bool has_next = S.next(ui + 1, nxt);
        const char* nA = has_next ? nxt.A : cA; const char* nB = has_next ? nxt.B : cB;
        if constexpr (GATHER) { if (has_next && wid == 0) S.stage_list(nxt, (ui + 1) & 1, lane); }
#pragma clang loop unroll(disable)
        for (int t = 0; t < nt; t += 2) {
            const bool last = (t == nt - 2);
            const char* a1 = cA + (size_t)(t + 1) * kstep;
            const char* a2 = last ? nA : cA + (size_t)(t + 2) * kstep; const char* b2 = last ? nB : cB + (size_t)(t + 2) * kstep;
            const char* a3 = a2 + kstep; const char* b3 = b2 + kstep;
            unsigned o2[2][2];
#pragma unroll
            for (int h = 0; h < 2; ++h)
#pragma unroll
                for (int i = 0; i < 2; ++i) o2[h][i] = cOff[h][i];
            if constexpr (GATHER) { if (last && has_next) {
#pragma unroll
                for (int h = 0; h < 2; ++h)
#pragma unroll
                    for (int i = 0; i < 2; ++i) { nOff[h][i] = S.row_fin(nxt, h * HALF + RA[i], S.stage_get((ui + 1) & 1, h * HALF + RA[i])) + (unsigned)CA[i] * 2u; o2[h][i] = nOff[h][i]; } } }
            PG8_STAGEA(PG8_SA(1, 1), a1, cOff, 1); PG8_LDB(B0, 0, 0); PG8_LDB(B1, 0, 1); PG8_SCHED; PG8_LDA(At, 0, 0);
            PG8_WAIT_V(8); PG8_WAIT_L(0); PG8_BAR; PG8_MMA(0, 0, At, B0); PG8_MMA(0, 1, At, B1); PG8_BAR; PG8_SCHED;
            PG8_STAGEB(PG8_SB(0, 0), b2); PG8_STAGEB(PG8_SB(0, 1), b2 + hstepB); PG8_STAGEA(PG8_SA(0, 0), a2, o2, 0); PG8_LDA(At, 0, 1);
            PG8_WAIT_V(8); PG8_WAIT_L(0); PG8_BAR; PG8_MMA(1, 0, At, B0); PG8_MMA(1, 1, At, B1); PG8_BAR; PG8_SCHED;
            PG8_STAGEA(PG8_SA(0, 1), a2, o2, 1); PG8_LDB(B0, 1, 0); PG8_LDB(B1, 1, 1); PG8_SCHED; PG8_LDA(At, 1, 0);
            PG8_WAIT_V(8); PG8_WAIT_L(0); PG8_BAR; PG8_MMA(0, 0, At, B0); PG8_MMA(0, 1, At, B1); PG8_BAR; PG8_SCHED;
            PG8_STAGEB(PG8_SB(1, 0), b3); PG8_STAGEB(PG8_SB(1, 1), b3 + hstepB); PG8_STAGEA(PG8_SA(1, 0), a3, o2, 0); PG8_LDA(At, 1, 1);
            PG8_WAIT_V(8); PG8_WAIT_L(0); PG8_BAR; PG8_MMA(1, 0, At, B0); PG8_MMA(1, 1, At, B1); PG8_BAR; PG8_SCHED;
        }
        asm volatile("s_nop 15\n\ts_nop 7" ::: "memory");
        if constexpr (ALIGN_EPI) { if (wr == 0) PG8_BAR; }
        E(acc, cur, wr, wc, fr, fq);
        if (!has_next) break;
#pragma unroll
        for (int a = 0; a < 2; ++a)
#pragma unroll
            for (int b = 0; b < 2; ++b)
#pragma unroll
                for (int m = 0; m < 4; ++m)
#pragma unroll
                    for (int n = 0; n < 2; ++n) acc[a][b][m][n] = (f32x4){0.f, 0.f, 0.f, 0.f};
        cur = nxt; cA = nA; cB = nB; ++ui;
        if constexpr (GATHER) {
#pragma unroll
            for (int h = 0; h < 2; ++h)
#pragma unroll
                for (int i = 0; i < 2; ++i) cOff[h][i] = nOff[h][i];
        }
        if constexpr (ALIGN_EPI) { if (wr == 1) PG8_BAR; }
    }
    PG8_WAIT_V(0);
    if constexpr (!ALIGN_EPI) { if (wr == 0) PG8_BAR; }
    PG8_BAR;
#undef PG8_SA
#undef PG8_SB
#undef PG8_STAGE2
#undef PG8_STAGEA
#undef PG8_STAGEB
#undef PG8_LDA
#undef PG8_LDB
#undef PG8_MMA
#undef PG8_V8
#undef PG8_WAIT_V
#undef PG8_WAIT_L
#undef PG8_BAR
#undef PG8_SCHED
}
}

namespace mla {
using bf16=__hip_bfloat16;
using bf16x8=__attribute__((ext_vector_type(8)))short;
using s16x4=__attribute__((ext_vector_type(4)))short;
using f32x16=__attribute__((ext_vector_type(16)))float;
using u32x4=__attribute__((ext_vector_type(4)))unsigned;
constexpr int SEQ=4096,DQK=96,DV=64,NHEAD=8;
constexpr int QP=768,KP=96,VP=64,OP=512;
constexpr int NW=8,QBLK=32,QB=QBLK*NW,KVBLK=64,NQB=SEQ/QB;
__device__ __forceinline__ int crow(int r,int hi){return (r&3)+8*(r>>2)+4*hi;}
#define SBAR() __builtin_amdgcn_sched_barrier(0)
__device__ __forceinline__ void cmask(f32x16&p0,f32x16&p1,int jb,int qrel,int hi){
  const float NEG=-INFINITY; int kb=64*jb+4*hi;
  #pragma unroll
  for(int r=0;r<16;++r){int kv=kb+(r&3)+8*(r>>2); if(kv>qrel)p0[r]=NEG; if(kv+32>qrel)p1[r]=NEG;}
}
constexpr int NSLOT=3, KSLOT=12288, VSLOT=8192;
constexpr int LDS_K=0, LDS_V=NSLOT*KSLOT, LDS_WS=LDS_V+NSLOT*VSLOT, LDS_OST=LDS_WS+NW*64*4, LDS_BYTES=LDS_OST+NW*4096;
__device__ __forceinline__ void glds16(const char*sbase,unsigned voff,unsigned lds_dst){unsigned keep;
  asm volatile("s_mov_b32 %0, m0\n\ts_mov_b32 m0, %2\n\ts_nop 0\n\tglobal_load_lds_dwordx4 %1, %3\n\ts_mov_b32 m0, %0":"=&s"(keep):"v"(voff),"s"(lds_dst),"s"(sbase):"memory");}
__device__ __forceinline__ const char* uni_ptr(const void*p){ const unsigned long long v=(unsigned long long)(uintptr_t)p; const unsigned lo=__builtin_amdgcn_readfirstlane((unsigned)v),hi=__builtin_amdgcn_readfirstlane((unsigned)(v>>32)); return (const char*)(uintptr_t)(((unsigned long long)hi<<32)|lo); }
__device__ __forceinline__ float max3f(float a,float b,float c){float r;asm("v_max3_f32 %0, %1, %2, %3":"=v"(r):"v"(a),"v"(b),"v"(c));return r;}
__device__ __forceinline__ float max2f(float a,float b){float r;asm("v_max_f32_e32 %0, %1, %2":"=v"(r):"v"(a),"v"(b));return r;}
__device__ __forceinline__ float fadd_s(float a,float b){float r;asm("v_add_f32_e32 %0, %1, %2":"=v"(r):"v"(a),"v"(b));return r;}
__device__ __forceinline__ float fsub_s(float a,float b){float r;asm("v_sub_f32_e32 %0, %1, %2":"=v"(r):"v"(a),"v"(b));return r;}
typedef float f32x2_t __attribute__((ext_vector_type(2))); typedef __bf16 bf16x2_t __attribute__((ext_vector_type(2)));
__device__ __forceinline__ unsigned cvtpk_s(float lo,float hi){f32x2_t v={lo,hi};bf16x2_t b=__builtin_convertvector(v,bf16x2_t);return __builtin_bit_cast(unsigned,b);}
#define WAIT_BAR(N) asm volatile("s_waitcnt vmcnt(" #N ") lgkmcnt(0)\n\ts_barrier":::"memory")

__device__ __forceinline__ void qkt(f32x16&p0,f32x16&p1,const char*Kslot,const bf16x8*qr,int r32,int hi){
  const f32x16 negm=f32x16{};
  const char*kb=Kslot+hi*1024+r32*16;
  #pragma unroll
  for(int d0=0;d0<6;++d0){
    const bf16x8 b0=*reinterpret_cast<const bf16x8*>(kb+d0*2048);
    const bf16x8 b1=*reinterpret_cast<const bf16x8*>(kb+d0*2048+512);
    if(d0==0){p0=__builtin_amdgcn_mfma_f32_32x32x16_bf16(b0,qr[0],negm,0,0,0);p1=__builtin_amdgcn_mfma_f32_32x32x16_bf16(b1,qr[0],negm,0,0,0);}
    else{p0=__builtin_amdgcn_mfma_f32_32x32x16_bf16(b0,qr[d0],p0,0,0,0);p1=__builtin_amdgcn_mfma_f32_32x32x16_bf16(b1,qr[d0],p1,0,0,0);}}
}
typedef __attribute__((address_space(3))) const char* lds_cptr;
typedef short v4i16_t __attribute__((ext_vector_type(4)));
__device__ __forceinline__ void kload12(bf16x8*kf,lds_cptr kp){
  #pragma unroll
  for(int j=0;j<6;++j){ kf[2*j]=*(const __attribute__((address_space(3))) bf16x8*)(kp+j*2048); kf[2*j+1]=*(const __attribute__((address_space(3))) bf16x8*)(kp+j*2048+512); }
}
__device__ __forceinline__ void kload2(bf16x8*kf,lds_cptr kp,int j){ kf[2*j]=*(const __attribute__((address_space(3))) bf16x8*)(kp+j*2048); kf[2*j+1]=*(const __attribute__((address_space(3))) bf16x8*)(kp+j*2048+512); }
__device__ __forceinline__ s16x4 vtr(lds_cptr p){ return __builtin_bit_cast(s16x4,__builtin_amdgcn_ds_read_tr16_b64_v4i16((__attribute__((address_space(3))) v4i16_t*)p)); }
__device__ __forceinline__ float rowmax(const f32x16&p0,const f32x16&p1){
  float a=max3f(p0[0],p0[1],p1[0]),b=max3f(p0[2],p0[3],p1[1]);a=max3f(a,p1[2],p1[3]);
  #pragma unroll
  for(int r=4;r<16;r+=4){a=max3f(a,p0[r],p0[r+1]);b=max3f(b,p0[r+2],p0[r+3]);a=max3f(a,p1[r],p1[r+1]);b=max3f(b,p1[r+2],p1[r+3]);}
  const float m=max2f(a,b);
  auto rr=__builtin_amdgcn_permlane32_swap(__float_as_uint(m),__float_as_uint(m),false,false);
  return max2f(__uint_as_float(rr[0]),__uint_as_float(rr[1]));
}
__device__ __forceinline__ void pv(f32x16*o,int vb,bf16x8 pa0,bf16x8 pa1,bf16x8 pa2,bf16x8 pa3){
  #pragma unroll
  for(int d0=0;d0<2;++d0){s16x4 lo[4],hi[4];
    #pragma unroll
    for(int ks=0;ks<4;++ks){
      asm volatile("ds_read_b64_tr_b16 %0,%1 offset:%c2":"=&v"(lo[ks]):"v"(vb),"i"(d0*4096+ks*1024):"memory");
      asm volatile("ds_read_b64_tr_b16 %0,%1 offset:%c2":"=&v"(hi[ks]):"v"(vb),"i"(d0*4096+ks*1024+512):"memory");}
    asm volatile("s_waitcnt lgkmcnt(0)":::"memory");SBAR();
    #define PK(k) (bf16x8){lo[k][0],lo[k][1],lo[k][2],lo[k][3],hi[k][0],hi[k][1],hi[k][2],hi[k][3]}
    o[d0]=__builtin_amdgcn_mfma_f32_32x32x16_bf16(pa0,PK(0),o[d0],0,0,0);
    o[d0]=__builtin_amdgcn_mfma_f32_32x32x16_bf16(pa1,PK(1),o[d0],0,0,0);
    o[d0]=__builtin_amdgcn_mfma_f32_32x32x16_bf16(pa2,PK(2),o[d0],0,0,0);
    o[d0]=__builtin_amdgcn_mfma_f32_32x32x16_bf16(pa3,PK(3),o[d0],0,0,0);
    #undef PK
  }
}

struct QXform { const float* rsq; const int* pos; const float* gq; const float* invrev; float c2; };
template<int THRL> __device__ __forceinline__ void attn_unit(const int tid,const QXform&QX,int b,int h,int qb,const bf16*Q,const bf16*__restrict__ K,const bf16*__restrict__ V,bf16*O,char*shm){
  const int lane=tid&63,r32=lane&31,hi=lane>>5; const int wid=__builtin_amdgcn_readfirstlane(tid>>6);
  const long rowbase=(long)b*SEQ; const int q0=qb*QB;
  const bf16*Qw=Q+(rowbase+q0+wid*QBLK)*QP+h*DQK;
  const bf16*Kh=K+((long)(b*NHEAD+h)*SEQ)*KP,*Vh=V+((long)(b*NHEAD+h)*SEQ)*VP;
  const unsigned lds0=(unsigned)(uintptr_t)shm;
  float*wsf=(float*)(shm+LDS_WS)+wid*64;
  const char*Kb=uni_ptr(Kh); const char*Vb=uni_ptr(Vh);
  const unsigned koffA=(unsigned)(wid*1024+lane*16), koffB=(unsigned)((8+(wid&3))*1024+lane*16);
  const unsigned voffV=(unsigned)(wid*1024+lane*16);
  const unsigned kdstA=lds0+LDS_K+wid*1024, kdstB=lds0+LDS_K+(8+(wid&3))*1024, vdst=lds0+LDS_V+wid*1024;
  #define KOF(s) ((s)+((s)>>1))
  #define DMA_K(t,slot) do{ const char*kt_=Kb+(size_t)(t)*(KVBLK*KP*2); glds16(kt_,koffA,(unsigned)__builtin_amdgcn_readfirstlane(kdstA+KOF(slot))); glds16(kt_,koffB,(unsigned)__builtin_amdgcn_readfirstlane(kdstB+KOF(slot))); }while(0)
  #define DMA_V(t,slot) glds16(Vb+(size_t)(t)*(KVBLK*VP*2),voffV,(unsigned)__builtin_amdgcn_readfirstlane(vdst+(slot)))
  const int vb0=(int)(lds0+LDS_V)+((lane>>4)&1)*32+(lane&3)*8+(4*hi+((lane&15)>>2))*64;
  const char*Kbase=shm+LDS_K; bf16x8 kf[12];
  const lds_cptr shm3=(lds_cptr)shm; const lds_cptr kp0=shm3+LDS_K+hi*1024+r32*16; const lds_cptr vp0=shm3+LDS_V+((lane>>4)&1)*32+(lane&3)*8+(4*hi+((lane&15)>>2))*64;
  const int NT=(q0+QB)/KVBLK;
  DMA_K(0,0);DMA_V(0,0);DMA_K(1,VSLOT);
  bf16x8 qr[6];
  { int lq=lane; asm volatile("":"+v"(lq));
    const int rq=lq&31,hq=lq>>5; const long trow=rowbase+q0+wid*QBLK+rq;
    const bf16*qp=Qw+(long)rq*QP+hq*8; u32x4 raw[6];
    _Pragma("unroll") for(int d0=0;d0<6;++d0)raw[d0]=*reinterpret_cast<const u32x4*>(qp+d0*16);
    const float rsq=QX.rsq[trow]; const float posf=(float)QX.pos[trow];
    float x[6][8]; float ss=0.f;
    _Pragma("unroll") for(int d0=0;d0<6;++d0) _Pragma("unroll") for(int j=0;j<4;++j){ const float a_=__uint_as_float(raw[d0][j]<<16)*rsq,b_=__uint_as_float(raw[d0][j]&0xffff0000u)*rsq; x[d0][2*j]=a_;x[d0][2*j+1]=b_; ss+=a_*a_+b_*b_; }
    ss+=__shfl_xor(ss,32);
    const float rn=QX.c2/sqrtf(ss*(1.f/96.f)+1e-6f);
    _Pragma("unroll") for(int d0=0;d0<4;++d0){ const float*g_=QX.gq+16*d0+8*hq; u32x4 w_;
      _Pragma("unroll") for(int j=0;j<4;++j)w_[j]=cvtpk_s(x[d0][2*j]*rn*g_[2*j],x[d0][2*j+1]*rn*g_[2*j+1]);
      qr[d0]=__builtin_bit_cast(bf16x8,w_); }
    { float lo_[8],hi_[8];
      _Pragma("unroll") for(int j=0;j<8;++j){ const int i_=8*hq+j; float rev=posf*QX.invrev[i_]; rev-=floorf(rev); const float sn_=__builtin_amdgcn_sinf(rev),cs_=__builtin_amdgcn_cosf(rev);
        const float a_=x[4][j]*rn*QX.gq[64+i_],b_=x[5][j]*rn*QX.gq[80+i_]; lo_[j]=a_*cs_-b_*sn_; hi_[j]=b_*cs_+a_*sn_; }
      u32x4 wl,wh; _Pragma("unroll") for(int j=0;j<4;++j){ wl[j]=cvtpk_s(lo_[2*j],lo_[2*j+1]); wh[j]=cvtpk_s(hi_[2*j],hi_[2*j+1]); }
      qr[4]=__builtin_bit_cast(bf16x8,wl); qr[5]=__builtin_bit_cast(bf16x8,wh); } }
  float mhat=0.f,l_reg=0.f;f32x16 o[2];o[0]=f32x16{};o[1]=f32x16{};f32x16 negm; { float z_=0.f; asm volatile("":"+v"(z_)); _Pragma("unroll") for(int r=0;r<16;++r)negm[r]=z_; }
  const int qrel=wid*QBLK+r32;
  #define CMASK(P0,P1,t) do{int jb_=(t)-(NT-4); if(jb_>=0)cmask(P0,P1,jb_,qrel,hi);}while(0)
  bool resc=false;
  #define START(P0,P1) do{ const float rm=rowmax(P0,P1); resc=false; \
    { const float dl=rm; mhat=fadd_s(mhat,dl); \
      _Pragma("unroll") for(int r=0;r<16;++r){P0[r]=fsub_s(P0[r],dl);P1[r]=fsub_s(P1[r],dl);} \
      _Pragma("unroll") for(int r=0;r<16;++r)negm[r]=-mhat; asm volatile("":"+v"(negm)); } \
    _Pragma("unroll") for(int r=0;r<16;++r)P0[r]=__builtin_amdgcn_exp2f(P0[r]); }while(0)
  #define RESC() do{ if(resc){ asm volatile("s_waitcnt lgkmcnt(0)":::"memory"); \
      _Pragma("unroll") for(int d_=0;d_<2;++d_) _Pragma("unroll") for(int r=0;r<16;++r)o[d_][r]*=wsf[crow(r,hi)]; } }while(0)
  f32x16 pA0,pA1,pB0,pB1;
  int sl_prev=0,sl_cur=0,sl_next=VSLOT;
  #define ROT() do{sl_prev=sl_cur;sl_cur=sl_next;sl_next=(sl_next==(NSLOT-1)*VSLOT)?0:sl_next+VSLOT;}while(0)
  DMA_K(2,2*VSLOT);
  WAIT_BAR(5);
  qkt(pA0,pA1,Kbase,qr,r32,hi);asm volatile("s_nop 15\n\ts_nop 7":"+v"(pA0),"+v"(pA1));CMASK(pA0,pA1,0);
  START(pA0,pA1);
  _Pragma("unroll") for(int r=0;r<16;++r)pA1[r]=__builtin_amdgcn_exp2f(pA1[r]);
  WAIT_BAR(0);
  DMA_K(3,0);DMA_V(1,VSLOT);
  ROT();
  kload12(kf,kp0+KOF(sl_cur));
  WAIT_BAR(3);
  s16x4 vlo[8],vhi[8]; u32x4 pw0,pw1,pw2,pw3;
  #define PKW(P,B) cvtpk_s(P[B],P[B+1])
  #define PAF(k) __builtin_bit_cast(bf16x8,pw##k)
  #define VFR(i) (bf16x8){vlo[i][0],vlo[i][1],vlo[i][2],vlo[i][3],vhi[i][0],vhi[i][1],vhi[i][2],vhi[i][3]}
  #define PIN(x) asm volatile("":"+v"(x))
  #define MX3(a,b,c) __builtin_fmaxf(__builtin_fmaxf((a),(b)),(c))
  #define GAPA(MF,A0,A1,A2,A3,W0,W1,PW) do{ MF; sacc+=A0; sacc+=A1; sacc+=A2; sacc+=A3; PIN(sacc); W0; W1; PIN(PW); SBAR(); }while(0)
  #define EX(v) __builtin_amdgcn_exp2f(v)
  #define GAPB(MF,X,B) do{ MF; X[B]=EX(X[B]); X[B+1]=EX(X[B+1]); X[B+2]=EX(X[B+2]); X[B+3]=EX(X[B+3]); PIN(X); SBAR(); }while(0)
  #define VRD(i) do{ vlo[i]=vtr(vp_+(((i)>>2)*4096+((i)&3)*1024)); vhi[i]=vtr(vp_+(((i)>>2)*4096+((i)&3)*1024+512)); }while(0)
  #define KRD(G,j) do{ if(G){ kload2(kf,kp0+KOF(sl_next),j); SBAR(); } }while(0)
  const f32x16 zero16=f32x16{};
  #define STEP(C0,C1,P0,P1,t,GK,GV,GL) do{ SBAR(); \
    const lds_cptr vp_=vp0+sl_prev; \
    VRD(0); SBAR(); float sacc=(P0[0]+P0[1]); \
    GAPA(C0=__builtin_amdgcn_mfma_f32_32x32x16_bf16(kf[0],qr[0],negm,0,0,0), P0[2],P0[3],P0[4],P0[5],     pw0[0]=PKW(P0,0), pw0[1]=PKW(P0,2), pw0); \
    VRD(4); SBAR(); GAPA(C1=__builtin_amdgcn_mfma_f32_32x32x16_bf16(kf[1],qr[0],negm,0,0,0), P0[6],P0[7],P0[8],P0[9],     pw0[2]=PKW(P0,4), pw0[3]=PKW(P0,6), pw0); \
    VRD(1); SBAR(); GAPA(C0=__builtin_amdgcn_mfma_f32_32x32x16_bf16(kf[2],qr[1],C0,0,0,0),   P0[10],P0[11],P0[12],P0[13], pw1[0]=PKW(P0,8), pw1[1]=PKW(P0,10), pw1); \
    VRD(5); SBAR(); GAPA(C1=__builtin_amdgcn_mfma_f32_32x32x16_bf16(kf[3],qr[1],C1,0,0,0),   P0[14],P0[15],P1[0],P1[1],   pw1[2]=PKW(P0,12),pw1[3]=PKW(P0,14), pw1); \
    VRD(2); SBAR(); GAPA(C0=__builtin_amdgcn_mfma_f32_32x32x16_bf16(kf[4],qr[2],C0,0,0,0),   P1[2],P1[3],P1[4],P1[5],     pw2[0]=PKW(P1,0), pw2[1]=PKW(P1,2), pw2); \
    VRD(6); SBAR(); GAPA(C1=__builtin_amdgcn_mfma_f32_32x32x16_bf16(kf[5],qr[2],C1,0,0,0),   P1[6],P1[7],P1[8],P1[9],     pw2[2]=PKW(P1,4), pw2[3]=PKW(P1,6), pw2); \
    VRD(3); SBAR(); GAPA(C0=__builtin_amdgcn_mfma_f32_32x32x16_bf16(kf[6],qr[3],C0,0,0,0),   P1[10],P1[11],P1[12],P1[13], pw3[0]=PKW(P1,8), pw3[1]=PKW(P1,10), pw3); \
    VRD(7); SBAR(); GAPA(C1=__builtin_amdgcn_mfma_f32_32x32x16_bf16(kf[7],qr[3],C1,0,0,0),   P1[14],P1[15],0.f,0.f,       pw3[2]=PKW(P1,12),pw3[3]=PKW(P1,14), pw3); \
    C0=__builtin_amdgcn_mfma_f32_32x32x16_bf16(kf[8],qr[4],C0,0,0,0); C1=__builtin_amdgcn_mfma_f32_32x32x16_bf16(kf[9],qr[4],C1,0,0,0); SBAR(); \
    C0=__builtin_amdgcn_mfma_f32_32x32x16_bf16(kf[10],qr[5],C0,0,0,0); C1=__builtin_amdgcn_mfma_f32_32x32x16_bf16(kf[11],qr[5],C1,0,0,0); SBAR(); \
    l_reg+=sacc; \
    if(GK){DMA_K((t)+3,sl_cur);} if(GV){DMA_V((t)+1,sl_next);} \
    CMASK(C0,C1,t); \
    { float a=MX3(C0[0],C0[1],C1[0]),b=MX3(C0[2],C0[3],C1[1]); a=MX3(a,C1[2],C1[3]); \
      _Pragma("unroll") for(int r=4;r<16;r+=4){a=MX3(a,C0[r],C0[r+1]);b=MX3(b,C0[r+2],C0[r+3]);a=MX3(a,C1[r],C1[r+1]);b=MX3(b,C1[r+2],C1[r+3]);} \
      float rm=__builtin_fmaxf(a,b); { auto rr=__builtin_amdgcn_permlane32_swap(__float_as_uint(rm),__float_as_uint(rm),false,false); rm=__builtin_fmaxf(__uint_as_float(rr[0]),__uint_as_float(rr[1])); } \
      resc=false; \
      if(__builtin_expect(__any(rm>(float)THRL),0)){ const float dl=__builtin_fmaxf(rm,0.f); mhat+=dl; \
        _Pragma("unroll") for(int r=0;r<16;++r){C0[r]-=dl;C1[r]-=dl;} \
        _Pragma("unroll") for(int r=0;r<16;++r)negm[r]=-mhat; asm volatile("":"+v"(negm)); \
        const float f=__builtin_amdgcn_exp2f(-dl); l_reg*=f; if(hi==0)wsf[r32]=f; resc=true; } } \
    SBAR(); \
    GAPB(o[0]=__builtin_amdgcn_mfma_f32_32x32x16_bf16(PAF(0),VFR(0),o[0],0,0,0), C0,0); \
    KRD(GL,0); GAPB(o[1]=__builtin_amdgcn_mfma_f32_32x32x16_bf16(PAF(0),VFR(4),o[1],0,0,0), C0,4); \
    KRD(GL,1); GAPB(o[0]=__builtin_amdgcn_mfma_f32_32x32x16_bf16(PAF(1),VFR(1),o[0],0,0,0), C0,8); \
    KRD(GL,2); GAPB(o[1]=__builtin_amdgcn_mfma_f32_32x32x16_bf16(PAF(1),VFR(5),o[1],0,0,0), C0,12); \
    KRD(GL,3); GAPB(o[0]=__builtin_amdgcn_mfma_f32_32x32x16_bf16(PAF(2),VFR(2),o[0],0,0,0), C1,0); \
    KRD(GL,4); GAPB(o[1]=__builtin_amdgcn_mfma_f32_32x32x16_bf16(PAF(2),VFR(6),o[1],0,0,0), C1,4); \
    KRD(GL,5); GAPB(o[0]=__builtin_amdgcn_mfma_f32_32x32x16_bf16(PAF(3),VFR(3),o[0],0,0,0), C1,8); \
    GAPB(o[1]=__builtin_amdgcn_mfma_f32_32x32x16_bf16(PAF(3),VFR(7),o[1],0,0,0), C1,12); \
    }while(0)
  int t=1;
  #undef CMASK
  #define CMASK(P0,P1,t) do{}while(0)
  for(;t+5<NT;t+=2){
    STEP(pB0,pB1,pA0,pA1,t,true,true,true);     WAIT_BAR(3); RESC(); ROT();
    STEP(pA0,pA1,pB0,pB1,t+1,true,true,true);   WAIT_BAR(3); RESC(); ROT();
  }
  #undef CMASK
  #define CMASK(P0,P1,t) do{int jb_=(t)-(NT-4); if(jb_>=0)cmask(P0,P1,jb_,qrel,hi);}while(0)
  #define ENDW(tt) do{ if((tt)+3<NT){WAIT_BAR(3);} else if((tt)+2<NT){WAIT_BAR(1);} else {WAIT_BAR(0);} }while(0)
  for(;t+1<NT;t+=2){
    STEP(pB0,pB1,pA0,pA1,t,(t+3<NT),(t+1<NT),(t+1<NT));       ENDW(t);   RESC(); ROT();
    STEP(pA0,pA1,pB0,pB1,t+1,(t+4<NT),(t+2<NT),(t+2<NT));     ENDW(t+1); RESC(); ROT();
  }
  STEP(pB0,pB1,pA0,pA1,NT-1,false,false,false); RESC();
  { float sacc=pB0[0]+pB0[1]; _Pragma("unroll") for(int r=2;r<16;++r)sacc+=pB0[r]; _Pragma("unroll") for(int r=0;r<16;++r)sacc+=pB1[r]; l_reg+=sacc;
    pw0=(u32x4){PKW(pB0,0),PKW(pB0,2),PKW(pB0,4),PKW(pB0,6)};pw1=(u32x4){PKW(pB0,8),PKW(pB0,10),PKW(pB0,12),PKW(pB0,14)};pw2=(u32x4){PKW(pB1,0),PKW(pB1,2),PKW(pB1,4),PKW(pB1,6)};pw3=(u32x4){PKW(pB1,8),PKW(pB1,10),PKW(pB1,12),PKW(pB1,14)};
    SBAR(); pv(o,vb0+sl_cur,PAF(0),PAF(1),PAF(2),PAF(3)); }
  #undef PKW
  #undef PAF
  #undef VFR
  #undef PIN
  #undef MX3
  #undef GAPA
  #undef GAPB
  #undef EX
  #undef VRD
  #undef KRD
  #undef STEP
  #undef ENDW
  {auto rr=__builtin_amdgcn_permlane32_swap(__float_as_uint(l_reg),__float_as_uint(l_reg),false,false);l_reg=__uint_as_float(rr[0])+__uint_as_float(rr[1]);}
  if(hi==0)wsf[32+r32]=l_reg;asm volatile("s_waitcnt lgkmcnt(0)":::"memory");
  float rli[16];
  #pragma unroll
  for(int r=0;r<16;++r)rli[r]=__builtin_amdgcn_rcpf(wsf[32+crow(r,hi)]);
  bf16*Ow=O+(rowbase+q0+wid*QBLK)*OP+h*DV;
  { bf16*stg=(bf16*)(shm+LDS_OST)+wid*2048;
    #pragma unroll
    for(int r=0;r<16;++r){const int orow=crow(r,hi);
      #pragma unroll
      for(int d0=0;d0<2;++d0)stg[orow*64+d0*32+r32]=__float2bfloat16(o[d0][r]*rli[r]);}
    asm volatile("s_waitcnt lgkmcnt(0)":::"memory");
    int lo_=lane; asm volatile("":"+v"(lo_));
    #pragma unroll
    for(int i=0;i<4;++i){const int row=i*8+(lo_>>3),ch=lo_&7; const u32x4 v=*(const u32x4*)(stg+row*64+ch*8); *(u32x4*)(Ow+(long)row*OP+ch*8)=v;} }
  asm volatile("s_waitcnt lgkmcnt(0)\n\ts_barrier":::"memory");
  #undef DMA_K
  #undef DMA_V
  #undef KOF
  #undef CMASK
  #undef START
  #undef RESC
  #undef ROT
}
#undef WAIT_BAR
}

constexpr int NWAVES = 8;
constexpr int BATCH = 16, SEQ = 4096, D = 1024, T = BATCH * SEQ;
constexpr int IN_COLS = 4768, N1 = 4864;
constexpr int MEM_LEN = 256, MROWS = BATCH * MEM_LEN;
constexpr int NEXP = 32, TOPK = 4, DFF = 1024, LISTCAP = T;
constexpr int ACT_TILES_MAX = (T * TOPK) / 256 + NEXP;
constexpr float EPS = 1e-6f;
constexpr float C2_MLA = 0.10206207261596575f * 1.4426950408889634f;
constexpr float C2_X = 0.08838834764831845f * 1.4426950408889634f;
constexpr float SX8 = 4.0f, SW8 = 64.0f, SA8 = 4.0f, SY8 = 8.0f, SH8 = 8.0f;
constexpr float SC8 = 20.0f, SWQ8 = 440.0f, SWKV8 = 360.0f;
constexpr float SM8 = 32.0f;
constexpr float SWI8 = 720.0f;
constexpr int PER_PHASE = 11;
constexpr int N_LAUNCHES = MK_N_LAUNCHES;

constexpr size_t MiB = 1u << 20;
constexpr size_t WS_CTL = 0, CTL_ZERO_BYTES = 1 * MiB;
constexpr size_t WS_LIST = 1 * MiB;
constexpr size_t WS_TOKG = 9 * MiB;
constexpr size_t WS_RSTD2 = 10 * MiB;
constexpr size_t WS_W1T = 9 * MiB;
constexpr size_t WS_WUQ = 19 * MiB;
constexpr size_t WS_WUKV = 20 * MiB;
constexpr size_t WS_WMEM = 21 * MiB;
constexpr size_t WS_WPOOL = 23 * MiB;
constexpr size_t WS_WMO = 24 * MiB, WS_WCO = 25 * MiB;
constexpr size_t WS_WO = 26 * MiB;
constexpr size_t WS_MEMN = 28 * MiB;
constexpr size_t WS_KVMK = 36 * MiB;
constexpr size_t WS_VTG = 40 * MiB;
constexpr size_t WS_HN = 64 * MiB;
constexpr size_t WS_V = 64 * MiB, WS_MIXED = 128 * MiB;
constexpr size_t WS_HSC = 60 * MiB;
constexpr size_t WS_CQ8 = 384 * MiB, WS_CKV8 = 416 * MiB;
constexpr size_t WS_RSQ = 62 * MiB;
constexpr size_t WS_MSC = 61 * MiB;
constexpr size_t WS_HN8 = 128 * MiB;
constexpr size_t WS_W1G8 = 448 * MiB;
constexpr size_t WS_GATES = 192 * MiB;
constexpr size_t WS_U = 576 * MiB, WS_AO = 576 * MiB;
constexpr size_t WS_CQKV = 640 * MiB, WS_CO = 640 * MiB;
constexpr size_t WS_QX = 736 * MiB;
constexpr size_t WS_Q = 800 * MiB;
constexpr size_t WS_KV = 896 * MiB, WS_MERGED = 896 * MiB;
constexpr size_t WS_HN2 = 16 * MiB;
constexpr size_t WS_WEI = 456 * MiB;
constexpr size_t WS_Y = 16 * MiB;
constexpr size_t WS_DELTA = 552 * MiB;
constexpr size_t WS_ACT = 680 * MiB;
constexpr size_t WS_WEO = 520 * MiB;
constexpr size_t WS_LRS = 960 * MiB, WS_LGATE = 968 * MiB;
constexpr size_t WS_RK = 552 * MiB;
constexpr size_t WS_PE = 560 * MiB, WS_PART = 568 * MiB;
constexpr size_t WS_END = 992 * MiB;
static_assert(WS_Y + (size_t)T * 4 * 1024 <= WS_WEI && WS_W1G8 + 3 * MiB <= WS_WEI && WS_WEI + (size_t)NEXP * 2048 * 1024 <= WS_WEO && WS_WEO + (size_t)NEXP * 1024 * 1024 <= WS_DELTA && WS_DELTA + (size_t)T * 1024 * 2 <= WS_ACT && WS_ACT + (size_t)ACT_TILES_MAX * 256 * 1024 <= WS_LRS && WS_DELTA + (size_t)T * 1024 * 2 <= WS_MERGED && WS_WEO + (size_t)NEXP * 1024 * 1024 <= WS_U, "late map / expert weight copies (written during P4, live to P9)");
static_assert(WS_W1T + (size_t)N1 * 1024 * 2 <= WS_WUQ && WS_VTG + 4 * MiB <= WS_HN && WS_GATES + (size_t)T * 3072 * 2 <= WS_U && WS_CQKV + (size_t)T * 768 * 2 <= WS_QX && WS_Q + (size_t)T * 768 * 2 <= WS_KV, "early map");
constexpr int CW_TMO = 0, CW_CODE = 1;
constexpr int CW_BAR = 4096;
constexpr int CW_GCNT = 16384;
constexpr int RING_OFF = 0, RING_BYTES = 131072;
constexpr int LDSCTL_OFF = RING_BYTES, MISC_OFF = LDSCTL_OFF + 320;
constexpr int LX_TSTART = LDSCTL_OFF + 512;
constexpr int LX_CNT = LDSCTL_OFF + 768;
constexpr int LX_LCNT = LDSCTL_OFF + 1024;
constexpr int LX_BASE = LDSCTL_OFF + 1280;
constexpr int LX_XWS = LDSCTL_OFF + 2048;
constexpr int LX_STASH = LDSCTL_OFF + 4096;
constexpr int LX_GATE = LDSCTL_OFF + 8192;
constexpr int LX_RS = LDSCTL_OFF + 12288;
constexpr int LX_TEXP = LDSCTL_OFF + 4096;
constexpr int LX_LSTG = LDSCTL_OFF + 6144;
constexpr int LX_RSKV = LDSCTL_OFF + 4096, LX_PESS = LDSCTL_OFF + 5120;
constexpr int LDS_BYTES = 147456;
static_assert(LX_RS + 1024 <= LDS_BYTES && LX_GATE + 4096 <= LX_RS && mla::LDS_BYTES <= RING_BYTES, "LDS map");

#define GAS __attribute__((address_space(1)))
#define LAS __attribute__((address_space(3)))
typedef unsigned short bf16;
typedef unsigned v4u __attribute__((ext_vector_type(4)));
typedef unsigned v2u __attribute__((ext_vector_type(2)));
typedef float f32x4 __attribute__((ext_vector_type(4)));
typedef float f32x16 __attribute__((ext_vector_type(16)));
typedef short bf16x8 __attribute__((ext_vector_type(8)));
typedef GAS unsigned gu32;
#define RLX_AGENT __ATOMIC_RELAXED, __HIP_MEMORY_SCOPE_AGENT
#define LDS_WAIT() asm volatile("s_waitcnt lgkmcnt(0)" ::: "memory")
#define VM_WAIT() asm volatile("s_waitcnt vmcnt(0)" ::: "memory")
__device__ __forceinline__ unsigned f2bf(float f) { unsigned u = __builtin_bit_cast(unsigned, f); return (u + 0x7fffu + ((u >> 16) & 1u)) >> 16; }
__device__ __forceinline__ unsigned pk2(float lo, float hi) { return pg8::cvt_pk_bf16(lo, hi); }
__device__ __forceinline__ float bflo(unsigned w) { return __uint_as_float(w << 16); }
__device__ __forceinline__ float bfhi(unsigned w) { return __uint_as_float(w & 0xffff0000u); }
__device__ __forceinline__ unsigned pk4_fp8(float a, float b, float c, float d) { int w = 0; w = __builtin_amdgcn_cvt_pk_fp8_f32(a, b, w, false); w = __builtin_amdgcn_cvt_pk_fp8_f32(c, d, w, true); return (unsigned)w; }

#define XB_TMO      128
#define XB_XCNT(j)  (256  + 64 * (j))
#define XB_XSUB(j)  (1280 + 64 * (j))
#define XB_XGEN(j)  (2304 + 64 * (j))
#define XB_TOP      3328
#define XB_TOPGEN   3392
#define XCD_BAR_WORDS 3456
#define XB_SPIN_CAP (1u << 18)
__device__ __forceinline__ unsigned xb_ld(unsigned* p)              { return __hip_atomic_load(p, __ATOMIC_RELAXED, __HIP_MEMORY_SCOPE_AGENT); }
__device__ __forceinline__ unsigned xb_add(unsigned* p, unsigned v) { return __hip_atomic_fetch_add(p, v, __ATOMIC_RELAXED, __HIP_MEMORY_SCOPE_AGENT); }
__device__ __forceinline__ unsigned xb_xcc_id() { return (unsigned)__builtin_amdgcn_s_getreg((3 << 11) | 20) & 0xFu; }
#define XB_SPIN(cond, bar) do { unsigned _sp = 0; while (cond) { __builtin_amdgcn_s_sleep(1); \
    if ((++_sp & 255u) == 0u) { if (xb_ld(&(bar)[XB_TMO])) break; if (_sp > XB_SPIN_CAP) { atomicAdd(&(bar)[XB_TMO], 1u); break; } } } } while (0)
struct XcdBarrier { unsigned* bar; unsigned x; volatile LAS unsigned* st; };
__device__ __forceinline__ XcdBarrier xcd_barrier_post(unsigned* bar, volatile LAS unsigned* st, const bool thread0) {
    XcdBarrier b; b.bar = bar; b.x = xb_xcc_id(); b.st = st;
    if (thread0) (void)xb_add(&bar[XB_XCNT(b.x)], 1u);
    return b;
}
__device__ __forceinline__ void xcd_barrier_complete(unsigned* bar, unsigned x, unsigned& nloc, unsigned& nx) {
    const unsigned G = gridDim.x * gridDim.y * gridDim.z;
    unsigned sum, cnt, mine, sp = 0u;
    for (;;) {
        sum = 0u; cnt = 0u; mine = 0u;
#pragma unroll
        for (unsigned j = 0; j < 16; ++j) { const unsigned c = xb_ld(&bar[XB_XCNT(j)]); sum += c; cnt += (c > 0u) ? 1u : 0u; mine = (j == x) ? c : mine; }
        if (sum == G) break;
        __builtin_amdgcn_s_sleep(1);
        if ((++sp & 255u) == 0u) { if (xb_ld(&bar[XB_TMO])) break; if (sp > XB_SPIN_CAP) { atomicAdd(&bar[XB_TMO], 1u); break; } }
    }
    nloc = mine > 0u ? mine : 1u; nx = cnt > 0u ? cnt : 1u;
}
__device__ __forceinline__ void xcd_barrier(const XcdBarrier& b, const bool thread0) {
    asm volatile("s_waitcnt vmcnt(0)" ::: "memory");
    __syncthreads();
    if (thread0) {
        unsigned* bar = b.bar;
        __builtin_amdgcn_s_waitcnt(0);
        unsigned nloc = b.st[0], nx = b.st[1];
        if (nloc == 0u) { xcd_barrier_complete(bar, b.x, nloc, nx); b.st[0] = nloc; b.st[1] = nx; }
        const unsigned old = xb_add(&bar[XB_XSUB(b.x)], 1u);
        const unsigned gen = old / nloc;
        if (old + 1u == (gen + 1u) * nloc) {
            __builtin_amdgcn_fence(__ATOMIC_RELEASE, "agent");
            asm volatile("s_waitcnt vmcnt(0)" ::: "memory");
            const unsigned og = xb_add(&bar[XB_TOP], 1u);
            const unsigned tg = og / nx;
            if (og + 1u == (tg + 1u) * nx) xb_add(&bar[XB_TOPGEN], 1u);
            else XB_SPIN(xb_ld(&bar[XB_TOPGEN]) == tg, bar);
            __builtin_amdgcn_fence(__ATOMIC_ACQUIRE, "agent");
            xb_add(&bar[XB_XGEN(b.x)], 1u);
            asm volatile("s_waitcnt vmcnt(0)" ::: "memory");
        } else {
            XB_SPIN(xb_ld(&bar[XB_XGEN(b.x)]) == gen, bar);
            __builtin_amdgcn_fence(__ATOMIC_ACQUIRE, "agent");
            asm volatile("s_waitcnt vmcnt(0)" ::: "memory");
        }
    }
    __syncthreads();
}

struct Frame {
    LAS unsigned char* lds;
    volatile LAS unsigned* MISC;
    gu32* ctl;
    int tid, lane, wave;
    int vcu, G;
    unsigned char* ws;
    const float* const* in;
    float* out;
};
__device__ __forceinline__ float wave_sum(float v) {
#pragma unroll
    for (int o = 1; o < 64; o <<= 1) v += __shfl_xor(v, o);
    return v;
}
__device__ __forceinline__ float sumsq8(v4u w) {
    float s = 0.f;
#pragma unroll
    for (int i = 0; i < 4; ++i) { const float a = bflo(w[i]), b = bfhi(w[i]); s += a * a + b * b; }
    return s;
}
__device__ __forceinline__ void transpose_item(const float* W, int ldw, int srccol, const float* ks, bf16* WT, int K, int nrow0, int k0, LAS float* scr, int lane) {
    float v[32];
#pragma unroll
    for (int i = 0; i < 32; ++i) v[i] = 0.f;
    if (srccol >= 0) {
#pragma unroll
        for (int i = 0; i < 32; ++i) { const int kk = 2 * i + (lane >> 5); v[i] = W[(size_t)(k0 + kk) * ldw + srccol + (lane & 31)]; } }
    if (ks) {
#pragma unroll
        for (int i = 0; i < 32; ++i) v[i] *= ks[k0 + 2 * i + (lane >> 5)]; }
#pragma unroll
    for (int i = 0; i < 32; ++i) scr[(2 * i + (lane >> 5)) * 33 + (lane & 31)] = v[i];
    LDS_WAIT(); asm volatile("" ::: "memory");
    const int c = lane & 7;
#pragma unroll
    for (int j = 0; j < 4; ++j) { const int n = (lane >> 3) + 8 * j; const LAS float* s = scr + (8 * c) * 33 + n;
        v4u o; o.x = pk2(s[0 * 33], s[1 * 33]); o.y = pk2(s[2 * 33], s[3 * 33]); o.z = pk2(s[4 * 33], s[5 * 33]); o.w = pk2(s[6 * 33], s[7 * 33]);
        *(GAS v4u*)(WT + (size_t)(nrow0 + n) * K + k0 + 8 * c) = o; }
    LDS_WAIT(); asm volatile("" ::: "memory");
}
__device__ __forceinline__ unsigned pk4_i8(float a, float b, float c, float d) {
    const int ia = (int)__builtin_rintf(fminf(fmaxf(a, -127.f), 127.f)), ib = (int)__builtin_rintf(fminf(fmaxf(b, -127.f), 127.f)), ic = (int)__builtin_rintf(fminf(fmaxf(c, -127.f), 127.f)), id = (int)__builtin_rintf(fminf(fmaxf(d, -127.f), 127.f));
    return (unsigned)(ia & 255) | ((unsigned)(ib & 255) << 8) | ((unsigned)(ic & 255) << 16) | ((unsigned)id << 24); }
__device__ __forceinline__ void transpose_item_i8(const float* W, int ldw, int srccol, float scale, unsigned char* WT, int K, int nrow0, int k0, LAS float* scr, int lane, const float* ks = nullptr) {
    float v[32];
#pragma unroll
    for (int i = 0; i < 32; ++i) v[i] = 0.f;
    if (srccol >= 0) {
#pragma unroll
        for (int i = 0; i < 32; ++i) { const int kk = 2 * i + (lane >> 5); v[i] = W[(size_t)(k0 + kk) * ldw + srccol + (lane & 31)] * scale; } }
    if (ks && srccol >= 0) {
#pragma unroll
        for (int i = 0; i < 32; ++i) v[i] *= ks[k0 + 2 * i + (lane >> 5)]; }
#pragma unroll
    for (int i = 0; i < 32; ++i) scr[(2 * i + (lane >> 5)) * 33 + (lane & 31)] = v[i];
    LDS_WAIT(); asm volatile("" ::: "memory");
    const int c = lane & 7;
#pragma unroll
    for (int j = 0; j < 4; ++j) { const int n = (lane >> 3) + 8 * j; const LAS float* s = scr + (8 * c) * 33 + n;
        v2u o; o.x = pk4_i8(s[0 * 33], s[1 * 33], s[2 * 33], s[3 * 33]); o.y = pk4_i8(s[4 * 33], s[5 * 33], s[6 * 33], s[7 * 33]);
        *(GAS v2u*)(WT + (size_t)(nrow0 + n) * K + k0 + 8 * c) = o; }
    LDS_WAIT(); asm volatile("" ::: "memory");
}
template <int NR> __device__ __forceinline__ void rms_rows_to_i8(int lane, const float* x0, size_t xstride, const f32x4 (&gg)[4], unsigned char* o0, float* hsc, int row0, int rstride, unsigned char* o8 = nullptr) {
    f32x4 v[NR][4];
#pragma unroll
    for (int r = 0; r < NR; ++r) { const GAS f32x4* xr = (const GAS f32x4*)(x0 + r * xstride) + lane;
#pragma unroll
        for (int j = 0; j < 4; ++j) v[r][j] = xr[64 * j]; }
#pragma unroll
    for (int r = 0; r < NR; ++r) { float s = 0.f, mx = 0.f;
#pragma unroll
        for (int j = 0; j < 4; ++j) { s += (v[r][j].x * v[r][j].x + v[r][j].y * v[r][j].y) + (v[r][j].z * v[r][j].z + v[r][j].w * v[r][j].w); v[r][j] = v[r][j] * gg[j];
            mx = fmaxf(mx, fmaxf(fmaxf(fabsf(v[r][j].x), fabsf(v[r][j].y)), fmaxf(fabsf(v[r][j].z), fabsf(v[r][j].w)))); }
#pragma unroll
        for (int o = 1; o < 64; o <<= 1) mx = fmaxf(mx, __shfl_xor(mx, o));
        const float rstd = 1.0f / sqrtf(wave_sum(s) * (1.f / 1024.f) + EPS);
        const float q = mx > 0.f ? 127.0f / mx : 0.f;
        GAS unsigned* o4 = (GAS unsigned*)(o0 + (size_t)r * xstride) + lane;
#pragma unroll
        for (int j = 0; j < 4; ++j) o4[64 * j] = pk4_i8(v[r][j].x * q, v[r][j].y * q, v[r][j].z * q, v[r][j].w * q);
        if (o8) { GAS unsigned* q8 = (GAS unsigned*)(o8 + (size_t)r * xstride) + lane; const float r8 = rstd * SH8;
#pragma unroll
            for (int j = 0; j < 4; ++j) q8[64 * j] = pk4_fp8(v[r][j].x * r8, v[r][j].y * r8, v[r][j].z * r8, v[r][j].w * r8); }
        if (lane == 0) hsc[row0 + r * rstride] = mx * rstd * (1.0f / (127.0f * SWI8)); }
}
__device__ __forceinline__ void transpose_item8(const float* W, int ldw, int srccol, const float* ks, float scale, unsigned char* WT, int K, int nrow0, int k0, LAS float* scr, int lane) {
    float v[32];
#pragma unroll
    for (int i = 0; i < 32; ++i) { const int kk = 2 * i + (lane >> 5); v[i] = W[(size_t)(k0 + kk) * ldw + srccol + (lane & 31)] * scale; }
    if (ks) {
#pragma unroll
        for (int i = 0; i < 32; ++i) v[i] *= ks[k0 + 2 * i + (lane >> 5)]; }
#pragma unroll
    for (int i = 0; i < 32; ++i) scr[(2 * i + (lane >> 5)) * 33 + (lane & 31)] = v[i];
    LDS_WAIT(); asm volatile("" ::: "memory");
    const int c = lane & 7;
#pragma unroll
    for (int j = 0; j < 4; ++j) { const int n = (lane >> 3) + 8 * j; const LAS float* s = scr + (8 * c) * 33 + n;
        v2u o; o.x = pk4_fp8(s[0 * 33], s[1 * 33], s[2 * 33], s[3 * 33]); o.y = pk4_fp8(s[4 * 33], s[5 * 33], s[6 * 33], s[7 * 33]);
        *(GAS v2u*)(WT + (size_t)(nrow0 + n) * K + k0 + 8 * c) = o; }
    LDS_WAIT(); asm volatile("" ::: "memory");
}
template <int NR> __device__ __forceinline__ void rms_rows_to_bf16(int lane, const float* x0, size_t xstride, const f32x4 (&gg)[4], bf16* o0, size_t ostride, unsigned char* o8f = nullptr) {
    f32x4 v[NR][4];
#pragma unroll
    for (int r = 0; r < NR; ++r) { const GAS f32x4* xr = (const GAS f32x4*)(x0 + r * xstride) + lane;
#pragma unroll
        for (int j = 0; j < 4; ++j) v[r][j] = xr[64 * j]; }
#pragma unroll
    for (int r = 0; r < NR; ++r) { float s = 0.f;
#pragma unroll
        for (int j = 0; j < 4; ++j) s += (v[r][j].x * v[r][j].x + v[r][j].y * v[r][j].y) + (v[r][j].z * v[r][j].z + v[r][j].w * v[r][j].w);
        const float rstd = 1.0f / sqrtf(wave_sum(s) * (1.f / 1024.f) + EPS);
        GAS unsigned long long* o8 = (GAS unsigned long long*)(o0 + r * ostride) + lane;
#pragma unroll
        for (int j = 0; j < 4; ++j)
            o8[64 * j] = (unsigned long long)pk2(v[r][j].x * rstd * gg[j].x, v[r][j].y * rstd * gg[j].y) | ((unsigned long long)pk2(v[r][j].z * rstd * gg[j].z, v[r][j].w * rstd * gg[j].w) << 32);
        if (o8f) { GAS unsigned* q = (GAS unsigned*)(o8f + r * ostride) + lane; const float r8 = rstd * SH8;
#pragma unroll
            for (int j = 0; j < 4; ++j) q[64 * j] = pk4_fp8(v[r][j].x * r8 * gg[j].x, v[r][j].y * r8 * gg[j].y, v[r][j].z * r8 * gg[j].z, v[r][j].w * r8 * gg[j].w); } }
}
__device__ __forceinline__ void rms_rows_all(int lane, int gw, int NGW, const float* X, const float* g, bf16* O, int nrows, unsigned char* O8 = nullptr) {
    f32x4 gg[4];
#pragma unroll
    for (int j = 0; j < 4; ++j) gg[j] = ((const GAS f32x4*)g + lane)[64 * j];
    int m = gw;
    for (; m + 3 * NGW < nrows; m += 4 * NGW) rms_rows_to_bf16<4>(lane, X + (size_t)m * D, (size_t)NGW * D, gg, O + (size_t)m * D, (size_t)NGW * D, O8 ? O8 + (size_t)m * D : nullptr);
    for (; m < nrows; m += NGW) rms_rows_to_bf16<1>(lane, X + (size_t)m * D, 0, gg, O + (size_t)m * D, 0, O8 ? O8 + (size_t)m * D : nullptr);
}

enum { I_X = 0, I_MEM, I_POS, I_GATTN, I_WIN, I_WPOOL, I_PSCALE, I_GQL, I_WUQ, I_GKVL, I_WUKV, I_GQM, I_GKM, I_GMEM, I_WMEMKV, I_GQC, I_GKC, I_WPO, I_WMO, I_WCO, I_WO, I_GFFN,
       I_WR, I_BR, I_WEI, I_BEI, I_WEO, I_BEO, N_IN };

__device__ __forceinline__ int fresh_lane() { int l; asm volatile("v_mbcnt_lo_u32_b32 %0, -1, 0\n\tv_mbcnt_hi_u32_b32 %0, -1, %0" : "=v"(l)); return l; }
#define REFRESH(F) do { int w_ = (F).wave; asm volatile("" : "+s"(w_)); (F).wave = w_; (F).lane = fresh_lane(); (F).tid = w_ * 64 + (F).lane; } while (0)
__device__ __forceinline__ void stagger(int g, int ticks) { if (g > 0) { const unsigned long long t0 = __builtin_amdgcn_s_memrealtime(), d = (unsigned long long)(g * ticks); while (__builtin_amdgcn_s_memrealtime() - t0 < d) __builtin_amdgcn_s_sleep(8); } }
#ifndef MK_STAG1
#define MK_STAG1 0
#endif
__device__ __forceinline__ void p0_prologue(Frame& F) {
    LAS float* scr = (LAS float*)(F.lds + RING_OFF + F.wave * 16384);
    const int gw = F.vcu * NWAVES + F.wave, NGW = F.G * NWAVES, lane = F.lane;
    unsigned char* ws = F.ws;
    constexpr int I1 = 16 * (1792 / 32), I1G = 16 * (3072 / 32), I2 = 8 * 24, I3 = 4 * 32, I4 = 16 * 32, I5 = 8 * 32, I6 = 8 * 32, I7 = 16 * 32;
    constexpr int NITEMS = I1 + I1G + I2 + I3 + I4 + I5 + I6 + I7;
    for (int it = gw; it < NITEMS; it += NGW) {
        int r = it;
        if (r < I1) { const int nnb = 1792 / 32, kb = r / nnb, nb = r % nnb, n0 = nb * 32; const int src = n0 < 1184 ? n0 : (n0 < 1280 ? -1 : n0 - 96);
            transpose_item_i8(F.in[I_WIN], IN_COLS, src, SWI8, ws + WS_W1T, 1024, n0, kb * 64, scr, lane); continue; } r -= I1;
        if (r < I1G) { const int nnb = 3072 / 32, kb = r / nnb, nb = r % nnb, n0 = nb * 32;
            transpose_item8(F.in[I_WIN], IN_COLS, 1696 + n0, nullptr, SW8, ws + WS_W1G8, 1024, n0, kb * 64, scr, lane); continue; } r -= I1G;
        if (r < I2) { const int kb = r / 24, nb = r % 24; transpose_item_i8(F.in[I_WUQ], 768, kb < 6 ? nb * 32 : -1, SWQ8, ws + WS_WUQ, 512, nb * 32, kb * 64, scr, lane, F.in[I_GQL]); continue; } r -= I2;
        if (r < I3) { const int kb = r / 32, nb = r % 32, head = 2 * (nb >> 3) + ((nb >> 1) & 1), lb = head * 4 + (nb & 1) * 2 + ((nb >> 2) & 1);
            transpose_item_i8(F.in[I_WUKV], 1024, lb * 32, SWKV8, ws + WS_WUKV, 256, nb * 32, kb * 64, scr, lane, F.in[I_GKVL]); continue; } r -= I3;
        if (r < I4) { const int kb = r / 32, nb = r % 32; transpose_item_i8(F.in[I_WMEMKV], 1024, nb * 32, SWI8, ws + WS_WMEM, 1024, nb * 32, kb * 64, scr, lane); continue; } r -= I4;
        if (r < I5) { const int kb = r / 32, nb = r % 32; transpose_item(F.in[I_WMO], 1024, nb * 32, nullptr, (bf16*)(ws + WS_WMO), 512, nb * 32, kb * 64, scr, lane); continue; } r -= I5;
        if (r < I6) { const int kb = r / 32, nb = r % 32; transpose_item(F.in[I_WCO], 1024, nb * 32, nullptr, (bf16*)(ws + WS_WCO), 512, nb * 32, kb * 64, scr, lane); continue; } r -= I6;
        { const int kb = r / 32, nb = r % 32; transpose_item_i8(F.in[I_WO], 1024, nb * 32, SWI8, ws + WS_WO, 1024, nb * 32, kb * 64, scr, lane); }
    }
    for (int it = gw; it < 2048; it += NGW) {
        const int kc = it >> 2, dq = it & 3, g = kc >> 7; const float* wp = F.in[I_WPOOL] + (size_t)kc * 128; const float* ps = F.in[I_PSCALE] + g * 128; const float* wpo = F.in[I_WPO] + (size_t)(g * 128) * 1024 + dq * 256 + lane;
        float a[4] = {0.f, 0.f, 0.f, 0.f};
#pragma unroll 8
        for (int j = 0; j < 128; ++j) { const float sc = wp[j] * ps[j]; const float* row = wpo + (size_t)j * 1024;
#pragma unroll
            for (int i = 0; i < 4; ++i) a[i] += sc * row[64 * i]; }
        bf16* wt = (bf16*)(ws + WS_WPOOL);
#pragma unroll
        for (int i = 0; i < 4; ++i) wt[(size_t)(dq * 256 + lane + 64 * i) * 512 + kc] = (bf16)f2bf(a[i]);
    }
    { f32x4 gg[4];
#pragma unroll
      for (int j = 0; j < 4; ++j) gg[j] = ((const GAS f32x4*)F.in[I_GATTN] + lane)[64 * j];
      int m = gw;
      for (; m + 3 * NGW < T; m += 4 * NGW) rms_rows_to_i8<4>(lane, F.in[I_X] + (size_t)m * D, (size_t)NGW * D, gg, ws + WS_HN + (size_t)m * D, (float*)(ws + WS_HSC), m, NGW, ws + WS_HN8 + (size_t)m * D);
      for (; m < T; m += NGW) rms_rows_to_i8<1>(lane, F.in[I_X] + (size_t)m * D, 0, gg, ws + WS_HN + (size_t)m * D, (float*)(ws + WS_HSC), m, 0, ws + WS_HN8 + (size_t)m * D); }
    { f32x4 gg[4];
#pragma unroll
      for (int j = 0; j < 4; ++j) gg[j] = ((const GAS f32x4*)F.in[I_GMEM] + lane)[64 * j];
      for (int m = gw; m < MROWS; m += NGW) rms_rows_to_i8<1>(lane, F.in[I_MEM] + (size_t)m * D, 0, gg, ws + WS_MEMN + (size_t)m * D, (float*)(ws + WS_MSC), m, 0); }
}

using pg8::Unit; using pg8::bf16_t;
struct DenseSched {
    int nM, nN, G, c; const char* A; const char* B; size_t tA, tB;
    __device__ __forceinline__ void init(const void* A_, int lda, const void* B_, int ldb, int M, int N, int G_, int c_) { A = (const char*)A_; B = (const char*)B_; nM = M / 256; nN = N / 256; G = G_; c = c_; tA = (size_t)256 * lda * 2; tB = (size_t)256 * ldb * 2; }
    __device__ __forceinline__ bool next(int i, Unit& u) const {
        const long L = (long)i * G + c; if (L >= (long)nM * nN) return false;
        pg8::tile_order((int)L, nM, nN, u.pm, u.pn); u.A = A + (size_t)u.pm * tA; u.B = B + (size_t)u.pn * tB; u.aux = 0; return true; }
};
struct EpiNull { static constexpr bool PERM = true, ACCUM = false;
    __device__ __forceinline__ void operator()(const pg8::f32x4 (&acc)[2][2][4][2], const Unit& u, int wr, int wc, int fr_, int fq_) const {
#pragma unroll
        for (int a = 0; a < 2; ++a)
#pragma unroll
            for (int b = 0; b < 2; ++b)
#pragma unroll
                for (int m = 0; m < 4; ++m) asm volatile("" :: "v"(acc[a][b][m][0]), "v"(acc[a][b][m][1])); } };
struct EpiStore {
    static constexpr bool PERM = true, ACCUM = false;
    bf16_t* O; int ldc; float sc = 1.0f;
    __device__ __forceinline__ void operator()(const pg8::f32x4 (&acc)[2][2][4][2], const Unit& u, int wr, int wc, int fr_, int fq_) const {
        int fr = fr_, fq = fq_; asm volatile("" : "+v"(fr), "+v"(fq));
        const int row0 = u.pm * 256 + wr * 64 + fr, col0 = u.pn * 256 + wc * 32 + 8 * fq;
#pragma unroll
        for (int ai = 0; ai < 2; ++ai)
#pragma unroll
            for (int m = 0; m < 4; ++m) { bf16_t* rowp = O + (size_t)(row0 + ai * 128 + m * 16) * ldc + col0;
#pragma unroll
                for (int bj = 0; bj < 2; ++bj) { const pg8::f32x4 v0 = acc[ai][bj][m][0] * sc, v1 = acc[ai][bj][m][1] * sc; pg8::u32x4 w;
                    w.x = pg8::cvt_pk_bf16(v0[0], v0[1]); w.y = pg8::cvt_pk_bf16(v0[2], v0[3]); w.z = pg8::cvt_pk_bf16(v1[0], v1[1]); w.w = pg8::cvt_pk_bf16(v1[2], v1[3]);
                    *(pg8::u32x4*)(rowp + bj * 128) = w; } }
    }
};
struct EpiP1 {
    static constexpr bool PERM = true, ACCUM = false;
    bf16_t *U, *QX; const float* hsc; unsigned char *CQ8, *CKV8; float *PART, *PE;
    __device__ __forceinline__ void operator()(const pg8::f32x4 (&acc)[2][2][4][2], const Unit& u, int wr, int wc, int fr_, int fq_) const {
        int fr = fr_, fq = fq_; asm volatile("" : "+v"(fr), "+v"(fq));
        const int pn = u.pn; bf16_t* base; int ldc, colt;
        if (pn < 2) { base = U; ldc = 512; colt = pn * 256; } else if (pn < 5) { base = U; ldc = 0; colt = (pn - 2) * 256; }
        else { base = QX; ldc = 512; colt = (pn - 5) * 256; }
        const int row0 = u.pm * 256 + wr * 64 + fr, col0 = colt + wc * 32 + 8 * fq;
        float sc[8];
#pragma unroll
        for (int i = 0; i < 8; ++i) sc[i] = hsc[row0 + (i >> 2) * 128 + (i & 3) * 16];
#pragma unroll
        for (int ai = 0; ai < 2; ++ai)
#pragma unroll
            for (int m = 0; m < 4; ++m) { bf16_t* rowp = base + (size_t)(row0 + ai * 128 + m * 16) * ldc + col0; const float s1 = sc[ai * 4 + m];
#pragma unroll
                for (int bj = 0; bj < 2; ++bj) { const pg8::f32x4 v0 = acc[ai][bj][m][0] * s1, v1 = acc[ai][bj][m][1] * s1;
                    if (pn < 2 || pn >= 5) {
                        pg8::u32x4 w; w.x = pg8::cvt_pk_bf16(v0[0], v0[1]); w.y = pg8::cvt_pk_bf16(v0[2], v0[3]); w.z = pg8::cvt_pk_bf16(v1[0], v1[1]); w.w = pg8::cvt_pk_bf16(v1[2], v1[3]);
                        *(pg8::u32x4*)(rowp + bj * 128) = w;
                    } else {
                        const int cc = col0 + bj * 128, blk = (pn - 2) * 2 + bj; const size_t row = (size_t)(row0 + ai * 128 + m * 16);
                        if (cc < 640) { pg8::u32x2 q; q.x = pk4_i8(v0[0] * SC8, v0[1] * SC8, v0[2] * SC8, v0[3] * SC8); q.y = pk4_i8(v1[0] * SC8, v1[1] * SC8, v1[2] * SC8, v1[3] * SC8);
                            unsigned char* d = cc < 384 ? CQ8 + row * 512 + cc : CKV8 + row * 256 + (cc - 384);
                            *(pg8::u32x2*)d = q; }
                        if (blk < 5) { float p = v0[0] * v0[0] + v0[1] * v0[1] + v0[2] * v0[2] + v0[3] * v0[3] + v1[0] * v1[0] + v1[1] * v1[1] + v1[2] * v1[2] + v1[3] * v1[3];
                            p += __shfl_xor(p, 16); p += __shfl_xor(p, 32);
                            if (fq == 0) PART[row * 20 + blk * 4 + wc] = p; }
                        else if (wc == 0) { *(pg8::f32x4*)(PE + row * 32 + 8 * fq) = v0; *(pg8::f32x4*)(PE + row * 32 + 8 * fq + 4) = v1; } } } }
    }
};
struct EpiGate8 {
    static constexpr bool PERM = true, ACCUM = false;
    unsigned char* GATES; float cs;
    __device__ __forceinline__ void operator()(const pg8::f32x4 (&acc)[2][2][4][2], const Unit& u, int wr, int wc, int fr_, int fq_) const {
        int fr = fr_, fq = fq_; asm volatile("" : "+v"(fr), "+v"(fq));
        const int row0 = u.pm * 256 + wr * 64 + fr, col0 = u.pn * 256 + wc * 32 + 8 * fq;
        float sc[8];
#pragma unroll
        for (int i = 0; i < 8; ++i) sc[i] = cs;
#pragma unroll
        for (int ai = 0; ai < 2; ++ai)
#pragma unroll
            for (int m = 0; m < 4; ++m) { unsigned char* rowp = GATES + (size_t)(row0 + ai * 128 + m * 16) * 3072 + col0; const float s1 = sc[ai * 4 + m];
#pragma unroll
                for (int bj = 0; bj < 2; ++bj) { unsigned q[8]; typedef float f2 __attribute__((ext_vector_type(2)));
#pragma unroll
                    for (int n = 0; n < 2; ++n)
#pragma unroll
                        for (int i = 0; i < 4; i += 2) { const f2 z = (f2){acc[ai][bj][m][n][i], acc[ai][bj][m][n][i + 1]} * s1;
                            f2 ee; ee.x = __builtin_amdgcn_exp2f(z.x); ee.y = __builtin_amdgcn_exp2f(z.y); const f2 dd = ee + 1.0f;
                            f2 g; g.x = __builtin_amdgcn_rcpf(dd.x); g.y = __builtin_amdgcn_rcpf(dd.y); g = g * 256.0f;
                            const unsigned q0 = (unsigned)g.x, q1 = (unsigned)g.y; q[4 * n + i] = q0 < 255u ? q0 : 255u; q[4 * n + i + 1] = q1 < 255u ? q1 : 255u; }
                    pg8::u32x2 w; w.x = q[0] | (q[1] << 8) | (q[2] << 16) | (q[3] << 24); w.y = q[4] | (q[5] << 8) | (q[6] << 16) | (q[7] << 24);
                    *(pg8::u32x2*)(rowp + bj * 128) = w; } }
    }
};
struct EpiMemKV {
    static constexpr bool PERM = true, ACCUM = false;
    bf16_t *KVMK, *VTG; const float* msc;
    __device__ __forceinline__ void operator()(const pg8::f32x4 (&acc)[2][2][4][2], const Unit& u, int wr, int wc, int fr_, int fq_) const {
        int fr = fr_, fq = fq_; asm volatile("" : "+v"(fr), "+v"(fq));
        const int row0 = u.pm * 256 + wr * 64 + fr;
        float sc[8];
#pragma unroll
        for (int i = 0; i < 8; ++i) sc[i] = msc[row0 + (i >> 2) * 128 + (i & 3) * 16];
        if (u.pn < 2) {
            const int col0 = u.pn * 256 + wc * 32 + 8 * fq;
#pragma unroll
            for (int ai = 0; ai < 2; ++ai)
#pragma unroll
                for (int m = 0; m < 4; ++m) { bf16_t* rowp = KVMK + (size_t)(row0 + ai * 128 + m * 16) * 512 + col0;
#pragma unroll
                    for (int bj = 0; bj < 2; ++bj) { const pg8::f32x4 v0 = acc[ai][bj][m][0] * sc[ai * 4 + m], v1 = acc[ai][bj][m][1] * sc[ai * 4 + m]; pg8::u32x4 w;
                        w.x = pg8::cvt_pk_bf16(v0[0], v0[1]); w.y = pg8::cvt_pk_bf16(v0[2], v0[3]); w.z = pg8::cvt_pk_bf16(v1[0], v1[1]); w.w = pg8::cvt_pk_bf16(v1[2], v1[3]);
                        *(pg8::u32x4*)(rowp + bj * 128) = w; } }
        } else {
#pragma unroll
            for (int ai = 0; ai < 2; ++ai)
#pragma unroll
                for (int m = 0; m < 4; ++m) { const int row = row0 + ai * 128 + m * 16, b = row >> 8, mm = row & 255;
                    const int pos = (mm & ~12) | ((mm & 4) << 1) | ((mm & 8) >> 1);
#pragma unroll
                    for (int bj = 0; bj < 2; ++bj) { const int hc = (u.pn - 2) * 2 + bj;
                        bf16_t* dst = VTG + ((size_t)(b * 4 + hc) * 128 + wc * 32 + 8 * fq) * 256 + pos;
#pragma unroll
                        for (int n = 0; n < 2; ++n)
#pragma unroll
                            for (int i = 0; i < 4; ++i) dst[(size_t)(4 * n + i) * 256] = (bf16_t)f2bf(acc[ai][bj][m][n][i] * sc[ai * 4 + m]); } }
        }
    }
};
struct MergeSched {
    int G, c; const char *A0, *B0; long dA1, dA2, dB1, dB2;
    __device__ __forceinline__ bool next(int i, Unit& u) const {
        const int ti = i / 3, br = i - 3 * ti; const long L = (long)ti * G + c; if (L >= 256 * 4) return false;
        pg8::tile_order((int)L, 256, 4, u.pm, u.pn); u.aux = br;
        const long b1 = br & 1, b2 = br >> 1;
        u.A = A0 + b1 * dA1 + b2 * dA2 + (size_t)u.pm * (256 * 512 * 2); u.B = B0 + b1 * dB1 + b2 * dB2 + (size_t)u.pn * (256 * 512 * 2); return true; }
};
struct EpiMerge {
    static constexpr bool PERM = true, ACCUM = true;
    const unsigned char* GATES; unsigned char* MERGED;
    __device__ __forceinline__ void operator()(const pg8::f32x4 (&acc)[2][2][4][2], const Unit& u, int wr, int wc, int fr_, int fq_) const {}
    __device__ __forceinline__ bool merge(pg8::f32x4 (&acc)[2][2][4][2], const Unit& u, int wr, int wc, int fr_, int fq_) const {
        int fr = fr_, fq = fq_; asm volatile("" : "+v"(fr), "+v"(fq));
        const int br = u.aux, row0 = u.pm * 256 + wr * 64 + fr, col0 = u.pn * 256 + wc * 32 + 8 * fq;
        pg8::u32x2 gaa[16], gbb[16];
        const int brn = br < 2 ? br + 1 : br;
#pragma unroll
        for (int i = 0; i < 16; ++i) { const unsigned char* gp = GATES + (size_t)(row0 + (i >> 3) * 128 + ((i >> 1) & 3) * 16) * 3072 + col0 + (i & 1) * 128;
            gaa[i] = *(const pg8::u32x2*)(gp + br * 1024); gbb[i] = *(const pg8::u32x2*)(gp + brn * 1024); }
#pragma unroll
        for (int ai = 0; ai < 2; ++ai)
#pragma unroll
            for (int m = 0; m < 4; ++m) { const size_t row = (size_t)(row0 + ai * 128 + m * 16);
#pragma unroll
                for (int bj = 0; bj < 2; ++bj) { const int c0 = col0 + bj * 128;
                    const pg8::u32x2 ga = gaa[ai * 8 + m * 2 + bj];
                    float f[8];
#pragma unroll
                    for (int i = 0; i < 4; ++i) { f[i] = (float)((ga.x >> (8 * i)) & 255u) + 0.5f; f[4 + i] = (float)((ga.y >> (8 * i)) & 255u) + 0.5f; }
                    if (br < 2) { const pg8::u32x2 gb = gbb[ai * 8 + m * 2 + bj];
#pragma unroll
                        for (int i = 0; i < 4; ++i) { f[i] *= __builtin_amdgcn_rcpf((float)((gb.x >> (8 * i)) & 255u) + 0.5f); f[4 + i] *= __builtin_amdgcn_rcpf((float)((gb.y >> (8 * i)) & 255u) + 0.5f); } }
                    else {
#pragma unroll
                        for (int i = 0; i < 8; ++i) f[i] *= (1.0f / 256.0f); }
#pragma unroll
                    for (int i = 0; i < 4; ++i) { acc[ai][bj][m][0][i] *= f[i]; acc[ai][bj][m][1][i] *= f[4 + i]; }
                    if (br == 2) { const pg8::f32x4 v0 = acc[ai][bj][m][0] * SM8, v1 = acc[ai][bj][m][1] * SM8;
                        pg8::u32x2 w; w.x = pk4_i8(v0[0], v0[1], v0[2], v0[3]); w.y = pk4_i8(v1[0], v1[1], v1[2], v1[3]);
                        *(pg8::u32x2*)(MERGED + row * 1024 + c0) = w; } } }
        return br < 2;
    }
};
struct EpiResF32 {
    static constexpr bool PERM = false, ACCUM = false;
    const float* X; float* O;
    __device__ __forceinline__ void operator()(const pg8::f32x4 (&acc)[2][2][4][2], const Unit& u, int wr, int wc, int fr_, int fq_) const {
        int fr = fr_, fq = fq_; asm volatile("" : "+v"(fr), "+v"(fq));
        const int row0 = u.pm * 256 + wr * 64 + fr, col0 = u.pn * 256 + wc * 32 + 4 * fq;
#pragma unroll
        for (int ai = 0; ai < 2; ++ai)
#pragma unroll
            for (int m = 0; m < 4; ++m) { const size_t off = (size_t)(row0 + ai * 128 + m * 16) * 1024 + col0;
#pragma unroll
                for (int bj = 0; bj < 2; ++bj)
#pragma unroll
                    for (int n = 0; n < 2; ++n) { const pg8::f32x4 xv = *(const pg8::f32x4*)(X + off + bj * 128 + n * 16); *(pg8::f32x4*)(O + off + bj * 128 + n * 16) = xv + acc[ai][bj][m][n]; } }
    }
};
struct MoeSched {
    int G, c, nM, nN; const LAS int* tstart; const LAS int* cnt; const int* list; const char* A; const char* B; size_t bexp, tB, tA; bool gather; const LAS unsigned char* texp; LAS int* lstg;
    __device__ __forceinline__ bool next(int i, Unit& u) const {
        const long L = (long)i * G + c; if (L >= (long)nM * nN) return false;
        int pm, pn; pg8::tile_order((int)L, nM, nN, pm, pn);
        const int e = __builtin_amdgcn_readfirstlane((int)texp[pm]);
        const int ts = __builtin_amdgcn_readfirstlane(tstart[e]);
        u.pm = pm; u.pn = pn; u.aux = e | ((pm - ts) << 8);
        u.A = gather ? A : A + (size_t)pm * tA; u.B = B + (size_t)e * bexp + (size_t)pn * tB; return true; }
    __device__ __forceinline__ unsigned row_off(const Unit& u, int row) const { return row_fin(u, row, row_raw(u, row)); }
    __device__ __forceinline__ int row_raw(const Unit& u, int row) const {
        const int e = u.aux & 255, idx = (u.aux >> 8) * 256 + row; return list[(size_t)e * LISTCAP + (idx < cnt[e] ? idx : 0)]; }
    __device__ __forceinline__ void stage_list(const Unit& u, int par, int lane) const {
        const int e = u.aux & 255, rt = u.aux >> 8; __builtin_amdgcn_global_load_lds((const unsigned*)(list + (size_t)e * LISTCAP + rt * 256 + lane * 4), (LAS unsigned*)(lstg + par * 256), 16, 0, 0); }
    __device__ __forceinline__ int stage_get(int par, int row) const { return lstg[par * 256 + row]; }
    __device__ __forceinline__ unsigned row_fin(const Unit& u, int row, int raw) const {
        const int e = u.aux & 255, idx = (u.aux >> 8) * 256 + row; const int ent = idx < cnt[e] ? raw : 0; return (unsigned)(ent >> 2) * 1024u; }
};
struct EpiMoeIn {
    static constexpr bool PERM = true, ACCUM = false;
    const LAS int* cnt; const float* lrs; const float* bin; unsigned char* ACT;
    __device__ __forceinline__ void operator()(const pg8::f32x4 (&acc)[2][2][4][2], const Unit& u, int wr, int wc, int fr_, int fq_) const {
        int fr = fr_, fq = fq_; asm volatile("" : "+v"(fr), "+v"(fq));
        const int e = u.aux & 255, rt = u.aux >> 8, ce = cnt[e], j0 = u.pn * 128 + wc * 32 + 8 * fq;
        float rs[8];
#pragma unroll
        for (int i = 0; i < 8; ++i) { const int idx = rt * 256 + (i >> 2) * 128 + wr * 64 + (i & 3) * 16 + fr; const float v_ = lrs[(size_t)e * LISTCAP + (idx < ce ? idx : 0)]; rs[i] = idx < ce ? v_ : 0.f; }
        const float* bg = bin + (size_t)e * 2048 + j0; const pg8::f32x4 bg0 = *(const pg8::f32x4*)bg, bg1 = *(const pg8::f32x4*)(bg + 4); pg8::f32x4 bl0 = *(const pg8::f32x4*)(bg + 1024), bl1 = *(const pg8::f32x4*)(bg + 1028);
        bl0 = (bl0 + 1.0f) * SA8; bl1 = (bl1 + 1.0f) * SA8;
#pragma unroll
        for (int ai = 0; ai < 2; ++ai)
#pragma unroll
            for (int m = 0; m < 4; ++m) { const int rl = ai * 128 + wr * 64 + m * 16 + fr; const float rsl = rs[ai * 4 + m], rsg = rsl * (1.0f / SA8);
                float a[8];
                typedef float f2 __attribute__((ext_vector_type(2)));
#pragma unroll
                for (int n = 0; n < 2; ++n)
#pragma unroll
                    for (int i = 0; i < 4; i += 2) {
                        const f2 ag = {acc[ai][0][m][n][i], acc[ai][0][m][n][i + 1]}, al = {acc[ai][1][m][n][i], acc[ai][1][m][n][i + 1]};
                        const f2 bgv = n ? (f2){bg1[i], bg1[i + 1]} : (f2){bg0[i], bg0[i + 1]}, blv = n ? (f2){bl1[i], bl1[i + 1]} : (f2){bl0[i], bl0[i + 1]};
                        f2 gl = ag * rsg + bgv; gl.x = fminf(gl.x, 7.0f); gl.y = fminf(gl.y, 7.0f);
                        f2 li = al * rsl + blv; li.x = __builtin_amdgcn_fmed3f(li.x, -6.0f * SA8, 8.0f * SA8); li.y = __builtin_amdgcn_fmed3f(li.y, -6.0f * SA8, 8.0f * SA8);
                        const f2 tt = gl * (-1.702f * 1.4426950408889634f);
                        f2 ee; ee.x = __builtin_amdgcn_exp2f(tt.x); ee.y = __builtin_amdgcn_exp2f(tt.y);
                        const f2 dd = ee + 1.0f;
                        f2 sg; sg.x = __builtin_amdgcn_rcpf(dd.x); sg.y = __builtin_amdgcn_rcpf(dd.y);
                        const f2 r2 = (gl * sg) * li;
                        a[4 * n + i] = r2.x; a[4 * n + i + 1] = r2.y; }
                pg8::u32x2 w; w.x = pk4_fp8(a[0], a[1], a[2], a[3]); w.y = pk4_fp8(a[4], a[5], a[6], a[7]);
                *(pg8::u32x2*)(ACT + ((size_t)u.pm * 256 + rl) * 1024 + j0) = w; }
    }
};
struct EpiMoeOut {
    static constexpr bool PERM = true, ACCUM = false;
    const LAS int* cnt; const int* list; const float* lgate; const float* bout; unsigned char* Y;
    __device__ __forceinline__ void operator()(const pg8::f32x4 (&acc)[2][2][4][2], const Unit& u, int wr, int wc, int fr_, int fq_) const {
        int fr = fr_, fq = fq_; asm volatile("" : "+v"(fr), "+v"(fq));
        const int e = u.aux & 255, rt = u.aux >> 8, ce = cnt[e], c0 = u.pn * 256 + wc * 32 + 8 * fq;
        const float* bo = bout + (size_t)e * 1024 + c0; pg8::f32x4 bv[2][2];
#pragma unroll
        for (int bj = 0; bj < 2; ++bj)
#pragma unroll
            for (int n = 0; n < 2; ++n) bv[bj][n] = *(const pg8::f32x4*)(bo + bj * 128 + 4 * n);
        int ent[8]; float g[8];
#pragma unroll
        for (int i = 0; i < 8; ++i) { const int idx = rt * 256 + (i >> 2) * 128 + wr * 64 + (i & 3) * 16 + fr; const bool ok = idx < ce; const size_t p_ = (size_t)e * LISTCAP + (ok ? idx : 0);
            const int en_ = list[p_]; const float g_ = lgate[p_]; ent[i] = ok ? en_ : -1; g[i] = ok ? g_ : 0.f; }
#pragma unroll
        for (int ai = 0; ai < 2; ++ai)
#pragma unroll
            for (int m = 0; m < 4; ++m) { const int i = ai * 4 + m;
                if (ent[i] >= 0) { const float gs = g[i] * SY8, gb = gs * (SA8 * SW8);
#pragma unroll
                    for (int bj = 0; bj < 2; ++bj) { const pg8::f32x4 v0 = acc[ai][bj][m][0] * gs + bv[bj][0] * gb, v1 = acc[ai][bj][m][1] * gs + bv[bj][1] * gb;
                        pg8::u32x2 w; w.x = pk4_fp8(v0[0], v0[1], v0[2], v0[3]); w.y = pk4_fp8(v1[0], v1[1], v1[2], v1[3]);
                        *(pg8::u32x2*)(Y + (size_t)ent[i] * 1024 + c0 + bj * 128) = w; } } }
    }
};
struct RowSched { int rt; const char* A; const char* B; size_t tA, tB;
    __device__ __forceinline__ bool next(int i, Unit& u) const { if (i >= 4) return false; u.pm = rt; u.pn = i; u.A = A + (size_t)rt * tA; u.B = B + (size_t)i * tB; u.aux = 0; return true; } };
struct EpiKV {
    static constexpr bool PERM = true, ACCUM = false;
    bf16_t* K; bf16_t* V; const LAS float* rskv; const LAS float* pess; const float* RK; const float* gk; float sc;
    __device__ __forceinline__ void operator()(const pg8::f32x4 (&acc)[2][2][4][2], const Unit& u, int wr, int wc, int fr_, int fq_) const {
        int fr = fr_, fq = fq_; asm volatile("" : "+v"(fr), "+v"(fq));
        const int head = 2 * u.pn + (wc >> 1);
        if (wc & 1) {
#pragma unroll
            for (int ai = 0; ai < 2; ++ai)
#pragma unroll
                for (int m = 0; m < 4; ++m) { const int row = ai * 128 + wr * 64 + m * 16 + fr; const float s_ = sc * rskv[row]; const int sq_ = (u.pm & 15) * 256 + row;
                    bf16_t* vp = V + ((size_t)((u.pm >> 4) * 8 + head) * SEQ + (sq_ & ~63)) * 64 + (sq_ & 63) * 32 + 8 * fq;
#pragma unroll
                    for (int bj = 0; bj < 2; ++bj) { const pg8::f32x4 v0 = acc[ai][bj][m][0] * s_, v1 = acc[ai][bj][m][1] * s_; pg8::u32x4 w;
                        w.x = pg8::cvt_pk_bf16(v0[0], v0[1]); w.y = pg8::cvt_pk_bf16(v0[2], v0[3]); w.z = pg8::cvt_pk_bf16(v1[0], v1[1]); w.w = pg8::cvt_pk_bf16(v1[2], v1[3]);
                        *(pg8::u32x4*)(vp + 2048 * bj) = w; } }
        } else {
            pg8::f32x4 g[2][2];
#pragma unroll
            for (int bj = 0; bj < 2; ++bj)
#pragma unroll
                for (int n = 0; n < 2; ++n) g[bj][n] = *(const pg8::f32x4*)(gk + 32 * bj + 8 * fq + 4 * n);
#pragma unroll
            for (int ai = 0; ai < 2; ++ai)
#pragma unroll
                for (int m = 0; m < 4; ++m) { const int row = ai * 128 + wr * 64 + m * 16 + fr; const size_t t = (size_t)u.pm * 256 + row; const float s_ = sc * rskv[row];
                    pg8::f32x4 k[2][2]; float ss = 0.f;
#pragma unroll
                    for (int bj = 0; bj < 2; ++bj)
#pragma unroll
                        for (int n = 0; n < 2; ++n) { k[bj][n] = acc[ai][bj][m][n] * s_; ss += k[bj][n][0] * k[bj][n][0] + k[bj][n][1] * k[bj][n][1] + k[bj][n][2] * k[bj][n][2] + k[bj][n][3] * k[bj][n][3]; }
                    ss += __shfl_xor(ss, 16); ss += __shfl_xor(ss, 32); ss += pess[row];
                    const float rn = 1.0f / sqrtf(ss * (1.f / 96.f) + EPS);
                    const int sq_ = (u.pm & 15) * 256 + row; bf16_t* kp = K + ((size_t)((u.pm >> 4) * 8 + head) * SEQ + (sq_ & ~63)) * 96 + (sq_ & 63) * 8;
#pragma unroll
                    for (int bj = 0; bj < 2; ++bj) { const pg8::f32x4 v0 = k[bj][0] * g[bj][0] * rn, v1 = k[bj][1] * g[bj][1] * rn; pg8::u32x4 w;
                        w.x = pg8::cvt_pk_bf16(v0[0], v0[1]); w.y = pg8::cvt_pk_bf16(v0[2], v0[3]); w.z = pg8::cvt_pk_bf16(v1[0], v1[1]); w.w = pg8::cvt_pk_bf16(v1[2], v1[3]);
                        *(pg8::u32x4*)(kp + (4 * bj + fq) * 512) = w; }
                    const pg8::f32x4 rl = *(const pg8::f32x4*)(RK + t * 32 + 4 * fq) * rn, rh = *(const pg8::f32x4*)(RK + t * 32 + 16 + 4 * fq) * rn;
                    pg8::u32x2 wl, wh; wl.x = pg8::cvt_pk_bf16(rl[0], rl[1]); wl.y = pg8::cvt_pk_bf16(rl[2], rl[3]); wh.x = pg8::cvt_pk_bf16(rh[0], rh[1]); wh.y = pg8::cvt_pk_bf16(rh[2], rh[3]);
                    *(pg8::u32x2*)(kp + (8 + (fq >> 1)) * 512 + (fq & 1) * 4) = wl; *(pg8::u32x2*)(kp + (10 + (fq >> 1)) * 512 + (fq & 1) * 4) = wh; }
        }
    }
};
__device__ const float ROPE_INVREV[16] = { 1.591549431e-01f, 8.949940161e-02f, 5.032921210e-02f, 2.830219583e-02f, 1.591549431e-02f, 8.949940161e-03f, 5.032921210e-03f, 2.830219583e-03f,
                                           1.591549431e-03f, 8.949940161e-04f, 5.032921210e-04f, 2.830219583e-04f, 1.591549431e-04f, 8.949940161e-05f, 5.032921210e-05f, 2.830219583e-05f };
__device__ __forceinline__ void kv_prepass(Frame& F, int rt) {
    const int lane = F.lane; unsigned char* ws = F.ws; LAS float* rskv = (LAS float*)(F.lds + LX_RSKV); LAS float* pess = (LAS float*)(F.lds + LX_PESS);
    const float* gk = F.in[I_GKM]; const int li = lane & 15, j = lane >> 4;
    const float g64 = gk[64 + li], g80 = gk[80 + li], invrev = ROPE_INVREV[li];
    float p0[8], p1[8], pa[8], pb[8]; int pos[8];
#pragma unroll
    for (int it = 0; it < 8; ++it) { const size_t t = (size_t)rt * 256 + F.wave * 32 + it * 4 + j; const float* part = (const float*)(ws + WS_PART) + t * 20; const float* pe = (const float*)(ws + WS_PE) + t * 32;
        p0[it] = part[li]; p1[it] = li < 4 ? part[16 + li] : 0.f; pa[it] = pe[li]; pb[it] = pe[16 + li]; pos[it] = ((const int*)F.in[I_POS])[t]; }
#pragma unroll
    for (int it = 0; it < 8; ++it) { const int r = F.wave * 32 + it * 4 + j; const size_t t = (size_t)rt * 256 + r;
        float sq = li < 12 ? p0[it] : 0.f, skv = (li >= 12 ? p0[it] : 0.f) + p1[it], pe2 = pa[it] * pa[it] + pb[it] * pb[it];
#pragma unroll
        for (int o = 1; o < 16; o <<= 1) { sq += __shfl_xor(sq, o); skv += __shfl_xor(skv, o); pe2 += __shfl_xor(pe2, o); }
        if (li == 0) { ((float*)(ws + WS_RSQ))[t] = 1.0f / sqrtf(sq * (1.f / 384.f) + EPS); rskv[r] = 1.0f / sqrtf(skv * (1.f / 256.f) + EPS); pess[r] = pe2; }
        float rev = (float)pos[it] * invrev; rev -= floorf(rev); const float sn = __builtin_amdgcn_sinf(rev), cs = __builtin_amdgcn_cosf(rev);
        const float x1 = pa[it] * g64, x2 = pb[it] * g80; float* rk = (float*)(ws + WS_RK) + t * 32; rk[li] = x1 * cs - x2 * sn; rk[16 + li] = x2 * cs + x1 * sn; }
}
struct P3In { v4u uw[16]; };
__device__ __forceinline__ void p3_load(Frame& F, int t, P3In& I) {
    const int lane = F.lane; unsigned char* ws = F.ws;
    const int s = t & (SEQ - 1), win = 2 << (lane >> 4), cntw = (s + 1 < win) ? s + 1 : win;
    const bf16* urow = (const bf16*)(ws + WS_U) + (size_t)t * 512 + lane * 8;
#pragma unroll
    for (int j = 0; j < 16; ++j) { I.uw[j] = (v4u){0u, 0u, 0u, 0u}; if (j < cntw) I.uw[j] = *(const GAS v4u*)(urow - (size_t)j * 512); }
}
__device__ __forceinline__ void p3_compute(Frame& F, int t, const P3In& I) {
    const int lane = F.lane; unsigned char* ws = F.ws;
    {
        const int s = t & (SEQ - 1), win = 2 << (lane >> 4), cntw = (s + 1 < win) ? s + 1 : win;
        float acc[8];
#pragma unroll
        for (int i = 0; i < 8; ++i) acc[i] = 0.f;
#pragma unroll
        for (int j = 0; j < 16; ++j)
#pragma unroll
            for (int i = 0; i < 4; ++i) { acc[2 * i] += bflo(I.uw[j][i]); acc[2 * i + 1] += bfhi(I.uw[j][i]); }
        const float inv = 1.0f / (float)cntw;
#pragma unroll
        for (int i = 0; i < 4; ++i) { acc[2 * i] = acc[2 * i] * inv - bflo(I.uw[0][i]); acc[2 * i + 1] = acc[2 * i + 1] * inv - bfhi(I.uw[0][i]); }
        v4u o; o.x = pk2(acc[0], acc[1]); o.y = pk2(acc[2], acc[3]); o.z = pk2(acc[4], acc[5]); o.w = pk2(acc[6], acc[7]);
        *(GAS v4u*)((bf16*)(ws + WS_MIXED) + (size_t)t * 512 + lane * 8) = o;
    }
}
template <int NT> __device__ __forceinline__ void p3_tokens(Frame& F, int t0) {
    P3In I[NT];
#pragma unroll
    for (int i = 0; i < NT; ++i) p3_load(F, t0 + i, I[i]);
    asm volatile("" ::: "memory");
#pragma unroll
    for (int i = 0; i < NT; ++i) p3_compute(F, t0 + i, I[i]);
}

namespace xat {
__device__ __forceinline__ int crow(int r, int hi) { return (r & 3) + 8 * (r >> 2) + 4 * hi; }
__device__ __forceinline__ void stage_kv(Frame& F, int b, int hc) {
    const int tid = F.tid; unsigned char* ws = F.ws; LAS unsigned char* lds = F.lds;
    { const int row = tid >> 1, half = tid & 1; const bf16* src = (const bf16*)(ws + WS_KVMK) + (size_t)(b * 256 + row) * 512 + hc * 128 + half * 64;
      v4u v[8]; float ss = 0.f; f32x4 gk[16];
#pragma unroll
      for (int c = 0; c < 16; ++c) gk[c] = *(const GAS f32x4*)(F.in[I_GKC] + half * 64 + 4 * c);
#pragma unroll
      for (int c = 0; c < 8; ++c) { v[c] = *(const GAS v4u*)(src + 8 * c); ss += sumsq8(v[c]); }
      ss += __shfl_xor(ss, 1);
      const float rstd = 1.0f / sqrtf(ss * (1.f / 128.f) + EPS);
#pragma unroll
      for (int c = 0; c < 8; ++c) { v4u o;
#pragma unroll
          for (int i = 0; i < 4; ++i) o[i] = pk2(bflo(v[c][i]) * rstd * gk[2 * c + (i >> 1)][2 * (i & 1)], bfhi(v[c][i]) * rstd * gk[2 * c + (i >> 1)][2 * (i & 1) + 1]);
          *(LAS v4u*)(lds + row * 256 + (((half * 8 + c) ^ (row & 15)) << 4)) = o; } }
    { const bf16* src = (const bf16*)(ws + WS_VTG) + (size_t)(b * 4 + hc) * 128 * 256;
#pragma unroll
      for (int i = 0; i < 8; ++i) { const int q = tid + 512 * i, d = q >> 5, ch = q & 31; const v4u v = *(const GAS v4u*)(src + (size_t)q * 8);
          *(LAS v4u*)(lds + 65536 + d * 512 + ((ch ^ (d & 15)) << 4)) = v; } }
}
__device__ __forceinline__ void unit(Frame& F, int b, int hc, int qb) {
    const int lane = F.lane, r32 = lane & 31, hi = lane >> 5, wid = F.wave; unsigned char* ws = F.ws; LAS unsigned char* lds = F.lds;
    const size_t row = (size_t)b * SEQ + qb * 256 + wid * 32 + r32;
    bf16x8 qr[8];
    { const bf16* qsrc = (const bf16*)(ws + WS_QX) + row * 512 + hc * 128 + hi * 8; v4u qv[8]; float ss = 0.f;
      f32x4 gq[16];
#pragma unroll
      for (int d0 = 0; d0 < 8; ++d0) { gq[2 * d0] = *(const GAS f32x4*)(F.in[I_GQC] + hi * 8 + 16 * d0); gq[2 * d0 + 1] = *(const GAS f32x4*)(F.in[I_GQC] + hi * 8 + 16 * d0 + 4); }
#pragma unroll
      for (int d0 = 0; d0 < 8; ++d0) { qv[d0] = *(const GAS v4u*)(qsrc + 16 * d0); ss += sumsq8(qv[d0]); }
      ss += __shfl_xor(ss, 32);
      const float rn = C2_X / sqrtf(ss * (1.f / 128.f) + EPS);
#pragma unroll
      for (int d0 = 0; d0 < 8; ++d0) { v4u o;
#pragma unroll
          for (int i = 0; i < 4; ++i) o[i] = pk2(bflo(qv[d0][i]) * rn * gq[2 * d0 + (i >> 1)][2 * (i & 1)], bfhi(qv[d0][i]) * rn * gq[2 * d0 + (i >> 1)][2 * (i & 1) + 1]);
          qr[d0] = __builtin_bit_cast(bf16x8, o); } }
    f32x16 o[4];
#pragma unroll
    for (int i = 0; i < 4; ++i) o[i] = f32x16{};
    float mrun = -1e30f, lrun = 0.f; const int r32_ = r32, hi_ = hi;
#pragma unroll 1
    for (int tt = 0; tt < 4; ++tt) {
        f32x16 p0 = f32x16{}, p1 = f32x16{};
        int r32 = r32_, hi = hi_; asm volatile("" : "+v"(r32), "+v"(hi));
        const int kr0 = 64 * tt + r32, kr1 = kr0 + 32;
        bf16x8 kf0[8], kf1[8];
#pragma unroll
        for (int d0 = 0; d0 < 8; ++d0) {
            kf0[d0] = *(const LAS bf16x8*)(lds + kr0 * 256 + (((2 * d0 + hi) ^ (kr0 & 15)) << 4));
            kf1[d0] = *(const LAS bf16x8*)(lds + kr1 * 256 + (((2 * d0 + hi) ^ (kr1 & 15)) << 4)); }
        __builtin_amdgcn_sched_barrier(0);
#pragma unroll
        for (int d0 = 0; d0 < 8; ++d0) {
            p0 = __builtin_amdgcn_mfma_f32_32x32x16_bf16(kf0[d0], qr[d0], p0, 0, 0, 0);
            p1 = __builtin_amdgcn_mfma_f32_32x32x16_bf16(kf1[d0], qr[d0], p1, 0, 0, 0); }
        __builtin_amdgcn_sched_barrier(0);
        bf16x8 vf[4][4];
#pragma unroll
        for (int ks = 0; ks < 2; ++ks) { const int ch = 2 * (4 * tt + ks) + hi;
#pragma unroll
            for (int d = 0; d < 4; ++d) { const int dr = r32 + 32 * d; vf[ks][d] = *(const LAS bf16x8*)(lds + 65536 + dr * 512 + ((ch ^ (dr & 15)) << 4)); } }
        __builtin_amdgcn_sched_barrier(0);
        float rm = fmaxf(p0[0], p1[0]);
#pragma unroll
        for (int r = 1; r < 16; ++r) rm = fmaxf(rm, fmaxf(p0[r], p1[r]));
        rm = fmaxf(rm, __shfl_xor(rm, 32));
        const float mnew = fmaxf(mrun, rm), sc = __builtin_amdgcn_exp2f(mrun - mnew); mrun = mnew;
        float ps = 0.f;
#pragma unroll
        for (int r = 0; r < 16; ++r) { p0[r] = __builtin_amdgcn_exp2f(p0[r] - mnew); p1[r] = __builtin_amdgcn_exp2f(p1[r] - mnew); ps += p0[r] + p1[r]; }
        lrun = lrun * sc + ps;
#pragma unroll
        for (int d = 0; d < 4; ++d) o[d] = o[d] * sc;
        v4u pw[4];
#pragma unroll
        for (int i = 0; i < 4; ++i) { pw[0][i] = pk2(p0[2 * i], p0[2 * i + 1]); pw[1][i] = pk2(p0[8 + 2 * i], p0[9 + 2 * i]); pw[2][i] = pk2(p1[2 * i], p1[2 * i + 1]); pw[3][i] = pk2(p1[8 + 2 * i], p1[9 + 2 * i]); }
#pragma unroll
        for (int ks = 2; ks < 4; ++ks) { const int ch = 2 * (4 * tt + ks) + hi;
#pragma unroll
            for (int d = 0; d < 4; ++d) { const int dr = r32 + 32 * d; vf[ks][d] = *(const LAS bf16x8*)(lds + 65536 + dr * 512 + ((ch ^ (dr & 15)) << 4)); } }
        __builtin_amdgcn_sched_barrier(0);
#pragma unroll
        for (int ks = 0; ks < 4; ++ks) { const bf16x8 pa = __builtin_bit_cast(bf16x8, pw[ks]);
#pragma unroll
            for (int d = 0; d < 4; ++d) o[d] = __builtin_amdgcn_mfma_f32_32x32x16_bf16(vf[ks][d], pa, o[d], 0, 0, 0); }
    }
    lrun += __shfl_xor(lrun, 32);
    const float rl = 1.0f / lrun;
    bf16* orow = (bf16*)(ws + WS_CO) + ((size_t)b * SEQ + qb * 256 + wid * 32 + r32) * 512 + hc * 128 + 4 * hi;
#pragma unroll
    for (int d = 0; d < 4; ++d)
#pragma unroll
        for (int g = 0; g < 4; ++g) { v2u w; w.x = pk2(o[d][4 * g] * rl, o[d][4 * g + 1] * rl); w.y = pk2(o[d][4 * g + 2] * rl, o[d][4 * g + 3] * rl);
            *(GAS v2u*)(orow + 32 * d + 8 * g) = w; }
}
}

__device__ __forceinline__ void router_tile(Frame& F, int t0, int lt0) {
    const int lane = F.lane, tok = lane & 31, kk = lane >> 5; unsigned char* ws = F.ws; LAS unsigned char* lds = F.lds;
    const LAS float* wr = (const LAS float*)(lds + RING_OFF);
    const float* xrow = F.in[I_X] + (size_t)(t0 + tok) * 1024 + 16 * kk;
    const bf16* drow = (const bf16*)(ws + WS_DELTA) + (size_t)(t0 + tok) * 1024 + 16 * kk;
    unsigned char* hrow = ws + WS_HN2 + (size_t)(t0 + tok) * 1024 + 16 * kk;
    f32x16 acc = f32x16{}; float ss = 0.f;
    constexpr int PD = 4;
    f32x4 ra[PD][4]; v4u rd[PD][2];
#pragma unroll
    for (int p = 0; p < PD; ++p) {
#pragma unroll
        for (int c = 0; c < 4; ++c) ra[p][c] = *(const GAS f32x4*)(xrow + 32 * p + 4 * c);
        rd[p][0] = *(const GAS v4u*)(drow + 32 * p); rd[p][1] = *(const GAS v4u*)(drow + 32 * p + 8); }
#pragma unroll 1
    for (int q0 = 0; q0 < 32; q0 += PD) {
#pragma unroll
        for (int p = 0; p < PD; ++p) {
            const int q = q0 + p; float a[16];
#pragma unroll
            for (int c = 0; c < 4; ++c) { const unsigned d0 = rd[p][c >> 1][2 * (c & 1)], d1 = rd[p][c >> 1][2 * (c & 1) + 1];
                a[4 * c] = ra[p][c].x + bflo(d0); a[4 * c + 1] = ra[p][c].y + bfhi(d0); a[4 * c + 2] = ra[p][c].z + bflo(d1); a[4 * c + 3] = ra[p][c].w + bfhi(d1); }
            if (q0 + PD < 32) {
#pragma unroll
                for (int c = 0; c < 4; ++c) ra[p][c] = *(const GAS f32x4*)(xrow + 32 * (q + PD) + 4 * c);
                rd[p][0] = *(const GAS v4u*)(drow + 32 * (q + PD)); rd[p][1] = *(const GAS v4u*)(drow + 32 * (q + PD) + 8); }
            const LAS float* wq = wr + (32 * q + 16 * kk) * 32 + tok;
#pragma unroll
            for (int s_ = 0; s_ < 16; ++s_) { ss += a[s_] * a[s_]; acc = __builtin_amdgcn_mfma_f32_32x32x2f32(wq[s_ * 32], a[s_], acc, 0, 0, 0); }
            v4u o;
#pragma unroll
            for (int c = 0; c < 4; ++c) o[c] = pk4_fp8(a[4 * c] * SX8, a[4 * c + 1] * SX8, a[4 * c + 2] * SX8, a[4 * c + 3] * SX8);
            *(GAS v4u*)(hrow + 32 * q) = o;
        }
    }
    ss += __shfl_xor(ss, 32);
    const float rstd = 1.0f / sqrtf(ss * (1.f / 1024.f) + EPS);
    if (kk == 0) ((LAS float*)(lds + LX_RS))[lt0 + tok] = rstd;
    const float* br = F.in[I_BR];
    float lg[16];
#pragma unroll
    for (int r = 0; r < 16; ++r) lg[r] = acc[r] * rstd + br[xat::crow(r, kk)];
    float tv[4]; int ti[4];
#pragma unroll
    for (int k = 0; k < 4; ++k) { float best = lg[0]; int bi = 0;
#pragma unroll
        for (int r = 1; r < 16; ++r) { const bool gt = lg[r] > best; best = gt ? lg[r] : best; bi = gt ? r : bi; }
        tv[k] = best; ti[k] = xat::crow(bi, kk);
#pragma unroll
        for (int r = 0; r < 16; ++r) lg[r] = (r == bi) ? -INFINITY : lg[r]; }
    float cv[8]; int ci[8];
#pragma unroll
    for (int k = 0; k < 4; ++k) { cv[k] = tv[k]; ci[k] = ti[k]; cv[4 + k] = __shfl_xor(tv[k], 32); ci[4 + k] = __shfl_xor(ti[k], 32); }
    float gv[4]; int ge[4];
#pragma unroll
    for (int k = 0; k < 4; ++k) { float best = cv[0]; int be = ci[0], bj = 0;
#pragma unroll
        for (int j = 1; j < 8; ++j) { const bool gt = (cv[j] > best) || (cv[j] == best && ci[j] < be); best = gt ? cv[j] : best; be = gt ? ci[j] : be; bj = gt ? j : bj; }
        gv[k] = best; ge[k] = be;
#pragma unroll
        for (int j = 0; j < 8; ++j) cv[j] = (j == bj) ? -INFINITY : cv[j]; }
    float ex[4], es = 0.f;
#pragma unroll
    for (int k = 0; k < 4; ++k) { ex[k] = __expf(gv[k] - gv[0]); es += ex[k]; }
    const float ies = 1.0f / es;
    if (kk == 0) {
        LAS int* lcnt = (LAS int*)(lds + LX_LCNT); LAS int* stash = (LAS int*)(lds + LX_STASH); LAS float* gst = (LAS float*)(lds + LX_GATE);
#pragma unroll
        for (int k = 0; k < 4; ++k) { const int li = __hip_atomic_fetch_add(lcnt + ge[k], 1, __ATOMIC_RELAXED, __HIP_MEMORY_SCOPE_WORKGROUP);
            stash[(lt0 + tok) * 4 + k] = ge[k] | (li << 8); gst[(lt0 + tok) * 4 + k] = ex[k] * ies; }
    }
}

struct CvItem { const float* src; int ks; unsigned char* dst; int k0; };
__device__ __forceinline__ CvItem cv_decode(Frame& F, int it) {
    constexpr int IE1 = 16 * 64, IE2 = 16 * 32; unsigned char* ws = F.ws; CvItem c;
    const int e = it / (IE1 + IE2); int r = it - e * (IE1 + IE2);
    if (r < IE1) { const int kb = r >> 6, nb = r & 63, n0 = nb * 32, srcc = ((n0 >> 7) & 1) * 1024 + (n0 >> 8) * 128 + (n0 & 127);
        c.src = F.in[I_WEI] + (size_t)e * 1024 * 2048 + (size_t)(kb * 64) * 2048 + srcc; c.ks = kb * 64; c.dst = ws + WS_WEI + (size_t)e * 2048 * 1024 + (size_t)n0 * 1024 + kb * 64; c.k0 = 2048; }
    else { r -= IE1; const int kb = r >> 5, nb = r & 31;
        c.src = F.in[I_WEO] + (size_t)e * 1024 * 1024 + (size_t)(kb * 64) * 1024 + nb * 32; c.ks = -1; c.dst = ws + WS_WEO + (size_t)e * 1024 * 1024 + (size_t)(nb * 32) * 1024 + kb * 64; c.k0 = 1024; }
    return c;
}
__device__ __forceinline__ void cv_load(const CvItem& c, int lane, float (&v)[32]) {
#pragma unroll
    for (int i = 0; i < 32; ++i) v[i] = c.src[(size_t)(2 * i + (lane >> 5)) * c.k0 + (lane & 31)];
}
__device__ __forceinline__ void cv_store(const CvItem& c, int lane, float (&v)[32], LAS float* scr, const LAS float* gl) {
    if (c.ks >= 0) { const LAS float* g_ = gl + c.ks + (lane >> 5);
#pragma unroll
        for (int i = 0; i < 32; ++i) v[i] *= g_[2 * i]; }
#pragma unroll
    for (int i = 0; i < 32; ++i) scr[(2 * i + (lane >> 5)) * 33 + (lane & 31)] = v[i] * SW8;
    LDS_WAIT(); asm volatile("" ::: "memory");
    const int cc = lane & 7;
#pragma unroll
    for (int j = 0; j < 4; ++j) { const int n = (lane >> 3) + 8 * j; const LAS float* s = scr + (8 * cc) * 33 + n;
        v2u o; o.x = pk4_fp8(s[0 * 33], s[1 * 33], s[2 * 33], s[3 * 33]); o.y = pk4_fp8(s[4 * 33], s[5 * 33], s[6 * 33], s[7 * 33]);
        *(GAS v2u*)(c.dst + (size_t)n * 1024 + 8 * cc) = o; }
    LDS_WAIT(); asm volatile("" ::: "memory");
}
__device__ __forceinline__ void expert_convert(Frame& F) {
    const int lane = F.lane; LAS unsigned char* lds = F.lds;
    {
        LAS float* scr = (LAS float*)(lds + RING_OFF + F.wave * 16384);
        LAS float* gl = (LAS float*)(lds + LX_STASH);
        for (int i = F.tid; i < 1024; i += NWAVES * 64) gl[i] = F.in[I_GFFN][i];
        __syncthreads();
        const int gw = F.vcu * NWAVES + F.wave, NGW = F.G * NWAVES;
        constexpr int NIT = NEXP * (16 * 64 + 16 * 32);
        for (int rep = 0; rep < MK_REPCV; ++rep) {
            for (int it = gw; it < NIT; it += 4 * NGW) {
                float v0[32], v1[32], v2[32], v3[32];
                const int i1 = it + NGW, i2 = it + 2 * NGW, i3 = it + 3 * NGW;
                const CvItem c0 = cv_decode(F, it); cv_load(c0, lane, v0);
                CvItem c1 = c0, c2 = c0, c3 = c0;
                if (i1 < NIT) { c1 = cv_decode(F, i1); cv_load(c1, lane, v1); }
                if (i2 < NIT) { c2 = cv_decode(F, i2); cv_load(c2, lane, v2); }
                if (i3 < NIT) { c3 = cv_decode(F, i3); cv_load(c3, lane, v3); }
                cv_store(c0, lane, v0, scr, gl);
                if (i1 < NIT) cv_store(c1, lane, v1, scr, gl);
                if (i2 < NIT) cv_store(c2, lane, v2, scr, gl);
                if (i3 < NIT) cv_store(c3, lane, v3, scr, gl);
            }
        }
    }
}
__device__ __forceinline__ void p7_router(Frame& F) {
    const int lane = F.lane, tid = F.tid; unsigned char* ws = F.ws; LAS unsigned char* lds = F.lds;
    { const float* wr = F.in[I_WR]; const float* g = F.in[I_GFFN];
#pragma unroll
      for (int j = 0; j < 8192 / (NWAVES * 64); ++j) { const int i = tid + j * NWAVES * 64; const f32x4 v = *(const GAS f32x4*)(wr + 4 * i); const float gg = g[i >> 3]; *(LAS f32x4*)(lds + RING_OFF + 16 * i) = v * gg; } }
    __syncthreads();
    LAS int* lcnt = (LAS int*)(lds + LX_LCNT); LAS int* lbase = (LAS int*)(lds + LX_BASE); LAS int* stash = (LAS int*)(lds + LX_STASH); LAS float* gst = (LAS float*)(lds + LX_GATE);
    for (int chunk = F.vcu; chunk < T / 256; chunk += F.G) {
        if (tid < NEXP) lcnt[tid] = 0;
        __syncthreads();
        router_tile(F, chunk * 256 + F.wave * 32, F.wave * 32);
        __syncthreads();
        if (tid < NEXP) lbase[tid] = (int)__hip_atomic_fetch_add((unsigned*)(F.ctl + CW_GCNT + 64 * tid), (unsigned)lcnt[tid], RLX_AGENT);
        __syncthreads();
        for (int idx = tid; idx < 1024; idx += NWAVES * 64) { const int st = stash[idx], e = st & 255, pos = lbase[e] + (st >> 8), ent = (chunk * 256 + (idx >> 2)) * 4 + (idx & 3);
            if (pos < LISTCAP) { const size_t li = (size_t)e * LISTCAP + pos; ((int*)(ws + WS_LIST))[li] = ent;
                ((float*)(ws + WS_LRS))[li] = ((LAS float*)(lds + LX_RS))[idx >> 2] * (SA8 / (SX8 * SW8)); ((float*)(ws + WS_LGATE))[li] = gst[idx] * (1.0f / (SA8 * SW8)); } }
        __syncthreads();
    }
}
__device__ __forceinline__ int moe_setup(Frame& F) {
    LAS int* tstart = (LAS int*)(F.lds + LX_TSTART); LAS int* cnt = (LAS int*)(F.lds + LX_CNT); LAS unsigned char* texp = (LAS unsigned char*)(F.lds + LX_TEXP);
    if (F.wave == 0) { const int lane = F.lane, e = lane & 31;
        int c = (int)__hip_atomic_load((unsigned*)(F.ctl + CW_GCNT + 64 * e), RLX_AGENT); c = c < LISTCAP ? c : LISTCAP;
        const int nt_ = (c + 255) >> 8; int incl = nt_;
#pragma unroll
        for (int o = 1; o < 32; o <<= 1) { const int v = __shfl_up(incl, o); if (lane >= o) incl += v; }
        if (lane < 32) { cnt[e] = c; tstart[e] = incl - nt_; if (e == NEXP - 1) tstart[NEXP] = incl < ACT_TILES_MAX ? incl : ACT_TILES_MAX; } }
    __syncthreads();
    const int ntiles = __builtin_amdgcn_readfirstlane(tstart[NEXP]);
    for (int pm = F.tid; pm < ntiles; pm += NWAVES * 64) { int lo = 0, hi = NEXP - 1;
        while (lo < hi) { const int mid = (lo + hi) >> 1; if (tstart[mid + 1] > pm) hi = mid; else lo = mid + 1; }
        texp[pm] = (unsigned char)lo; }
    __syncthreads();
    return ntiles;
}

struct Args { const float* in[N_IN]; float* out; unsigned char* ws; int ph_lo, ph_hi, li, pad; };
__global__ void __launch_bounds__(NWAVES * 64, 2) fwd_kernel(Args args) {
    extern __shared__ __attribute__((aligned(16))) unsigned char lds[];
    Frame F;
    F.lds = (LAS unsigned char*)lds;
    F.MISC = (volatile LAS unsigned*)(F.lds + MISC_OFF);
    F.tid = threadIdx.x; F.lane = F.tid & 63; F.wave = __builtin_amdgcn_readfirstlane(F.tid >> 6);
    F.G = gridDim.x; { const int bx = blockIdx.x; F.vcu = (F.G % 8 == 0) ? (bx % 8) * (F.G / 8) + bx / 8 : bx; }
    F.ws = args.ws; F.out = args.out; F.in = args.in;
    unsigned char* ws = args.ws;
    F.ctl = (gu32*)(ws + WS_CTL);
    for (int u = F.tid; u < (LDS_BYTES - LDSCTL_OFF) / 4; u += NWAVES * 64) ((LAS unsigned*)(F.lds + LDSCTL_OFF))[u] = 0u;
    __syncthreads();
    XcdBarrier bar; bar.bar = (unsigned*)(F.ctl + CW_BAR); bar.x = 0; bar.st = nullptr;
    if (N_LAUNCHES != PER_PHASE) bar = xcd_barrier_post((unsigned*)(F.ctl + CW_BAR), F.MISC + 8, F.tid == 0);
#define GRID_BAR(seam) do { if (N_LAUNCHES == PER_PHASE) { if (F.tid == 0) __hip_atomic_store(F.ctl + CW_TMO, 0xBADBA0u | (unsigned)(seam), RLX_AGENT); } else { xcd_barrier(bar, F.tid == 0); } } while (0)
    const int lo = args.ph_lo, hi = args.ph_hi;
#ifndef MK_PHASE_MASK
#define MK_PHASE_MASK 0x7ff
#endif
#define IN(k) (((MK_PHASE_MASK >> (k)) & 1) && lo <= (k) && (k) < hi)
#define BOTH(k) (IN(k) && IN((k) + 1))
    const int gw = F.vcu * NWAVES + F.wave, NGW = F.G * NWAVES;

    if (IN(0)) { REFRESH(F); for (int rep = 0; rep < MK_REP0; ++rep) p0_prologue(F); if (BOTH(0)) GRID_BAR(0); }

    if (IN(1)) { REFRESH(F);
        { DenseSched S; S.init(ws + WS_HN, 512, ws + WS_W1T, 512, T, 1792, F.G, (int)blockIdx.x);
          EpiP1 E{(bf16_t*)(ws + WS_U), (bf16_t*)(ws + WS_QX), (const float*)(ws + WS_HSC), ws + WS_CQ8, ws + WS_CKV8, (float*)(ws + WS_PART), (float*)(ws + WS_PE)};
          pg8::gemm_phase_i8<EpiP1, DenseSched>(F.lds + RING_OFF, F.tid, 1024, 1024, 1024, S, E); }
        { DenseSched S; S.init(ws + WS_HN8, 512, ws + WS_W1G8, 512, T, 3072, F.G, (int)blockIdx.x);
          EpiGate8 E{ws + WS_GATES, -1.4426950408889634f / (SH8 * SW8)};
          pg8::gemm_phase_f8<EpiGate8, DenseSched>(F.lds + RING_OFF, F.tid, 1024, 1024, 1024, S, E); }
        if (BOTH(1)) GRID_BAR(1);
    }

    if (IN(2)) { REFRESH(F);
        for (int rep = 0; rep < MK_REP2; ++rep) {
        { DenseSched S; S.init(ws + WS_CQ8, 256, ws + WS_WUQ, 256, T, 768, F.G, (int)blockIdx.x);
          EpiStore E{(bf16_t*)(ws + WS_Q), 768, 1.0f / (SC8 * SWQ8)};
          pg8::gemm_phase_i8<EpiStore, DenseSched>(F.lds + RING_OFF, F.tid, 512, 512, 512, S, E); }
        for (int rt = F.vcu; rt < T / 256; rt += F.G) {
          REFRESH(F); kv_prepass(F, rt);
          asm volatile("s_waitcnt vmcnt(0) lgkmcnt(0)" ::: "memory"); __syncthreads(); __builtin_amdgcn_fence(__ATOMIC_ACQUIRE, "agent");
          REFRESH(F);
          RowSched S{rt, (const char*)(ws + WS_CKV8), (const char*)(ws + WS_WUKV), (size_t)256 * 256, (size_t)256 * 256};
          EpiKV E{(bf16_t*)(ws + WS_KV), (bf16_t*)(ws + WS_V), (const LAS float*)(F.lds + LX_RSKV), (const LAS float*)(F.lds + LX_PESS), (const float*)(ws + WS_RK), F.in[I_GKM], 1.0f / (SC8 * SWKV8)};
          int k2 = 256; asm volatile("" : "+s"(k2));
          pg8::gemm_phase_i8<EpiKV, RowSched>(F.lds + RING_OFF, F.tid, k2, 256, 256, S, E);
          __syncthreads(); }
        { DenseSched S; S.init(ws + WS_MEMN, 512, ws + WS_WMEM, 512, MROWS, 1024, F.G, (int)blockIdx.x);
          EpiMemKV E{(bf16_t*)(ws + WS_KVMK), (bf16_t*)(ws + WS_VTG), (const float*)(ws + WS_MSC)};
          pg8::gemm_phase_i8<EpiMemKV, DenseSched>(F.lds + RING_OFF, F.tid, 1024, 1024, 1024, S, E); }
        }
        if (BOTH(2)) GRID_BAR(2);
    }

    if (IN(3)) { REFRESH(F);
        const int per = T / NGW;
        if (per * NGW == T && (per & 1) == 0) { for (int i = 0; i < per; i += 2) p3_tokens<2>(F, gw * per + i); }
        else { for (int t = gw; t < T; t += NGW) p3_tokens<1>(F, t); }
        if (BOTH(3)) GRID_BAR(3);
    }

    if (IN(4)) { const mla::QXform QX{(const float*)(ws + WS_RSQ), (const int*)F.in[I_POS], F.in[I_GQM], ROPE_INVREV, C2_MLA};
        for (int rep4 = 0; rep4 < MK_REP4; ++rep4) { REFRESH(F);
#ifndef NO_MLA
        for (int vv = F.vcu; vv < 256 * MK_REPMLA; vv += F.G) {
            const int bh = (vv & 255) >> 1, s = vv & 1;
            for (int i = 0; i < 8; ++i) { const int j2 = (i >> 1) * 2 + s, qb = (i & 1) ? 15 - j2 : j2;
                mla::attn_unit<8>(F.tid, QX, bh >> 3, bh & 7, qb, (const mla::bf16*)(ws + WS_Q), (const mla::bf16*)(ws + WS_KV), (const mla::bf16*)(ws + WS_V), (mla::bf16*)(ws + WS_AO), (char*)lds + RING_OFF);
                if (vv == F.vcu && i == (vv & 7)) { REFRESH(F); expert_convert(F); __syncthreads(); REFRESH(F); } }
        }
#endif
        __syncthreads();
        REFRESH(F);
#ifndef NO_XAT
        for (int vv = F.vcu; vv < 256 * MK_REPX; vv += F.G) {
            const int b = (vv & 255) >> 4, hc = (vv >> 2) & 3;
            xat::stage_kv(F, b, hc);
            __syncthreads();
            for (int i = 0; i < 4; ++i) xat::unit(F, b, hc, (vv & 3) * 4 + i);
            __syncthreads();
        }
#endif
        }
        if (BOTH(4)) GRID_BAR(4);
    }

    if (IN(5)) { REFRESH(F);
        MergeSched S; S.G = F.G; S.c = (int)blockIdx.x;
        S.A0 = (const char*)(ws + WS_MIXED); S.dA1 = (long)WS_AO - (long)WS_MIXED; S.dA2 = (long)WS_CO - (long)WS_MIXED;
        S.B0 = (const char*)(ws + WS_WPOOL); S.dB1 = (long)WS_WMO - (long)WS_WPOOL; S.dB2 = (long)WS_WCO - (long)WS_WPOOL;
        EpiMerge E{ws + WS_GATES, ws + WS_MERGED};
        for (int rep = 0; rep < MK_REP5; ++rep) pg8::gemm_phase<EpiMerge, MergeSched>(F.lds + RING_OFF, F.tid, 512, 512, 512, S, E);
        if (BOTH(5)) GRID_BAR(5);
    }

    if (IN(6)) { REFRESH(F);
        DenseSched S; S.init(ws + WS_MERGED, 512, ws + WS_WO, 512, T, 1024, F.G, (int)blockIdx.x);
        EpiStore E{(bf16_t*)(ws + WS_DELTA), 1024, 1.0f / (SM8 * SWI8)};
        pg8::gemm_phase_i8<EpiStore, DenseSched>(F.lds + RING_OFF, F.tid, 1024, 1024, 1024, S, E);
        if (BOTH(6)) GRID_BAR(6);
    }

    if (IN(7)) { REFRESH(F); p7_router(F); if (BOTH(7)) GRID_BAR(7); }

    if (IN(8)) { REFRESH(F);
        const int ntiles = moe_setup(F);
        MoeSched S; S.G = F.G; S.c = (int)blockIdx.x; S.nM = ntiles; S.nN = 8; S.tstart = (const LAS int*)(F.lds + LX_TSTART); S.cnt = (const LAS int*)(F.lds + LX_CNT); S.texp = (const LAS unsigned char*)(F.lds + LX_TEXP); S.lstg = (LAS int*)(F.lds + LX_LSTG);
        S.list = (const int*)(ws + WS_LIST); S.A = (const char*)(ws + WS_HN2); S.B = (const char*)(ws + WS_WEI); S.bexp = (size_t)2048 * 1024; S.tB = (size_t)256 * 1024; S.tA = 0; S.gather = true;
        EpiMoeIn E{S.cnt, (const float*)(ws + WS_LRS), F.in[I_BEI], ws + WS_ACT};
        for (int rep = 0; rep < MK_REP8; ++rep) pg8::gemm_phase_f8<EpiMoeIn, MoeSched, true>(F.lds + RING_OFF, F.tid, 1024, 1024, 1024, S, E);
        if (BOTH(8)) GRID_BAR(8);
    }

    if (IN(9)) { REFRESH(F);
        const int ntiles = moe_setup(F);
        MoeSched S; S.G = F.G; S.c = (int)blockIdx.x; S.nM = ntiles; S.nN = 4; S.tstart = (const LAS int*)(F.lds + LX_TSTART); S.cnt = (const LAS int*)(F.lds + LX_CNT); S.texp = (const LAS unsigned char*)(F.lds + LX_TEXP); S.lstg = (LAS int*)(F.lds + LX_LSTG);
        S.list = (const int*)(ws + WS_LIST); S.A = (const char*)(ws + WS_ACT); S.B = (const char*)(ws + WS_WEO); S.bexp = (size_t)1024 * 1024; S.tB = (size_t)256 * 1024; S.tA = (size_t)256 * 1024; S.gather = false;
        EpiMoeOut E{S.cnt, S.list, (const float*)(ws + WS_LGATE), F.in[I_BEO], ws + WS_Y};
        pg8::gemm_phase_f8<EpiMoeOut, MoeSched, false>(F.lds + RING_OFF, F.tid, 1024, 1024, 1024, S, E);
#if MK_REP9 > 1
        { EpiNull EN; pg8::gemm_phase_f8<EpiNull, MoeSched, false>(F.lds + RING_OFF, F.tid, 1024, 1024, 1024, S, EN); }
#endif
        if (BOTH(9)) GRID_BAR(9);
    }

    if (IN(10)) { REFRESH(F);
        for (int rep = 0; rep < MK_REP10; ++rep)
        for (int t0 = gw; t0 < T; t0 += 2 * NGW) {
            f32x4 v[2][4]; v2u dl[2][4]; unsigned w[2][4][4];
#pragma unroll
            for (int r = 0; r < 2; ++r) { const int t = t0 + r * NGW; if (t < T) {
                const GAS f32x4* xi = (const GAS f32x4*)(F.in[I_X] + (size_t)t * 1024) + F.lane; const GAS unsigned* y = (const GAS unsigned*)(ws + WS_Y + (size_t)t * 4096) + F.lane;
                const GAS v2u* dp = (const GAS v2u*)((const bf16*)(ws + WS_DELTA) + (size_t)t * 1024) + F.lane;
#pragma unroll
                for (int j = 0; j < 4; ++j) { v[r][j] = xi[64 * j]; dl[r][j] = dp[64 * j];
#pragma unroll
                    for (int s4 = 0; s4 < 4; ++s4) w[r][s4][j] = y[s4 * 256 + 64 * j]; } } }
#pragma unroll
            for (int r = 0; r < 2; ++r) { const int t = t0 + r * NGW; if (t < T) {
                GAS f32x4* o = (GAS f32x4*)(F.out + (size_t)t * 1024) + F.lane;
#pragma unroll
                for (int j = 0; j < 4; ++j) { f32x4 x = v[r][j]; const v2u dd = dl[r][j];
                    x.x += bflo(dd.x); x.y += bfhi(dd.x); x.z += bflo(dd.y); x.w += bfhi(dd.y);
                    float ax = 0.f, ay = 0.f, az = 0.f, aw = 0.f;
#pragma unroll
                    for (int s4 = 0; s4 < 4; ++s4) { const unsigned ww = w[r][s4][j]; const auto lo = __builtin_amdgcn_cvt_pk_f32_fp8((int)ww, false), hi = __builtin_amdgcn_cvt_pk_f32_fp8((int)ww, true);
                        ax += lo[0]; ay += lo[1]; az += hi[0]; aw += hi[1]; }
                    x.x += ax * (1.0f / SY8); x.y += ay * (1.0f / SY8); x.z += az * (1.0f / SY8); x.w += aw * (1.0f / SY8);
                    o[64 * j] = x; } } }
        }
    }
#undef IN
#undef BOTH
#undef GRID_BAR
}

extern "C" void kernel_launch(void* const* d_in, const int* in_sizes, int n_in, void* d_out, int out_size, void* d_ws, size_t ws_size, hipStream_t stream) {
    static int grid = 0;
    if (grid == 0) {
        if (n_in != N_IN || in_sizes[0] != T * D || out_size != T * D || ws_size < WS_END) { fprintf(stderr, "kernel_launch: unexpected shapes (n_in %d, in0 %d, out %d, ws %zu); nothing launched\n", n_in, n_in > 0 ? in_sizes[0] : -1, out_size, ws_size); grid = -1; return; }
        int dev = 0, cus = 0, per_cu = 0;
        if (hipGetDevice(&dev) != hipSuccess || hipDeviceGetAttribute(&cus, hipDeviceAttributeMultiprocessorCount, dev) != hipSuccess) { grid = -1; return; }
        if (hipFuncSetAttribute((const void*)fwd_kernel, hipFuncAttributeMaxDynamicSharedMemorySize, LDS_BYTES) != hipSuccess) { fprintf(stderr, "kernel_launch: hipFuncSetAttribute failed\n"); grid = -1; return; }
        if (hipOccupancyMaxActiveBlocksPerMultiprocessor(&per_cu, (const void*)fwd_kernel, NWAVES * 64, LDS_BYTES) != hipSuccess || per_cu < 1)
            fprintf(stderr, "kernel_launch: note: occupancy query reports %d workgroups per CU\n", per_cu);
        (void)hipGetLastError();
        grid = cus;
    }
    if (grid < 0) return;
    if (hipMemsetAsync((char*)d_ws + WS_CTL, 0, CTL_ZERO_BYTES, stream) != hipSuccess) { fprintf(stderr, "kernel_launch: hipMemsetAsync failed\n"); return; }
    Args a{};
    for (int i = 0; i < N_IN; ++i) a.in[i] = (const float*)d_in[i];
    a.out = (float*)d_out; a.ws = (unsigned char*)d_ws;
    const int last = MK_LAST_PHASE;
    if (N_LAUNCHES == PER_PHASE) {
        for (int li = 0; li < last; ++li) { a.ph_lo = li; a.ph_hi = li + 1; a.li = li; hipLaunchKernelGGL(fwd_kernel, dim3(grid), dim3(NWAVES * 64), LDS_BYTES, stream, a); }
    } else {
        a.ph_lo = 0; a.ph_hi = last; a.li = 0; hipLaunchKernelGGL(fwd_kernel, dim3(grid), dim3(NWAVES * 64), LDS_BYTES, stream, a);
    }
    const hipError_t le = hipPeekAtLastError();
    if (le != hipSuccess) fprintf(stderr, "kernel_launch: launch failed: %s\n", hipGetErrorName(le));
}
```

```cpp
#include <hip/hip_runtime.h>
#include <hip/hip_bf16.h>
#include <cstdio>
#include <cstdint>

#ifndef MK_N_LAUNCHES
#define MK_N_LAUNCHES 1
#endif
#ifndef MK_REP1
#define MK_REP1 1
#endif
#ifndef MK_REP4
#define MK_REP4 1
#endif
#ifndef MK_REP5
#define MK_REP5 1
#endif
#ifndef MK_REP6
#define MK_REP6 1
#endif
#ifndef MK_REP8
#define MK_REP8 1
#endif
#ifndef MK_REP9
#define MK_REP9 1
#endif
#ifndef MK_REP10
#define MK_REP10 1
#endif
#ifndef MK_REPCV
#define MK_REPCV 1
#endif
#ifndef MK_REPMLA
#define MK_REPMLA 1
#endif
#ifndef MK_REP0
#define MK_REP0 1
#endif
#ifndef MK_REP2
#define MK_REP2 1
#endif
#ifndef MK_REPX
#define MK_REPX 1
#endif
#ifndef MK_MMAPRIO
#define MK_MMAPRIO 0
#endif
#ifndef MK_LAST_PHASE
#define MK_LAST_PHASE 11
#endif

namespace pg8 {
#define PG8_LAS __attribute__((address_space(3)))
typedef unsigned short bf16_t;
typedef short bf16x8 __attribute__((ext_vector_type(8)));
typedef float f32x4 __attribute__((ext_vector_type(4)));
typedef unsigned u32x4 __attribute__((ext_vector_type(4)));
typedef unsigned u32x2 __attribute__((ext_vector_type(2)));
constexpr int BM = 256, BK = 64, HALF = 128, HTB = HALF * BK * 2, STAGE_BYTES = 8 * HTB, NXCD = 8, WGM = 8;

__host__ __device__ __forceinline__ int lds_byte(int r, int c) { const int st = (r >> 4) * 2 + (c >> 5), rr = r & 15, cc = c & 31, ob = rr * 64 + cc * 2; return st * 1024 + (ob ^ (((ob >> 9) & 1) << 5)); }
__host__ __device__ __forceinline__ void stage_rc(int b, int& R, int& C) { const int st = b / 1024, sb = b % 1024, swz = sb ^ (((sb >> 9) & 1) << 5); R = (st >> 1) * 16 + swz / 64; C = (st & 1) * 32 + (swz % 64) / 2; }
__host__ __device__ __forceinline__ int perm32(int rho) { const int n = rho >> 4, i = rho & 15; return 8 * (i >> 2) + 4 * n + (i & 3); }

struct Unit { int pm, pn; const char* A; const char* B; int aux; };

__device__ __forceinline__ void tile_order(int L, int nM, int nN, int& pm, int& pn) {
    const int nwg = nM * nN; int wgid = L;
    { const int q = nwg / NXCD, r = nwg % NXCD, xcd = wgid % NXCD, off = wgid / NXCD; wgid = (xcd < r ? xcd * (q + 1) : r * (q + 1) + (xcd - r) * q) + off; }
    const int nig = WGM * nN, gid = wgid / nig, fm = gid * WGM, gsz = (nM - fm) < WGM ? (nM - fm) : WGM;
    pm = fm + ((wgid % nig) % gsz); pn = (wgid % nig) / gsz;
}

__device__ __forceinline__ unsigned cvt_pk_bf16(float lo, float hi) { unsigned r; asm volatile("v_cvt_pk_bf16_f32 %0, %1, %2" : "=v"(r) : "v"(lo), "v"(hi)); return r; }
__device__ __forceinline__ float bf_lo(unsigned w) { return __uint_as_float(w << 16); }
__device__ __forceinline__ float bf_hi(unsigned w) { return __uint_as_float(w & 0xffff0000u); }
__device__ __forceinline__ float sigmoidf_fast(float x) { return __builtin_amdgcn_rcpf(1.0f + __builtin_amdgcn_exp2f(-1.4426950408889634f * x)); }

template <class Epi, class Sched, bool GATHER = false, bool ALIGN_EPI = true>
__device__ __forceinline__ void gemm_phase(PG8_LAS unsigned char* lds, const int tid, const int K, const int lda, const int ldb, const Sched& S, const Epi& E) {
    const int wid = __builtin_amdgcn_readfirstlane(tid >> 6), lane = tid & 63, wr = wid >> 2, wc = wid & 3, fr = lane & 15, fq = lane >> 4;
    const int nt = K / BK;
    int RA[2], CA[2]; unsigned voffB[2];
#pragma unroll
    for (int i = 0; i < 2; ++i) { int R, C; stage_rc(tid * 16 + i * 8192, R, C); const int Rb = Epi::PERM ? ((R & ~31) + perm32(R & 31)) : R;
        RA[i] = R; CA[i] = C; voffB[i] = (unsigned)(Rb * ldb + C) * 2u; }
    const size_t kstep = (size_t)(BK * 2);
    const size_t hstepB = (size_t)HALF * ldb * 2;
    const unsigned ldsw = (unsigned)wid * 1024u;
    const int aoff = lds_byte(wr * 64 + fr, fq * 8), boff = lds_byte(wc * 32 + fr, fq * 8);
#define PG8_SA(b, h) (((b) * 2 + (h)) * HTB)
#define PG8_SB(b, h) ((4 + (b) * 2 + (h)) * HTB)
#define PG8_STAGE2(bufoff, gbase, o0, o1) do { \
        __builtin_amdgcn_global_load_lds((const unsigned*)((const char*)(gbase) + (o0)), (PG8_LAS unsigned*)(lds + (bufoff) + ldsw), 16, 0, 0); \
        __builtin_amdgcn_global_load_lds((const unsigned*)((const char*)(gbase) + (o1)), (PG8_LAS unsigned*)(lds + (bufoff) + ldsw + 8192), 16, 0, 0); } while (0)
#define PG8_STAGEB(bufoff, gbase) PG8_STAGE2(bufoff, gbase, voffB[0], voffB[1])
#define PG8_STAGEA(bufoff, gbase, OFF, h) PG8_STAGE2(bufoff, gbase, OFF[h][0], OFF[h][1])
#define PG8_LDA(dst, b, h) do { _Pragma("unroll") for (int m = 0; m < 4; ++m) _Pragma("unroll") for (int k = 0; k < 2; ++k) dst[m][k] = *(const PG8_LAS bf16x8*)(lds + PG8_SA(b, h) + aoff + m * 2048 + k * 1024); } while (0)
#define PG8_LDB(dst, b, h) do { _Pragma("unroll") for (int n = 0; n < 2; ++n) _Pragma("unroll") for (int k = 0; k < 2; ++k) dst[n][k] = *(const PG8_LAS bf16x8*)(lds + PG8_SB(b, h) + boff + n * 2048 + k * 1024); } while (0)
#define PG8_MMA(ai, bj, At, Bt) do { __builtin_amdgcn_s_setprio(MK_MMAPRIO); _Pragma("unroll") for (int m = 0; m < 4; ++m) _Pragma("unroll") for (int n = 0; n < 2; ++n) _Pragma("unroll") for (int k = 0; k < 2; ++k) \
        acc[ai][bj][m][n] = __builtin_amdgcn_mfma_f32_16x16x32_bf16(Bt[n][k], At[m][k], acc[ai][bj][m][n], 0, 0, 0); __builtin_amdgcn_s_setprio(0); } while (0)
#define PG8_WAIT_V(n) asm volatile("s_waitcnt vmcnt(" #n ")" ::: "memory")
#define PG8_WAIT_L(n) asm volatile("s_waitcnt lgkmcnt(" #n ")" ::: "memory")
#define PG8_BAR __builtin_amdgcn_s_barrier()
#define PG8_SCHED __builtin_amdgcn_sched_barrier(0)
    Unit cur, nxt; int ui = 0;
    if (!S.next(0, cur)) return;
    f32x4 acc[2][2][4][2];
#pragma unroll
    for (int a = 0; a < 2; ++a)
#pragma unroll
        for (int b = 0; b < 2; ++b)
#pragma unroll
            for (int m = 0; m < 4; ++m)
#pragma unroll
                for (int n = 0; n < 2; ++n) acc[a][b][m][n] = (f32x4){0.f, 0.f, 0.f, 0.f};
    bf16x8 At[4][2], B0[2][2], B1[2][2];
    unsigned cOff[2][2], nOff[2][2];
#pragma unroll
    for (int h = 0; h < 2; ++h)
#pragma unroll
        for (int i = 0; i < 2; ++i) {
            if constexpr (GATHER) cOff[h][i] = S.row_off(cur, h * HALF + RA[i]) + (unsigned)CA[i] * 2u;
            else cOff[h][i] = (unsigned)((h * HALF + RA[i]) * lda + CA[i]) * 2u;
            nOff[h][i] = cOff[h][i];
        }
    const char* cA = cur.A; const char* cB = cur.B;
    PG8_STAGEB(PG8_SB(0, 0), cB); PG8_STAGEB(PG8_SB(0, 1), cB + hstepB); PG8_STAGEA(PG8_SA(0, 0), cA, cOff, 0); PG8_STAGEA(PG8_SA(0, 1), cA, cOff, 1);
    if (wr == 1) PG8_BAR;
    PG8_WAIT_V(2); PG8_BAR;
    PG8_STAGEB(PG8_SB(1, 0), cB + kstep); PG8_STAGEA(PG8_SA(1, 0), cA + kstep, cOff, 0); PG8_STAGEB(PG8_SB(1, 1), cB + hstepB + kstep);
    PG8_WAIT_V(6); PG8_BAR;
    for (;;) {
        const bool has_next = S.next(ui + 1, nxt);
        const char* nA = has_next ? nxt.A : cA; const char* nB = has_next ? nxt.B : cB;
        if constexpr (GATHER) {
            if (has_next) {
#pragma unroll
                for (int h = 0; h < 2; ++h)
#pragma unroll
                    for (int i = 0; i < 2; ++i) nOff[h][i] = S.row_off(nxt, h * HALF + RA[i]) + (unsigned)CA[i] * 2u;
            }
        }
        for (int t = 0; t < nt; t += 2) {
            const bool last = (t == nt - 2);
            const char* a1 = cA + (size_t)(t + 1) * kstep;
            const char* a2 = last ? nA : cA + (size_t)(t + 2) * kstep; const char* b2 = last ? nB : cB + (size_t)(t + 2) * kstep;
            const char* a3 = a2 + kstep; const char* b3 = b2 + kstep;
            unsigned o2[2][2];
#pragma unroll
            for (int h = 0; h < 2; ++h)
#pragma unroll
                for (int i = 0; i < 2; ++i) { if constexpr (GATHER) o2[h][i] = last ? nOff[h][i] : cOff[h][i]; else o2[h][i] = cOff[h][i]; }
            PG8_STAGEA(PG8_SA(1, 1), a1, cOff, 1); PG8_LDB(B0, 0, 0); PG8_LDB(B1, 0, 1); PG8_SCHED; PG8_LDA(At, 0, 0);
            PG8_WAIT_V(8); PG8_WAIT_L(0); PG8_BAR; PG8_MMA(0, 0, At, B0); PG8_MMA(0, 1, At, B1); PG8_BAR; PG8_SCHED;
            PG8_STAGEB(PG8_SB(0, 0), b2); PG8_STAGEB(PG8_SB(0, 1), b2 + hstepB); PG8_STAGEA(PG8_SA(0, 0), a2, o2, 0); PG8_LDA(At, 0, 1);
            PG8_WAIT_V(8); PG8_WAIT_L(0); PG8_BAR; PG8_MMA(1, 0, At, B0); PG8_MMA(1, 1, At, B1); PG8_BAR; PG8_SCHED;
            PG8_STAGEA(PG8_SA(0, 1), a2, o2, 1); PG8_LDB(B0, 1, 0); PG8_LDB(B1, 1, 1); PG8_SCHED; PG8_LDA(At, 1, 0);
            PG8_WAIT_V(8); PG8_WAIT_L(0); PG8_BAR; PG8_MMA(0, 0, At, B0); PG8_MMA(0, 1, At, B1); PG8_BAR; PG8_SCHED;
            PG8_STAGEB(PG8_SB(1, 0), b3); PG8_STAGEB(PG8_SB(1, 1), b3 + hstepB); PG8_STAGEA(PG8_SA(1, 0), a3, o2, 0); PG8_LDA(At, 1, 1);
            PG8_WAIT_V(8); PG8_WAIT_L(0); PG8_BAR; PG8_MMA(1, 0, At, B0); PG8_MMA(1, 1, At, B1); PG8_BAR; PG8_SCHED;
        }
        if constexpr (ALIGN_EPI) { if (wr == 0) PG8_BAR; }
        bool keep = false;
        if constexpr (Epi::ACCUM) keep = E.merge(acc, cur, wr, wc, fr, fq); else E(acc, cur, wr, wc, fr, fq);
        if (!has_next) break;
        if (!keep) {
#pragma unroll
        for (int a = 0; a < 2; ++a)
#pragma unroll
            for (int b = 0; b < 2; ++b)
#pragma unroll
                for (int m = 0; m < 4; ++m)
#pragma unroll
                    for (int n = 0; n < 2; ++n) acc[a][b][m][n] = (f32x4){0.f, 0.f, 0.f, 0.f};
        }
        cur = nxt; cA = nA; cB = nB; ++ui;
        if constexpr (GATHER) {
#pragma unroll
            for (int h = 0; h < 2; ++h)
#pragma unroll
                for (int i = 0; i < 2; ++i) cOff[h][i] = nOff[h][i];
        }
        if constexpr (ALIGN_EPI) { if (wr == 1) PG8_BAR; }
    }
    PG8_WAIT_V(0);
    if constexpr (!ALIGN_EPI) { if (wr == 0) PG8_BAR; }
    PG8_BAR;
#undef PG8_SA
#undef PG8_SB
#undef PG8_STAGE2
#undef PG8_STAGEA
#undef PG8_STAGEB
#undef PG8_LDA
#undef PG8_LDB
#undef PG8_MMA
#undef PG8_WAIT_V
#undef PG8_WAIT_L
#undef PG8_BAR
#undef PG8_SCHED
}
typedef int i32x4_t __attribute__((ext_vector_type(4)));
template <class Epi, class Sched, bool GATHER = false, bool ALIGN_EPI = true>
__device__ __forceinline__ void gemm_phase_i8(PG8_LAS unsigned char* lds, const int tid, const int K, const int lda, const int ldb, const Sched& S, const Epi& E) {
    const int wid = __builtin_amdgcn_readfirstlane(tid >> 6), lane = tid & 63, wr = wid >> 2, wc = wid & 3, fr = lane & 15, fq = lane >> 4;
    const int nt = K / 128;
    int RA[2], CA[2]; unsigned voffB[2];
#pragma unroll
    for (int i = 0; i < 2; ++i) { int R, C; stage_rc(tid * 16 + i * 8192, R, C); const int Rb = Epi::PERM ? ((R & ~31) + perm32(R & 31)) : R;
        RA[i] = R; CA[i] = C; voffB[i] = (unsigned)(Rb * ldb + C * 2); }
    const size_t kstep = (size_t)(BK * 2);
    const size_t hstepB = (size_t)HALF * ldb;
    const unsigned ldsw = (unsigned)wid * 1024u;
    const int aoff = lds_byte(wr * 64 + fr, fq * 8), boff = lds_byte(wc * 32 + fr, fq * 8);
#define PG8_SA(b, h) (((b) * 2 + (h)) * HTB)
#define PG8_SB(b, h) ((4 + (b) * 2 + (h)) * HTB)
#define PG8_STAGE2(bufoff, gbase, o0, o1) do { \
        __builtin_amdgcn_global_load_lds((const unsigned*)((const char*)(gbase) + (o0)), (PG8_LAS unsigned*)(lds + (bufoff) + ldsw), 16, 0, 0); \
        __builtin_amdgcn_global_load_lds((const unsigned*)((const char*)(gbase) + (o1)), (PG8_LAS unsigned*)(lds + (bufoff) + ldsw + 8192), 16, 0, 0); } while (0)
#define PG8_STAGEB(bufoff, gbase) PG8_STAGE2(bufoff, gbase, voffB[0], voffB[1])
#define PG8_STAGEA(bufoff, gbase, OFF, h) PG8_STAGE2(bufoff, gbase, OFF[h][0], OFF[h][1])
#define PG8_LDA(dst, b, h) do { _Pragma("unroll") for (int m = 0; m < 4; ++m) _Pragma("unroll") for (int k = 0; k < 2; ++k) dst[m][k] = *(const PG8_LAS bf16x8*)(lds + PG8_SA(b, h) + aoff + m * 2048 + k * 1024); } while (0)
#define PG8_LDB(dst, b, h) do { _Pragma("unroll") for (int n = 0; n < 2; ++n) _Pragma("unroll") for (int k = 0; k < 2; ++k) dst[n][k] = *(const PG8_LAS bf16x8*)(lds + PG8_SB(b, h) + boff + n * 2048 + k * 1024); } while (0)
#define PG8_MMA(ai, bj, At, Bt) do { __builtin_amdgcn_s_setprio(MK_MMAPRIO); _Pragma("unroll") for (int m = 0; m < 4; ++m) _Pragma("unroll") for (int n = 0; n < 2; ++n) _Pragma("unroll") for (int k = 0; k < 2; ++k) \
        acc[ai][bj][m][n] = __builtin_bit_cast(f32x4, __builtin_amdgcn_mfma_i32_16x16x64_i8(__builtin_bit_cast(i32x4_t, Bt[n][k]), __builtin_bit_cast(i32x4_t, At[m][k]), __builtin_bit_cast(i32x4_t, acc[ai][bj][m][n]), 0, 0, 0)); __builtin_amdgcn_s_setprio(0); } while (0)
#define PG8_WAIT_V(n) asm volatile("s_waitcnt vmcnt(" #n ")" ::: "memory")
#define PG8_WAIT_L(n) asm volatile("s_waitcnt lgkmcnt(" #n ")" ::: "memory")
#define PG8_BAR __builtin_amdgcn_s_barrier()
#define PG8_SCHED __builtin_amdgcn_sched_barrier(0)
    Unit cur, nxt; int ui = 0;
    if (!S.next(0, cur)) return;
    f32x4 acc[2][2][4][2];
#pragma unroll
    for (int a = 0; a < 2; ++a)
#pragma unroll
        for (int b = 0; b < 2; ++b)
#pragma unroll
            for (int m = 0; m < 4; ++m)
#pragma unroll
                for (int n = 0; n < 2; ++n) acc[a][b][m][n] = (f32x4){0.f, 0.f, 0.f, 0.f};
    bf16x8 At[4][2], B0[2][2], B1[2][2];
    unsigned cOff[2][2], nOff[2][2];
#pragma unroll
    for (int h = 0; h < 2; ++h)
#pragma unroll
        for (int i = 0; i < 2; ++i) {
            if constexpr (GATHER) cOff[h][i] = S.row_off(cur, h * HALF + RA[i]) + (unsigned)CA[i] * 2u;
            else cOff[h][i] = (unsigned)((h * HALF + RA[i]) * lda) + (unsigned)CA[i] * 2u;
            nOff[h][i] = cOff[h][i];
        }
    const char* cA = cur.A; const char* cB = cur.B;
    PG8_STAGEB(PG8_SB(0, 0), cB); PG8_STAGEB(PG8_SB(0, 1), cB + hstepB); PG8_STAGEA(PG8_SA(0, 0), cA, cOff, 0); PG8_STAGEA(PG8_SA(0, 1), cA, cOff, 1);
    if (wr == 1) PG8_BAR;
    PG8_WAIT_V(2); PG8_BAR;
    PG8_STAGEB(PG8_SB(1, 0), cB + kstep); PG8_STAGEA(PG8_SA(1, 0), cA + kstep, cOff, 0); PG8_STAGEB(PG8_SB(1, 1), cB + hstepB + kstep);
    PG8_WAIT_V(6); PG8_BAR;
    for (;;) {
        const bool has_next = S.next(ui + 1, nxt);
        const char* nA = has_next ? nxt.A : cA; const char* nB = has_next ? nxt.B : cB;
        if constexpr (GATHER) {
            if (has_next) {
#pragma unroll
                for (int h = 0; h < 2; ++h)
#pragma unroll
                    for (int i = 0; i < 2; ++i) nOff[h][i] = S.row_off(nxt, h * HALF + RA[i]) + (unsigned)CA[i] * 2u;
            }
        }
#pragma clang loop unroll(disable)
        for (int t = 0; t < nt; t += 2) {
            const bool last = (t == nt - 2);
            const char* a1 = cA + (size_t)(t + 1) * kstep;
            const char* a2 = last ? nA : cA + (size_t)(t + 2) * kstep; const char* b2 = last ? nB : cB + (size_t)(t + 2) * kstep;
            const char* a3 = a2 + kstep; const char* b3 = b2 + kstep;
            unsigned o2[2][2];
#pragma unroll
            for (int h = 0; h < 2; ++h)
#pragma unroll
                for (int i = 0; i < 2; ++i) { if constexpr (GATHER) o2[h][i] = last ? nOff[h][i] : cOff[h][i]; else o2[h][i] = cOff[h][i]; }
            PG8_STAGEA(PG8_SA(1, 1), a1, cOff, 1); PG8_LDB(B0, 0, 0); PG8_LDB(B1, 0, 1); PG8_SCHED; PG8_LDA(At, 0, 0);
            PG8_WAIT_V(8); PG8_WAIT_L(0); PG8_BAR; PG8_MMA(0, 0, At, B0); PG8_MMA(0, 1, At, B1); PG8_BAR; PG8_SCHED;
            PG8_STAGEB(PG8_SB(0, 0), b2); PG8_STAGEB(PG8_SB(0, 1), b2 + hstepB); PG8_STAGEA(PG8_SA(0, 0), a2, o2, 0); PG8_LDA(At, 0, 1);
            PG8_WAIT_V(8); PG8_WAIT_L(0); PG8_BAR; PG8_MMA(1, 0, At, B0); PG8_MMA(1, 1, At, B1); PG8_BAR; PG8_SCHED;
            PG8_STAGEA(PG8_SA(0, 1), a2, o2, 1); PG8_LDB(B0, 1, 0); PG8_LDB(B1, 1, 1); PG8_SCHED; PG8_LDA(At, 1, 0);
            PG8_WAIT_V(8); PG8_WAIT_L(0); PG8_BAR; PG8_MMA(0, 0, At, B0); PG8_MMA(0, 1, At, B1); PG8_BAR; PG8_SCHED;
            PG8_STAGEB(PG8_SB(1, 0), b3); PG8_STAGEB(PG8_SB(1, 1), b3 + hstepB); PG8_STAGEA(PG8_SA(1, 0), a3, o2, 0); PG8_LDA(At, 1, 1);
            PG8_WAIT_V(8); PG8_WAIT_L(0); PG8_BAR; PG8_MMA(1, 0, At, B0); PG8_MMA(1, 1, At, B1); PG8_BAR; PG8_SCHED;
        }
        if constexpr (ALIGN_EPI) { if (wr == 0) PG8_BAR; }
        bool keep = false;
#pragma unroll
        for (int a_ = 0; a_ < 2; ++a_)
#pragma unroll
            for (int b_ = 0; b_ < 2; ++b_)
#pragma unroll
                for (int m_ = 0; m_ < 4; ++m_)
#pragma unroll
                    for (int n_ = 0; n_ < 2; ++n_) { const i32x4_t iv = __builtin_bit_cast(i32x4_t, acc[a_][b_][m_][n_]); acc[a_][b_][m_][n_] = (f32x4){(float)iv[0], (float)iv[1], (float)iv[2], (float)iv[3]}; }
        E(acc, cur, wr, wc, fr, fq);
        if (!has_next) break;
        if (!keep) {
#pragma unroll
        for (int a = 0; a < 2; ++a)
#pragma unroll
            for (int b = 0; b < 2; ++b)
#pragma unroll
                for (int m = 0; m < 4; ++m)
#pragma unroll
                    for (int n = 0; n < 2; ++n) acc[a][b][m][n] = (f32x4){0.f, 0.f, 0.f, 0.f};
        }
        cur = nxt; cA = nA; cB = nB; ++ui;
        if constexpr (GATHER) {
#pragma unroll
            for (int h = 0; h < 2; ++h)
#pragma unroll
                for (int i = 0; i < 2; ++i) cOff[h][i] = nOff[h][i];
        }
        if constexpr (ALIGN_EPI) { if (wr == 1) PG8_BAR; }
    }
    PG8_WAIT_V(0);
    if constexpr (!ALIGN_EPI) { if (wr == 0) PG8_BAR; }
    PG8_BAR;
#undef PG8_SA
#undef PG8_SB
#undef PG8_STAGE2
#undef PG8_STAGEA
#undef PG8_STAGEB
#undef PG8_LDA
#undef PG8_LDB
#undef PG8_MMA
#undef PG8_WAIT_V
#undef PG8_WAIT_L
#undef PG8_BAR
#undef PG8_SCHED
}
__host__ __device__ __forceinline__ int lds_byte8(int r, int ch) { const int fr = r & 15; return (r >> 4) * 2048 + (ch >> 2) * 1024 + ((fr * 64 + (ch & 3) * 16) ^ (((fr >> 2) & 1) << 4)); }
__host__ __device__ __forceinline__ void stage_rc8(int b, int& R, int& CH) { const int blk = b >> 11, h2 = (b >> 10) & 1, w = b & 1023, fr = w >> 6; R = blk * 16 + fr; CH = h2 * 4 + (((w ^ (((fr >> 2) & 1) << 4)) >> 4) & 3); }
typedef int v8i __attribute__((ext_vector_type(8)));
typedef int v4i __attribute__((ext_vector_type(4)));
template <class Epi, class Sched, bool GATHER = false, bool ALIGN_EPI = true>
__device__ __forceinline__ void gemm_phase_f8(PG8_LAS unsigned char* lds, const int tid, const int K, const int lda, const int ldb, const Sched& S, const Epi& E) {
    const int wid = __builtin_amdgcn_readfirstlane(tid >> 6), lane = tid & 63, wr = wid >> 2, wc = wid & 3, fr = lane & 15, fq = lane >> 4;
    const int nt = K / 128;
    int RA[2], CA[2]; unsigned voffB[2];
#pragma unroll
    for (int i = 0; i < 2; ++i) { int R, C; stage_rc8(tid * 16 + i * 8192, R, C); const int Rb = Epi::PERM ? ((R & ~31) + perm32(R & 31)) : R;
        RA[i] = R; CA[i] = C * 8; voffB[i] = (unsigned)(Rb * ldb + C * 16); }
    const size_t kstep = (size_t)(BK * 2);
    const size_t hstepB = (size_t)HALF * ldb;
    const unsigned ldsw = (unsigned)wid * 1024u;
    const int aoff0 = lds_byte8(wr * 64 + fr, 2 * fq), aoff1 = lds_byte8(wr * 64 + fr, 2 * fq + 1), boff0 = lds_byte8(wc * 32 + fr, 2 * fq), boff1 = lds_byte8(wc * 32 + fr, 2 * fq + 1);
#define PG8_SA(b, h) (((b) * 2 + (h)) * HTB)
#define PG8_SB(b, h) ((4 + (b) * 2 + (h)) * HTB)
#define PG8_STAGE2(bufoff, gbase, o0, o1) do { \
        __builtin_amdgcn_global_load_lds((const unsigned*)((const char*)(gbase) + (o0)), (PG8_LAS unsigned*)(lds + (bufoff) + ldsw), 16, 0, 0); \
        __builtin_amdgcn_global_load_lds((const unsigned*)((const char*)(gbase) + (o1)), (PG8_LAS unsigned*)(lds + (bufoff) + ldsw + 8192), 16, 0, 0); } while (0)
#define PG8_STAGEB(bufoff, gbase) PG8_STAGE2(bufoff, gbase, voffB[0], voffB[1])
#define PG8_STAGEA(bufoff, gbase, OFF, h) PG8_STAGE2(bufoff, gbase, OFF[h][0], OFF[h][1])
#define PG8_LDA(dst, b, h) do { _Pragma("unroll") for (int m = 0; m < 4; ++m) { dst[m][0] = *(const PG8_LAS v4i*)(lds + PG8_SA(b, h) + aoff0 + m * 2048); dst[m][1] = *(const PG8_LAS v4i*)(lds + PG8_SA(b, h) + aoff1 + m * 2048); } } while (0)
#define PG8_LDB(dst, b, h) do { _Pragma("unroll") for (int n = 0; n < 2; ++n) { dst[n][0] = *(const PG8_LAS v4i*)(lds + PG8_SB(b, h) + boff0 + n * 2048); dst[n][1] = *(const PG8_LAS v4i*)(lds + PG8_SB(b, h) + boff1 + n * 2048); } } while (0)
#define PG8_V8(x) __builtin_shufflevector(x[0], x[1], 0, 1, 2, 3, 4, 5, 6, 7)
#define PG8_MMA(ai, bj, At, Bt) do { __builtin_amdgcn_s_setprio(MK_MMAPRIO); _Pragma("unroll") for (int m = 0; m < 4; ++m) _Pragma("unroll") for (int n = 0; n < 2; ++n) \
        asm volatile("v_mfma_scale_f32_16x16x128_f8f6f4 %0, %1, %2, %0, %3, %3 op_sel_hi:[0,0,0]" : "+v"(acc[ai][bj][m][n]) : "v"(PG8_V8(Bt[n])), "v"(PG8_V8(At[m])), "v"(sc1)); __builtin_amdgcn_s_setprio(0); } while (0)
#define PG8_WAIT_V(n) asm volatile("s_waitcnt vmcnt(" #n ")" ::: "memory")
#define PG8_WAIT_L(n) asm volatile("s_waitcnt lgkmcnt(" #n ")" ::: "memory")
#define PG8_BAR __builtin_amdgcn_s_barrier()
#define PG8_SCHED __builtin_amdgcn_sched_barrier(0)
    int sc1 = 0x7f7f7f7f; asm volatile("" : "+v"(sc1));
    Unit cur, nxt; int ui = 0;
    if (!S.next(0, cur)) return;
    f32x4 acc[2][2][4][2];
#pragma unroll
    for (int a = 0; a < 2; ++a)
#pragma unroll
        for (int b = 0; b < 2; ++b)
#pragma unroll
            for (int m = 0; m < 4; ++m)
#pragma unroll
                for (int n = 0; n < 2; ++n) acc[a][b][m][n] = (f32x4){0.f, 0.f, 0.f, 0.f};
    v4i At[4][2], B0[2][2], B1[2][2];
    unsigned cOff[2][2], nOff[2][2];
#pragma unroll
    for (int h = 0; h < 2; ++h)
#pragma unroll
        for (int i = 0; i < 2; ++i) {
            if constexpr (GATHER) cOff[h][i] = S.row_off(cur, h * HALF + RA[i]) + (unsigned)CA[i] * 2u;
            else cOff[h][i] = (unsigned)((h * HALF + RA[i]) * lda) + (unsigned)CA[i] * 2u;
            nOff[h][i] = cOff[h][i];
        }
    const char* cA = cur.A; const char* cB = cur.B;
    PG8_STAGEB(PG8_SB(0, 0), cB); PG8_STAGEB(PG8_SB(0, 1), cB + hstepB); PG8_STAGEA(PG8_SA(0, 0), cA, cOff, 0); PG8_STAGEA(PG8_SA(0, 1), cA, cOff, 1);
    if (wr == 1) PG8_BAR;
    PG8_WAIT_V(2); PG8_BAR;
    PG8_STAGEB(PG8_SB(1, 0), cB + kstep); PG8_STAGEA(PG8_SA(1, 0), cA + kstep, cOff, 0); PG8_STAGEB(PG8_SB(1, 1), cB + hstepB + kstep);
    PG8_WAIT_V(6); PG8_BAR;
    for (;;) {
        const bool has_next = S.next(ui + 1, nxt);
        const char* nA = has_next ? nxt.A : cA; const char* nB = has_next ? nxt.B : cB;
        if constexpr (GATHER) { if (has_next && wid == 0) S.stage_list(nxt, (ui + 1) & 1, lane); }
#pragma clang loop unroll(disable)
        for (int t = 0; t < nt; t += 2) {
            const bool last = (t == nt - 2);
            const char* a1 = cA + (size_t)(t + 1) * kstep;
            const char* a2 = last ? nA : cA + (size_t)(t + 2) * kstep; const char* b2 = last ? nB : cB + (size_t)(t + 2) * kstep;
            const char* a3 = a2 + kstep; const char* b3 = b2 + kstep;
            unsigned o2[2][2];
#pragma unroll
            for (int h = 0; h < 2; ++h)
#pragma unroll
                for (int i = 0; i < 2; ++i) o2[h][i] = cOff[h][i];
            if constexpr (GATHER) { if (last && has_next) {
#pragma unroll
                for (int h = 0; h < 2; ++h)
#pragma unroll
                    for (int i = 0; i < 2; ++i) { nOff[h][i] = S.row_fin(nxt, h * HALF + RA[i], S.stage_get((ui + 1) & 1, h * HALF + RA[i])) + (unsigned)CA[i] * 2u; o2[h][i] = nOff[h][i]; } } }
            PG8_STAGEA(PG8_SA(1, 1), a1, cOff, 1); PG8_LDB(B0, 0, 0); PG8_LDB(B1, 0, 1); PG8_SCHED; PG8_LDA(At, 0, 0);
            PG8_WAIT_V(8); PG8_WAIT_L(0); PG8_BAR; PG8_MMA(0, 0, At, B0); PG8_MMA(0, 1, At, B1); PG8_BAR; PG8_SCHED;
            PG8_STAGEB(PG8_SB(0, 0), b2); PG8_STAGEB(PG8_SB(0, 1), b2 + hstepB); PG8_STAGEA(PG8_SA(0, 0), a2, o2, 0); PG8_LDA(At, 0, 1);
            PG8_WAIT_V(8); PG8_WAIT_L(0); PG8_BAR; PG8_MMA(1, 0, At, B0); PG8_MMA(1, 1, At, B1); PG8_BAR; PG8_SCHED;
            PG8_STAGEA(PG8_SA(0, 1), a2, o2, 1); PG8_LDB(B0, 1, 0); PG8_LDB(B1, 1, 1); PG8_SCHED; PG8_LDA(At, 1, 0);
            PG8_WAIT_V(8); PG8_WAIT_L(0); PG8_BAR; PG8_MMA(0, 0, At, B0); PG8_MMA(0, 1, At, B1); PG8_BAR; PG8_SCHED;
            PG8_STAGEB(PG8_SB(1, 0), b3); PG8_STAGEB(PG8_SB(1, 1), b3 + hstepB); PG8_STAGEA(PG8_SA(1, 0), a3, o2, 0); PG8_LDA(At, 1, 1);
            PG8_WAIT_V(8); PG8_WAIT_L(0); PG8_BAR; PG8_MMA(1, 0, At, B0); PG8_MMA(1, 1, At, B1); PG8_BAR; PG8_SCHED;
        }
        asm volatile("s_nop 15\n\ts_nop 7" ::: "memory");
        if constexpr (ALIGN_EPI) { if (wr == 0) PG8_BAR; }
        E(acc, cur, wr, wc, fr, fq);
        if (!has_next) break;
#pragma unroll
        for (int a = 0; a < 2; ++a)
#pragma unroll
            for (int b = 0; b < 2; ++b)
#pragma unroll
                for (int m = 0; m < 4; ++m)
#pragma unroll
                    for (int n = 0; n < 2; ++n) acc[a][b][m][n] = (f32x4){0.f, 0.f, 0.f, 0.f};
        cur = nxt; cA = nA; cB = nB; ++ui;
        if constexpr (GATHER) {
#pragma unroll
            for (int h = 0; h < 2; ++h)
#pragma unroll
                for (int i = 0; i < 2; ++i) cOff[h][i] = nOff[h][i];
        }
        if constexpr (ALIGN_EPI) { if (wr == 1) PG8_BAR; }
    }
    PG8_WAIT_V(0);
    if constexpr (!ALIGN_EPI) { if (wr == 0) PG8_BAR; }
    PG8_BAR;
#undef PG8_SA
#undef PG8_SB
#undef PG8_STAGE2
#undef PG8_STAGEA
#undef PG8_STAGEB
#undef PG8_LDA
#undef PG8_LDB
#undef PG8_MMA
#undef PG8_V8
#undef PG8_WAIT_V
#undef PG8_WAIT_L
#undef PG8_BAR
#undef PG8_SCHED
}
}

namespace mla {
using bf16=__hip_bfloat16;
using bf16x8=__attribute__((ext_vector_type(8)))short;
using s16x4=__attribute__((ext_vector_type(4)))short;
using f32x16=__attribute__((ext_vector_type(16)))float;
using u32x4=__attribute__((ext_vector_type(4)))unsigned;
constexpr int SEQ=4096,DQK=96,DV=64,NHEAD=8;
constexpr int QP=768,KP=96,VP=64,OP=512;
constexpr int NW=8,QBLK=32,QB=QBLK*NW,KVBLK=64,NQB=SEQ/QB;
__device__ __forceinline__ int crow(int r,int hi){return (r&3)+8*(r>>2)+4*hi;}
#define SBAR() __builtin_amdgcn_sched_barrier(0)
__device__ __forceinline__ void cmask(f32x16&p0,f32x16&p1,int jb,int qrel,int hi){
  const float NEG=-INFINITY; int kb=64*jb+4*hi;
  #pragma unroll
  for(int r=0;r<16;++r){int kv=kb+(r&3)+8*(r>>2); if(kv>qrel)p0[r]=NEG; if(kv+32>qrel)p1[r]=NEG;}
}
constexpr int NSLOT=3, KSLOT=12288, VSLOT=8192;
constexpr int LDS_K=0, LDS_V=NSLOT*KSLOT, LDS_WS=LDS_V+NSLOT*VSLOT, LDS_OST=LDS_WS+NW*64*4, LDS_BYTES=LDS_OST+NW*4096;
__device__ __forceinline__ void glds16(const char*sbase,unsigned voff,unsigned lds_dst){unsigned keep;
  asm volatile("s_mov_b32 %0, m0\n\ts_mov_b32 m0, %2\n\ts_nop 0\n\tglobal_load_lds_dwordx4 %1, %3\n\ts_mov_b32 m0, %0":"=&s"(keep):"v"(voff),"s"(lds_dst),"s"(sbase):"memory");}
__device__ __forceinline__ const char* uni_ptr(const void*p){ const unsigned long long v=(unsigned long long)(uintptr_t)p; const unsigned lo=__builtin_amdgcn_readfirstlane((unsigned)v),hi=__builtin_amdgcn_readfirstlane((unsigned)(v>>32)); return (const char*)(uintptr_t)(((unsigned long long)hi<<32)|lo); }
__device__ __forceinline__ float max3f(float a,float b,float c){float r;asm("v_max3_f32 %0, %1, %2, %3":"=v"(r):"v"(a),"v"(b),"v"(c));return r;}
__device__ __forceinline__ float max2f(float a,float b){float r;asm("v_max_f32_e32 %0, %1, %2":"=v"(r):"v"(a),"v"(b));return r;}
__device__ __forceinline__ float fadd_s(float a,float b){float r;asm("v_add_f32_e32 %0, %1, %2":"=v"(r):"v"(a),"v"(b));return r;}
__device__ __forceinline__ float fsub_s(float a,float b){float r;asm("v_sub_f32_e32 %0, %1, %2":"=v"(r):"v"(a),"v"(b));return r;}
typedef float f32x2_t __attribute__((ext_vector_type(2))); typedef __bf16 bf16x2_t __attribute__((ext_vector_type(2)));
__device__ __forceinline__ unsigned cvtpk_s(float lo,float hi){f32x2_t v={lo,hi};bf16x2_t b=__builtin_convertvector(v,bf16x2_t);return __builtin_bit_cast(unsigned,b);}
#define WAIT_BAR(N) asm volatile("s_waitcnt vmcnt(" #N ") lgkmcnt(0)\n\ts_barrier":::"memory")

__device__ __forceinline__ void qkt(f32x16&p0,f32x16&p1,const char*Kslot,const bf16x8*qr,int r32,int hi){
  const f32x16 negm=f32x16{};
  const char*kb=Kslot+hi*1024+r32*16;
  #pragma unroll
  for(int d0=0;d0<6;++d0){
    const bf16x8 b0=*reinterpret_cast<const bf16x8*>(kb+d0*2048);
    const bf16x8 b1=*reinterpret_cast<const bf16x8*>(kb+d0*2048+512);
    if(d0==0){p0=__builtin_amdgcn_mfma_f32_32x32x16_bf16(b0,qr[0],negm,0,0,0);p1=__builtin_amdgcn_mfma_f32_32x32x16_bf16(b1,qr[0],negm,0,0,0);}
    else{p0=__builtin_amdgcn_mfma_f32_32x32x16_bf16(b0,qr[d0],p0,0,0,0);p1=__builtin_amdgcn_mfma_f32_32x32x16_bf16(b1,qr[d0],p1,0,0,0);}}
}
typedef __attribute__((address_space(3))) const char* lds_cptr;
typedef short v4i16_t __attribute__((ext_vector_type(4)));
__device__ __forceinline__ void kload12(bf16x8*kf,lds_cptr kp){
  #pragma unroll
  for(int j=0;j<6;++j){ kf[2*j]=*(const __attribute__((address_space(3))) bf16x8*)(kp+j*2048); kf[2*j+1]=*(const __attribute__((address_space(3))) bf16x8*)(kp+j*2048+512); }
}
__device__ __forceinline__ void kload2(bf16x8*kf,lds_cptr kp,int j){ kf[2*j]=*(const __attribute__((address_space(3))) bf16x8*)(kp+j*2048); kf[2*j+1]=*(const __attribute__((address_space(3))) bf16x8*)(kp+j*2048+512); }
__device__ __forceinline__ s16x4 vtr(lds_cptr p){ return __builtin_bit_cast(s16x4,__builtin_amdgcn_ds_read_tr16_b64_v4i16((__attribute__((address_space(3))) v4i16_t*)p)); }
__device__ __forceinline__ float rowmax(const f32x16&p0,const f32x16&p1){
  float a=max3f(p0[0],p0[1],p1[0]),b=max3f(p0[2],p0[3],p1[1]);a=max3f(a,p1[2],p1[3]);
  #pragma unroll
  for(int r=4;r<16;r+=4){a=max3f(a,p0[r],p0[r+1]);b=max3f(b,p0[r+2],p0[r+3]);a=max3f(a,p1[r],p1[r+1]);b=max3f(b,p1[r+2],p1[r+3]);}
  const float m=max2f(a,b);
  auto rr=__builtin_amdgcn_permlane32_swap(__float_as_uint(m),__float_as_uint(m),false,false);
  return max2f(__uint_as_float(rr[0]),__uint_as_float(rr[1]));
}
__device__ __forceinline__ void pv(f32x16*o,int vb,bf16x8 pa0,bf16x8 pa1,bf16x8 pa2,bf16x8 pa3){
  #pragma unroll
  for(int d0=0;d0<2;++d0){s16x4 lo[4],hi[4];
    #pragma unroll
    for(int ks=0;ks<4;++ks){
      asm volatile("ds_read_b64_tr_b16 %0,%1 offset:%c2":"=&v"(lo[ks]):"v"(vb),"i"(d0*4096+ks*1024):"memory");
      asm volatile("ds_read_b64_tr_b16 %0,%1 offset:%c2":"=&v"(hi[ks]):"v"(vb),"i"(d0*4096+ks*1024+512):"memory");}
    asm volatile("s_waitcnt lgkmcnt(0)":::"memory");SBAR();
    #define PK(k) (bf16x8){lo[k][0],lo[k][1],lo[k][2],lo[k][3],hi[k][0],hi[k][1],hi[k][2],hi[k][3]}
    o[d0]=__builtin_amdgcn_mfma_f32_32x32x16_bf16(pa0,PK(0),o[d0],0,0,0);
    o[d0]=__builtin_amdgcn_mfma_f32_32x32x16_bf16(pa1,PK(1),o[d0],0,0,0);
    o[d0]=__builtin_amdgcn_mfma_f32_32x32x16_bf16(pa2,PK(2),o[d0],0,0,0);
    o[d0]=__builtin_amdgcn_mfma_f32_32x32x16_bf16(pa3,PK(3),o[d0],0,0,0);
    #undef PK
  }
}

struct QXform { const float* rsq; const int* pos; const float* gq; const float* invrev; float c2; };
template<int THRL> __device__ __forceinline__ void attn_unit(const int tid,const QXform&QX,int b,int h,int qb,const bf16*Q,const bf16*__restrict__ K,const bf16*__restrict__ V,bf16*O,char*shm){
  const int lane=tid&63,r32=lane&31,hi=lane>>5; const int wid=__builtin_amdgcn_readfirstlane(tid>>6);
  const long rowbase=(long)b*SEQ; const int q0=qb*QB;
  const bf16*Qw=Q+(rowbase+q0+wid*QBLK)*QP+h*DQK;
  const bf16*Kh=K+((long)(b*NHEAD+h)*SEQ)*KP,*Vh=V+((long)(b*NHEAD+h)*SEQ)*VP;
  const unsigned lds0=(unsigned)(uintptr_t)shm;
  float*wsf=(float*)(shm+LDS_WS)+wid*64;
  const char*Kb=uni_ptr(Kh); const char*Vb=uni_ptr(Vh);
  const unsigned koffA=(unsigned)(wid*1024+lane*16), koffB=(unsigned)((8+(wid&3))*1024+lane*16);
  const unsigned voffV=(unsigned)(wid*1024+lane*16);
  const unsigned kdstA=lds0+LDS_K+wid*1024, kdstB=lds0+LDS_K+(8+(wid&3))*1024, vdst=lds0+LDS_V+wid*1024;
  #define KOF(s) ((s)+((s)>>1))
  #define DMA_K(t,slot) do{ const char*kt_=Kb+(size_t)(t)*(KVBLK*KP*2); glds16(kt_,koffA,(unsigned)__builtin_amdgcn_readfirstlane(kdstA+KOF(slot))); glds16(kt_,koffB,(unsigned)__builtin_amdgcn_readfirstlane(kdstB+KOF(slot))); }while(0)
  #define DMA_V(t,slot) glds16(Vb+(size_t)(t)*(KVBLK*VP*2),voffV,(unsigned)__builtin_amdgcn_readfirstlane(vdst+(slot)))
  const int vb0=(int)(lds0+LDS_V)+((lane>>4)&1)*32+(lane&3)*8+(4*hi+((lane&15)>>2))*64;
  const char*Kbase=shm+LDS_K; bf16x8 kf[12];
  const lds_cptr shm3=(lds_cptr)shm; const lds_cptr kp0=shm3+LDS_K+hi*1024+r32*16; const lds_cptr vp0=shm3+LDS_V+((lane>>4)&1)*32+(lane&3)*8+(4*hi+((lane&15)>>2))*64;
  const int NT=(q0+QB)/KVBLK;
  DMA_K(0,0);DMA_V(0,0);DMA_K(1,VSLOT);
  bf16x8 qr[6];
  { int lq=lane; asm volatile("":"+v"(lq));
    const int rq=lq&31,hq=lq>>5; const long trow=rowbase+q0+wid*QBLK+rq;
    const bf16*qp=Qw+(long)rq*QP+hq*8; u32x4 raw[6];
    _Pragma("unroll") for(int d0=0;d0<6;++d0)raw[d0]=*reinterpret_cast<const u32x4*>(qp+d0*16);
    const float rsq=QX.rsq[trow]; const float posf=(float)QX.pos[trow];
    float x[6][8]; float ss=0.f;
    _Pragma("unroll") for(int d0=0;d0<6;++d0) _Pragma("unroll") for(int j=0;j<4;++j){ const float a_=__uint_as_float(raw[d0][j]<<16)*rsq,b_=__uint_as_float(raw[d0][j]&0xffff0000u)*rsq; x[d0][2*j]=a_;x[d0][2*j+1]=b_; ss+=a_*a_+b_*b_; }
    ss+=__shfl_xor(ss,32);
    const float rn=QX.c2/sqrtf(ss*(1.f/96.f)+1e-6f);
    _Pragma("unroll") for(int d0=0;d0<4;++d0){ const float*g_=QX.gq+16*d0+8*hq; u32x4 w_;
      _Pragma("unroll") for(int j=0;j<4;++j)w_[j]=cvtpk_s(x[d0][2*j]*rn*g_[2*j],x[d0][2*j+1]*rn*g_[2*j+1]);
      qr[d0]=__builtin_bit_cast(bf16x8,w_); }
    { float lo_[8],hi_[8];
      _Pragma("unroll") for(int j=0;j<8;++j){ const int i_=8*hq+j; float rev=posf*QX.invrev[i_]; rev-=floorf(rev); const float sn_=__builtin_amdgcn_sinf(rev),cs_=__builtin_amdgcn_cosf(rev);
        const float a_=x[4][j]*rn*QX.gq[64+i_],b_=x[5][j]*rn*QX.gq[80+i_]; lo_[j]=a_*cs_-b_*sn_; hi_[j]=b_*cs_+a_*sn_; }
      u32x4 wl,wh; _Pragma("unroll") for(int j=0;j<4;++j){ wl[j]=cvtpk_s(lo_[2*j],lo_[2*j+1]); wh[j]=cvtpk_s(hi_[2*j],hi_[2*j+1]); }
      qr[4]=__builtin_bit_cast(bf16x8,wl); qr[5]=__builtin_bit_cast(bf16x8,wh); } }
  float mhat=0.f,l_reg=0.f;f32x16 o[2];o[0]=f32x16{};o[1]=f32x16{};f32x16 negm; { float z_=0.f; asm volatile("":"+v"(z_)); _Pragma("unroll") for(int r=0;r<16;++r)negm[r]=z_; }
  const int qrel=wid*QBLK+r32;
  #define CMASK(P0,P1,t) do{int jb_=(t)-(NT-4); if(jb_>=0)cmask(P0,P1,jb_,qrel,hi);}while(0)
  bool resc=false;
  #define START(P0,P1) do{ const float rm=rowmax(P0,P1); resc=false; \
    { const float dl=rm; mhat=fadd_s(mhat,dl); \
      _Pragma("unroll") for(int r=0;r<16;++r){P0[r]=fsub_s(P0[r],dl);P1[r]=fsub_s(P1[r],dl);} \
      _Pragma("unroll") for(int r=0;r<16;++r)negm[r]=-mhat; asm volatile("":"+v"(negm)); } \
    _Pragma("unroll") for(int r=0;r<16;++r)P0[r]=__builtin_amdgcn_exp2f(P0[r]); }while(0)
  #define RESC() do{ if(resc){ asm volatile("s_waitcnt lgkmcnt(0)":::"memory"); \
      _Pragma("unroll") for(int d_=0;d_<2;++d_) _Pragma("unroll") for(int r=0;r<16;++r)o[d_][r]*=wsf[crow(r,hi)]; } }while(0)
  f32x16 pA0,pA1,pB0,pB1;
  int sl_prev=0,sl_cur=0,sl_next=VSLOT;
  #define ROT() do{sl_prev=sl_cur;sl_cur=sl_next;sl_next=(sl_next==(NSLOT-1)*VSLOT)?0:sl_next+VSLOT;}while(0)
  DMA_K(2,2*VSLOT);
  WAIT_BAR(5);
  qkt(pA0,pA1,Kbase,qr,r32,hi);asm volatile("s_nop 15\n\ts_nop 7":"+v"(pA0),"+v"(pA1));CMASK(pA0,pA1,0);
  START(pA0,pA1);
  _Pragma("unroll") for(int r=0;r<16;++r)pA1[r]=__builtin_amdgcn_exp2f(pA1[r]);
  WAIT_BAR(0);
  DMA_K(3,0);DMA_V(1,VSLOT);
  ROT();
  kload12(kf,kp0+KOF(sl_cur));
  WAIT_BAR(3);
  s16x4 vlo[8],vhi[8]; u32x4 pw0,pw1,pw2,pw3;
  #define PKW(P,B) cvtpk_s(P[B],P[B+1])
  #define PAF(k) __builtin_bit_cast(bf16x8,pw##k)
  #define VFR(i) (bf16x8){vlo[i][0],vlo[i][1],vlo[i][2],vlo[i][3],vhi[i][0],vhi[i][1],vhi[i][2],vhi[i][3]}
  #define PIN(x) asm volatile("":"+v"(x))
  #define MX3(a,b,c) __builtin_fmaxf(__builtin_fmaxf((a),(b)),(c))
  #define GAPA(MF,A0,A1,A2,A3,W0,W1,PW) do{ MF; sacc+=A0; sacc+=A1; sacc+=A2; sacc+=A3; PIN(sacc); W0; W1; PIN(PW); SBAR(); }while(0)
  #define EX(v) __builtin_amdgcn_exp2f(v)
  #define GAPB(MF,X,B) do{ MF; X[B]=EX(X[B]); X[B+1]=EX(X[B+1]); X[B+2]=EX(X[B+2]); X[B+3]=EX(X[B+3]); PIN(X); SBAR(); }while(0)
  #define VRD(i) do{ vlo[i]=vtr(vp_+(((i)>>2)*4096+((i)&3)*1024)); vhi[i]=vtr(vp_+(((i)>>2)*4096+((i)&3)*1024+512)); }while(0)
  #define KRD(G,j) do{ if(G){ kload2(kf,kp0+KOF(sl_next),j); SBAR(); } }while(0)
  const f32x16 zero16=f32x16{};
  #define STEP(C0,C1,P0,P1,t,GK,GV,GL) do{ SBAR(); \
    const lds_cptr vp_=vp0+sl_prev; \
    VRD(0); SBAR(); float sacc=(P0[0]+P0[1]); \
    GAPA(C0=__builtin_amdgcn_mfma_f32_32x32x16_bf16(kf[0],qr[0],negm,0,0,0), P0[2],P0[3],P0[4],P0[5],     pw0[0]=PKW(P0,0), pw0[1]=PKW(P0,2), pw0); \
    VRD(4); SBAR(); GAPA(C1=__builtin_amdgcn_mfma_f32_32x32x16_bf16(kf[1],qr[0],negm,0,0,0), P0[6],P0[7],P0[8],P0[9],     pw0[2]=PKW(P0,4), pw0[3]=PKW(P0,6), pw0); \
    VRD(1); SBAR(); GAPA(C0=__builtin_amdgcn_mfma_f32_32x32x16_bf16(kf[2],qr[1],C0,0,0,0),   P0[10],P0[11],P0[12],P0[13], pw1[0]=PKW(P0,8), pw1[1]=PKW(P0,10), pw1); \
    VRD(5); SBAR(); GAPA(C1=__builtin_amdgcn_mfma_f32_32x32x16_bf16(kf[3],qr[1],C1,0,0,0),   P0[14],P0[15],P1[0],P1[1],   pw1[2]=PKW(P0,12),pw1[3]=PKW(P0,14), pw1); \
    VRD(2); SBAR(); GAPA(C0=__builtin_amdgcn_mfma_f32_32x32x16_bf16(kf[4],qr[2],C0,0,0,0),   P1[2],P1[3],P1[4],P1[5],     pw2[0]=PKW(P1,0), pw2[1]=PKW(P1,2), pw2); \
    VRD(6); SBAR(); GAPA(C1=__builtin_amdgcn_mfma_f32_32x32x16_bf16(kf[5],qr[2],C1,0,0,0),   P1[6],P1[7],P1[8],P1[9],     pw2[2]=PKW(P1,4), pw2[3]=PKW(P1,6), pw2); \
    VRD(3); SBAR(); GAPA(C0=__builtin_amdgcn_mfma_f32_32x32x16_bf16(kf[6],qr[3],C0,0,0,0),   P1[10],P1[11],P1[12],P1[13], pw3[0]=PKW(P1,8), pw3[1]=PKW(P1,10), pw3); \
    VRD(7); SBAR(); GAPA(C1=__builtin_amdgcn_mfma_f32_32x32x16_bf16(kf[7],qr[3],C1,0,0,0),   P1[14],P1[15],0.f,0.f,       pw3[2]=PKW(P1,12),pw3[3]=PKW(P1,14), pw3); \
    C0=__builtin_amdgcn_mfma_f32_32x32x16_bf16(kf[8],qr[4],C0,0,0,0); C1=__builtin_amdgcn_mfma_f32_32x32x16_bf16(kf[9],qr[4],C1,0,0,0); SBAR(); \
    C0=__builtin_amdgcn_mfma_f32_32x32x16_bf16(kf[10],qr[5],C0,0,0,0); C1=__builtin_amdgcn_mfma_f32_32x32x16_bf16(kf[11],qr[5],C1,0,0,0); SBAR(); \
    l_reg+=sacc; \
    if(GK){DMA_K((t)+3,sl_cur);} if(GV){DMA_V((t)+1,sl_next);} \
    CMASK(C0,C1,t); \
    { float a=MX3(C0[0],C0[1],C1[0]),b=MX3(C0[2],C0[3],C1[1]); a=MX3(a,C1[2],C1[3]); \
      _Pragma("unroll") for(int r=4;r<16;r+=4){a=MX3(a,C0[r],C0[r+1]);b=MX3(b,C0[r+2],C0[r+3]);a=MX3(a,C1[r],C1[r+1]);b=MX3(b,C1[r+2],C1[r+3]);} \
      float rm=__builtin_fmaxf(a,b); { auto rr=__builtin_amdgcn_permlane32_swap(__float_as_uint(rm),__float_as_uint(rm),false,false); rm=__builtin_fmaxf(__uint_as_float(rr[0]),__uint_as_float(rr[1])); } \
      resc=false; \
      if(__builtin_expect(__any(rm>(float)THRL),0)){ const float dl=__builtin_fmaxf(rm,0.f); mhat+=dl; \
        _Pragma("unroll") for(int r=0;r<16;++r){C0[r]-=dl;C1[r]-=dl;} \
        _Pragma("unroll") for(int r=0;r<16;++r)negm[r]=-mhat; asm volatile("":"+v"(negm)); \
        const float f=__builtin_amdgcn_exp2f(-dl); l_reg*=f; if(hi==0)wsf[r32]=f; resc=true; } } \
    SBAR(); \
    GAPB(o[0]=__builtin_amdgcn_mfma_f32_32x32x16_bf16(PAF(0),VFR(0),o[0],0,0,0), C0,0); \
    KRD(GL,0); GAPB(o[1]=__builtin_amdgcn_mfma_f32_32x32x16_bf16(PAF(0),VFR(4),o[1],0,0,0), C0,4); \
    KRD(GL,1); GAPB(o[0]=__builtin_amdgcn_mfma_f32_32x32x16_bf16(PAF(1),VFR(1),o[0],0,0,0), C0,8); \
    KRD(GL,2); GAPB(o[1]=__builtin_amdgcn_mfma_f32_32x32x16_bf16(PAF(1),VFR(5),o[1],0,0,0), C0,12); \
    KRD(GL,3); GAPB(o[0]=__builtin_amdgcn_mfma_f32_32x32x16_bf16(PAF(2),VFR(2),o[0],0,0,0), C1,0); \
    KRD(GL,4); GAPB(o[1]=__builtin_amdgcn_mfma_f32_32x32x16_bf16(PAF(2),VFR(6),o[1],0,0,0), C1,4); \
    KRD(GL,5); GAPB(o[0]=__builtin_amdgcn_mfma_f32_32x32x16_bf16(PAF(3),VFR(3),o[0],0,0,0), C1,8); \
    GAPB(o[1]=__builtin_amdgcn_mfma_f32_32x32x16_bf16(PAF(3),VFR(7),o[1],0,0,0), C1,12); \
    }while(0)
  int t=1;
  #undef CMASK
  #define CMASK(P0,P1,t) do{}while(0)
  for(;t+5<NT;t+=2){
    STEP(pB0,pB1,pA0,pA1,t,true,true,true);     WAIT_BAR(3); RESC(); ROT();
    STEP(pA0,pA1,pB0,pB1,t+1,true,true,true);   WAIT_BAR(3); RESC(); ROT();
  }
  #undef CMASK
  #define CMASK(P0,P1,t) do{int jb_=(t)-(NT-4); if(jb_>=0)cmask(P0,P1,jb_,qrel,hi);}while(0)
  #define ENDW(tt) do{ if((tt)+3<NT){WAIT_BAR(3);} else if((tt)+2<NT){WAIT_BAR(1);} else {WAIT_BAR(0);} }while(0)
  for(;t+1<NT;t+=2){
    STEP(pB0,pB1,pA0,pA1,t,(t+3<NT),(t+1<NT),(t+1<NT));       ENDW(t);   RESC(); ROT();
    STEP(pA0,pA1,pB0,pB1,t+1,(t+4<NT),(t+2<NT),(t+2<NT));     ENDW(t+1); RESC(); ROT();
  }
  STEP(pB0,pB1,pA0,pA1,NT-1,false,false,false); RESC();
  { float sacc=pB0[0]+pB0[1]; _Pragma("unroll") for(int r=2;r<16;++r)sacc+=pB0[r]; _Pragma("unroll") for(int r=0;r<16;++r)sacc+=pB1[r]; l_reg+=sacc;
    pw0=(u32x4){PKW(pB0,0),PKW(pB0,2),PKW(pB0,4),PKW(pB0,6)};pw1=(u32x4){PKW(pB0,8),PKW(pB0,10),PKW(pB0,12),PKW(pB0,14)};pw2=(u32x4){PKW(pB1,0),PKW(pB1,2),PKW(pB1,4),PKW(pB1,6)};pw3=(u32x4){PKW(pB1,8),PKW(pB1,10),PKW(pB1,12),PKW(pB1,14)};
    SBAR(); pv(o,vb0+sl_cur,PAF(0),PAF(1),PAF(2),PAF(3)); }
  #undef PKW
  #undef PAF
  #undef VFR
  #undef PIN
  #undef MX3
  #undef GAPA
  #undef GAPB
  #undef EX
  #undef VRD
  #undef KRD
  #undef STEP
  #undef ENDW
  {auto rr=__builtin_amdgcn_permlane32_swap(__float_as_uint(l_reg),__float_as_uint(l_reg),false,false);l_reg=__uint_as_float(rr[0])+__uint_as_float(rr[1]);}
  if(hi==0)wsf[32+r32]=l_reg;asm volatile("s_waitcnt lgkmcnt(0)":::"memory");
  float rli[16];
  #pragma unroll
  for(int r=0;r<16;++r)rli[r]=__builtin_amdgcn_rcpf(wsf[32+crow(r,hi)]);
  bf16*Ow=O+(rowbase+q0+wid*QBLK)*OP+h*DV;
  { bf16*stg=(bf16*)(shm+LDS_OST)+wid*2048;
    #pragma unroll
    for(int r=0;r<16;++r){const int orow=crow(r,hi);
      #pragma unroll
      for(int d0=0;d0<2;++d0)stg[orow*64+d0*32+r32]=__float2bfloat16(o[d0][r]*rli[r]);}
    asm volatile("s_waitcnt lgkmcnt(0)":::"memory");
    int lo_=lane; asm volatile("":"+v"(lo_));
    #pragma unroll
    for(int i=0;i<4;++i){const int row=i*8+(lo_>>3),ch=lo_&7; const u32x4 v=*(const u32x4*)(stg+row*64+ch*8); *(u32x4*)(Ow+(long)row*OP+ch*8)=v;} }
  asm volatile("s_waitcnt lgkmcnt(0)\n\ts_barrier":::"memory");
  #undef DMA_K
  #undef DMA_V
  #undef KOF
  #undef CMASK
  #undef START
  #undef RESC
  #undef ROT
}
#undef WAIT_BAR
}

constexpr int NWAVES = 8;
constexpr int BATCH = 16, SEQ = 4096, D = 1024, T = BATCH * SEQ;
constexpr int IN_COLS = 4768, N1 = 4864;
constexpr int MEM_LEN = 256, MROWS = BATCH * MEM_LEN;
constexpr int NEXP = 32, TOPK = 4, DFF = 1024, LISTCAP = T;
constexpr int ACT_TILES_MAX = (T * TOPK) / 256 + NEXP;
constexpr float EPS = 1e-6f;
constexpr float C2_MLA = 0.10206207261596575f * 1.4426950408889634f;
constexpr float C2_X = 0.08838834764831845f * 1.4426950408889634f;
constexpr float SX8 = 4.0f, SW8 = 64.0f, SA8 = 4.0f, SY8 = 8.0f, SH8 = 8.0f;
constexpr float SC8 = 20.0f, SWQ8 = 440.0f, SWKV8 = 360.0f;
constexpr float SM8 = 32.0f;
constexpr float SWI8 = 720.0f;
constexpr int PER_PHASE = 11;
constexpr int N_LAUNCHES = MK_N_LAUNCHES;

constexpr size_t MiB = 1u << 20;
constexpr size_t WS_CTL = 0, CTL_ZERO_BYTES = 1 * MiB;
constexpr size_t WS_LIST = 1 * MiB;
constexpr size_t WS_TOKG = 9 * MiB;
constexpr size_t WS_RSTD2 = 10 * MiB;
constexpr size_t WS_W1T = 9 * MiB;
constexpr size_t WS_WUQ = 19 * MiB;
constexpr size_t WS_WUKV = 20 * MiB;
constexpr size_t WS_WMEM = 21 * MiB;
constexpr size_t WS_WPOOL = 23 * MiB;
constexpr size_t WS_WMO = 24 * MiB, WS_WCO = 25 * MiB;
constexpr size_t WS_WO = 26 * MiB;
constexpr size_t WS_MEMN = 28 * MiB;
constexpr size_t WS_KVMK = 36 * MiB;
constexpr size_t WS_VTG = 40 * MiB;
constexpr size_t WS_HN = 64 * MiB;
constexpr size_t WS_V = 64 * MiB, WS_MIXED = 128 * MiB;
constexpr size_t WS_HSC = 60 * MiB;
constexpr size_t WS_CQ8 = 384 * MiB, WS_CKV8 = 416 * MiB;
constexpr size_t WS_RSQ = 62 * MiB;
constexpr size_t WS_MSC = 61 * MiB;
constexpr size_t WS_HN8 = 384 * MiB;
constexpr size_t WS_W1G8 = 448 * MiB;
constexpr size_t WS_GATES = 192 * MiB;
constexpr size_t WS_U = 576 * MiB, WS_AO = 576 * MiB;
constexpr size_t WS_CQKV = 640 * MiB, WS_CO = 640 * MiB;
constexpr size_t WS_QX = 736 * MiB;
constexpr size_t WS_Q = 800 * MiB;
constexpr size_t WS_KV = 896 * MiB, WS_MERGED = 896 * MiB;
constexpr size_t WS_HN2 = 16 * MiB;
constexpr size_t WS_WEI = 456 * MiB;
constexpr size_t WS_Y = 16 * MiB;
constexpr size_t WS_DELTA = 552 * MiB;
constexpr size_t WS_ACT = 680 * MiB;
constexpr size_t WS_WEO = 520 * MiB;
constexpr size_t WS_LRS = 960 * MiB, WS_LGATE = 968 * MiB;
constexpr size_t WS_RK = 552 * MiB;
constexpr size_t WS_PE = 560 * MiB, WS_PART = 568 * MiB;
constexpr size_t WS_END = 992 * MiB;
static_assert(WS_Y + (size_t)T * 4 * 1024 <= WS_WEI && WS_W1G8 + 3 * MiB <= WS_WEI && WS_WEI + (size_t)NEXP * 2048 * 1024 <= WS_WEO && WS_WEO + (size_t)NEXP * 1024 * 1024 <= WS_DELTA && WS_DELTA + (size_t)T * 1024 * 2 <= WS_ACT && WS_ACT + (size_t)ACT_TILES_MAX * 256 * 1024 <= WS_LRS && WS_DELTA + (size_t)T * 1024 * 2 <= WS_MERGED && WS_WEO + (size_t)NEXP * 1024 * 1024 <= WS_U, "late map / expert weight copies (written during P4, live to P9)");
static_assert(WS_W1T + (size_t)N1 * 1024 * 2 <= WS_WUQ && WS_VTG + 4 * MiB <= WS_HN && WS_GATES + (size_t)T * 3072 * 2 <= WS_U && WS_CQKV + (size_t)T * 768 * 2 <= WS_QX && WS_Q + (size_t)T * 768 * 2 <= WS_KV, "early map");
constexpr int CW_TMO = 0, CW_CODE = 1;
constexpr int CW_BAR = 4096;
constexpr int CW_GCNT = 16384;
constexpr int RING_OFF = 0, RING_BYTES = 131072;
constexpr int LDSCTL_OFF = RING_BYTES, MISC_OFF = LDSCTL_OFF + 320;
constexpr int LX_TSTART = LDSCTL_OFF + 512;
constexpr int LX_CNT = LDSCTL_OFF + 768;
constexpr int LX_LCNT = LDSCTL_OFF + 1024;
constexpr int LX_BASE = LDSCTL_OFF + 1280;
constexpr int LX_XWS = LDSCTL_OFF + 2048;
constexpr int LX_STASH = LDSCTL_OFF + 4096;
constexpr int LX_GATE = LDSCTL_OFF + 8192;
constexpr int LX_RS = LDSCTL_OFF + 12288;
constexpr int LX_TEXP = LDSCTL_OFF + 4096;
constexpr int LX_LSTG = LDSCTL_OFF + 6144;
constexpr int LX_RSKV = LDSCTL_OFF + 4096, LX_PESS = LDSCTL_OFF + 5120;
constexpr int LDS_BYTES = 147456;
static_assert(LX_RS + 1024 <= LDS_BYTES && LX_GATE + 4096 <= LX_RS && mla::LDS_BYTES <= RING_BYTES, "LDS map");

#define GAS __attribute__((address_space(1)))
#define LAS __attribute__((address_space(3)))
typedef unsigned short bf16;
typedef unsigned v4u __attribute__((ext_vector_type(4)));
typedef unsigned v2u __attribute__((ext_vector_type(2)));
typedef float f32x4 __attribute__((ext_vector_type(4)));
typedef float f32x16 __attribute__((ext_vector_type(16)));
typedef short bf16x8 __attribute__((ext_vector_type(8)));
typedef GAS unsigned gu32;
#define RLX_AGENT __ATOMIC_RELAXED, __HIP_MEMORY_SCOPE_AGENT
#define LDS_WAIT() asm volatile("s_waitcnt lgkmcnt(0)" ::: "memory")
#define VM_WAIT() asm volatile("s_waitcnt vmcnt(0)" ::: "memory")
__device__ __forceinline__ unsigned f2bf(float f) { unsigned u = __builtin_bit_cast(unsigned, f); return (u + 0x7fffu + ((u >> 16) & 1u)) >> 16; }
__device__ __forceinline__ unsigned pk2(float lo, float hi) { return pg8::cvt_pk_bf16(lo, hi); }
__device__ __forceinline__ float bflo(unsigned w) { return __uint_as_float(w << 16); }
__device__ __forceinline__ float bfhi(unsigned w) { return __uint_as_float(w & 0xffff0000u); }
__device__ __forceinline__ unsigned pk4_fp8(float a, float b, float c, float d) { int w = 0; w = __builtin_amdgcn_cvt_pk_fp8_f32(a, b, w, false); w = __builtin_amdgcn_cvt_pk_fp8_f32(c, d, w, true); return (unsigned)w; }

#define XB_TMO      128
#define XB_XCNT(j)  (256  + 64 * (j))
#define XB_XSUB(j)  (1280 + 64 * (j))
#define XB_XGEN(j)  (2304 + 64 * (j))
#define XB_TOP      3328
#define XB_TOPGEN   3392
#define XCD_BAR_WORDS 3456
#define XB_SPIN_CAP (1u << 18)
__device__ __forceinline__ unsigned xb_ld(unsigned* p)              { return __hip_atomic_load(p, __ATOMIC_RELAXED, __HIP_MEMORY_SCOPE_AGENT); }
__device__ __forceinline__ unsigned xb_add(unsigned* p, unsigned v) { return __hip_atomic_fetch_add(p, v, __ATOMIC_RELAXED, __HIP_MEMORY_SCOPE_AGENT); }
__device__ __forceinline__ unsigned xb_xcc_id() { return (unsigned)__builtin_amdgcn_s_getreg((3 << 11) | 20) & 0xFu; }
#define XB_SPIN(cond, bar) do { unsigned _sp = 0; while (cond) { __builtin_amdgcn_s_sleep(1); \
    if ((++_sp & 255u) == 0u) { if (xb_ld(&(bar)[XB_TMO])) break; if (_sp > XB_SPIN_CAP) { atomicAdd(&(bar)[XB_TMO], 1u); break; } } } } while (0)
struct XcdBarrier { unsigned* bar; unsigned x; volatile LAS unsigned* st; };
__device__ __forceinline__ XcdBarrier xcd_barrier_post(unsigned* bar, volatile LAS unsigned* st, const bool thread0) {
    XcdBarrier b; b.bar = bar; b.x = xb_xcc_id(); b.st = st;
    if (thread0) (void)xb_add(&bar[XB_XCNT(b.x)], 1u);
    return b;
}
__device__ __forceinline__ void xcd_barrier_complete(unsigned* bar, unsigned x, unsigned& nloc, unsigned& nx) {
    const unsigned G = gridDim.x * gridDim.y * gridDim.z;
    unsigned sum, cnt, mine, sp = 0u;
    for (;;) {
        sum = 0u; cnt = 0u; mine = 0u;
#pragma unroll
        for (unsigned j = 0; j < 16; ++j) { const unsigned c = xb_ld(&bar[XB_XCNT(j)]); sum += c; cnt += (c > 0u) ? 1u : 0u; mine = (j == x) ? c : mine; }
        if (sum == G) break;
        __builtin_amdgcn_s_sleep(1);
        if ((++sp & 255u) == 0u) { if (xb_ld(&bar[XB_TMO])) break; if (sp > XB_SPIN_CAP) { atomicAdd(&bar[XB_TMO], 1u); break; } }
    }
    nloc = mine > 0u ? mine : 1u; nx = cnt > 0u ? cnt : 1u;
}
__device__ __forceinline__ void xcd_barrier(const XcdBarrier& b, const bool thread0) {
    asm volatile("s_waitcnt vmcnt(0)" ::: "memory");
    __syncthreads();
    if (thread0) {
        unsigned* bar = b.bar;
        __builtin_amdgcn_s_waitcnt(0);
        unsigned nloc = b.st[0], nx = b.st[1];
        if (nloc == 0u) { xcd_barrier_complete(bar, b.x, nloc, nx); b.st[0] = nloc; b.st[1] = nx; }
        const unsigned old = xb_add(&bar[XB_XSUB(b.x)], 1u);
        const unsigned gen = old / nloc;
        if (old + 1u == (gen + 1u) * nloc) {
            __builtin_amdgcn_fence(__ATOMIC_RELEASE, "agent");
            asm volatile("s_waitcnt vmcnt(0)" ::: "memory");
            const unsigned og = xb_add(&bar[XB_TOP], 1u);
            const unsigned tg = og / nx;
            if (og + 1u == (tg + 1u) * nx) xb_add(&bar[XB_TOPGEN], 1u);
            else XB_SPIN(xb_ld(&bar[XB_TOPGEN]) == tg, bar);
            __builtin_amdgcn_fence(__ATOMIC_ACQUIRE, "agent");
            xb_add(&bar[XB_XGEN(b.x)], 1u);
            asm volatile("s_waitcnt vmcnt(0)" ::: "memory");
        } else {
            XB_SPIN(xb_ld(&bar[XB_XGEN(b.x)]) == gen, bar);
            __builtin_amdgcn_fence(__ATOMIC_ACQUIRE, "agent");
            asm volatile("s_waitcnt vmcnt(0)" ::: "memory");
        }
    }
    __syncthreads();
}

struct Frame {
    LAS unsigned char* lds;
    volatile LAS unsigned* MISC;
    gu32* ctl;
    int tid, lane, wave;
    int vcu, G;
    unsigned char* ws;
    const float* const* in;
    float* out;
};
__device__ __forceinline__ float wave_sum(float v) {
#pragma unroll
    for (int o = 1; o < 64; o <<= 1) v += __shfl_xor(v, o);
    return v;
}
__device__ __forceinline__ float sumsq8(v4u w) {
    float s = 0.f;
#pragma unroll
    for (int i = 0; i < 4; ++i) { const float a = bflo(w[i]), b = bfhi(w[i]); s += a * a + b * b; }
    return s;
}
__device__ __forceinline__ void transpose_item(const float* W, int ldw, int srccol, const float* ks, bf16* WT, int K, int nrow0, int k0, LAS float* scr, int lane) {
    float v[32];
#pragma unroll
    for (int i = 0; i < 32; ++i) v[i] = 0.f;
    if (srccol >= 0) {
#pragma unroll
        for (int i = 0; i < 32; ++i) { const int kk = 2 * i + (lane >> 5); v[i] = W[(size_t)(k0 + kk) * ldw + srccol + (lane & 31)]; } }
    if (ks) {
#pragma unroll
        for (int i = 0; i < 32; ++i) v[i] *= ks[k0 + 2 * i + (lane >> 5)]; }
#pragma unroll
    for (int i = 0; i < 32; ++i) scr[(2 * i + (lane >> 5)) * 33 + (lane & 31)] = v[i];
    LDS_WAIT(); asm volatile("" ::: "memory");
    const int c = lane & 7;
#pragma unroll
    for (int j = 0; j < 4; ++j) { const int n = (lane >> 3) + 8 * j; const LAS float* s = scr + (8 * c) * 33 + n;
        v4u o; o.x = pk2(s[0 * 33], s[1 * 33]); o.y = pk2(s[2 * 33], s[3 * 33]); o.z = pk2(s[4 * 33], s[5 * 33]); o.w = pk2(s[6 * 33], s[7 * 33]);
        *(GAS v4u*)(WT + (size_t)(nrow0 + n) * K + k0 + 8 * c) = o; }
    LDS_WAIT(); asm volatile("" ::: "memory");
}
__device__ __forceinline__ unsigned pk4_i8(float a, float b, float c, float d) {
    const int ia = (int)__builtin_rintf(fminf(fmaxf(a, -127.f), 127.f)), ib = (int)__builtin_rintf(fminf(fmaxf(b, -127.f), 127.f)), ic = (int)__builtin_rintf(fminf(fmaxf(c, -127.f), 127.f)), id = (int)__builtin_rintf(fminf(fmaxf(d, -127.f), 127.f));
    return (unsigned)(ia & 255) | ((unsigned)(ib & 255) << 8) | ((unsigned)(ic & 255) << 16) | ((unsigned)id << 24); }
__device__ __forceinline__ void transpose_item_i8(const float* W, int ldw, int srccol, float scale, unsigned char* WT, int K, int nrow0, int k0, LAS float* scr, int lane, const float* ks = nullptr) {
    float v[32];
#pragma unroll
    for (int i = 0; i < 32; ++i) v[i] = 0.f;
    if (srccol >= 0) {
#pragma unroll
        for (int i = 0; i < 32; ++i) { const int kk = 2 * i + (lane >> 5); v[i] = W[(size_t)(k0 + kk) * ldw + srccol + (lane & 31)] * scale; } }
    if (ks && srccol >= 0) {
#pragma unroll
        for (int i = 0; i < 32; ++i) v[i] *= ks[k0 + 2 * i + (lane >> 5)]; }
#pragma unroll
    for (int i = 0; i < 32; ++i) scr[(2 * i + (lane >> 5)) * 33 + (lane & 31)] = v[i];
    LDS_WAIT(); asm volatile("" ::: "memory");
    const int c = lane & 7;
#pragma unroll
    for (int j = 0; j < 4; ++j) { const int n = (lane >> 3) + 8 * j; const LAS float* s = scr + (8 * c) * 33 + n;
        v2u o; o.x = pk4_i8(s[0 * 33], s[1 * 33], s[2 * 33], s[3 * 33]); o.y = pk4_i8(s[4 * 33], s[5 * 33], s[6 * 33], s[7 * 33]);
        *(GAS v2u*)(WT + (size_t)(nrow0 + n) * K + k0 + 8 * c) = o; }
    LDS_WAIT(); asm volatile("" ::: "memory");
}
template <int NR> __device__ __forceinline__ void rms_rows_to_i8(int lane, const float* x0, size_t xstride, const f32x4 (&gg)[4], unsigned char* o0, float* hsc, int row0, int rstride) {
    f32x4 v[NR][4];
#pragma unroll
    for (int r = 0; r < NR; ++r) { const GAS f32x4* xr = (const GAS f32x4*)(x0 + r * xstride) + lane;
#pragma unroll
        for (int j = 0; j < 4; ++j) v[r][j] = xr[64 * j]; }
#pragma unroll
    for (int r = 0; r < NR; ++r) { float s = 0.f, mx = 0.f;
#pragma unroll
        for (int j = 0; j < 4; ++j) { s += (v[r][j].x * v[r][j].x + v[r][j].y * v[r][j].y) + (v[r][j].z * v[r][j].z + v[r][j].w * v[r][j].w); v[r][j] = v[r][j] * gg[j];
            mx = fmaxf(mx, fmaxf(fmaxf(fabsf(v[r][j].x), fabsf(v[r][j].y)), fmaxf(fabsf(v[r][j].z), fabsf(v[r][j].w)))); }
#pragma unroll
        for (int o = 1; o < 64; o <<= 1) mx = fmaxf(mx, __shfl_xor(mx, o));
        const float rstd = 1.0f / sqrtf(wave_sum(s) * (1.f / 1024.f) + EPS);
        const float q = mx > 0.f ? 127.0f / mx : 0.f;
        GAS unsigned* o4 = (GAS unsigned*)(o0 + (size_t)r * xstride) + lane;
#pragma unroll
        for (int j = 0; j < 4; ++j) o4[64 * j] = pk4_i8(v[r][j].x * q, v[r][j].y * q, v[r][j].z * q, v[r][j].w * q);
        if (lane == 0) hsc[row0 + r * rstride] = mx * rstd * (1.0f / (127.0f * SWI8)); }
}
__device__ __forceinline__ void transpose_item8(const float* W, int ldw, int srccol, const float* ks, float scale, unsigned char* WT, int K, int nrow0, int k0, LAS float* scr, int lane) {
    float v[32];
#pragma unroll
    for (int i = 0; i < 32; ++i) { const int kk = 2 * i + (lane >> 5); v[i] = W[(size_t)(k0 + kk) * ldw + srccol + (lane & 31)] * scale; }
    if (ks) {
#pragma unroll
        for (int i = 0; i < 32; ++i) v[i] *= ks[k0 + 2 * i + (lane >> 5)]; }
#pragma unroll
    for (int i = 0; i < 32; ++i) scr[(2 * i + (lane >> 5)) * 33 + (lane & 31)] = v[i];
    LDS_WAIT(); asm volatile("" ::: "memory");
    const int c = lane & 7;
#pragma unroll
    for (int j = 0; j < 4; ++j) { const int n = (lane >> 3) + 8 * j; const LAS float* s = scr + (8 * c) * 33 + n;
        v2u o; o.x = pk4_fp8(s[0 * 33], s[1 * 33], s[2 * 33], s[3 * 33]); o.y = pk4_fp8(s[4 * 33], s[5 * 33], s[6 * 33], s[7 * 33]);
        *(GAS v2u*)(WT + (size_t)(nrow0 + n) * K + k0 + 8 * c) = o; }
    LDS_WAIT(); asm volatile("" ::: "memory");
}
template <int NR> __device__ __forceinline__ void rms_rows_to_bf16(int lane, const float* x0, size_t xstride, const f32x4 (&gg)[4], bf16* o0, size_t ostride, unsigned char* o8f = nullptr) {
    f32x4 v[NR][4];
#pragma unroll
    for (int r = 0; r < NR; ++r) { const GAS f32x4* xr = (const GAS f32x4*)(x0 + r * xstride) + lane;
#pragma unroll
        for (int j = 0; j < 4; ++j) v[r][j] = xr[64 * j]; }
#pragma unroll
    for (int r = 0; r < NR; ++r) { float s = 0.f;
#pragma unroll
        for (int j = 0; j < 4; ++j) s += (v[r][j].x * v[r][j].x + v[r][j].y * v[r][j].y) + (v[r][j].z * v[r][j].z + v[r][j].w * v[r][j].w);
        const float rstd = 1.0f / sqrtf(wave_sum(s) * (1.f / 1024.f) + EPS);
        GAS unsigned long long* o8 = (GAS unsigned long long*)(o0 + r * ostride) + lane;
#pragma unroll
        for (int j = 0; j < 4; ++j)
            o8[64 * j] = (unsigned long long)pk2(v[r][j].x * rstd * gg[j].x, v[r][j].y * rstd * gg[j].y) | ((unsigned long long)pk2(v[r][j].z * rstd * gg[j].z, v[r][j].w * rstd * gg[j].w) << 32);
        if (o8f) { GAS unsigned* q = (GAS unsigned*)(o8f + r * ostride) + lane; const float r8 = rstd * SH8;
#pragma unroll
            for (int j = 0; j < 4; ++j) q[64 * j] = pk4_fp8(v[r][j].x * r8 * gg[j].x, v[r][j].y * r8 * gg[j].y, v[r][j].z * r8 * gg[j].z, v[r][j].w * r8 * gg[j].w); } }
}
__device__ __forceinline__ void rms_rows_all(int lane, int gw, int NGW, const float* X, const float* g, bf16* O, int nrows, unsigned char* O8 = nullptr) {
    f32x4 gg[4];
#pragma unroll
    for (int j = 0; j < 4; ++j) gg[j] = ((const GAS f32x4*)g + lane)[64 * j];
    int m = gw;
    for (; m + 3 * NGW < nrows; m += 4 * NGW) rms_rows_to_bf16<4>(lane, X + (size_t)m * D, (size_t)NGW * D, gg, O + (size_t)m * D, (size_t)NGW * D, O8 ? O8 + (size_t)m * D : nullptr);
    for (; m < nrows; m += NGW) rms_rows_to_bf16<1>(lane, X + (size_t)m * D, 0, gg, O + (size_t)m * D, 0, O8 ? O8 + (size_t)m * D : nullptr);
}

enum { I_X = 0, I_MEM, I_POS, I_GATTN, I_WIN, I_WPOOL, I_PSCALE, I_GQL, I_WUQ, I_GKVL, I_WUKV, I_GQM, I_GKM, I_GMEM, I_WMEMKV, I_GQC, I_GKC, I_WPO, I_WMO, I_WCO, I_WO, I_GFFN,
       I_WR, I_BR, I_WEI, I_BEI, I_WEO, I_BEO, N_IN };

__device__ __forceinline__ int fresh_lane() { int l; asm volatile("v_mbcnt_lo_u32_b32 %0, -1, 0\n\tv_mbcnt_hi_u32_b32 %0, -1, %0" : "=v"(l)); return l; }
#define REFRESH(F) do { int w_ = (F).wave; asm volatile("" : "+s"(w_)); (F).wave = w_; (F).lane = fresh_lane(); (F).tid = w_ * 64 + (F).lane; } while (0)
__device__ __forceinline__ void stagger(int g, int ticks) { if (g > 0) { const unsigned long long t0 = __builtin_amdgcn_s_memrealtime(), d = (unsigned long long)(g * ticks); while (__builtin_amdgcn_s_memrealtime() - t0 < d) __builtin_amdgcn_s_sleep(8); } }
#ifndef MK_STAG1
#define MK_STAG1 0
#endif
__device__ __forceinline__ void p0_prologue(Frame& F) {
    LAS float* scr = (LAS float*)(F.lds + RING_OFF + F.wave * 16384);
    const int gw = F.vcu * NWAVES + F.wave, NGW = F.G * NWAVES, lane = F.lane;
    unsigned char* ws = F.ws;
    constexpr int I1 = 16 * (1792 / 32), I1G = 16 * (3072 / 32), I2 = 8 * 24, I3 = 4 * 32, I4 = 16 * 32, I5 = 8 * 32, I6 = 8 * 32, I7 = 16 * 32;
    constexpr int NITEMS = I1 + I1G + I2 + I3 + I4 + I5 + I6 + I7;
    for (int it = gw; it < NITEMS; it += NGW) {
        int r = it;
        if (r < I1) { const int nnb = 1792 / 32, kb = r / nnb, nb = r % nnb, n0 = nb * 32; const int src = n0 < 1184 ? n0 : (n0 < 1280 ? -1 : n0 - 96);
            transpose_item_i8(F.in[I_WIN], IN_COLS, src, SWI8, ws + WS_W1T, 1024, n0, kb * 64, scr, lane); continue; } r -= I1;
        if (r < I1G) { const int nnb = 3072 / 32, kb = r / nnb, nb = r % nnb, n0 = nb * 32;
            transpose_item_i8(F.in[I_WIN], IN_COLS, 1696 + n0, SWI8, ws + WS_W1G8, 1024, n0, kb * 64, scr, lane); continue; } r -= I1G;
        if (r < I2) { const int kb = r / 24, nb = r % 24; transpose_item_i8(F.in[I_WUQ], 768, kb < 6 ? nb * 32 : -1, SWQ8, ws + WS_WUQ, 512, nb * 32, kb * 64, scr, lane, F.in[I_GQL]); continue; } r -= I2;
        if (r < I3) { const int kb = r / 32, nb = r % 32, head = 2 * (nb >> 3) + ((nb >> 1) & 1), lb = head * 4 + (nb & 1) * 2 + ((nb >> 2) & 1);
            transpose_item_i8(F.in[I_WUKV], 1024, lb * 32, SWKV8, ws + WS_WUKV, 256, nb * 32, kb * 64, scr, lane, F.in[I_GKVL]); continue; } r -= I3;
        if (r < I4) { const int kb = r / 32, nb = r % 32; transpose_item_i8(F.in[I_WMEMKV], 1024, nb * 32, SWI8, ws + WS_WMEM, 1024, nb * 32, kb * 64, scr, lane); continue; } r -= I4;
        if (r < I5) { const int kb = r / 32, nb = r % 32; transpose_item(F.in[I_WMO], 1024, nb * 32, nullptr, (bf16*)(ws + WS_WMO), 512, nb * 32, kb * 64, scr, lane); continue; } r -= I5;
        if (r < I6) { const int kb = r / 32, nb = r % 32; transpose_item(F.in[I_WCO], 1024, nb * 32, nullptr, (bf16*)(ws + WS_WCO), 512, nb * 32, kb * 64, scr, lane); continue; } r -= I6;
        { const int kb = r / 32, nb = r % 32; transpose_item_i8(F.in[I_WO], 1024, nb * 32, SWI8, ws + WS_WO, 1024, nb * 32, kb * 64, scr, lane); }
    }
    for (int it = gw; it < 2048; it += NGW) {
        const int kc = it >> 2, dq = it & 3, g = kc >> 7; const float* wp = F.in[I_WPOOL] + (size_t)kc * 128; const float* ps = F.in[I_PSCALE] + g * 128; const float* wpo = F.in[I_WPO] + (size_t)(g * 128) * 1024 + dq * 256 + lane;
        float a[4] = {0.f, 0.f, 0.f, 0.f};
#pragma unroll 8
        for (int j = 0; j < 128; ++j) { const float sc = wp[j] * ps[j]; const float* row = wpo + (size_t)j * 1024;
#pragma unroll
            for (int i = 0; i < 4; ++i) a[i] += sc * row[64 * i]; }
        bf16* wt = (bf16*)(ws + WS_WPOOL);
#pragma unroll
        for (int i = 0; i < 4; ++i) wt[(size_t)(dq * 256 + lane + 64 * i) * 512 + kc] = (bf16)f2bf(a[i]);
    }
    { f32x4 gg[4];
#pragma unroll
      for (int j = 0; j < 4; ++j) gg[j] = ((const GAS f32x4*)F.in[I_GATTN] + lane)[64 * j];
      int m = gw;
      for (; m + 7 * NGW < T; m += 8 * NGW) rms_rows_to_i8<8>(lane, F.in[I_X] + (size_t)m * D, (size_t)NGW * D, gg, ws + WS_HN + (size_t)m * D, (float*)(ws + WS_HSC), m, NGW);
      for (; m + 3 * NGW < T; m += 4 * NGW) rms_rows_to_i8<4>(lane, F.in[I_X] + (size_t)m * D, (size_t)NGW * D, gg, ws + WS_HN + (size_t)m * D, (float*)(ws + WS_HSC), m, NGW);
      for (; m < T; m += NGW) rms_rows_to_i8<1>(lane, F.in[I_X] + (size_t)m * D, 0, gg, ws + WS_HN + (size_t)m * D, (float*)(ws + WS_HSC), m, 0); }
    { f32x4 gg[4];
#pragma unroll
      for (int j = 0; j < 4; ++j) gg[j] = ((const GAS f32x4*)F.in[I_GMEM] + lane)[64 * j];
      for (int m = gw; m < MROWS; m += NGW) rms_rows_to_i8<1>(lane, F.in[I_MEM] + (size_t)m * D, 0, gg, ws + WS_MEMN + (size_t)m * D, (float*)(ws + WS_MSC), m, 0); }
}

using pg8::Unit; using pg8::bf16_t;
struct DenseSched {
    int nM, nN, G, c; const char* A; const char* B; size_t tA, tB;
    __device__ __forceinline__ void init(const void* A_, int lda, const void* B_, int ldb, int M, int N, int G_, int c_) { A = (const char*)A_; B = (const char*)B_; nM = M / 256; nN = N / 256; G = G_; c = c_; tA = (size_t)256 * lda * 2; tB = (size_t)256 * ldb * 2; }
    __device__ __forceinline__ bool next(int i, Unit& u) const {
        const long L = (long)i * G + c; if (L >= (long)nM * nN) return false;
        pg8::tile_order((int)L, nM, nN, u.pm, u.pn); u.A = A + (size_t)u.pm * tA; u.B = B + (size_t)u.pn * tB; u.aux = 0; return true; }
};
struct EpiNull { static constexpr bool PERM = true, ACCUM = false;
    __device__ __forceinline__ void operator()(const pg8::f32x4 (&acc)[2][2][4][2], const Unit& u, int wr, int wc, int fr_, int fq_) const {
#pragma unroll
        for (int a = 0; a < 2; ++a)
#pragma unroll
            for (int b = 0; b < 2; ++b)
#pragma unroll
                for (int m = 0; m < 4; ++m) asm volatile("" :: "v"(acc[a][b][m][0]), "v"(acc[a][b][m][1])); } };
struct EpiStore {
    static constexpr bool PERM = true, ACCUM = false;
    bf16_t* O; int ldc; float sc = 1.0f;
    __device__ __forceinline__ void operator()(const pg8::f32x4 (&acc)[2][2][4][2], const Unit& u, int wr, int wc, int fr_, int fq_) const {
        int fr = fr_, fq = fq_; asm volatile("" : "+v"(fr), "+v"(fq));
        const int row0 = u.pm * 256 + wr * 64 + fr, col0 = u.pn * 256 + wc * 32 + 8 * fq;
#pragma unroll
        for (int ai = 0; ai < 2; ++ai)
#pragma unroll
            for (int m = 0; m < 4; ++m) { bf16_t* rowp = O + (size_t)(row0 + ai * 128 + m * 16) * ldc + col0;
#pragma unroll
                for (int bj = 0; bj < 2; ++bj) { const pg8::f32x4 v0 = acc[ai][bj][m][0] * sc, v1 = acc[ai][bj][m][1] * sc; pg8::u32x4 w;
                    w.x = pg8::cvt_pk_bf16(v0[0], v0[1]); w.y = pg8::cvt_pk_bf16(v0[2], v0[3]); w.z = pg8::cvt_pk_bf16(v1[0], v1[1]); w.w = pg8::cvt_pk_bf16(v1[2], v1[3]);
                    *(pg8::u32x4*)(rowp + bj * 128) = w; } }
    }
};
struct EpiP1 {
    static constexpr bool PERM = true, ACCUM = false;
    bf16_t *U, *QX; const float* hsc; unsigned char *CQ8, *CKV8; float *PART, *PE;
    __device__ __forceinline__ void operator()(const pg8::f32x4 (&acc)[2][2][4][2], const Unit& u, int wr, int wc, int fr_, int fq_) const {
        int fr = fr_, fq = fq_; asm volatile("" : "+v"(fr), "+v"(fq));
        const int pn = u.pn; bf16_t* base; int ldc, colt;
        if (pn < 2) { base = U; ldc = 512; colt = pn * 256; } else if (pn < 5) { base = U; ldc = 0; colt = (pn - 2) * 256; }
        else { base = QX; ldc = 512; colt = (pn - 5) * 256; }
        const int row0 = u.pm * 256 + wr * 64 + fr, col0 = colt + wc * 32 + 8 * fq;
        float sc[8];
#pragma unroll
        for (int i = 0; i < 8; ++i) sc[i] = hsc[row0 + (i >> 2) * 128 + (i & 3) * 16];
#pragma unroll
        for (int ai = 0; ai < 2; ++ai)
#pragma unroll
            for (int m = 0; m < 4; ++m) { bf16_t* rowp = base + (size_t)(row0 + ai * 128 + m * 16) * ldc + col0; const float s1 = sc[ai * 4 + m];
#pragma unroll
                for (int bj = 0; bj < 2; ++bj) { const pg8::f32x4 v0 = acc[ai][bj][m][0] * s1, v1 = acc[ai][bj][m][1] * s1;
                    if (pn < 2 || pn >= 5) {
                        pg8::u32x4 w; w.x = pg8::cvt_pk_bf16(v0[0], v0[1]); w.y = pg8::cvt_pk_bf16(v0[2], v0[3]); w.z = pg8::cvt_pk_bf16(v1[0], v1[1]); w.w = pg8::cvt_pk_bf16(v1[2], v1[3]);
                        *(pg8::u32x4*)(rowp + bj * 128) = w;
                    } else {
                        const int cc = col0 + bj * 128, blk = (pn - 2) * 2 + bj; const size_t row = (size_t)(row0 + ai * 128 + m * 16);
                        if (cc < 640) { pg8::u32x2 q; q.x = pk4_i8(v0[0] * SC8, v0[1] * SC8, v0[2] * SC8, v0[3] * SC8); q.y = pk4_i8(v1[0] * SC8, v1[1] * SC8, v1[2] * SC8, v1[3] * SC8);
                            unsigned char* d = cc < 384 ? CQ8 + row * 512 + cc : CKV8 + row * 256 + (cc - 384);
                            *(pg8::u32x2*)d = q; }
                        if (blk < 5) { float p = v0[0] * v0[0] + v0[1] * v0[1] + v0[2] * v0[2] + v0[3] * v0[3] + v1[0] * v1[0] + v1[1] * v1[1] + v1[2] * v1[2] + v1[3] * v1[3];
                            p += __shfl_xor(p, 16); p += __shfl_xor(p, 32);
                            if (fq == 0) PART[row * 20 + blk * 4 + wc] = p; }
                        else if (wc == 0) { *(pg8::f32x4*)(PE + row * 32 + 8 * fq) = v0; *(pg8::f32x4*)(PE + row * 32 + 8 * fq + 4) = v1; } } } }
    }
};
struct EpiGate8 {
    static constexpr bool PERM = true, ACCUM = false;
    unsigned char* GATES; const float* hsc;
    __device__ __forceinline__ void operator()(const pg8::f32x4 (&acc)[2][2][4][2], const Unit& u, int wr, int wc, int fr_, int fq_) const {
        int fr = fr_, fq = fq_; asm volatile("" : "+v"(fr), "+v"(fq));
        const int row0 = u.pm * 256 + wr * 64 + fr, col0 = u.pn * 256 + wc * 32 + 8 * fq;
        float sc[8];
#pragma unroll
        for (int i = 0; i < 8; ++i) sc[i] = hsc[row0 + (i >> 2) * 128 + (i & 3) * 16] * -1.4426950408889634f;
#pragma unroll
        for (int ai = 0; ai < 2; ++ai)
#pragma unroll
            for (int m = 0; m < 4; ++m) { unsigned char* rowp = GATES + (size_t)(row0 + ai * 128 + m * 16) * 3072 + col0; const float s1 = sc[ai * 4 + m];
#pragma unroll
                for (int bj = 0; bj < 2; ++bj) { unsigned q[8]; typedef float f2 __attribute__((ext_vector_type(2)));
#pragma unroll
                    for (int n = 0; n < 2; ++n)
#pragma unroll
                        for (int i = 0; i < 4; i += 2) { const f2 z = (f2){acc[ai][bj][m][n][i], acc[ai][bj][m][n][i + 1]} * s1;
                            f2 ee; ee.x = __builtin_amdgcn_exp2f(z.x); ee.y = __builtin_amdgcn_exp2f(z.y); const f2 dd = ee + 1.0f;
                            f2 g; g.x = __builtin_amdgcn_rcpf(dd.x); g.y = __builtin_amdgcn_rcpf(dd.y); g = g * 256.0f;
                            const unsigned q0 = (unsigned)g.x, q1 = (unsigned)g.y; q[4 * n + i] = q0 < 255u ? q0 : 255u; q[4 * n + i + 1] = q1 < 255u ? q1 : 255u; }
                    pg8::u32x2 w; w.x = q[0] | (q[1] << 8) | (q[2] << 16) | (q[3] << 24); w.y = q[4] | (q[5] << 8) | (q[6] << 16) | (q[7] << 24);
                    *(pg8::u32x2*)(rowp + bj * 128) = w; } }
    }
};
struct EpiMemKV {
    static constexpr bool PERM = true, ACCUM = false;
    bf16_t *KVMK, *VTG; const float* msc;
    __device__ __forceinline__ void operator()(const pg8::f32x4 (&acc)[2][2][4][2], const Unit& u, int wr, int wc, int fr_, int fq_) const {
        int fr = fr_, fq = fq_; asm volatile("" : "+v"(fr), "+v"(fq));
        const int row0 = u.pm * 256 + wr * 64 + fr;
        float sc[8];
#pragma unroll
        for (int i = 0; i < 8; ++i) sc[i] = msc[row0 + (i >> 2) * 128 + (i & 3) * 16];
        if (u.pn < 2) {
            const int col0 = u.pn * 256 + wc * 32 + 8 * fq;
#pragma unroll
            for (int ai = 0; ai < 2; ++ai)
#pragma unroll
                for (int m = 0; m < 4; ++m) { bf16_t* rowp = KVMK + (size_t)(row0 + ai * 128 + m * 16) * 512 + col0;
#pragma unroll
                    for (int bj = 0; bj < 2; ++bj) { const pg8::f32x4 v0 = acc[ai][bj][m][0] * sc[ai * 4 + m], v1 = acc[ai][bj][m][1] * sc[ai * 4 + m]; pg8::u32x4 w;
                        w.x = pg8::cvt_pk_bf16(v0[0], v0[1]); w.y = pg8::cvt_pk_bf16(v0[2], v0[3]); w.z = pg8::cvt_pk_bf16(v1[0], v1[1]); w.w = pg8::cvt_pk_bf16(v1[2], v1[3]);
                        *(pg8::u32x4*)(rowp + bj * 128) = w; } }
        } else {
#pragma unroll
            for (int ai = 0; ai < 2; ++ai)
#pragma unroll
                for (int m = 0; m < 4; ++m) { const int row = row0 + ai * 128 + m * 16, b = row >> 8, mm = row & 255;
                    const int pos = (mm & ~12) | ((mm & 4) << 1) | ((mm & 8) >> 1);
#pragma unroll
                    for (int bj = 0; bj < 2; ++bj) { const int hc = (u.pn - 2) * 2 + bj;
                        bf16_t* dst = VTG + ((size_t)(b * 4 + hc) * 128 + wc * 32 + 8 * fq) * 256 + pos;
#pragma unroll
                        for (int n = 0; n < 2; ++n)
#pragma unroll
                            for (int i = 0; i < 4; ++i) dst[(size_t)(4 * n + i) * 256] = (bf16_t)f2bf(acc[ai][bj][m][n][i] * sc[ai * 4 + m]); } }
        }
    }
};
struct MergeSched {
    int G, c; const char *A0, *B0; long dA1, dA2, dB1, dB2;
    __device__ __forceinline__ bool next(int i, Unit& u) const {
        const int ti = i / 3, br = i - 3 * ti; const long L = (long)ti * G + c; if (L >= 256 * 4) return false;
        pg8::tile_order((int)L, 256, 4, u.pm, u.pn); u.aux = br;
        const long b1 = br & 1, b2 = br >> 1;
        u.A = A0 + b1 * dA1 + b2 * dA2 + (size_t)u.pm * (256 * 512 * 2); u.B = B0 + b1 * dB1 + b2 * dB2 + (size_t)u.pn * (256 * 512 * 2); return true; }
};
struct EpiMerge {
    static constexpr bool PERM = true, ACCUM = true;
    const unsigned char* GATES; unsigned char* MERGED;
    __device__ __forceinline__ void operator()(const pg8::f32x4 (&acc)[2][2][4][2], const Unit& u, int wr, int wc, int fr_, int fq_) const {}
    __device__ __forceinline__ bool merge(pg8::f32x4 (&acc)[2][2][4][2], const Unit& u, int wr, int wc, int fr_, int fq_) const {
        int fr = fr_, fq = fq_; asm volatile("" : "+v"(fr), "+v"(fq));
        const int br = u.aux, row0 = u.pm * 256 + wr * 64 + fr, col0 = u.pn * 256 + wc * 32 + 8 * fq;
        pg8::u32x2 gaa[16], gbb[16];
        const int brn = br < 2 ? br + 1 : br;
#pragma unroll
        for (int i = 0; i < 16; ++i) { const unsigned char* gp = GATES + (size_t)(row0 + (i >> 3) * 128 + ((i >> 1) & 3) * 16) * 3072 + col0 + (i & 1) * 128;
            gaa[i] = *(const pg8::u32x2*)(gp + br * 1024); gbb[i] = *(const pg8::u32x2*)(gp + brn * 1024); }
#pragma unroll
        for (int ai = 0; ai < 2; ++ai)
#pragma unroll
            for (int m = 0; m < 4; ++m) { const size_t row = (size_t)(row0 + ai * 128 + m * 16);
#pragma unroll
                for (int bj = 0; bj < 2; ++bj) { const int c0 = col0 + bj * 128;
                    const pg8::u32x2 ga = gaa[ai * 8 + m * 2 + bj];
                    float f[8];
#pragma unroll
                    for (int i = 0; i < 4; ++i) { f[i] = (float)((ga.x >> (8 * i)) & 255u) + 0.5f; f[4 + i] = (float)((ga.y >> (8 * i)) & 255u) + 0.5f; }
                    if (br < 2) { const pg8::u32x2 gb = gbb[ai * 8 + m * 2 + bj];
#pragma unroll
                        for (int i = 0; i < 4; ++i) { f[i] *= __builtin_amdgcn_rcpf((float)((gb.x >> (8 * i)) & 255u) + 0.5f); f[4 + i] *= __builtin_amdgcn_rcpf((float)((gb.y >> (8 * i)) & 255u) + 0.5f); } }
                    else {
#pragma unroll
                        for (int i = 0; i < 8; ++i) f[i] *= (1.0f / 256.0f); }
#pragma unroll
                    for (int i = 0; i < 4; ++i) { acc[ai][bj][m][0][i] *= f[i]; acc[ai][bj][m][1][i] *= f[4 + i]; }
                    if (br == 2) { const pg8::f32x4 v0 = acc[ai][bj][m][0] * SM8, v1 = acc[ai][bj][m][1] * SM8;
                        pg8::u32x2 w; w.x = pk4_i8(v0[0], v0[1], v0[2], v0[3]); w.y = pk4_i8(v1[0], v1[1], v1[2], v1[3]);
                        *(pg8::u32x2*)(MERGED + row * 1024 + c0) = w; } } }
        return br < 2;
    }
};
struct EpiResF32 {
    static constexpr bool PERM = false, ACCUM = false;
    const float* X; float* O;
    __device__ __forceinline__ void operator()(const pg8::f32x4 (&acc)[2][2][4][2], const Unit& u, int wr, int wc, int fr_, int fq_) const {
        int fr = fr_, fq = fq_; asm volatile("" : "+v"(fr), "+v"(fq));
        const int row0 = u.pm * 256 + wr * 64 + fr, col0 = u.pn * 256 + wc * 32 + 4 * fq;
#pragma unroll
        for (int ai = 0; ai < 2; ++ai)
#pragma unroll
            for (int m = 0; m < 4; ++m) { const size_t off = (size_t)(row0 + ai * 128 + m * 16) * 1024 + col0;
#pragma unroll
                for (int bj = 0; bj < 2; ++bj)
#pragma unroll
                    for (int n = 0; n < 2; ++n) { const pg8::f32x4 xv = *(const pg8::f32x4*)(X + off + bj * 128 + n * 16); *(pg8::f32x4*)(O + off + bj * 128 + n * 16) = xv + acc[ai][bj][m][n]; } }
    }
};
struct MoeSched {
    int G, c, nM, nN; const LAS int* tstart; const LAS int* cnt; const int* list; const char* A; const char* B; size_t bexp, tB, tA; bool gather; const LAS unsigned char* texp; LAS int* lstg;
    __device__ __forceinline__ bool next(int i, Unit& u) const {
        const long L = (long)i * G + c; if (L >= (long)nM * nN) return false;
        int pm, pn; pg8::tile_order((int)L, nM, nN, pm, pn);
        const int e = __builtin_amdgcn_readfirstlane((int)texp[pm]);
        const int ts = __builtin_amdgcn_readfirstlane(tstart[e]);
        u.pm = pm; u.pn = pn; u.aux = e | ((pm - ts) << 8);
        u.A = gather ? A : A + (size_t)pm * tA; u.B = B + (size_t)e * bexp + (size_t)pn * tB; return true; }
    __device__ __forceinline__ unsigned row_off(const Unit& u, int row) const { return row_fin(u, row, row_raw(u, row)); }
    __device__ __forceinline__ int row_raw(const Unit& u, int row) const {
        const int e = u.aux & 255, idx = (u.aux >> 8) * 256 + row; return list[(size_t)e * LISTCAP + (idx < cnt[e] ? idx : 0)]; }
    __device__ __forceinline__ void stage_list(const Unit& u, int par, int lane) const {
        const int e = u.aux & 255, rt = u.aux >> 8; __builtin_amdgcn_global_load_lds((const unsigned*)(list + (size_t)e * LISTCAP + rt * 256 + lane * 4), (LAS unsigned*)(lstg + par * 256), 16, 0, 0); }
    __device__ __forceinline__ int stage_get(int par, int row) const { return lstg[par * 256 + row]; }
    __device__ __forceinline__ unsigned row_fin(const Unit& u, int row, int raw) const {
        const int e = u.aux & 255, idx = (u.aux >> 8) * 256 + row; const int ent = idx < cnt[e] ? raw : 0; return (unsigned)(ent >> 2) * 1024u; }
};
struct EpiMoeIn {
    static constexpr bool PERM = true, ACCUM = false;
    const LAS int* cnt; const float* lrs; const float* bin; unsigned char* ACT;
    __device__ __forceinline__ void operator()(const pg8::f32x4 (&acc)[2][2][4][2], const Unit& u, int wr, int wc, int fr_, int fq_) const {
        int fr = fr_, fq = fq_; asm volatile("" : "+v"(fr), "+v"(fq));
        const int e = u.aux & 255, rt = u.aux >> 8, ce = cnt[e], j0 = u.pn * 128 + wc * 32 + 8 * fq;
        float rs[8];
#pragma unroll
        for (int i = 0; i < 8; ++i) { const int idx = rt * 256 + (i >> 2) * 128 + wr * 64 + (i & 3) * 16 + fr; const float v_ = lrs[(size_t)e * LISTCAP + (idx < ce ? idx : 0)]; rs[i] = idx < ce ? v_ : 0.f; }
        const float* bg = bin + (size_t)e * 2048 + j0; const pg8::f32x4 bg0 = *(const pg8::f32x4*)bg, bg1 = *(const pg8::f32x4*)(bg + 4); pg8::f32x4 bl0 = *(const pg8::f32x4*)(bg + 1024), bl1 = *(const pg8::f32x4*)(bg + 1028);
        bl0 = (bl0 + 1.0f) * SA8; bl1 = (bl1 + 1.0f) * SA8;
#pragma unroll
        for (int ai = 0; ai < 2; ++ai)
#pragma unroll
            for (int m = 0; m < 4; ++m) { const int rl = ai * 128 + wr * 64 + m * 16 + fr; const float rsl = rs[ai * 4 + m], rsg = rsl * (1.0f / SA8);
                float a[8];
                typedef float f2 __attribute__((ext_vector_type(2)));
#pragma unroll
                for (int n = 0; n < 2; ++n)
#pragma unroll
                    for (int i = 0; i < 4; i += 2) {
                        const f2 ag = {acc[ai][0][m][n][i], acc[ai][0][m][n][i + 1]}, al = {acc[ai][1][m][n][i], acc[ai][1][m][n][i + 1]};
                        const f2 bgv = n ? (f2){bg1[i], bg1[i + 1]} : (f2){bg0[i], bg0[i + 1]}, blv = n ? (f2){bl1[i], bl1[i + 1]} : (f2){bl0[i], bl0[i + 1]};
                        f2 gl = ag * rsg + bgv; gl.x = fminf(gl.x, 7.0f); gl.y = fminf(gl.y, 7.0f);
                        f2 li = al * rsl + blv; li.x = __builtin_amdgcn_fmed3f(li.x, -6.0f * SA8, 8.0f * SA8); li.y = __builtin_amdgcn_fmed3f(li.y, -6.0f * SA8, 8.0f * SA8);
                        const f2 tt = gl * (-1.702f * 1.4426950408889634f);
                        f2 ee; ee.x = __builtin_amdgcn_exp2f(tt.x); ee.y = __builtin_amdgcn_exp2f(tt.y);
                        const f2 dd = ee + 1.0f;
                        f2 sg; sg.x = __builtin_amdgcn_rcpf(dd.x); sg.y = __builtin_amdgcn_rcpf(dd.y);
                        const f2 r2 = (gl * sg) * li;
                        a[4 * n + i] = r2.x; a[4 * n + i + 1] = r2.y; }
                pg8::u32x2 w; w.x = pk4_fp8(a[0], a[1], a[2], a[3]); w.y = pk4_fp8(a[4], a[5], a[6], a[7]);
                *(pg8::u32x2*)(ACT + ((size_t)u.pm * 256 + rl) * 1024 + j0) = w; }
    }
};
struct EpiMoeOut {
    static constexpr bool PERM = true, ACCUM = false;
    const LAS int* cnt; const int* list; const float* lgate; const float* bout; unsigned char* Y;
    __device__ __forceinline__ void operator()(const pg8::f32x4 (&acc)[2][2][4][2], const Unit& u, int wr, int wc, int fr_, int fq_) const {
        int fr = fr_, fq = fq_; asm volatile("" : "+v"(fr), "+v"(fq));
        const int e = u.aux & 255, rt = u.aux >> 8, ce = cnt[e], c0 = u.pn * 256 + wc * 32 + 8 * fq;
        const float* bo = bout + (size_t)e * 1024 + c0; pg8::f32x4 bv[2][2];
#pragma unroll
        for (int bj = 0; bj < 2; ++bj)
#pragma unroll
            for (int n = 0; n < 2; ++n) bv[bj][n] = *(const pg8::f32x4*)(bo + bj * 128 + 4 * n);
        int ent[8]; float g[8];
#pragma unroll
        for (int i = 0; i < 8; ++i) { const int idx = rt * 256 + (i >> 2) * 128 + wr * 64 + (i & 3) * 16 + fr; const bool ok = idx < ce; const size_t p_ = (size_t)e * LISTCAP + (ok ? idx : 0);
            const int en_ = list[p_]; const float g_ = lgate[p_]; ent[i] = ok ? en_ : -1; g[i] = ok ? g_ : 0.f; }
#pragma unroll
        for (int ai = 0; ai < 2; ++ai)
#pragma unroll
            for (int m = 0; m < 4; ++m) { const int i = ai * 4 + m;
                if (ent[i] >= 0) { const float gs = g[i] * SY8, gb = gs * (SA8 * SW8);
#pragma unroll
                    for (int bj = 0; bj < 2; ++bj) { const pg8::f32x4 v0 = acc[ai][bj][m][0] * gs + bv[bj][0] * gb, v1 = acc[ai][bj][m][1] * gs + bv[bj][1] * gb;
                        pg8::u32x2 w; w.x = pk4_fp8(v0[0], v0[1], v0[2], v0[3]); w.y = pk4_fp8(v1[0], v1[1], v1[2], v1[3]);
                        *(pg8::u32x2*)(Y + (size_t)ent[i] * 1024 + c0 + bj * 128) = w; } } }
    }
};
struct RowSched { int rt; const char* A; const char* B; size_t tA, tB;
    __device__ __forceinline__ bool next(int i, Unit& u) const { if (i >= 4) return false; u.pm = rt; u.pn = i; u.A = A + (size_t)rt * tA; u.B = B + (size_t)i * tB; u.aux = 0; return true; } };
struct EpiKV {
    static constexpr bool PERM = true, ACCUM = false;
    bf16_t* K; bf16_t* V; const LAS float* rskv; const LAS float* pess; const float* RK; const float* gk; float sc;
    __device__ __forceinline__ void operator()(const pg8::f32x4 (&acc)[2][2][4][2], const Unit& u, int wr, int wc, int fr_, int fq_) const {
        int fr = fr_, fq = fq_; asm volatile("" : "+v"(fr), "+v"(fq));
        const int head = 2 * u.pn + (wc >> 1);
        if (wc & 1) {
#pragma unroll
            for (int ai = 0; ai < 2; ++ai)
#pragma unroll
                for (int m = 0; m < 4; ++m) { const int row = ai * 128 + wr * 64 + m * 16 + fr; const float s_ = sc * rskv[row]; const int sq_ = (u.pm & 15) * 256 + row;
                    bf16_t* vp = V + ((size_t)((u.pm >> 4) * 8 + head) * SEQ + (sq_ & ~63)) * 64 + (sq_ & 63) * 32 + 8 * fq;
#pragma unroll
                    for (int bj = 0; bj < 2; ++bj) { const pg8::f32x4 v0 = acc[ai][bj][m][0] * s_, v1 = acc[ai][bj][m][1] * s_; pg8::u32x4 w;
                        w.x = pg8::cvt_pk_bf16(v0[0], v0[1]); w.y = pg8::cvt_pk_bf16(v0[2], v0[3]); w.z = pg8::cvt_pk_bf16(v1[0], v1[1]); w.w = pg8::cvt_pk_bf16(v1[2], v1[3]);
                        *(pg8::u32x4*)(vp + 2048 * bj) = w; } }
        } else {
            pg8::f32x4 g[2][2];
#pragma unroll
            for (int bj = 0; bj < 2; ++bj)
#pragma unroll
                for (int n = 0; n < 2; ++n) g[bj][n] = *(const pg8::f32x4*)(gk + 32 * bj + 8 * fq + 4 * n);
#pragma unroll
            for (int ai = 0; ai < 2; ++ai)
#pragma unroll
                for (int m = 0; m < 4; ++m) { const int row = ai * 128 + wr * 64 + m * 16 + fr; const size_t t = (size_t)u.pm * 256 + row; const float s_ = sc * rskv[row];
                    pg8::f32x4 k[2][2]; float ss = 0.f;
#pragma unroll
                    for (int bj = 0; bj < 2; ++bj)
#pragma unroll
                        for (int n = 0; n < 2; ++n) { k[bj][n] = acc[ai][bj][m][n] * s_; ss += k[bj][n][0] * k[bj][n][0] + k[bj][n][1] * k[bj][n][1] + k[bj][n][2] * k[bj][n][2] + k[bj][n][3] * k[bj][n][3]; }
                    ss += __shfl_xor(ss, 16); ss += __shfl_xor(ss, 32); ss += pess[row];
                    const float rn = 1.0f / sqrtf(ss * (1.f / 96.f) + EPS);
                    const int sq_ = (u.pm & 15) * 256 + row; bf16_t* kp = K + ((size_t)((u.pm >> 4) * 8 + head) * SEQ + (sq_ & ~63)) * 96 + (sq_ & 63) * 8;
#pragma unroll
                    for (int bj = 0; bj < 2; ++bj) { const pg8::f32x4 v0 = k[bj][0] * g[bj][0] * rn, v1 = k[bj][1] * g[bj][1] * rn; pg8::u32x4 w;
                        w.x = pg8::cvt_pk_bf16(v0[0], v0[1]); w.y = pg8::cvt_pk_bf16(v0[2], v0[3]); w.z = pg8::cvt_pk_bf16(v1[0], v1[1]); w.w = pg8::cvt_pk_bf16(v1[2], v1[3]);
                        *(pg8::u32x4*)(kp + (4 * bj + fq) * 512) = w; }
                    const pg8::f32x4 rl = *(const pg8::f32x4*)(RK + t * 32 + 4 * fq) * rn, rh = *(const pg8::f32x4*)(RK + t * 32 + 16 + 4 * fq) * rn;
                    pg8::u32x2 wl, wh; wl.x = pg8::cvt_pk_bf16(rl[0], rl[1]); wl.y = pg8::cvt_pk_bf16(rl[2], rl[3]); wh.x = pg8::cvt_pk_bf16(rh[0], rh[1]); wh.y = pg8::cvt_pk_bf16(rh[2], rh[3]);
                    *(pg8::u32x2*)(kp + (8 + (fq >> 1)) * 512 + (fq & 1) * 4) = wl; *(pg8::u32x2*)(kp + (10 + (fq >> 1)) * 512 + (fq & 1) * 4) = wh; }
        }
    }
};
__device__ const float ROPE_INVREV[16] = { 1.591549431e-01f, 8.949940161e-02f, 5.032921210e-02f, 2.830219583e-02f, 1.591549431e-02f, 8.949940161e-03f, 5.032921210e-03f, 2.830219583e-03f,
                                           1.591549431e-03f, 8.949940161e-04f, 5.032921210e-04f, 2.830219583e-04f, 1.591549431e-04f, 8.949940161e-05f, 5.032921210e-05f, 2.830219583e-05f };
__device__ __forceinline__ void kv_prepass(Frame& F, int rt) {
    const int lane = F.lane; unsigned char* ws = F.ws; LAS float* rskv = (LAS float*)(F.lds + LX_RSKV); LAS float* pess = (LAS float*)(F.lds + LX_PESS);
    const float* gk = F.in[I_GKM]; const int li = lane & 15, j = lane >> 4;
    const float g64 = gk[64 + li], g80 = gk[80 + li], invrev = ROPE_INVREV[li];
    float p0[8], p1[8], pa[8], pb[8]; int pos[8];
#pragma unroll
    for (int it = 0; it < 8; ++it) { const size_t t = (size_t)rt * 256 + F.wave * 32 + it * 4 + j; const float* part = (const float*)(ws + WS_PART) + t * 20; const float* pe = (const float*)(ws + WS_PE) + t * 32;
        p0[it] = part[li]; p1[it] = li < 4 ? part[16 + li] : 0.f; pa[it] = pe[li]; pb[it] = pe[16 + li]; pos[it] = ((const int*)F.in[I_POS])[t]; }
#pragma unroll
    for (int it = 0; it < 8; ++it) { const int r = F.wave * 32 + it * 4 + j; const size_t t = (size_t)rt * 256 + r;
        float sq = li < 12 ? p0[it] : 0.f, skv = (li >= 12 ? p0[it] : 0.f) + p1[it], pe2 = pa[it] * pa[it] + pb[it] * pb[it];
#pragma unroll
        for (int o = 1; o < 16; o <<= 1) { sq += __shfl_xor(sq, o); skv += __shfl_xor(skv, o); pe2 += __shfl_xor(pe2, o); }
        if (li == 0) { ((float*)(ws + WS_RSQ))[t] = 1.0f / sqrtf(sq * (1.f / 384.f) + EPS); rskv[r] = 1.0f / sqrtf(skv * (1.f / 256.f) + EPS); pess[r] = pe2; }
        float rev = (float)pos[it] * invrev; rev -= floorf(rev); const float sn = __builtin_amdgcn_sinf(rev), cs = __builtin_amdgcn_cosf(rev);
        const float x1 = pa[it] * g64, x2 = pb[it] * g80; float* rk = (float*)(ws + WS_RK) + t * 32; rk[li] = x1 * cs - x2 * sn; rk[16 + li] = x2 * cs + x1 * sn; }
}
struct P3In { v4u uw[16]; };
__device__ __forceinline__ void p3_load(Frame& F, int t, P3In& I) {
    const int lane = F.lane; unsigned char* ws = F.ws;
    const int s = t & (SEQ - 1), win = 2 << (lane >> 4), cntw = (s + 1 < win) ? s + 1 : win;
    const bf16* urow = (const bf16*)(ws + WS_U) + (size_t)t * 512 + lane * 8;
#pragma unroll
    for (int j = 0; j < 16; ++j) { I.uw[j] = (v4u){0u, 0u, 0u, 0u}; if (j < cntw) I.uw[j] = *(const GAS v4u*)(urow - (size_t)j * 512); }
}
__device__ __forceinline__ void p3_compute(Frame& F, int t, const P3In& I) {
    const int lane = F.lane; unsigned char* ws = F.ws;
    {
        const int s = t & (SEQ - 1), win = 2 << (lane >> 4), cntw = (s + 1 < win) ? s + 1 : win;
        float acc[8];
#pragma unroll
        for (int i = 0; i < 8; ++i) acc[i] = 0.f;
#pragma unroll
        for (int j = 0; j < 16; ++j)
#pragma unroll
            for (int i = 0; i < 4; ++i) { acc[2 * i] += bflo(I.uw[j][i]); acc[2 * i + 1] += bfhi(I.uw[j][i]); }
        const float inv = 1.0f / (float)cntw;
#pragma unroll
        for (int i = 0; i < 4; ++i) { acc[2 * i] = acc[2 * i] * inv - bflo(I.uw[0][i]); acc[2 * i + 1] = acc[2 * i + 1] * inv - bfhi(I.uw[0][i]); }
        v4u o; o.x = pk2(acc[0], acc[1]); o.y = pk2(acc[2], acc[3]); o.z = pk2(acc[4], acc[5]); o.w = pk2(acc[6], acc[7]);
        *(GAS v4u*)((bf16*)(ws + WS_MIXED) + (size_t)t * 512 + lane * 8) = o;
    }
}
template <int NT> __device__ __forceinline__ void p3_tokens(Frame& F, int t0) {
    P3In I[NT];
#pragma unroll
    for (int i = 0; i < NT; ++i) p3_load(F, t0 + i, I[i]);
    asm volatile("" ::: "memory");
#pragma unroll
    for (int i = 0; i < NT; ++i) p3_compute(F, t0 + i, I[i]);
}

namespace xat {
__device__ __forceinline__ int crow(int r, int hi) { return (r & 3) + 8 * (r >> 2) + 4 * hi; }
__device__ __forceinline__ void stage_kv(Frame& F, int b, int hc) {
    const int tid = F.tid; unsigned char* ws = F.ws; LAS unsigned char* lds = F.lds;
    { const int row = tid >> 1, half = tid & 1; const bf16* src = (const bf16*)(ws + WS_KVMK) + (size_t)(b * 256 + row) * 512 + hc * 128 + half * 64;
      v4u v[8]; float ss = 0.f; f32x4 gk[16];
#pragma unroll
      for (int c = 0; c < 16; ++c) gk[c] = *(const GAS f32x4*)(F.in[I_GKC] + half * 64 + 4 * c);
#pragma unroll
      for (int c = 0; c < 8; ++c) { v[c] = *(const GAS v4u*)(src + 8 * c); ss += sumsq8(v[c]); }
      ss += __shfl_xor(ss, 1);
      const float rstd = 1.0f / sqrtf(ss * (1.f / 128.f) + EPS);
#pragma unroll
      for (int c = 0; c < 8; ++c) { v4u o;
#pragma unroll
          for (int i = 0; i < 4; ++i) o[i] = pk2(bflo(v[c][i]) * rstd * gk[2 * c + (i >> 1)][2 * (i & 1)], bfhi(v[c][i]) * rstd * gk[2 * c + (i >> 1)][2 * (i & 1) + 1]);
          *(LAS v4u*)(lds + row * 256 + (((half * 8 + c) ^ (row & 15)) << 4)) = o; } }
    { const bf16* src = (const bf16*)(ws + WS_VTG) + (size_t)(b * 4 + hc) * 128 * 256;
#pragma unroll
      for (int i = 0; i < 8; ++i) { const int q = tid + 512 * i, d = q >> 5, ch = q & 31; const v4u v = *(const GAS v4u*)(src + (size_t)q * 8);
          *(LAS v4u*)(lds + 65536 + d * 512 + ((ch ^ (d & 15)) << 4)) = v; } }
}
__device__ __forceinline__ void unit(Frame& F, int b, int hc, int qb) {
    const int lane = F.lane, r32 = lane & 31, hi = lane >> 5, wid = F.wave; unsigned char* ws = F.ws; LAS unsigned char* lds = F.lds;
    const size_t row = (size_t)b * SEQ + qb * 256 + wid * 32 + r32;
    bf16x8 qr[8];
    { const bf16* qsrc = (const bf16*)(ws + WS_QX) + row * 512 + hc * 128 + hi * 8; v4u qv[8]; float ss = 0.f;
      f32x4 gq[16];
#pragma unroll
      for (int d0 = 0; d0 < 8; ++d0) { gq[2 * d0] = *(const GAS f32x4*)(F.in[I_GQC] + hi * 8 + 16 * d0); gq[2 * d0 + 1] = *(const GAS f32x4*)(F.in[I_GQC] + hi * 8 + 16 * d0 + 4); }
#pragma unroll
      for (int d0 = 0; d0 < 8; ++d0) { qv[d0] = *(const GAS v4u*)(qsrc + 16 * d0); ss += sumsq8(qv[d0]); }
      ss += __shfl_xor(ss, 32);
      const float rn = C2_X / sqrtf(ss * (1.f / 128.f) + EPS);
#pragma unroll
      for (int d0 = 0; d0 < 8; ++d0) { v4u o;
#pragma unroll
          for (int i = 0; i < 4; ++i) o[i] = pk2(bflo(qv[d0][i]) * rn * gq[2 * d0 + (i >> 1)][2 * (i & 1)], bfhi(qv[d0][i]) * rn * gq[2 * d0 + (i >> 1)][2 * (i & 1) + 1]);
          qr[d0] = __builtin_bit_cast(bf16x8, o); } }
    f32x16 o[4];
#pragma unroll
    for (int i = 0; i < 4; ++i) o[i] = f32x16{};
    float mrun = -1e30f, lrun = 0.f; const int r32_ = r32, hi_ = hi;
#pragma unroll 1
    for (int tt = 0; tt < 4; ++tt) {
        f32x16 p0 = f32x16{}, p1 = f32x16{};
        int r32 = r32_, hi = hi_; asm volatile("" : "+v"(r32), "+v"(hi));
        const int kr0 = 64 * tt + r32, kr1 = kr0 + 32;
        bf16x8 kf0[8], kf1[8];
#pragma unroll
        for (int d0 = 0; d0 < 8; ++d0) {
            kf0[d0] = *(const LAS bf16x8*)(lds + kr0 * 256 + (((2 * d0 + hi) ^ (kr0 & 15)) << 4));
            kf1[d0] = *(const LAS bf16x8*)(lds + kr1 * 256 + (((2 * d0 + hi) ^ (kr1 & 15)) << 4)); }
        __builtin_amdgcn_sched_barrier(0);
#pragma unroll
        for (int d0 = 0; d0 < 8; ++d0) {
            p0 = __builtin_amdgcn_mfma_f32_32x32x16_bf16(kf0[d0], qr[d0], p0, 0, 0, 0);
            p1 = __builtin_amdgcn_mfma_f32_32x32x16_bf16(kf1[d0], qr[d0], p1, 0, 0, 0); }
        __builtin_amdgcn_sched_barrier(0);
        bf16x8 vf[4][4];
#pragma unroll
        for (int ks = 0; ks < 2; ++ks) { const int ch = 2 * (4 * tt + ks) + hi;
#pragma unroll
            for (int d = 0; d < 4; ++d) { const int dr = r32 + 32 * d; vf[ks][d] = *(const LAS bf16x8*)(lds + 65536 + dr * 512 + ((ch ^ (dr & 15)) << 4)); } }
        __builtin_amdgcn_sched_barrier(0);
        float rm = fmaxf(p0[0], p1[0]);
#pragma unroll
        for (int r = 1; r < 16; ++r) rm = fmaxf(rm, fmaxf(p0[r], p1[r]));
        rm = fmaxf(rm, __shfl_xor(rm, 32));
        const float mnew = fmaxf(mrun, rm), sc = __builtin_amdgcn_exp2f(mrun - mnew); mrun = mnew;
        float ps = 0.f;
#pragma unroll
        for (int r = 0; r < 16; ++r) { p0[r] = __builtin_amdgcn_exp2f(p0[r] - mnew); p1[r] = __builtin_amdgcn_exp2f(p1[r] - mnew); ps += p0[r] + p1[r]; }
        lrun = lrun * sc + ps;
#pragma unroll
        for (int d = 0; d < 4; ++d) o[d] = o[d] * sc;
        v4u pw[4];
#pragma unroll
        for (int i = 0; i < 4; ++i) { pw[0][i] = pk2(p0[2 * i], p0[2 * i + 1]); pw[1][i] = pk2(p0[8 + 2 * i], p0[9 + 2 * i]); pw[2][i] = pk2(p1[2 * i], p1[2 * i + 1]); pw[3][i] = pk2(p1[8 + 2 * i], p1[9 + 2 * i]); }
#pragma unroll
        for (int ks = 2; ks < 4; ++ks) { const int ch = 2 * (4 * tt + ks) + hi;
#pragma unroll
            for (int d = 0; d < 4; ++d) { const int dr = r32 + 32 * d; vf[ks][d] = *(const LAS bf16x8*)(lds + 65536 + dr * 512 + ((ch ^ (dr & 15)) << 4)); } }
        __builtin_amdgcn_sched_barrier(0);
#pragma unroll
        for (int ks = 0; ks < 4; ++ks) { const bf16x8 pa = __builtin_bit_cast(bf16x8, pw[ks]);
#pragma unroll
            for (int d = 0; d < 4; ++d) o[d] = __builtin_amdgcn_mfma_f32_32x32x16_bf16(vf[ks][d], pa, o[d], 0, 0, 0); }
    }
    lrun += __shfl_xor(lrun, 32);
    const float rl = 1.0f / lrun;
    bf16* orow = (bf16*)(ws + WS_CO) + ((size_t)b * SEQ + qb * 256 + wid * 32 + r32) * 512 + hc * 128 + 4 * hi;
#pragma unroll
    for (int d = 0; d < 4; ++d)
#pragma unroll
        for (int g = 0; g < 4; ++g) { v2u w; w.x = pk2(o[d][4 * g] * rl, o[d][4 * g + 1] * rl); w.y = pk2(o[d][4 * g + 2] * rl, o[d][4 * g + 3] * rl);
            *(GAS v2u*)(orow + 32 * d + 8 * g) = w; }
}
}

__device__ __forceinline__ void router_tile(Frame& F, int t0, int lt0) {
    const int lane = F.lane, tok = lane & 31, kk = lane >> 5; unsigned char* ws = F.ws; LAS unsigned char* lds = F.lds;
    const LAS float* wr = (const LAS float*)(lds + RING_OFF);
    const float* xrow = F.in[I_X] + (size_t)(t0 + tok) * 1024 + 16 * kk;
    const bf16* drow = (const bf16*)(ws + WS_DELTA) + (size_t)(t0 + tok) * 1024 + 16 * kk;
    unsigned char* hrow = ws + WS_HN2 + (size_t)(t0 + tok) * 1024 + 16 * kk;
    f32x16 acc = f32x16{}; float ss = 0.f;
    constexpr int PD = 4;
    f32x4 ra[PD][4]; v4u rd[PD][2];
#pragma unroll
    for (int p = 0; p < PD; ++p) {
#pragma unroll
        for (int c = 0; c < 4; ++c) ra[p][c] = *(const GAS f32x4*)(xrow + 32 * p + 4 * c);
        rd[p][0] = *(const GAS v4u*)(drow + 32 * p); rd[p][1] = *(const GAS v4u*)(drow + 32 * p + 8); }
#pragma unroll 1
    for (int q0 = 0; q0 < 32; q0 += PD) {
#pragma unroll
        for (int p = 0; p < PD; ++p) {
            const int q = q0 + p; float a[16];
#pragma unroll
            for (int c = 0; c < 4; ++c) { const unsigned d0 = rd[p][c >> 1][2 * (c & 1)], d1 = rd[p][c >> 1][2 * (c & 1) + 1];
                a[4 * c] = ra[p][c].x + bflo(d0); a[4 * c + 1] = ra[p][c].y + bfhi(d0); a[4 * c + 2] = ra[p][c].z + bflo(d1); a[4 * c + 3] = ra[p][c].w + bfhi(d1); }
            if (q0 + PD < 32) {
#pragma unroll
                for (int c = 0; c < 4; ++c) ra[p][c] = *(const GAS f32x4*)(xrow + 32 * (q + PD) + 4 * c);
                rd[p][0] = *(const GAS v4u*)(drow + 32 * (q + PD)); rd[p][1] = *(const GAS v4u*)(drow + 32 * (q + PD) + 8); }
            const LAS float* wq = wr + (32 * q + 16 * kk) * 32 + tok;
#pragma unroll
            for (int s_ = 0; s_ < 16; ++s_) { ss += a[s_] * a[s_]; acc = __builtin_amdgcn_mfma_f32_32x32x2f32(wq[s_ * 32], a[s_], acc, 0, 0, 0); }
            v4u o;
#pragma unroll
            for (int c = 0; c < 4; ++c) o[c] = pk4_fp8(a[4 * c] * SX8, a[4 * c + 1] * SX8, a[4 * c + 2] * SX8, a[4 * c + 3] * SX8);
            *(GAS v4u*)(hrow + 32 * q) = o;
        }
    }
    ss += __shfl_xor(ss, 32);
    const float rstd = 1.0f / sqrtf(ss * (1.f / 1024.f) + EPS);
    if (kk == 0) ((LAS float*)(lds + LX_RS))[lt0 + tok] = rstd;
    const float* br = F.in[I_BR];
    float lg[16];
#pragma unroll
    for (int r = 0; r < 16; ++r) lg[r] = acc[r] * rstd + br[xat::crow(r, kk)];
    float tv[4]; int ti[4];
#pragma unroll
    for (int k = 0; k < 4; ++k) { float best = lg[0]; int bi = 0;
#pragma unroll
        for (int r = 1; r < 16; ++r) { const bool gt = lg[r] > best; best = gt ? lg[r] : best; bi = gt ? r : bi; }
        tv[k] = best; ti[k] = xat::crow(bi, kk);
#pragma unroll
        for (int r = 0; r < 16; ++r) lg[r] = (r == bi) ? -INFINITY : lg[r]; }
    float cv[8]; int ci[8];
#pragma unroll
    for (int k = 0; k < 4; ++k) { cv[k] = tv[k]; ci[k] = ti[k]; cv[4 + k] = __shfl_xor(tv[k], 32); ci[4 + k] = __shfl_xor(ti[k], 32); }
    float gv[4]; int ge[4];
#pragma unroll
    for (int k = 0; k < 4; ++k) { float best = cv[0]; int be = ci[0], bj = 0;
#pragma unroll
        for (int j = 1; j < 8; ++j) { const bool gt = (cv[j] > best) || (cv[j] == best && ci[j] < be); best = gt ? cv[j] : best; be = gt ? ci[j] : be; bj = gt ? j : bj; }
        gv[k] = best; ge[k] = be;
#pragma unroll
        for (int j = 0; j < 8; ++j) cv[j] = (j == bj) ? -INFINITY : cv[j]; }
    float ex[4], es = 0.f;
#pragma unroll
    for (int k = 0; k < 4; ++k) { ex[k] = __expf(gv[k] - gv[0]); es += ex[k]; }
    const float ies = 1.0f / es;
    if (kk == 0) {
        LAS int* lcnt = (LAS int*)(lds + LX_LCNT); LAS int* stash = (LAS int*)(lds + LX_STASH); LAS float* gst = (LAS float*)(lds + LX_GATE);
#pragma unroll
        for (int k = 0; k < 4; ++k) { const int li = __hip_atomic_fetch_add(lcnt + ge[k], 1, __ATOMIC_RELAXED, __HIP_MEMORY_SCOPE_WORKGROUP);
            stash[(lt0 + tok) * 4 + k] = ge[k] | (li << 8); gst[(lt0 + tok) * 4 + k] = ex[k] * ies; }
    }
}

struct CvItem { const float* src; int ks; unsigned char* dst; int k0; };
__device__ __forceinline__ CvItem cv_decode(Frame& F, int it) {
    constexpr int IE1 = 16 * 64, IE2 = 16 * 32; unsigned char* ws = F.ws; CvItem c;
    const int e = it / (IE1 + IE2); int r = it - e * (IE1 + IE2);
    if (r < IE1) { const int kb = r >> 6, nb = r & 63, n0 = nb * 32, srcc = ((n0 >> 7) & 1) * 1024 + (n0 >> 8) * 128 + (n0 & 127);
        c.src = F.in[I_WEI] + (size_t)e * 1024 * 2048 + (size_t)(kb * 64) * 2048 + srcc; c.ks = kb * 64; c.dst = ws + WS_WEI + (size_t)e * 2048 * 1024 + (size_t)n0 * 1024 + kb * 64; c.k0 = 2048; }
    else { r -= IE1; const int kb = r >> 5, nb = r & 31;
        c.src = F.in[I_WEO] + (size_t)e * 1024 * 1024 + (size_t)(kb * 64) * 1024 + nb * 32; c.ks = -1; c.dst = ws + WS_WEO + (size_t)e * 1024 * 1024 + (size_t)(nb * 32) * 1024 + kb * 64; c.k0 = 1024; }
    return c;
}
__device__ __forceinline__ void cv_load(const CvItem& c, int lane, float (&v)[32]) {
#pragma unroll
    for (int i = 0; i < 32; ++i) v[i] = c.src[(size_t)(2 * i + (lane >> 5)) * c.k0 + (lane & 31)];
}
__device__ __forceinline__ void cv_store(const CvItem& c, int lane, float (&v)[32], LAS float* scr, const LAS float* gl) {
    if (c.ks >= 0) { const LAS float* g_ = gl + c.ks + (lane >> 5);
#pragma unroll
        for (int i = 0; i < 32; ++i) v[i] *= g_[2 * i]; }
#pragma unroll
    for (int i = 0; i < 32; ++i) scr[(2 * i + (lane >> 5)) * 33 + (lane & 31)] = v[i] * SW8;
    LDS_WAIT(); asm volatile("" ::: "memory");
    const int cc = lane & 7;
#pragma unroll
    for (int j = 0; j < 4; ++j) { const int n = (lane >> 3) + 8 * j; const LAS float* s = scr + (8 * cc) * 33 + n;
        v2u o; o.x = pk4_fp8(s[0 * 33], s[1 * 33], s[2 * 33], s[3 * 33]); o.y = pk4_fp8(s[4 * 33], s[5 * 33], s[6 * 33], s[7 * 33]);
        *(GAS v2u*)(c.dst + (size_t)n * 1024 + 8 * cc) = o; }
    LDS_WAIT(); asm volatile("" ::: "memory");
}
__device__ __forceinline__ void expert_convert(Frame& F) {
    const int lane = F.lane; LAS unsigned char* lds = F.lds;
    {
        LAS float* scr = (LAS float*)(lds + RING_OFF + F.wave * 16384);
        LAS float* gl = (LAS float*)(lds + LX_STASH);
        for (int i = F.tid; i < 1024; i += NWAVES * 64) gl[i] = F.in[I_GFFN][i];
        __syncthreads();
        const int gw = F.vcu * NWAVES + F.wave, NGW = F.G * NWAVES;
        constexpr int NIT = NEXP * (16 * 64 + 16 * 32);
        for (int rep = 0; rep < MK_REPCV; ++rep) {
            for (int it = gw; it < NIT; it += 4 * NGW) {
                float v0[32], v1[32], v2[32], v3[32];
                const int i1 = it + NGW, i2 = it + 2 * NGW, i3 = it + 3 * NGW;
                const CvItem c0 = cv_decode(F, it); cv_load(c0, lane, v0);
                CvItem c1 = c0, c2 = c0, c3 = c0;
                if (i1 < NIT) { c1 = cv_decode(F, i1); cv_load(c1, lane, v1); }
                if (i2 < NIT) { c2 = cv_decode(F, i2); cv_load(c2, lane, v2); }
                if (i3 < NIT) { c3 = cv_decode(F, i3); cv_load(c3, lane, v3); }
                cv_store(c0, lane, v0, scr, gl);
                if (i1 < NIT) cv_store(c1, lane, v1, scr, gl);
                if (i2 < NIT) cv_store(c2, lane, v2, scr, gl);
                if (i3 < NIT) cv_store(c3, lane, v3, scr, gl);
            }
        }
    }
}
__device__ __forceinline__ void p7_router(Frame& F) {
    const int lane = F.lane, tid = F.tid; unsigned char* ws = F.ws; LAS unsigned char* lds = F.lds;
    { const float* wr = F.in[I_WR]; const float* g = F.in[I_GFFN];
#pragma unroll
      for (int j = 0; j < 8192 / (NWAVES * 64); ++j) { const int i = tid + j * NWAVES * 64; const f32x4 v = *(const GAS f32x4*)(wr + 4 * i); const float gg = g[i >> 3]; *(LAS f32x4*)(lds + RING_OFF + 16 * i) = v * gg; } }
    __syncthreads();
    LAS int* lcnt = (LAS int*)(lds + LX_LCNT); LAS int* lbase = (LAS int*)(lds + LX_BASE); LAS int* stash = (LAS int*)(lds + LX_STASH); LAS float* gst = (LAS float*)(lds + LX_GATE);
    for (int chunk = F.vcu; chunk < T / 256; chunk += F.G) {
        if (tid < NEXP) lcnt[tid] = 0;
        __syncthreads();
        router_tile(F, chunk * 256 + F.wave * 32, F.wave * 32);
        __syncthreads();
        if (tid < NEXP) lbase[tid] = (int)__hip_atomic_fetch_add((unsigned*)(F.ctl + CW_GCNT + 64 * tid), (unsigned)lcnt[tid], RLX_AGENT);
        __syncthreads();
        for (int idx = tid; idx < 1024; idx += NWAVES * 64) { const int st = stash[idx], e = st & 255, pos = lbase[e] + (st >> 8), ent = (chunk * 256 + (idx >> 2)) * 4 + (idx & 3);
            if (pos < LISTCAP) { const size_t li = (size_t)e * LISTCAP + pos; ((int*)(ws + WS_LIST))[li] = ent;
                ((float*)(ws + WS_LRS))[li] = ((LAS float*)(lds + LX_RS))[idx >> 2] * (SA8 / (SX8 * SW8)); ((float*)(ws + WS_LGATE))[li] = gst[idx] * (1.0f / (SA8 * SW8)); } }
        __syncthreads();
    }
}
__device__ __forceinline__ int moe_setup(Frame& F) {
    LAS int* tstart = (LAS int*)(F.lds + LX_TSTART); LAS int* cnt = (LAS int*)(F.lds + LX_CNT); LAS unsigned char* texp = (LAS unsigned char*)(F.lds + LX_TEXP);
    if (F.wave == 0) { const int lane = F.lane, e = lane & 31;
        int c = (int)__hip_atomic_load((unsigned*)(F.ctl + CW_GCNT + 64 * e), RLX_AGENT); c = c < LISTCAP ? c : LISTCAP;
        const int nt_ = (c + 255) >> 8; int incl = nt_;
#pragma unroll
        for (int o = 1; o < 32; o <<= 1) { const int v = __shfl_up(incl, o); if (lane >= o) incl += v; }
        if (lane < 32) { cnt[e] = c; tstart[e] = incl - nt_; if (e == NEXP - 1) tstart[NEXP] = incl < ACT_TILES_MAX ? incl : ACT_TILES_MAX; } }
    __syncthreads();
    const int ntiles = __builtin_amdgcn_readfirstlane(tstart[NEXP]);
    for (int pm = F.tid; pm < ntiles; pm += NWAVES * 64) { int lo = 0, hi = NEXP - 1;
        while (lo < hi) { const int mid = (lo + hi) >> 1; if (tstart[mid + 1] > pm) hi = mid; else lo = mid + 1; }
        texp[pm] = (unsigned char)lo; }
    __syncthreads();
    return ntiles;
}

struct Args { const float* in[N_IN]; float* out; unsigned char* ws; int ph_lo, ph_hi, li, pad; };
__global__ void __launch_bounds__(NWAVES * 64, 2) fwd_kernel(Args args) {
    extern __shared__ __attribute__((aligned(16))) unsigned char lds[];
    Frame F;
    F.lds = (LAS unsigned char*)lds;
    F.MISC = (volatile LAS unsigned*)(F.lds + MISC_OFF);
    F.tid = threadIdx.x; F.lane = F.tid & 63; F.wave = __builtin_amdgcn_readfirstlane(F.tid >> 6);
    F.G = gridDim.x; { const int bx = blockIdx.x; F.vcu = (F.G % 8 == 0) ? (bx % 8) * (F.G / 8) + bx / 8 : bx; }
    F.ws = args.ws; F.out = args.out; F.in = args.in;
    unsigned char* ws = args.ws;
    F.ctl = (gu32*)(ws + WS_CTL);
    for (int u = F.tid; u < (LDS_BYTES - LDSCTL_OFF) / 4; u += NWAVES * 64) ((LAS unsigned*)(F.lds + LDSCTL_OFF))[u] = 0u;
    __syncthreads();
    XcdBarrier bar; bar.bar = (unsigned*)(F.ctl + CW_BAR); bar.x = 0; bar.st = nullptr;
    if (N_LAUNCHES != PER_PHASE) bar = xcd_barrier_post((unsigned*)(F.ctl + CW_BAR), F.MISC + 8, F.tid == 0);
#define GRID_BAR(seam) do { if (N_LAUNCHES == PER_PHASE) { if (F.tid == 0) __hip_atomic_store(F.ctl + CW_TMO, 0xBADBA0u | (unsigned)(seam), RLX_AGENT); } else { xcd_barrier(bar, F.tid == 0); } } while (0)
    const int lo = args.ph_lo, hi = args.ph_hi;
#ifndef MK_PHASE_MASK
#define MK_PHASE_MASK 0x7ff
#endif
#define IN(k) (((MK_PHASE_MASK >> (k)) & 1) && lo <= (k) && (k) < hi)
#define BOTH(k) (IN(k) && IN((k) + 1))
    const int gw = F.vcu * NWAVES + F.wave, NGW = F.G * NWAVES;

    if (IN(0)) { REFRESH(F); for (int rep = 0; rep < MK_REP0; ++rep) p0_prologue(F); if (BOTH(0)) GRID_BAR(0); }

    if (IN(1)) { REFRESH(F);
        { DenseSched S; S.init(ws + WS_HN, 512, ws + WS_W1T, 512, T, 1792, F.G, (int)blockIdx.x);
          EpiP1 E{(bf16_t*)(ws + WS_U), (bf16_t*)(ws + WS_QX), (const float*)(ws + WS_HSC), ws + WS_CQ8, ws + WS_CKV8, (float*)(ws + WS_PART), (float*)(ws + WS_PE)};
          pg8::gemm_phase_i8<EpiP1, DenseSched>(F.lds + RING_OFF, F.tid, 1024, 1024, 1024, S, E); }
        { DenseSched S; S.init(ws + WS_HN, 512, ws + WS_W1G8, 512, T, 3072, F.G, (int)blockIdx.x);
          EpiGate8 E{ws + WS_GATES, (const float*)(ws + WS_HSC)};
          pg8::gemm_phase_i8<EpiGate8, DenseSched>(F.lds + RING_OFF, F.tid, 1024, 1024, 1024, S, E); }
        if (BOTH(1)) GRID_BAR(1);
    }

    if (IN(2)) { REFRESH(F);
        for (int rep = 0; rep < MK_REP2; ++rep) {
        { DenseSched S; S.init(ws + WS_CQ8, 256, ws + WS_WUQ, 256, T, 768, F.G, (int)blockIdx.x);
          EpiStore E{(bf16_t*)(ws + WS_Q), 768, 1.0f / (SC8 * SWQ8)};
          pg8::gemm_phase_i8<EpiStore, DenseSched>(F.lds + RING_OFF, F.tid, 512, 512, 512, S, E); }
        for (int rt = F.vcu; rt < T / 256; rt += F.G) {
          REFRESH(F); kv_prepass(F, rt);
          asm volatile("s_waitcnt vmcnt(0) lgkmcnt(0)" ::: "memory"); __syncthreads(); __builtin_amdgcn_fence(__ATOMIC_ACQUIRE, "agent");
          REFRESH(F);
          RowSched S{rt, (const char*)(ws + WS_CKV8), (const char*)(ws + WS_WUKV), (size_t)256 * 256, (size_t)256 * 256};
          EpiKV E{(bf16_t*)(ws + WS_KV), (bf16_t*)(ws + WS_V), (const LAS float*)(F.lds + LX_RSKV), (const LAS float*)(F.lds + LX_PESS), (const float*)(ws + WS_RK), F.in[I_GKM], 1.0f / (SC8 * SWKV8)};
          int k2 = 256; asm volatile("" : "+s"(k2));
          pg8::gemm_phase_i8<EpiKV, RowSched>(F.lds + RING_OFF, F.tid, k2, 256, 256, S, E);
          __syncthreads(); }
        { DenseSched S; S.init(ws + WS_MEMN, 512, ws + WS_WMEM, 512, MROWS, 1024, F.G, (int)blockIdx.x);
          EpiMemKV E{(bf16_t*)(ws + WS_KVMK), (bf16_t*)(ws + WS_VTG), (const float*)(ws + WS_MSC)};
          pg8::gemm_phase_i8<EpiMemKV, DenseSched>(F.lds + RING_OFF, F.tid, 1024, 1024, 1024, S, E); }
        }
        if (BOTH(2)) GRID_BAR(2);
    }

    if (IN(3)) { REFRESH(F);
        const int per = T / NGW;
        if (per * NGW == T && (per & 1) == 0) { for (int i = 0; i < per; i += 2) p3_tokens<2>(F, gw * per + i); }
        else { for (int t = gw; t < T; t += NGW) p3_tokens<1>(F, t); }
        if (BOTH(3)) GRID_BAR(3);
    }

    if (IN(4)) { const mla::QXform QX{(const float*)(ws + WS_RSQ), (const int*)F.in[I_POS], F.in[I_GQM], ROPE_INVREV, C2_MLA};
        for (int rep4 = 0; rep4 < MK_REP4; ++rep4) { REFRESH(F);
#ifndef NO_MLA
        for (int vv = F.vcu; vv < 256 * MK_REPMLA; vv += F.G) {
            const int bh = (vv & 255) >> 1, s = vv & 1;
            for (int i = 0; i < 8; ++i) { const int j2 = (i >> 1) * 2 + s, qb = (i & 1) ? 15 - j2 : j2;
                mla::attn_unit<8>(F.tid, QX, bh >> 3, bh & 7, qb, (const mla::bf16*)(ws + WS_Q), (const mla::bf16*)(ws + WS_KV), (const mla::bf16*)(ws + WS_V), (mla::bf16*)(ws + WS_AO), (char*)lds + RING_OFF);
                if (vv == F.vcu && i == (vv & 7)) { REFRESH(F); expert_convert(F); __syncthreads(); REFRESH(F); } }
        }
#endif
        __syncthreads();
        REFRESH(F);
#ifndef NO_XAT
        for (int vv = F.vcu; vv < 256 * MK_REPX; vv += F.G) {
            const int b = (vv & 255) >> 4, hc = (vv >> 2) & 3;
            xat::stage_kv(F, b, hc);
            __syncthreads();
            for (int i = 0; i < 4; ++i) xat::unit(F, b, hc, (vv & 3) * 4 + i);
            __syncthreads();
        }
#endif
        }
        if (BOTH(4)) GRID_BAR(4);
    }

    if (IN(5)) { REFRESH(F);
        MergeSched S; S.G = F.G; S.c = (int)blockIdx.x;
        S.A0 = (const char*)(ws + WS_MIXED); S.dA1 = (long)WS_AO - (long)WS_MIXED; S.dA2 = (long)WS_CO - (long)WS_MIXED;
        S.B0 = (const char*)(ws + WS_WPOOL); S.dB1 = (long)WS_WMO - (long)WS_WPOOL; S.dB2 = (long)WS_WCO - (long)WS_WPOOL;
        EpiMerge E{ws + WS_GATES, ws + WS_MERGED};
        for (int rep = 0; rep < MK_REP5; ++rep) pg8::gemm_phase<EpiMerge, MergeSched>(F.lds + RING_OFF, F.tid, 512, 512, 512, S, E);
        if (BOTH(5)) GRID_BAR(5);
    }

    if (IN(6)) { REFRESH(F);
        DenseSched S; S.init(ws + WS_MERGED, 512, ws + WS_WO, 512, T, 1024, F.G, (int)blockIdx.x);
        EpiStore E{(bf16_t*)(ws + WS_DELTA), 1024, 1.0f / (SM8 * SWI8)};
        pg8::gemm_phase_i8<EpiStore, DenseSched>(F.lds + RING_OFF, F.tid, 1024, 1024, 1024, S, E);
        if (BOTH(6)) GRID_BAR(6);
    }

    if (IN(7)) { REFRESH(F); p7_router(F); if (BOTH(7)) GRID_BAR(7); }

    if (IN(8)) { REFRESH(F);
        const int ntiles = moe_setup(F);
        MoeSched S; S.G = F.G; S.c = (int)blockIdx.x; S.nM = ntiles; S.nN = 8; S.tstart = (const LAS int*)(F.lds + LX_TSTART); S.cnt = (const LAS int*)(F.lds + LX_CNT); S.texp = (const LAS unsigned char*)(F.lds + LX_TEXP); S.lstg = (LAS int*)(F.lds + LX_LSTG);
        S.list = (const int*)(ws + WS_LIST); S.A = (const char*)(ws + WS_HN2); S.B = (const char*)(ws + WS_WEI); S.bexp = (size_t)2048 * 1024; S.tB = (size_t)256 * 1024; S.tA = 0; S.gather = true;
        EpiMoeIn E{S.cnt, (const float*)(ws + WS_LRS), F.in[I_BEI], ws + WS_ACT};
        for (int rep = 0; rep < MK_REP8; ++rep) pg8::gemm_phase_f8<EpiMoeIn, MoeSched, true>(F.lds + RING_OFF, F.tid, 1024, 1024, 1024, S, E);
        if (BOTH(8)) GRID_BAR(8);
    }

    if (IN(9)) { REFRESH(F);
        const int ntiles = moe_setup(F);
        MoeSched S; S.G = F.G; S.c = (int)blockIdx.x; S.nM = ntiles; S.nN = 4; S.tstart = (const LAS int*)(F.lds + LX_TSTART); S.cnt = (const LAS int*)(F.lds + LX_CNT); S.texp = (const LAS unsigned char*)(F.lds + LX_TEXP); S.lstg = (LAS int*)(F.lds + LX_LSTG);
        S.list = (const int*)(ws + WS_LIST); S.A = (const char*)(ws + WS_ACT); S.B = (const char*)(ws + WS_WEO); S.bexp = (size_t)1024 * 1024; S.tB = (size_t)256 * 1024; S.tA = (size_t)256 * 1024; S.gather = false;
        EpiMoeOut E{S.cnt, S.list, (const float*)(ws + WS_LGATE), F.in[I_BEO], ws + WS_Y};
        pg8::gemm_phase_f8<EpiMoeOut, MoeSched, false>(F.lds + RING_OFF, F.tid, 1024, 1024, 1024, S, E);
#if MK_REP9 > 1
        { EpiNull EN; pg8::gemm_phase_f8<EpiNull, MoeSched, false>(F.lds + RING_OFF, F.tid, 1024, 1024, 1024, S, EN); }
#endif
        if (BOTH(9)) GRID_BAR(9);
    }

    if (IN(10)) { REFRESH(F);
        for (int rep = 0; rep < MK_REP10; ++rep)
        for (int t0 = gw; t0 < T; t0 += 2 * NGW) {
            f32x4 v[2][4]; v2u dl[2][4]; unsigned w[2][4][4];
#pragma unroll
            for (int r = 0; r < 2; ++r) { const int t = t0 + r * NGW; if (t < T) {
                const GAS f32x4* xi = (const GAS f32x4*)(F.in[I_X] + (size_t)t * 1024) + F.lane; const GAS unsigned* y = (const GAS unsigned*)(ws + WS_Y + (size_t)t * 4096) + F.lane;
                const GAS v2u* dp = (const GAS v2u*)((const bf16*)(ws + WS_DELTA) + (size_t)t * 1024) + F.lane;
#pragma unroll
                for (int j = 0; j < 4; ++j) { v[r][j] = xi[64 * j]; dl[r][j] = dp[64 * j];
#pragma unroll
                    for (int s4 = 0; s4 < 4; ++s4) w[r][s4][j] = y[s4 * 256 + 64 * j]; } } }
#pragma unroll
            for (int r = 0; r < 2; ++r) { const int t = t0 + r * NGW; if (t < T) {
                GAS f32x4* o = (GAS f32x4*)(F.out + (size_t)t * 1024) + F.lane;
#pragma unroll
                for (int j = 0; j < 4; ++j) { f32x4 x = v[r][j]; const v2u dd = dl[r][j];
                    x.x += bflo(dd.x); x.y += bfhi(dd.x); x.z += bflo(dd.y); x.w += bfhi(dd.y);
                    float ax = 0.f, ay = 0.f, az = 0.f, aw = 0.f;
#pragma unroll
                    for (int s4 = 0; s4 < 4; ++s4) { const unsigned ww = w[r][s4][j]; const auto lo = __builtin_amdgcn_cvt_pk_f32_fp8((int)ww, false), hi = __builtin_amdgcn_cvt_pk_f32_fp8((int)ww, true);
                        ax += lo[0]; ay += lo[1]; az += hi[0]; aw += hi[1]; }
                    x.x += ax * (1.0f / SY8); x.y += ay * (1.0f / SY8); x.z += az * (1.0f / SY8); x.w += aw * (1.0f / SY8);
                    o[64 * j] = x; } } }
        }
    }
#undef IN
#undef BOTH
#undef GRID_BAR
}

extern "C" void kernel_launch(void* const* d_in, const int* in_sizes, int n_in, void* d_out, int out_size, void* d_ws, size_t ws_size, hipStream_t stream) {
    static int grid = 0;
    if (grid == 0) {
        if (n_in != N_IN || in_sizes[0] != T * D || out_size != T * D || ws_size < WS_END) { fprintf(stderr, "kernel_launch: unexpected shapes (n_in %d, in0 %d, out %d, ws %zu); nothing launched\n", n_in, n_in > 0 ? in_sizes[0] : -1, out_size, ws_size); grid = -1; return; }
        int dev = 0, cus = 0, per_cu = 0;
        if (hipGetDevice(&dev) != hipSuccess || hipDeviceGetAttribute(&cus, hipDeviceAttributeMultiprocessorCount, dev) != hipSuccess) { grid = -1; return; }
        if (hipFuncSetAttribute((const void*)fwd_kernel, hipFuncAttributeMaxDynamicSharedMemorySize, LDS_BYTES) != hipSuccess) { fprintf(stderr, "kernel_launch: hipFuncSetAttribute failed\n"); grid = -1; return; }
        if (hipOccupancyMaxActiveBlocksPerMultiprocessor(&per_cu, (const void*)fwd_kernel, NWAVES * 64, LDS_BYTES) != hipSuccess || per_cu < 1)
            fprintf(stderr, "kernel_launch: note: occupancy query reports %d workgroups per CU\n", per_cu);
        (void)hipGetLastError();
        grid = cus;
    }
    if (grid < 0) return;
    if (hipMemsetAsync((char*)d_ws + WS_CTL, 0, CTL_ZERO_BYTES, stream) != hipSuccess) { fprintf(stderr, "kernel_launch: hipMemsetAsync failed\n"); return; }
    Args a{};
    for (int i = 0; i < N_IN; ++i) a.in[i] = (const float*)d_in[i];
    a.out = (float*)d_out; a.ws = (unsigned char*)d_ws;
    const int last = MK_LAST_PHASE;
    if (N_LAUNCHES == PER_PHASE) {
        for (int li = 0; li < last; ++li) { a.ph_lo = li; a.ph_hi = li + 1; a.li = li; hipLaunchKernelGGL(fwd_kernel, dim3(grid), dim3(NWAVES * 64), LDS_BYTES, stream, a); }
    } else {
        a.ph_lo = 0; a.ph_hi = last; a.li = 0; hipLaunchKernelGGL(fwd_kernel, dim3(grid), dim3(NWAVES * 64), LDS_BYTES, stream, a);
    }
    const hipError_t le = hipPeekAtLastError();
    if (le != hipSuccess) fprintf(stderr, "kernel_launch: launch failed: %s\n", hipGetErrorName(le));
}
```
